# Optimizing an MI355X kernel written in HIP

```python
import math
import jax, jax.numpy as jnp
from jax import lax
import numpy as np

D_MODEL = 1024
BATCH = 2
SEQ = 8192
DEPTH = 2

GRID_W = 64
CTX_LEN = 256
EPS = 1e-6
ROPE_BASE = 10000.0
ATTN_BLOCK = 128

A_HEADS = 4
A_DK = 128
A_DV = 128
A_WIDTH = A_HEADS * A_DK
HGRN_CHUNK = 16
B_HEADS = 4
B_HALF = 64
B_DV = 2 * B_HALF
B_WIDTH = B_HEADS * B_DV
EVEN_IN = 5 * A_WIDTH + 3 * B_WIDTH
C_HEADS = 16
C_KV_HEADS = 4
C_HEAD_DIM = 64
C_WINDOW = 128
ODD_IN = (C_HEADS + 2 * C_KV_HEADS) * C_HEAD_DIM
N_EXPERTS = 16
N_GROUPS = 4
EXPERTS_PER_GROUP = N_EXPERTS // N_GROUPS
TOP_K = 2
D_EXPERT = 1024
MOE_BLOCK = 128

N_EVEN = (DEPTH + 1) // 2
N_ODD = DEPTH // 2

kernel_name = 'hybrid_hgrn2_diffattn_swa_groupmoe_dit'

F32 = jnp.float32


def rms_norm(x, g):
    xf = x.astype(F32)
    y = xf * lax.rsqrt(jnp.mean(xf * xf, axis=-1, keepdims=True) + EPS)
    return (y * g.astype(F32)).astype(x.dtype)


def axial_rope_tables(n_tokens, dim):
    n_rows = n_tokens // GRID_W
    row = jnp.repeat(jnp.arange(n_rows), GRID_W).astype(F32)
    col = jnp.tile(jnp.arange(GRID_W), n_rows).astype(F32)
    half = dim // 2
    inv = 1.0 / (ROPE_BASE ** (jnp.arange(0, half, 2, dtype=F32) / half))
    ar = row[:, None] * inv
    ac = col[:, None] * inv
    ang = jnp.concatenate([ar, ar, ac, ac], axis=-1)
    return jnp.cos(ang), jnp.sin(ang)


def _rotate_half(x):
    x1, x2 = jnp.split(x, 2, axis=-1)
    return jnp.concatenate([-x2, x1], axis=-1)


def apply_axial_rope(x, cos, sin):
    xr, xc = jnp.split(x, 2, axis=-1)
    xrot = jnp.concatenate([_rotate_half(xr), _rotate_half(xc)], axis=-1)
    return (x * cos[None, :, None, :] + xrot * sin[None, :, None, :]).astype(x.dtype)


def hgrn2_scan(q, k, v, logf, s0):
    b_, t_, h_, _ = q.shape
    dv = v.shape[-1]
    n = t_ // HGRN_CHUNK

    def chunks(a):
        return a.astype(F32).reshape(b_, n, HGRN_CHUNK, h_, a.shape[-1])

    qc, kc, vc, lf = chunks(q), chunks(k), chunks(v), chunks(logf)
    cum = jnp.cumsum(lf, axis=2)
    total = cum[:, :, -1]
    tri = jnp.tril(jnp.ones((HGRN_CHUNK, HGRN_CHUNK), dtype=bool))
    diff = cum[:, :, :, None] - cum[:, :, None, :]
    decay = jnp.exp(jnp.where(tri[:, :, None, None], diff, -jnp.inf))
    scores = jnp.einsum('bnthk,bntshk,bnshk->bnhts', qc, decay, kc)
    o_intra = jnp.einsum('bnhts,bnshv->bnthv', scores, vc)
    q_in = qc * jnp.exp(cum)
    k_out = kc * jnp.exp(total[:, :, None] - cum)

    def step(state, inp):
        q_n, k_n, v_n, tot_n = inp
        o_n = jnp.einsum('bthk,bhkv->bthv', q_n, state)
        state = state * jnp.exp(tot_n)[..., None] + jnp.einsum('bshk,bshv->bhkv', k_n, v_n)
        return state, o_n

    xs = (jnp.moveaxis(q_in, 1, 0), jnp.moveaxis(k_out, 1, 0), jnp.moveaxis(vc, 1, 0), jnp.moveaxis(total, 1, 0))
    s_final, o_inter = lax.scan(step, s0, xs)
    o = o_intra + jnp.moveaxis(o_inter, 0, 1)
    return o.reshape(b_, t_, h_, dv), s_final


def hgrn2_mixer(p, pc, lb, onorm_g):
    b_ = p.shape[0]

    def heads(a):
        return a.reshape(a.shape[0], a.shape[1], A_HEADS, -1)

    def split(a):
        q, ff, fb, i, g = jnp.split(a, 5, axis=-1)
        q = heads(jax.nn.silu(q.astype(F32)) * (A_DK ** -0.5))
        return q, heads(ff), heads(fb), heads(i), heads(g)

    ql, ffl, fbl, il, gl = split(p)
    qc, ffc, fbc, ic, gc = split(pc)
    lb = lb.astype(F32).reshape(2, A_HEADS, A_DK)

    def gates(f_raw, lb_d):
        f = lb_d + (1.0 - lb_d) * jax.nn.sigmoid(f_raw.astype(F32))
        return 1.0 - f, jnp.log(f)

    def direction(d, reverse, f_lat, f_ctx):
        fl = (lambda a: jnp.flip(a, axis=1)) if reverse else (lambda a: a)
        k_c, lf_c = gates(f_ctx, lb[d])
        k_l, lf_l = gates(f_lat, lb[d])
        s0 = jnp.zeros((b_, A_HEADS, A_DK, A_DV), F32)
        o_c, s_c = hgrn2_scan(fl(qc), fl(k_c), fl(ic), fl(lf_c), s0)
        o_l, _ = hgrn2_scan(fl(ql), fl(k_l), fl(il), fl(lf_l), s_c)
        return fl(o_c), fl(o_l)

    oc_f, ol_f = direction(0, False, ffl, ffc)
    oc_b, ol_b = direction(1, True, fbl, fbc)

    def finish(o, g):
        y = rms_norm(o, onorm_g) * jax.nn.silu(g.astype(F32))
        return y.reshape(y.shape[0], y.shape[1], A_WIDTH)

    return finish(ol_f + ol_b, gl), finish(oc_f + oc_b, gc)


def diff_attention_mixer(p, pc, lam_p, subln_g, lambda_init, rope, need_ctx):
    b_, t_, _ = p.shape

    def split_qkv(a):
        bb, tt = a.shape[0], a.shape[1]
        q, k, v = jnp.split(a, 3, axis=-1)
        return (q.reshape(bb, tt, B_HEADS, 2, B_HALF), k.reshape(bb, tt, B_HEADS, 2, B_HALF),
                v.reshape(bb, tt, B_HEADS, B_DV))

    q, k, v = split_qkv(p)
    qc, kc, vc = split_qkv(pc)
    cos, sin = rope
    q = apply_axial_rope(q.reshape(b_, t_, 2 * B_HEADS, B_HALF), cos, sin).reshape(b_, t_, B_HEADS, 2, B_HALF)
    k = apply_axial_rope(k.reshape(b_, t_, 2 * B_HEADS, B_HALF), cos, sin).reshape(b_, t_, B_HEADS, 2, B_HALF)
    lam_p = lam_p.astype(F32)
    lam = jnp.exp(jnp.sum(lam_p[0] * lam_p[1])) - jnp.exp(jnp.sum(lam_p[2] * lam_p[3])) + lambda_init
    scale = B_HALF ** -0.5

    def attend(qb, keys, vals):
        s = jnp.einsum('bqhmd,bkhmd->bhmqk', qb, keys).astype(F32) * scale
        pm = jax.nn.softmax(s, axis=-1)
        a = pm[:, :, 0] - lam * pm[:, :, 1]
        return jnp.einsum('bhqk,bkhv->bqhv', a, vals)

    keys = jnp.concatenate([kc, k], axis=1)
    vals = jnp.concatenate([vc, v], axis=1)
    nb = t_ // ATTN_BLOCK
    qb = jnp.moveaxis(q.reshape(b_, nb, ATTN_BLOCK, B_HEADS, 2, B_HALF), 1, 0)
    o = lax.map(lambda blk: attend(blk, keys, vals), qb)
    o = jnp.moveaxis(o, 0, 1).reshape(b_, t_, B_HEADS, B_DV)

    def finish(o):
        y = rms_norm(o, subln_g) * (1.0 - lambda_init)
        return y.reshape(y.shape[0], y.shape[1], B_WIDTH)

    y = finish(o)
    yc = finish(attend(qc, kc, vc)) if need_ctx else None
    return y, yc


def even_layer_mixer(h, hc, w_in, w_out, lb, onorm_g, lam_p, subln_g, lambda_init, rope, need_ctx):
    p = h @ w_in
    pc = hc @ w_in
    ya, yac = hgrn2_mixer(p[..., :5 * A_WIDTH], pc[..., :5 * A_WIDTH], lb, onorm_g)
    yb, ybc = diff_attention_mixer(p[..., 5 * A_WIDTH:], pc[..., 5 * A_WIDTH:], lam_p, subln_g, lambda_init, rope, need_ctx)
    y = jnp.concatenate([ya, yb], axis=-1) @ w_out
    yc = (jnp.concatenate([yac, ybc], axis=-1) @ w_out) if need_ctx else None
    return y, yc


def _sink_attend(qb, parts, sink_logit):
    scale = C_HEAD_DIM ** -0.5
    logits = []
    for kk, _, valid in parts:
        s = jnp.einsum('bqkgd,bskd->bkgqs', qb, kk).astype(F32) * scale
        if valid is not None:
            s = jnp.where(valid, s, -jnp.inf)
        logits.append(s)
    b_, nq = qb.shape[0], qb.shape[1]
    sink_col = jnp.broadcast_to(sink_logit[None, :, :, None, None], (b_, C_KV_HEADS, C_HEADS // C_KV_HEADS, nq, 1))
    pr = jax.nn.softmax(jnp.concatenate([sink_col] + logits, axis=-1), axis=-1)
    out = 0.0
    off = 1
    for (_, vv, _), s in zip(parts, logits):
        n = s.shape[-1]
        out = out + jnp.einsum('bkgqs,bskd->bqkgd', pr[..., off:off + n], vv)
        off += n
    return out


def odd_layer_mixer(h, hc, w_qkv, w_out, sink, rope, need_ctx):
    b_, t_, d_ = h.shape
    n_ctx = hc.shape[1]
    grp = C_HEADS // C_KV_HEADS
    q_cols = C_HEADS * C_HEAD_DIM
    p = h @ w_qkv
    q = p[..., :q_cols].reshape(b_, t_, C_HEADS, C_HEAD_DIM)
    k, v = jnp.split(p[..., q_cols:], 2, axis=-1)
    k = k.reshape(b_, t_, C_KV_HEADS, C_HEAD_DIM)
    v = v.reshape(b_, t_, C_KV_HEADS, C_HEAD_DIM)
    if need_ctx:
        pc = hc @ w_qkv
        qc = pc[..., :q_cols].reshape(b_, n_ctx, C_KV_HEADS, grp, C_HEAD_DIM)
        kvc = pc[..., q_cols:]
    else:
        kvc = hc @ w_qkv[:, q_cols:]
    kc, vc = jnp.split(kvc, 2, axis=-1)
    kc = kc.reshape(b_, n_ctx, C_KV_HEADS, C_HEAD_DIM)
    vc = vc.reshape(b_, n_ctx, C_KV_HEADS, C_HEAD_DIM)
    cos, sin = rope
    q = apply_axial_rope(q, cos, sin).reshape(b_, t_, C_KV_HEADS, grp, C_HEAD_DIM)
    k = apply_axial_rope(k, cos, sin)
    sink_logit = sink.astype(F32).reshape(C_KV_HEADS, grp)
    pad = ((0, 0), (C_WINDOW, C_WINDOW), (0, 0), (0, 0))
    kp = jnp.pad(k, pad)
    vp = jnp.pad(v, pad)
    span = ATTN_BLOCK + 2 * C_WINDOW
    nb = t_ // ATTN_BLOCK

    def block(n):
        start = n * ATTN_BLOCK
        qb = lax.dynamic_slice_in_dim(q, start, ATTN_BLOCK, axis=1)
        kb = lax.dynamic_slice_in_dim(kp, start, span, axis=1)
        vb = lax.dynamic_slice_in_dim(vp, start, span, axis=1)
        qpos = start + jnp.arange(ATTN_BLOCK)
        kpos = start - C_WINDOW + jnp.arange(span)
        valid = (jnp.abs(qpos[:, None] - kpos[None, :]) <= C_WINDOW) & (kpos[None, :] >= 0) & (kpos[None, :] < t_)
        return _sink_attend(qb, [(kc, vc, None), (kb, vb, valid)], sink_logit)

    o = lax.map(block, jnp.arange(nb))
    y = jnp.moveaxis(o, 0, 1).reshape(b_, t_, d_) @ w_out
    yc = None
    if need_ctx:
        yc = _sink_attend(qc, [(kc, vc, None)], sink_logit).reshape(b_, n_ctx, d_) @ w_out
    return y, yc


def routed_moe(h2d, router_w, router_b, w_gate, w_up, w_down):
    n_tok, d_ = h2d.shape
    aff = jax.nn.sigmoid(jnp.dot(h2d, router_w).astype(F32))
    sel = (aff + router_b.astype(F32)).reshape(n_tok, N_GROUPS, EXPERTS_PER_GROUP)
    group_score = jnp.sum(lax.top_k(sel, TOP_K)[0], axis=-1)
    grp = jnp.argmax(group_score, axis=-1)
    in_group = jnp.take_along_axis(sel, grp[:, None, None], axis=1)[:, 0]
    _, local = lax.top_k(in_group, TOP_K)
    expert = (grp[:, None] * EXPERTS_PER_GROUP + local).astype(jnp.int32)
    wts = jnp.take_along_axis(aff, expert, axis=1)
    wts = wts / jnp.sum(wts, axis=-1, keepdims=True)
    n_assign = n_tok * TOP_K
    n_blocks = -(-n_assign // MOE_BLOCK) + N_EXPERTS
    n_rows = n_blocks * MOE_BLOCK
    flat_e = expert.reshape(-1)
    flat_t = jnp.repeat(jnp.arange(n_tok, dtype=jnp.int32), TOP_K)
    flat_w = wts.reshape(-1)
    order = jnp.argsort(flat_e)
    e_sorted = flat_e[order]
    counts = jnp.bincount(flat_e, length=N_EXPERTS)
    padded = (counts + MOE_BLOCK - 1) // MOE_BLOCK * MOE_BLOCK
    pad_end = jnp.cumsum(padded)
    pad_start = pad_end - padded
    start = jnp.cumsum(counts) - counts
    dest = pad_start[e_sorted] + jnp.arange(n_assign) - start[e_sorted]
    row_tok = jnp.full((n_rows,), n_tok, jnp.int32).at[dest].set(flat_t[order])
    row_w = jnp.zeros((n_rows,), F32).at[dest].set(flat_w[order])
    block_start = jnp.arange(n_blocks) * MOE_BLOCK
    block_e = jnp.minimum(jnp.sum(pad_end[None, :] <= block_start[:, None], axis=1), N_EXPERTS - 1)
    x_pad = jnp.concatenate([h2d, jnp.zeros((1, d_), h2d.dtype)], axis=0)
    xb = x_pad[row_tok].reshape(n_blocks, MOE_BLOCK, d_)

    def expert_block(args):
        xblk, e = args
        hid = jax.nn.silu(xblk @ w_gate[e]) * (xblk @ w_up[e])
        return hid @ w_down[e]

    yb = lax.map(expert_block, (xb, block_e)).reshape(n_rows, d_)
    out = jnp.zeros((n_tok + 1, d_), F32).at[row_tok].add(yb * row_w[:, None])
    return out[:n_tok]


def setup_inputs(seed: int = 0) -> dict:
    key = jax.random.key(seed)
    ks = jax.random.split(key, 24)
    d = D_MODEL
    nrm = jax.random.normal
    return {
        'x': nrm(ks[0], (BATCH, SEQ, d), F32),
        'c': nrm(ks[1], (BATCH, d), F32),
        'ctx': nrm(ks[2], (BATCH, CTX_LEN, d), F32),
        'c_ctx': nrm(ks[3], (d,), F32),
        'ada_w': nrm(ks[4], (DEPTH, d, 6 * d), F32) * (0.5 * d ** -0.5),
        'ada_b': nrm(ks[5], (DEPTH, 6 * d), F32) * 0.02,
        'norm_mix_g': 1.0 + 0.02 * nrm(ks[6], (DEPTH, d), F32),
        'norm_ffn_g': 1.0 + 0.02 * nrm(ks[7], (DEPTH, d), F32),
        'even_w_in': nrm(ks[8], (N_EVEN, d, EVEN_IN), F32) * d ** -0.5,
        'even_w_out': nrm(ks[9], (N_EVEN, A_WIDTH + B_WIDTH, d), F32) * (A_WIDTH + B_WIDTH) ** -0.5,
        'hgrn_lb_logits': 0.1 * nrm(ks[10], (DEPTH + 1, 2, A_WIDTH), F32),
        'hgrn_onorm_g': 1.0 + 0.02 * nrm(ks[11], (N_EVEN, A_DV), F32),
        'diff_lambda': 0.1 * nrm(ks[12], (N_EVEN, 4, B_HALF), F32),
        'diff_subln_g': 1.0 + 0.02 * nrm(ks[13], (N_EVEN, B_DV), F32),
        'odd_w_qkv': nrm(ks[14], (N_ODD, d, ODD_IN), F32) * d ** -0.5,
        'odd_w_out': nrm(ks[15], (N_ODD, C_HEADS * C_HEAD_DIM, d), F32) * (C_HEADS * C_HEAD_DIM) ** -0.5,
        'swa_sink': 0.5 * nrm(ks[16], (N_ODD, C_HEADS), F32),
        'router_w': nrm(ks[17], (d, N_EXPERTS), F32) * d ** -0.5,
        'router_b': 0.01 * nrm(ks[18], (N_EXPERTS,), F32),
        'moe_w_gate': nrm(ks[19], (DEPTH, N_EXPERTS, d, D_EXPERT), F32) * d ** -0.5,
        'moe_w_up': nrm(ks[20], (DEPTH, N_EXPERTS, d, D_EXPERT), F32) * d ** -0.5,
        'moe_w_down': nrm(ks[21], (DEPTH, N_EXPERTS, D_EXPERT, d), F32) * D_EXPERT ** -0.5,
        'final_norm_g': 1.0 + 0.02 * nrm(ks[22], (d,), F32),
    }


def reference(x, c, ctx, c_ctx, ada_w, ada_b, norm_mix_g, norm_ffn_g, even_w_in, even_w_out,
              hgrn_lb_logits, hgrn_onorm_g, diff_lambda, diff_subln_g, odd_w_qkv, odd_w_out, swa_sink,
              router_w, router_b, moe_w_gate, moe_w_up, moe_w_down, final_norm_g):
    b_, t_, d_ = x.shape
    n_ctx = ctx.shape[1]
    rope_b = axial_rope_tables(t_, B_HALF)
    rope_c = axial_rope_tables(t_, C_HEAD_DIM)
    lower_bounds = jnp.cumsum(jax.nn.softmax(hgrn_lb_logits.astype(F32), axis=0), axis=0)
    xc = ctx
    for layer in range(DEPTH):
        last = layer == DEPTH - 1
        w_ada, b_ada = ada_w[layer], ada_b[layer]
        mod = (jax.nn.silu(c) @ w_ada + b_ada)[:, None, :]
        mod_c = (jax.nn.silu(c_ctx) @ w_ada + b_ada)[None, None, :]
        sh1, sc1, g1, sh2, sc2, g2 = jnp.split(mod, 6, axis=-1)
        csh1, csc1, cg1, csh2, csc2, cg2 = jnp.split(mod_c, 6, axis=-1)
        h = rms_norm(x, norm_mix_g[layer]) * (1.0 + sc1) + sh1
        hc = rms_norm(xc, norm_mix_g[layer]) * (1.0 + csc1) + csh1
        if layer % 2 == 0:
            j = layer // 2
            lambda_init = 0.8 - 0.6 * math.exp(-0.3 * layer)
            y, yc = even_layer_mixer(h, hc, even_w_in[j], even_w_out[j], lower_bounds[layer], hgrn_onorm_g[j],
                                     diff_lambda[j], diff_subln_g[j], lambda_init, rope_b, not last)
        else:
            j = layer // 2
            y, yc = odd_layer_mixer(h, hc, odd_w_qkv[j], odd_w_out[j], swa_sink[j], rope_c, not last)
        x = x + g1 * y
        h2 = rms_norm(x, norm_ffn_g[layer]) * (1.0 + sc2) + sh2
        if last:
            f = routed_moe(h2.reshape(-1, d_), router_w, router_b,
                           moe_w_gate[layer], moe_w_up[layer], moe_w_down[layer])
            x = x + g2 * f.reshape(b_, t_, d_)
        else:
            xc = xc + cg1 * yc
            hc2 = rms_norm(xc, norm_ffn_g[layer]) * (1.0 + csc2) + csh2
            tokens = jnp.concatenate([h2.reshape(-1, d_), hc2.reshape(-1, d_)], axis=0)
            f = routed_moe(tokens, router_w, router_b, moe_w_gate[layer], moe_w_up[layer], moe_w_down[layer])
            x = x + g2 * f[:b_ * t_].reshape(b_, t_, d_)
            xc = xc + cg2 * f[b_ * t_:].reshape(b_, n_ctx, d_)
    return rms_norm(x, final_norm_g)
```

```cpp
#include <hip/hip_runtime.h>
#include <hip/hip_cooperative_groups.h>
#include <hip/hip_bf16.h>
#include <cstdio>
#include <cstdint>
#include <cmath>
namespace cg = cooperative_groups;

constexpr int DMODEL = 1024, NBATCH = 2, TLAT = 8192, TCTX = 256;
constexpr int SB = TLAT + TCTX;
constexpr int MR = NBATCH * SB;
constexpr int NEXP = 16;
constexpr int MOE_MAXT = 152;
constexpr float EPS_ = 1e-6f;
constexpr float LOG2E = 1.4426950408889634f;
constexpr float C2 = 0.125f * LOG2E;
constexpr int NCHUNK = SB / 64;

constexpr size_t MiB = 1u << 20;
constexpr size_t WS_CTL = 0, CTL_ZERO_BYTES = 64 * 1024;
constexpr size_t WS_MOD = 1 * MiB;
constexpr size_t WS_LB = WS_MOD + 256 * 1024;
constexpr size_t WS_LAM = WS_LB + 8 * 1024;
constexpr size_t WS_ROPE = WS_LAM + 1024;
constexpr size_t WS_EXPID = 2 * MiB;
constexpr size_t WS_EXPW = WS_EXPID + 256 * 1024;
constexpr size_t WS_RANK = WS_EXPW + 256 * 1024;
constexpr size_t WS_TOKSLOT = WS_RANK + 256 * 1024;
constexpr size_t WS_CNT = WS_TOKSLOT + 256 * 1024;
constexpr size_t WS_META = WS_CNT + 32 * 1024;
constexpr size_t WS_ROWW = 4 * MiB;
constexpr size_t WS_TOT = 5 * MiB;
constexpr size_t WS_WIN = 8 * MiB;
constexpr size_t WS_WOE = 16 * MiB;
constexpr size_t WS_WQKV = 18 * MiB;
constexpr size_t WS_WOO = 21 * MiB;
constexpr size_t WS_MOE0_13 = 24 * MiB;
constexpr size_t WS_MOE0_2 = 88 * MiB;
constexpr size_t WS_X = 120 * MiB;
constexpr size_t WS_H = 186 * MiB;
constexpr size_t WS_R = 219 * MiB;
constexpr size_t WS_QH = WS_R;
constexpr size_t WS_LFF = WS_QH + 33 * MiB / 2;
constexpr size_t WS_LFB = WS_LFF + 33 * MiB;
constexpr size_t WS_IV = WS_LFB + 33 * MiB;
constexpr size_t WS_GG = WS_IV + 33 * MiB / 2;
constexpr size_t WS_DQ = WS_GG + 33 * MiB / 2;
constexpr size_t WS_DK = WS_DQ + 33 * MiB / 2;
constexpr size_t WS_DV = WS_DK + 33 * MiB / 2;
constexpr size_t WS_U = WS_DV + 33 * MiB / 2;
constexpr size_t WS_S = WS_U + 66 * MiB;
constexpr size_t WS_OATT = WS_U;
constexpr size_t WS_END0 = WS_S + 66 * MiB;
constexpr size_t WS_MOE1_13 = WS_R;
constexpr size_t WS_MOE1_2 = WS_R + 64 * MiB;
constexpr size_t WS_XS = WS_R + 96 * MiB;
constexpr size_t WS_HID = WS_XS + 76 * MiB;
constexpr size_t WS_Q1 = WS_HID + 76 * MiB;
constexpr size_t WS_K1 = WS_Q1 + 33 * MiB;
constexpr size_t WS_V1 = WS_K1 + 33 * MiB / 4;
constexpr size_t WS_END1 = WS_V1 + 33 * MiB / 4;
constexpr size_t WS_NEED = (WS_END0 > WS_END1 ? WS_END0 : WS_END1);
static_assert(WS_NEED <= 553810048ull, "d_ws map exceeds the guaranteed workspace");
static_assert((size_t)MOE_MAXT * 256 * 1024 * 2 <= 76 * MiB, "XS size");

#define GAS __attribute__((address_space(1)))
#define LAS __attribute__((address_space(3)))
typedef unsigned short bf16;
typedef unsigned v4u __attribute__((ext_vector_type(4)));
typedef float f32x4 __attribute__((ext_vector_type(4)));
typedef short bf16x8 __attribute__((ext_vector_type(8)));
typedef GAS unsigned gu32;
typedef GAS unsigned long long gu64;
#define RLX_AGENT __ATOMIC_RELAXED, __HIP_MEMORY_SCOPE_AGENT
#define LDS_WAIT() asm volatile("s_waitcnt lgkmcnt(0)" ::: "memory")
#define VM_WAIT() asm volatile("s_waitcnt vmcnt(0)" ::: "memory")
__device__ __forceinline__ unsigned long long rt() { return __builtin_amdgcn_s_memrealtime(); }
__device__ __forceinline__ unsigned f2bf(float f) { unsigned u = __builtin_bit_cast(unsigned, f); return (u + 0x7fffu + ((u >> 16) & 1u)) >> 16; }
__device__ __forceinline__ unsigned pk2(float lo, float hi) { return f2bf(lo) | (f2bf(hi) << 16); }

#define XB_TMO      128
#define XB_XCNT(j)  (256  + 64 * (j))
#define XB_XSUB(j)  (1280 + 64 * (j))
#define XB_XGEN(j)  (2304 + 64 * (j))
#define XB_TOP      3328
#define XB_TOPGEN   3392
#define XCD_BAR_WORDS 3456
#define XB_SPIN_CAP (1u << 18)

__device__ __forceinline__ unsigned xb_ld(unsigned* p)              { return __hip_atomic_load(p, __ATOMIC_RELAXED, __HIP_MEMORY_SCOPE_AGENT); }
__device__ __forceinline__ unsigned xb_add(unsigned* p, unsigned v) { return __hip_atomic_fetch_add(p, v, __ATOMIC_RELAXED, __HIP_MEMORY_SCOPE_AGENT); }
__device__ __forceinline__ unsigned xb_xcc_id() { return (unsigned)__builtin_amdgcn_s_getreg((3 << 11) | 20) & 0xFu; }
#define XB_SPIN(cond, bar) do { unsigned _sp = 0; while (cond) { __builtin_amdgcn_s_sleep(1); \
    if ((++_sp & 255u) == 0u) { if (xb_ld(&(bar)[XB_TMO])) break; if (_sp > XB_SPIN_CAP) { atomicAdd(&(bar)[XB_TMO], 1u); break; } } } } while (0)

struct XcdBarrier {
    unsigned* bar; unsigned x;
    volatile LAS unsigned* st;
};

__device__ __forceinline__ XcdBarrier xcd_barrier_post(unsigned* bar, volatile LAS unsigned* st) {
    XcdBarrier b; b.bar = bar; b.x = xb_xcc_id(); b.st = st;
    if (threadIdx.x == 0) (void)xb_add(&bar[XB_XCNT(b.x)], 1u);
    return b;
}
__device__ __forceinline__ void xcd_barrier_complete(unsigned* bar, unsigned x, unsigned& nloc, unsigned& nx) {
    const unsigned G = gridDim.x * gridDim.y * gridDim.z;
    unsigned sum, cnt, mine, sp = 0u;
    for (;;) {
        sum = 0u; cnt = 0u; mine = 0u;
#pragma unroll
        for (unsigned j = 0; j < 16; ++j) { const unsigned c = xb_ld(&bar[XB_XCNT(j)]); sum += c; cnt += (c > 0u) ? 1u : 0u; mine = (j == x) ? c : mine; }
        if (sum == G) break;
        __builtin_amdgcn_s_sleep(1);
        if ((++sp & 255u) == 0u) { if (xb_ld(&bar[XB_TMO])) break; if (sp > XB_SPIN_CAP) { atomicAdd(&bar[XB_TMO], 1u); break; } }
    }
    nloc = mine > 0u ? mine : 1u; nx = cnt > 0u ? cnt : 1u;
}

__device__ __forceinline__ void xcd_barrier(const XcdBarrier& b) {
    asm volatile("s_waitcnt vmcnt(0)" ::: "memory");
    __syncthreads();
    if (threadIdx.x == 0) {
        unsigned* bar = b.bar;
        __builtin_amdgcn_s_waitcnt(0);
        unsigned nloc = b.st[0], nx = b.st[1];
        if (nloc == 0u) { xcd_barrier_complete(bar, b.x, nloc, nx); b.st[0] = nloc; b.st[1] = nx; }
        const unsigned old = xb_add(&bar[XB_XSUB(b.x)], 1u);
        const unsigned gen = old / nloc;
        if (old + 1u == (gen + 1u) * nloc) {
            __builtin_amdgcn_fence(__ATOMIC_RELEASE, "agent");
            asm volatile("s_waitcnt vmcnt(0)" ::: "memory");
            const unsigned og = xb_add(&bar[XB_TOP], 1u);
            const unsigned tg = og / nx;
            if (og + 1u == (tg + 1u) * nx) xb_add(&bar[XB_TOPGEN], 1u);
            else XB_SPIN(xb_ld(&bar[XB_TOPGEN]) == tg, bar);
            __builtin_amdgcn_fence(__ATOMIC_ACQUIRE, "agent");
            xb_add(&bar[XB_XGEN(b.x)], 1u);
            asm volatile("s_waitcnt vmcnt(0)" ::: "memory");
        } else {
            XB_SPIN(xb_ld(&bar[XB_XGEN(b.x)]) == gen, bar);
            __builtin_amdgcn_fence(__ATOMIC_ACQUIRE, "agent");
            asm volatile("s_waitcnt vmcnt(0)" ::: "memory");
        }
    }
    __syncthreads();
}
namespace pg8 {
#define PG8_LAS __attribute__((address_space(3)))
typedef unsigned short bf16_t;
typedef short bf16x8 __attribute__((ext_vector_type(8)));
typedef float f32x4 __attribute__((ext_vector_type(4)));
typedef unsigned u32x4 __attribute__((ext_vector_type(4)));
constexpr int BM = 256, BK = 64, HALF = 128, HTB = HALF * BK * 2  , STAGE_BYTES = 8 * HTB, NXCD = 8, WGM = 8;

__host__ __device__ __forceinline__ int lds_byte(int r, int c) { const int st = (r >> 4) * 2 + (c >> 5), rr = r & 15, cc = c & 31, ob = rr * 64 + cc * 2; return st * 1024 + (ob ^ (((ob >> 9) & 1) << 5)); }
__host__ __device__ __forceinline__ void stage_rc(int b, int& R, int& C) { const int st = b / 1024, sb = b % 1024, swz = sb ^ (((sb >> 9) & 1) << 5); R = (st >> 1) * 16 + swz / 64; C = (st & 1) * 32 + (swz % 64) / 2; }
__host__ __device__ __forceinline__ int perm32(int rho) { const int n = rho >> 4, i = rho & 15; return 8 * (i >> 2) + 4 * n + (i & 3); }

struct Unit { int pm, pn, be; };
struct Gemm { const bf16_t* A; const bf16_t* Bt; int M, N, K; size_t bes; };
__device__ __forceinline__ unsigned cvt_pk_bf16(float lo, float hi) { unsigned r; asm volatile("v_cvt_pk_bf16_f32 %0, %1, %2" : "=v"(r) : "v"(lo), "v"(hi)); return r; }
typedef float f32x2 __attribute__((ext_vector_type(2)));

struct DenseOrder {
    int nM, nN, nwg, G, c; bool skipctx;
    __device__ void init(int nM_, int nN_, int G_, int c_, bool skip_) { nM = nM_; nN = nN_; nwg = nM * nN; G = G_; c = c_; skipctx = skip_; }
    __device__ bool next(int i, Unit& u) const {
        const long L = (long)i * G + c; if (L >= nwg) return false;
        int wgid = (int)L; { const int q = nwg / NXCD, r = nwg % NXCD, xcd = wgid % NXCD, off = wgid / NXCD; wgid = (xcd < r ? xcd * (q + 1) : r * (q + 1) + (xcd - r) * q) + off; }
        const int nig = WGM * nN, gid = wgid / nig, fm = gid * WGM, gsz = (nM - fm) < WGM ? (nM - fm) : WGM;
        int pm = fm + ((wgid % nig) % gsz); u.pn = (wgid % nig) / gsz; u.be = 0;
        if (skipctx) pm = (pm >> 5) * 33 + 1 + (pm & 31);
        u.pm = pm; return true;
    }
    __device__ __forceinline__ void a_ready(const Unit&) const {}
    __device__ __forceinline__ void done(const Unit&) const {}
};
struct MoeOrder {
    int nM, nN, nwg, G, c; const int* tile_e;
    __device__ void init(int nM_, int nN_, int G_, int c_, const int* te) { nM = nM_; nN = nN_; nwg = nM * nN; G = G_; c = c_; tile_e = te; }
    __device__ bool next(int i, Unit& u) const {
        const long L = (long)i * G + c; if (L >= nwg) return false;
        int wgid = (int)L; { const int q = nwg / NXCD, r = nwg % NXCD, xcd = wgid % NXCD, off = wgid / NXCD; wgid = (xcd < r ? xcd * (q + 1) : r * (q + 1) + (xcd - r) * q) + off; }
        const int nig = WGM * nN, gid = wgid / nig, fm = gid * WGM, gsz = (nM - fm) < WGM ? (nM - fm) : WGM;
        u.pm = fm + ((wgid % nig) % gsz); u.pn = (wgid % nig) / gsz; u.be = __builtin_amdgcn_readfirstlane(tile_e[u.pm]); return true;
    }
    __device__ __forceinline__ void a_ready(const Unit&) const {}
    __device__ __forceinline__ void done(const Unit&) const {}
};

typedef unsigned u32x2 __attribute__((ext_vector_type(2)));
typedef float f32x2 __attribute__((ext_vector_type(2)));
__device__ __forceinline__ float silu_f(float v) { return v / (1.f + __expf(-v)); }
__device__ __forceinline__ float sigm_f(float v) { return 1.f / (1.f + __expf(-v)); }
__device__ __forceinline__ u32x2 pk4(f32x4 v) { u32x2 w; w.x = cvt_pk_bf16(v[0], v[1]); w.y = cvt_pk_bf16(v[2], v[3]); return w; }

struct EpiInProj {
    static constexpr bool PERM = false, AFTER_DRAIN = false;
    bf16_t *QH, *IV, *GG, *DQ, *DK, *DV; float *LFF, *LFB; const float* LB; const float* ROPE;
    __device__ __forceinline__ void operator()(const f32x4 (&acc)[2][2][4][2], const Unit& u, int wr, int wc, int fr, int fq) const {
        const int seg = u.pn >> 1;
        const int cb = (u.pn & 1) * 256 + wc * 32 + 4 * fq;
        const int jt = u.pm % 33; const bool latent = jt != 0;
        const int s0 = jt * 256 + wr * 64 + fr;
        const size_t row0 = (size_t)u.pm * 256 + wr * 64 + fr;
        if (seg == 1 || seg == 2) {
            float* LF = seg == 1 ? LFF : LFB; const float* lbp = LB + (seg - 1) * 512;
#pragma unroll
            for (int bj = 0; bj < 2; ++bj)
#pragma unroll
                for (int n = 0; n < 2; ++n) { const int col = cb + bj * 128 + n * 16; const f32x4 lb = *(const f32x4*)(lbp + col);
#pragma unroll
                    for (int ai = 0; ai < 2; ++ai)
#pragma unroll
                        for (int m = 0; m < 4; ++m) { const f32x4 v = acc[ai][bj][m][n]; f32x4 o;
#pragma unroll
                            for (int e = 0; e < 4; ++e) { const float f = lb[e] + (1.f - lb[e]) * sigm_f(v[e]); o[e] = __logf(f); }
                            *(f32x4*)(LF + (row0 + ai * 128 + m * 16) * 512 + col) = o; } }
        } else if (seg == 5 || seg == 6) {
            bf16_t* O = seg == 5 ? DQ : DK; const float sc = seg == 5 ? C2 : 1.f;
#pragma unroll
            for (int ai = 0; ai < 2; ++ai)
#pragma unroll
                for (int m = 0; m < 4; ++m) {
                    f32x4 cs0 = {1.f, 0.f, 1.f, 0.f}, cs1 = {1.f, 0.f, 1.f, 0.f};
                    if (latent) { const int tau = s0 + ai * 128 + m * 16 - 256; const int pos = (wc & 1) ? (tau & 63) : (tau >> 6);
                        const float* rp = ROPE + (pos * 16 + 4 * fq) * 2; cs0 = *(const f32x4*)rp; cs1 = *(const f32x4*)(rp + 4); }
                    const float co[4] = {cs0[0], cs0[2], cs1[0], cs1[2]}, si[4] = {cs0[1], cs0[3], cs1[1], cs1[3]};
#pragma unroll
                    for (int bj = 0; bj < 2; ++bj) { const f32x4 a0 = acc[ai][bj][m][0], a1 = acc[ai][bj][m][1]; f32x4 o0, o1;
#pragma unroll
                        for (int e = 0; e < 4; ++e) { o0[e] = (a0[e] * co[e] - a1[e] * si[e]) * sc; o1[e] = (a1[e] * co[e] + a0[e] * si[e]) * sc; }
                        bf16_t* p = O + (row0 + ai * 128 + m * 16) * 512 + cb + bj * 128;
                        *(u32x2*)p = pk4(o0); *(u32x2*)(p + 16) = pk4(o1); } }
        } else {
            bf16_t* O = seg == 0 ? QH : seg == 3 ? IV : seg == 4 ? GG : DV;
#pragma unroll
            for (int ai = 0; ai < 2; ++ai)
#pragma unroll
                for (int m = 0; m < 4; ++m)
#pragma unroll
                    for (int bj = 0; bj < 2; ++bj)
#pragma unroll
                        for (int n = 0; n < 2; ++n) { f32x4 v = acc[ai][bj][m][n];
                            if (seg == 0) {
#pragma unroll
                                for (int e = 0; e < 4; ++e) v[e] = silu_f(v[e]) * 0.08838834764831845f; }
                            else if (seg == 4) {
#pragma unroll
                                for (int e = 0; e < 4; ++e) v[e] = silu_f(v[e]); }
                            *(u32x2*)(O + (row0 + ai * 128 + m * 16) * 512 + cb + bj * 128 + n * 16) = pk4(v); }
        }
    }
};

struct EpiOut0 {
    static constexpr bool PERM = false, AFTER_DRAIN = false;
    const float* x; const float* ctx; const float* MODL; float* X;
    __device__ __forceinline__ void operator()(const f32x4 (&acc)[2][2][4][2], const Unit& u, int wr, int wc, int fr, int fq) const {
        const int b = u.pm / 33, jt = u.pm % 33; const int vec = jt == 0 ? 2 : b;
        const int col0 = u.pn * 256 + wc * 32 + 4 * fq; const float* gp = MODL + vec * 6144 + 2048 + col0;
        f32x4 gv[2][2];
#pragma unroll
        for (int bj = 0; bj < 2; ++bj)
#pragma unroll
            for (int n = 0; n < 2; ++n) gv[bj][n] = *(const f32x4*)(gp + bj * 128 + n * 16);
#pragma unroll
        for (int ai = 0; ai < 2; ++ai)
#pragma unroll
            for (int m = 0; m < 4; ++m) { const int sl = ai * 128 + wr * 64 + m * 16 + fr;
                const float* src = jt == 0 ? ctx + ((size_t)b * 256 + sl) * 1024 : x + ((size_t)b * 8192 + (jt - 1) * 256 + sl) * 1024;
                float* dst = X + ((size_t)u.pm * 256 + sl) * 1024;
#pragma unroll
                for (int bj = 0; bj < 2; ++bj)
#pragma unroll
                    for (int n = 0; n < 2; ++n) { const int c = col0 + bj * 128 + n * 16; *(f32x4*)(dst + c) = *(const f32x4*)(src + c) + gv[bj][n] * acc[ai][bj][m][n]; } }
    }
};
struct EpiOut1 {
    static constexpr bool PERM = false, AFTER_DRAIN = false;
    const float* MODL; float* X;
    __device__ __forceinline__ void operator()(const f32x4 (&acc)[2][2][4][2], const Unit& u, int wr, int wc, int fr, int fq) const {
        const int b = u.pm / 33; const int col0 = u.pn * 256 + wc * 32 + 4 * fq; const float* gp = MODL + b * 6144 + 2048 + col0;
        f32x4 gv[2][2];
#pragma unroll
        for (int bj = 0; bj < 2; ++bj)
#pragma unroll
            for (int n = 0; n < 2; ++n) gv[bj][n] = *(const f32x4*)(gp + bj * 128 + n * 16);
#pragma unroll
        for (int ai = 0; ai < 2; ++ai)
#pragma unroll
            for (int m = 0; m < 4; ++m) { float* dst = X + ((size_t)u.pm * 256 + ai * 128 + wr * 64 + m * 16 + fr) * 1024;
#pragma unroll
                for (int bj = 0; bj < 2; ++bj)
#pragma unroll
                    for (int n = 0; n < 2; ++n) { const int c = col0 + bj * 128 + n * 16; *(f32x4*)(dst + c) = *(const f32x4*)(dst + c) + gv[bj][n] * acc[ai][bj][m][n]; } }
    }
};
struct EpiGateUp {
    static constexpr bool PERM = true, AFTER_DRAIN = false;
    bf16_t* HID;
    __device__ __forceinline__ void operator()(const f32x4 (&acc)[2][2][4][2], const Unit& u, int wr, int wc, int fr, int fq) const {
        const int col0 = u.pn * 128 + wc * 32 + 8 * fq;
#pragma unroll
        for (int ai = 0; ai < 2; ++ai)
#pragma unroll
            for (int m = 0; m < 4; ++m) { f32x4 h0, h1;
#pragma unroll
                for (int e = 0; e < 4; ++e) { h0[e] = silu_f(acc[ai][0][m][0][e]) * acc[ai][1][m][0][e]; h1[e] = silu_f(acc[ai][0][m][1][e]) * acc[ai][1][m][1][e]; }
                u32x4 w; w.x = cvt_pk_bf16(h0[0], h0[1]); w.y = cvt_pk_bf16(h0[2], h0[3]); w.z = cvt_pk_bf16(h1[0], h1[1]); w.w = cvt_pk_bf16(h1[2], h1[3]);
                *(u32x4*)(HID + ((size_t)u.pm * 256 + ai * 128 + wr * 64 + m * 16 + fr) * 1024 + col0) = w; }
    }
};
struct EpiDown {
    static constexpr bool PERM = true, AFTER_DRAIN = false;
    bf16_t* YB; const float* ROWW;
    __device__ __forceinline__ void operator()(const f32x4 (&acc)[2][2][4][2], const Unit& u, int wr, int wc, int fr, int fq) const {
        const int col0 = u.pn * 256 + wc * 32 + 8 * fq;
#pragma unroll
        for (int ai = 0; ai < 2; ++ai)
#pragma unroll
            for (int m = 0; m < 4; ++m) { const size_t row = (size_t)u.pm * 256 + ai * 128 + wr * 64 + m * 16 + fr; const float w_ = ROWW[row];
#pragma unroll
                for (int bj = 0; bj < 2; ++bj) { const f32x4 v0 = acc[ai][bj][m][0] * w_, v1 = acc[ai][bj][m][1] * w_;
                    u32x4 w; w.x = cvt_pk_bf16(v0[0], v0[1]); w.y = cvt_pk_bf16(v0[2], v0[3]); w.z = cvt_pk_bf16(v1[0], v1[1]); w.w = cvt_pk_bf16(v1[2], v1[3]);
                    *(u32x4*)(YB + row * 1024 + col0 + bj * 128) = w; } }
    }
};
struct EpiQKV1 {
    static constexpr bool PERM = false, AFTER_DRAIN = false;
    bf16_t *Q1, *K1, *V1; const float* ROPE;
    __device__ __forceinline__ void operator()(const f32x4 (&acc)[2][2][4][2], const Unit& u, int wr, int wc, int fr, int fq) const {
        const int jt = u.pm % 33; const bool latent = jt != 0;
        const int s0 = jt * 256 + wr * 64 + fr; const size_t row0 = (size_t)u.pm * 256 + wr * 64 + fr;
        const int cb = wc * 32 + 4 * fq;
        if (u.pn == 5) {
#pragma unroll
            for (int ai = 0; ai < 2; ++ai)
#pragma unroll
                for (int m = 0; m < 4; ++m)
#pragma unroll
                    for (int bj = 0; bj < 2; ++bj)
#pragma unroll
                        for (int n = 0; n < 2; ++n) *(u32x2*)(V1 + (row0 + ai * 128 + m * 16) * 256 + cb + bj * 128 + n * 16) = pk4(acc[ai][bj][m][n]);
        } else {
            const bool isq = u.pn < 4; bf16_t* O = isq ? Q1 + u.pn * 256 : K1; const int pitch = isq ? 1024 : 256; const float sc = isq ? C2 : 1.f;
#pragma unroll
            for (int ai = 0; ai < 2; ++ai)
#pragma unroll
                for (int m = 0; m < 4; ++m) {
                    f32x4 cs0 = {1.f, 0.f, 1.f, 0.f}, cs1 = {1.f, 0.f, 1.f, 0.f};
                    if (latent) { const int tau = s0 + ai * 128 + m * 16 - 256; const int pos = (wc & 1) ? (tau & 63) : (tau >> 6);
                        const float* rp = ROPE + (pos * 16 + 4 * fq) * 2; cs0 = *(const f32x4*)rp; cs1 = *(const f32x4*)(rp + 4); }
                    const float co[4] = {cs0[0], cs0[2], cs1[0], cs1[2]}, si[4] = {cs0[1], cs0[3], cs1[1], cs1[3]};
#pragma unroll
                    for (int bj = 0; bj < 2; ++bj) { const f32x4 a0 = acc[ai][bj][m][0], a1 = acc[ai][bj][m][1]; f32x4 o0, o1;
#pragma unroll
                        for (int e = 0; e < 4; ++e) { o0[e] = (a0[e] * co[e] - a1[e] * si[e]) * sc; o1[e] = (a1[e] * co[e] + a0[e] * si[e]) * sc; }
                        bf16_t* p = O + (row0 + ai * 128 + m * 16) * pitch + cb + bj * 128;
                        *(u32x2*)p = pk4(o0); *(u32x2*)(p + 16) = pk4(o1); } }
        }
    }
};
template <class Epi, class Sched, bool ALIGN_EPI = false, bool SP2 = false>
__device__ __forceinline__ void gemm_phase(PG8_LAS unsigned char* lds, const Gemm g, const Sched& S, const Epi& E) {
    const int tid = threadIdx.x, wid = __builtin_amdgcn_readfirstlane(tid >> 6), lane = tid & 63, wr = wid >> 2, wc = wid & 3, fr = lane & 15, fq = lane >> 4;
    const int K = g.K, nt = K / BK;
    unsigned voffA[2], voffB[2];
#pragma unroll
    for (int i = 0; i < 2; ++i) { int R, C; stage_rc(tid * 16 + i * 8192, R, C); const int Rb = Epi::PERM ? ((R & ~31) + perm32(R & 31)) : R;
        voffA[i] = (unsigned)(R * K + C) * 2u; voffB[i] = (unsigned)(Rb * K + C) * 2u; }
    const size_t kstep = (size_t)(BK * 2);
    const size_t hstep = (size_t)HALF * K * 2;
    const size_t tstep = 2 * hstep;
    const unsigned ldsw = (unsigned)wid * 1024u;
    const int aoff = lds_byte(wr * 64 + fr, fq * 8), boff = lds_byte(wc * 32 + fr, fq * 8);
#define PG8_SA(b, h) (((b) * 2 + (h)) * HTB)
#define PG8_SB(b, h) ((4 + (b) * 2 + (h)) * HTB)
#define PG8_STAGE(bufoff, gbase, voff) do { _Pragma("unroll") for (int _i = 0; _i < 2; ++_i) \
        __builtin_amdgcn_global_load_lds((const unsigned*)((const char*)(gbase) + (voff)[_i]), (PG8_LAS unsigned*)(lds + (bufoff) + ldsw + _i * 8192), 16, 0, 0); } while (0)
#define PG8_LDA(dst, b, h) do { _Pragma("unroll") for (int m = 0; m < 4; ++m) _Pragma("unroll") for (int k = 0; k < 2; ++k) dst[m][k] = *(const PG8_LAS bf16x8*)(lds + PG8_SA(b, h) + aoff + m * 2048 + k * 1024); } while (0)
#define PG8_LDB(dst, b, h) do { _Pragma("unroll") for (int n = 0; n < 2; ++n) _Pragma("unroll") for (int k = 0; k < 2; ++k) dst[n][k] = *(const PG8_LAS bf16x8*)(lds + PG8_SB(b, h) + boff + n * 2048 + k * 1024); } while (0)
#define PG8_MMA(ai, bj, At, Bt) do { __builtin_amdgcn_s_setprio(1); _Pragma("unroll") for (int m = 0; m < 4; ++m) _Pragma("unroll") for (int n = 0; n < 2; ++n) _Pragma("unroll") for (int k = 0; k < 2; ++k) \
        acc[ai][bj][m][n] = __builtin_amdgcn_mfma_f32_16x16x32_bf16(Bt[n][k], At[m][k], acc[ai][bj][m][n], 0, 0, 0); __builtin_amdgcn_s_setprio(0); } while (0)
#define PG8_WAIT_V(n) asm volatile("s_waitcnt vmcnt(" #n ")" ::: "memory")
#define PG8_WAIT_L(n) asm volatile("s_waitcnt lgkmcnt(" #n ")" ::: "memory")
#define PG8_BAR __builtin_amdgcn_s_barrier()
#define PG8_SCHED __builtin_amdgcn_sched_barrier(0)
    Unit cur, nxt; int ui = 0;
    if (!S.next(0, cur)) return;
    f32x4 acc[2][2][4][2];
#pragma unroll
    for (int a = 0; a < 2; ++a)
#pragma unroll
        for (int b = 0; b < 2; ++b)
#pragma unroll
            for (int m = 0; m < 4; ++m)
#pragma unroll
                for (int n = 0; n < 2; ++n) acc[a][b][m][n] = (f32x4){0.f, 0.f, 0.f, 0.f};
    bf16x8 At[4][2], B0[2][2], B1[2][2];
    const char* cA = (const char*)g.A + (size_t)cur.pm * tstep; const char* cB = (const char*)g.Bt + (size_t)cur.be * g.bes + (size_t)cur.pn * tstep;
    S.a_ready(cur);
    if constexpr (SP2) {
        PG8_STAGE(PG8_SB(0, 0), cB, voffB); PG8_STAGE(PG8_SB(0, 1), cB + hstep, voffB); PG8_STAGE(PG8_SA(0, 0), cA, voffA); PG8_STAGE(PG8_SA(0, 1), cA + hstep, voffA);
        if (wr == 1) PG8_BAR;
        PG8_WAIT_V(2); PG8_BAR;
        PG8_STAGE(PG8_SB(1, 0), cB + kstep, voffB); PG8_STAGE(PG8_SA(1, 0), cA + kstep, voffA); PG8_STAGE(PG8_SB(1, 1), cB + hstep + kstep, voffB);
        PG8_WAIT_V(6); PG8_BAR;
    } else {
        PG8_STAGE(PG8_SB(0, 0), cB, voffB); PG8_STAGE(PG8_SA(0, 0), cA, voffA); PG8_STAGE(PG8_SB(0, 1), cB + hstep, voffB); PG8_STAGE(PG8_SA(0, 1), cA + hstep, voffA);
        if (wr == 1) PG8_BAR;
        PG8_WAIT_V(4); PG8_BAR;
        PG8_STAGE(PG8_SB(1, 0), cB + kstep, voffB); PG8_STAGE(PG8_SA(1, 0), cA + kstep, voffA); PG8_STAGE(PG8_SB(1, 1), cB + hstep + kstep, voffB);
        PG8_WAIT_V(6); PG8_BAR;
    }
    for (;;) {
        const bool has_next = S.next(ui + 1, nxt);
        const char* nA = has_next ? (const char*)g.A + (size_t)nxt.pm * tstep : cA; const char* nB = has_next ? (const char*)g.Bt + (size_t)nxt.be * g.bes + (size_t)nxt.pn * tstep : cB;
        for (int t = 0; t < nt; t += 2) {
            const bool last = (t == nt - 2);
            const char* a1 = cA + (size_t)(t + 1) * kstep;
            const char* a2 = last ? nA : cA + (size_t)(t + 2) * kstep; const char* b2 = last ? nB : cB + (size_t)(t + 2) * kstep;
            const char* a3 = a2 + kstep; const char* b3 = b2 + kstep;
            if (last && has_next) S.a_ready(nxt);
            if constexpr (SP2) {
            PG8_LDB(B0, 0, 0); PG8_LDB(B1, 0, 1); PG8_SCHED; PG8_LDA(At, 0, 0); PG8_STAGE(PG8_SA(1, 1), a1 + hstep, voffA);
            PG8_WAIT_V(8); PG8_WAIT_L(0); PG8_BAR; PG8_MMA(0, 0, At, B0); PG8_MMA(0, 1, At, B1); PG8_BAR; PG8_SCHED;
            PG8_LDA(At, 0, 1); PG8_STAGE(PG8_SB(0, 0), b2, voffB); PG8_STAGE(PG8_SB(0, 1), b2 + hstep, voffB); PG8_STAGE(PG8_SA(0, 0), a2, voffA);
            PG8_WAIT_V(8); PG8_WAIT_L(0); PG8_BAR; PG8_MMA(1, 0, At, B0); PG8_MMA(1, 1, At, B1); PG8_BAR; PG8_SCHED;
            PG8_LDB(B0, 1, 0); PG8_LDB(B1, 1, 1); PG8_SCHED; PG8_LDA(At, 1, 0); PG8_STAGE(PG8_SA(0, 1), a2 + hstep, voffA);
            PG8_WAIT_V(8); PG8_WAIT_L(0); PG8_BAR; PG8_MMA(0, 0, At, B0); PG8_MMA(0, 1, At, B1); PG8_BAR; PG8_SCHED;
            PG8_LDA(At, 1, 1); PG8_STAGE(PG8_SB(1, 0), b3, voffB); PG8_STAGE(PG8_SB(1, 1), b3 + hstep, voffB); PG8_STAGE(PG8_SA(1, 0), a3, voffA);
            PG8_WAIT_V(8); PG8_WAIT_L(0); PG8_BAR; PG8_MMA(1, 0, At, B0); PG8_MMA(1, 1, At, B1); PG8_BAR; PG8_SCHED;
            } else {
            PG8_LDB(B0, 0, 0); PG8_SCHED; PG8_LDA(At, 0, 0); PG8_STAGE(PG8_SA(1, 1), a1 + hstep, voffA);
            PG8_WAIT_L(8); PG8_BAR; PG8_WAIT_L(0); PG8_MMA(0, 0, At, B0); PG8_BAR; PG8_SCHED;
            PG8_LDB(B1, 0, 1); PG8_STAGE(PG8_SB(0, 0), b2, voffB);
            PG8_BAR; PG8_WAIT_L(0); PG8_MMA(0, 1, At, B1); PG8_BAR;
            PG8_LDA(At, 0, 1); PG8_STAGE(PG8_SA(0, 0), a2, voffA);
            PG8_BAR; PG8_WAIT_L(0); PG8_MMA(1, 0, At, B0); PG8_BAR; PG8_SCHED;
            PG8_STAGE(PG8_SB(0, 1), b2 + hstep, voffB);
            PG8_WAIT_V(6); PG8_BAR; PG8_MMA(1, 1, At, B1); PG8_BAR;
            PG8_LDB(B0, 1, 0); PG8_SCHED; PG8_LDA(At, 1, 0); PG8_STAGE(PG8_SA(0, 1), a2 + hstep, voffA);
            PG8_WAIT_L(8); PG8_BAR; PG8_WAIT_L(0); PG8_MMA(0, 0, At, B0); PG8_BAR; PG8_SCHED;
            PG8_LDB(B1, 1, 1); PG8_STAGE(PG8_SB(1, 0), b3, voffB);
            PG8_BAR; PG8_WAIT_L(0); PG8_MMA(0, 1, At, B1); PG8_BAR;
            PG8_LDA(At, 1, 1); PG8_STAGE(PG8_SA(1, 0), a3, voffA);
            PG8_BAR; PG8_WAIT_L(0); PG8_MMA(1, 0, At, B0); PG8_BAR; PG8_SCHED;
            PG8_STAGE(PG8_SB(1, 1), b3 + hstep, voffB);
            PG8_WAIT_V(6); PG8_BAR; PG8_MMA(1, 1, At, B1); PG8_BAR;
            }
        }
        if constexpr (ALIGN_EPI) { if (wr == 0) PG8_BAR; }
        if constexpr (!Epi::AFTER_DRAIN) { E(acc, cur, wr, wc, fr, fq); S.done(cur); }
        if (!has_next) break;
#pragma unroll
        for (int a = 0; a < 2; ++a)
#pragma unroll
            for (int b = 0; b < 2; ++b)
#pragma unroll
                for (int m = 0; m < 4; ++m)
#pragma unroll
                    for (int n = 0; n < 2; ++n) acc[a][b][m][n] = (f32x4){0.f, 0.f, 0.f, 0.f};
        cur = nxt; cA = nA; cB = nB; ++ui;
        if constexpr (ALIGN_EPI) { if (wr == 1) PG8_BAR; }
    }
    PG8_WAIT_V(0);
    if constexpr (!ALIGN_EPI) { if (wr == 0) PG8_BAR; }
    PG8_BAR;
    if constexpr (Epi::AFTER_DRAIN) { E.fused(acc, cur, wr, wc, fr, fq, lds, wid, lane); S.done(cur); }
#undef PG8_SA
#undef PG8_SB
#undef PG8_STAGE
#undef PG8_LDA
#undef PG8_LDB
#undef PG8_MMA
#undef PG8_WAIT_V
#undef PG8_WAIT_L
#undef PG8_BAR
#undef PG8_SCHED
}
}
namespace attn_body {
using bf16=__hip_bfloat16;
using bf16x8=__attribute__((ext_vector_type(8)))short;
using s16x4=__attribute__((ext_vector_type(4)))short;
using f32x16=__attribute__((ext_vector_type(16)))float;
using u32x4=__attribute__((ext_vector_type(4)))unsigned;
constexpr int D=64;
constexpr int NW=8,QBLK=32,QB=QBLK*NW,KVBLK=64;
constexpr int ATTN_UNIT_ROWS=QB;
__device__ __forceinline__ int crow(int r,int hi){return (r&3)+8*(r>>2)+4*hi;}
#define SBAR() __builtin_amdgcn_sched_barrier(0)
__device__ __forceinline__ void swamask(f32x16&p0,f32x16&p1,int dq0,bool tin,int hi){
  const float NEG=-INFINITY;
  #pragma unroll
  for(int r=0;r<16;++r){const int kv=4*hi+(r&3)+8*(r>>2); const int d0=dq0-kv, d1=d0-32;
    if(!(tin&&d0>=-128&&d0<=128))p0[r]=NEG; if(!(tin&&d1>=-128&&d1<=128))p1[r]=NEG;}
}

constexpr int NSLOT=3, SLOTB=8192;
constexpr int LDS_K=0, LDS_V=NSLOT*SLOTB, LDS_WS=2*NSLOT*SLOTB, LDS_OST=LDS_WS+NW*64*4, LDS_BYTES=LDS_OST+NW*4096;
constexpr float C2A=0.125f*1.4426950408889634f;
__device__ __forceinline__ void glds16(const void*gsrc,unsigned lds_dst){unsigned keep;
  asm volatile("s_mov_b32 %0, m0\n\ts_mov_b32 m0, %2\n\ts_nop 0\n\tglobal_load_lds_dwordx4 %1, off\n\ts_mov_b32 m0, %0":"=&s"(keep):"v"(gsrc),"s"(lds_dst):"memory");}
__device__ __forceinline__ float max3f(float a,float b,float c){float r;asm("v_max3_f32 %0, %1, %2, %3":"=v"(r):"v"(a),"v"(b),"v"(c));return r;}
__device__ __forceinline__ float max2f(float a,float b){float r;asm("v_max_f32_e32 %0, %1, %2":"=v"(r):"v"(a),"v"(b));return r;}
__device__ __forceinline__ float fadd_s(float a,float b){float r;asm("v_add_f32_e32 %0, %1, %2":"=v"(r):"v"(a),"v"(b));return r;}
__device__ __forceinline__ float fsub_s(float a,float b){float r;asm("v_sub_f32_e32 %0, %1, %2":"=v"(r):"v"(a),"v"(b));return r;}
typedef float f32x2_t __attribute__((ext_vector_type(2))); typedef __bf16 bf16x2_t __attribute__((ext_vector_type(2)));
__device__ __forceinline__ unsigned cvtpk_s(float lo,float hi){f32x2_t v={lo,hi};bf16x2_t b=__builtin_convertvector(v,bf16x2_t);return __builtin_bit_cast(unsigned,b);}
#define WAIT_BAR(N) asm volatile("s_waitcnt vmcnt(" #N ") lgkmcnt(0)\n\ts_barrier":::"memory")

__device__ __forceinline__ void qkt(f32x16&p0,f32x16&p1,const char*Kslot,const bf16x8*qr,const f32x16&negm,int r32,int hi){
  const char*kb=Kslot+hi*1024+r32*16;
  #pragma unroll
  for(int d0=0;d0<4;++d0){
    const bf16x8 b0=*reinterpret_cast<const bf16x8*>(kb+d0*2048);
    const bf16x8 b1=*reinterpret_cast<const bf16x8*>(kb+d0*2048+512);
    if(d0==0){p0=__builtin_amdgcn_mfma_f32_32x32x16_bf16(b0,qr[0],negm,0,0,0);p1=__builtin_amdgcn_mfma_f32_32x32x16_bf16(b1,qr[0],negm,0,0,0);}
    else{p0=__builtin_amdgcn_mfma_f32_32x32x16_bf16(b0,qr[d0],p0,0,0,0);p1=__builtin_amdgcn_mfma_f32_32x32x16_bf16(b1,qr[d0],p1,0,0,0);}}
}
typedef __attribute__((address_space(3))) const char* lds_cptr;
typedef short v4i16_t __attribute__((ext_vector_type(4)));
__device__ __forceinline__ void kload8(bf16x8*kf,lds_cptr kp){
  kf[0]=*(const __attribute__((address_space(3))) bf16x8*)(kp);      kf[1]=*(const __attribute__((address_space(3))) bf16x8*)(kp+512);
  kf[2]=*(const __attribute__((address_space(3))) bf16x8*)(kp+2048); kf[3]=*(const __attribute__((address_space(3))) bf16x8*)(kp+2560);
  kf[4]=*(const __attribute__((address_space(3))) bf16x8*)(kp+4096); kf[5]=*(const __attribute__((address_space(3))) bf16x8*)(kp+4608);
  kf[6]=*(const __attribute__((address_space(3))) bf16x8*)(kp+6144); kf[7]=*(const __attribute__((address_space(3))) bf16x8*)(kp+6656);
}
__device__ __forceinline__ void kload2(bf16x8*kf,lds_cptr kp,int j){ kf[2*j]=*(const __attribute__((address_space(3))) bf16x8*)(kp+j*2048); kf[2*j+1]=*(const __attribute__((address_space(3))) bf16x8*)(kp+j*2048+512); }
__device__ __forceinline__ s16x4 vtr(lds_cptr p){ return __builtin_bit_cast(s16x4,__builtin_amdgcn_ds_read_tr16_b64_v4i16((__attribute__((address_space(3))) v4i16_t*)p)); }
__device__ __forceinline__ float rowmax(const f32x16&p0,const f32x16&p1){
  float a=max3f(p0[0],p0[1],p1[0]),b=max3f(p0[2],p0[3],p1[1]);a=max3f(a,p1[2],p1[3]);
  #pragma unroll
  for(int r=4;r<16;r+=4){a=max3f(a,p0[r],p0[r+1]);b=max3f(b,p0[r+2],p0[r+3]);a=max3f(a,p1[r],p1[r+1]);b=max3f(b,p1[r+2],p1[r+3]);}
  const float m=max2f(a,b);
  auto rr=__builtin_amdgcn_permlane32_swap(__float_as_uint(m),__float_as_uint(m),false,false);
  return max2f(__uint_as_float(rr[0]),__uint_as_float(rr[1]));
}
__device__ __forceinline__ void pv(f32x16*o,int vb,bf16x8 pa0,bf16x8 pa1,bf16x8 pa2,bf16x8 pa3){
  #pragma unroll
  for(int d0=0;d0<2;++d0){s16x4 lo[4],hi[4];
    #pragma unroll
    for(int ks=0;ks<4;++ks){
      asm volatile("ds_read_b64_tr_b16 %0,%1 offset:%c2":"=&v"(lo[ks]):"v"(vb),"i"(d0*4096+ks*1024):"memory");
      asm volatile("ds_read_b64_tr_b16 %0,%1 offset:%c2":"=&v"(hi[ks]):"v"(vb),"i"(d0*4096+ks*1024+512):"memory");}
    asm volatile("s_waitcnt lgkmcnt(0)":::"memory");SBAR();
    #define PK(k) (bf16x8){lo[k][0],lo[k][1],lo[k][2],lo[k][3],hi[k][0],hi[k][1],hi[k][2],hi[k][3]}
    o[d0]=__builtin_amdgcn_mfma_f32_32x32x16_bf16(pa0,PK(0),o[d0],0,0,0);
    o[d0]=__builtin_amdgcn_mfma_f32_32x32x16_bf16(pa1,PK(1),o[d0],0,0,0);
    o[d0]=__builtin_amdgcn_mfma_f32_32x32x16_bf16(pa2,PK(2),o[d0],0,0,0);
    o[d0]=__builtin_amdgcn_mfma_f32_32x32x16_bf16(pa3,PK(3),o[d0],0,0,0);
    #undef PK
  }
}

#ifndef ATTN_STORE16
#define ATTN_STORE16(p,v) (*(u32x4*)(p)=(v))
#endif
template<int THRL,int MODE> __device__ __forceinline__ void attn_unit(const bf16*Qw0,int QP,const bf16*__restrict__ Kh,int KP,const bf16*__restrict__ Vh,int VP,bf16*Ow0,int OP,int NT,int tau0,float sink_l2,char*shm){
  const int tid=threadIdx.x,lane=tid&63,r32=lane&31,hi=lane>>5; const int wid=__builtin_amdgcn_readfirstlane(tid>>6);
  const bf16*Qw=Qw0+(long)(wid*QBLK)*QP;
  const unsigned lds0=(unsigned)(uintptr_t)shm;
  float*wsf=(float*)(shm+LDS_WS)+wid*64;
  const bf16*ksrc=Kh+(long)lane*KP+wid*8;
  const bf16*vsrc=Vh+(long)(16*(wid&3)+(lane>>2))*VP+(wid>>2)*32+(lane&3)*8;
  const unsigned kdst=lds0+LDS_K+wid*1024, vdst=lds0+LDS_V+wid*1024;
  #define TROW(t) ((MODE==0||(t)<4)?(long)(t)*KVBLK:(long)(256+min(max(tau0-128+64*((t)-4),0),8192-64)))
  #define DMA_K(t,slot) glds16(ksrc+TROW(t)*KP,(unsigned)__builtin_amdgcn_readfirstlane(kdst+(slot)))
  #define DMA_V(t,slot) glds16(vsrc+TROW(t)*VP,(unsigned)__builtin_amdgcn_readfirstlane(vdst+(slot)))
  const int vb0=(int)(lds0+LDS_V)+((lane>>4)&1)*32+(lane&3)*8+(4*hi+((lane&15)>>2))*64;
  const char*Kbase=shm+LDS_K; bf16x8 kf[8];
  const lds_cptr shm3=(lds_cptr)shm; const lds_cptr kp0=shm3+LDS_K+hi*1024+r32*16; const lds_cptr vp0=shm3+LDS_V+((lane>>4)&1)*32+(lane&3)*8+(4*hi+((lane&15)>>2))*64;
  DMA_K(0,0);DMA_V(0,0);DMA_K(1,SLOTB);
  bf16x8 qr[4];
  #pragma unroll
  for(int d0=0;d0<4;++d0)qr[d0]=*reinterpret_cast<const bf16x8*>(&Qw[(long)r32*QP+d0*16+hi*8]);
  float mhat=0.f,l_reg=0.f;f32x16 o[2];o[0]=f32x16{};o[1]=f32x16{};f32x16 negm=f32x16{};asm volatile("":"+v"(negm));
  const int qrel=wid*QBLK+r32;
  #define CMASK(P0,P1,t) do{ if(MODE==1){ if((t)>=4){ const int ts_=tau0-128+64*((t)-4); swamask(P0,P1,qrel+128-64*((t)-4),(ts_>=0&&ts_<8192),hi);} } }while(0)
  bool resc=false;
  #define START(P0,P1) do{ const float rm=rowmax(P0,P1); resc=false; \
    { const float dl=rm; mhat=fadd_s(mhat,dl); \
      _Pragma("unroll") for(int r=0;r<16;++r){P0[r]=fsub_s(P0[r],dl);P1[r]=fsub_s(P1[r],dl);} \
      _Pragma("unroll") for(int r=0;r<16;++r)negm[r]=-mhat; asm volatile("":"+v"(negm)); } \
    _Pragma("unroll") for(int r=0;r<16;++r)P0[r]=__builtin_amdgcn_exp2f(P0[r]); }while(0)
  #define RESC() do{ if(resc){ asm volatile("s_waitcnt lgkmcnt(0)":::"memory"); \
      _Pragma("unroll") for(int d_=0;d_<2;++d_) _Pragma("unroll") for(int r=0;r<16;++r)o[d_][r]*=wsf[crow(r,hi)]; } }while(0)
  f32x16 pA0,pA1,pB0,pB1;
  int sl_prev=0,sl_cur=0,sl_next=SLOTB;
  #define ROT() do{sl_prev=sl_cur;sl_cur=sl_next;sl_next=(sl_next==(NSLOT-1)*SLOTB)?0:sl_next+SLOTB;}while(0)
  DMA_K(2,2*SLOTB);
  WAIT_BAR(3);
  qkt(pA0,pA1,Kbase,qr,negm,r32,hi);asm volatile("s_nop 15\n\ts_nop 7":"+v"(pA0),"+v"(pA1));CMASK(pA0,pA1,0);
  START(pA0,pA1);
  _Pragma("unroll") for(int r=0;r<16;++r)pA1[r]=__builtin_amdgcn_exp2f(pA1[r]);
  WAIT_BAR(0);
  DMA_K(3,0);DMA_V(1,SLOTB);
  ROT();
  kload8(kf,kp0+sl_cur);
  WAIT_BAR(2);
  s16x4 vlo[8],vhi[8]; u32x4 pw0,pw1,pw2,pw3;
  #define PKW(P,B) cvtpk_s(P[B],P[B+1])
  #define PAF(k) __builtin_bit_cast(bf16x8,pw##k)
  #define VFR(i) (bf16x8){vlo[i][0],vlo[i][1],vlo[i][2],vlo[i][3],vhi[i][0],vhi[i][1],vhi[i][2],vhi[i][3]}
  #define PIN(x) asm volatile("":"+v"(x))
  #define MX3(a,b,c) __builtin_fmaxf(__builtin_fmaxf((a),(b)),(c))
  #define GAPA(MF,A0,A1,A2,A3,W0,W1,PW) do{ MF; sacc+=A0; sacc+=A1; sacc+=A2; sacc+=A3; PIN(sacc); W0; W1; PIN(PW); SBAR(); }while(0)
  #define EX(v) __builtin_amdgcn_exp2f(v)
  #define GAPB(MF,X,B) do{ MF; X[B]=EX(X[B]); X[B+1]=EX(X[B+1]); X[B+2]=EX(X[B+2]); X[B+3]=EX(X[B+3]); PIN(X); SBAR(); }while(0)
  #define VRD(i) do{ vlo[i]=vtr(vp_+(((i)>>2)*4096+((i)&3)*1024)); vhi[i]=vtr(vp_+(((i)>>2)*4096+((i)&3)*1024+512)); }while(0)
  #define KRD(G,j) do{ if(G){ kload2(kf,kp0+sl_next,j); SBAR(); } }while(0)
  #define STEP(C0,C1,P0,P1,t,GK,GV,GL) do{ SBAR(); \
    const lds_cptr vp_=vp0+sl_prev; \
    VRD(0); SBAR(); float sacc=(P0[0]+P0[1]); \
    GAPA(C0=__builtin_amdgcn_mfma_f32_32x32x16_bf16(kf[0],qr[0],negm,0,0,0), P0[2],P0[3],P0[4],P0[5],     pw0[0]=PKW(P0,0), pw0[1]=PKW(P0,2), pw0); \
    VRD(4); SBAR(); GAPA(C1=__builtin_amdgcn_mfma_f32_32x32x16_bf16(kf[1],qr[0],negm,0,0,0), P0[6],P0[7],P0[8],P0[9],     pw0[2]=PKW(P0,4), pw0[3]=PKW(P0,6), pw0); \
    VRD(1); SBAR(); GAPA(C0=__builtin_amdgcn_mfma_f32_32x32x16_bf16(kf[2],qr[1],C0,0,0,0),   P0[10],P0[11],P0[12],P0[13], pw1[0]=PKW(P0,8), pw1[1]=PKW(P0,10), pw1); \
    VRD(5); SBAR(); GAPA(C1=__builtin_amdgcn_mfma_f32_32x32x16_bf16(kf[3],qr[1],C1,0,0,0),   P0[14],P0[15],P1[0],P1[1],   pw1[2]=PKW(P0,12),pw1[3]=PKW(P0,14), pw1); \
    VRD(2); SBAR(); GAPA(C0=__builtin_amdgcn_mfma_f32_32x32x16_bf16(kf[4],qr[2],C0,0,0,0),   P1[2],P1[3],P1[4],P1[5],     pw2[0]=PKW(P1,0), pw2[1]=PKW(P1,2), pw2); \
    VRD(6); SBAR(); GAPA(C1=__builtin_amdgcn_mfma_f32_32x32x16_bf16(kf[5],qr[2],C1,0,0,0),   P1[6],P1[7],P1[8],P1[9],     pw2[2]=PKW(P1,4), pw2[3]=PKW(P1,6), pw2); \
    VRD(3); SBAR(); GAPA(C0=__builtin_amdgcn_mfma_f32_32x32x16_bf16(kf[6],qr[3],C0,0,0,0),   P1[10],P1[11],P1[12],P1[13], pw3[0]=PKW(P1,8), pw3[1]=PKW(P1,10), pw3); \
    VRD(7); SBAR(); GAPA(C1=__builtin_amdgcn_mfma_f32_32x32x16_bf16(kf[7],qr[3],C1,0,0,0),   P1[14],P1[15],0.f,0.f,       pw3[2]=PKW(P1,12),pw3[3]=PKW(P1,14), pw3); \
    l_reg+=sacc; \
    if(GK){DMA_K((t)+3,sl_cur);} if(GV){DMA_V((t)+1,sl_next);} \
    CMASK(C0,C1,t); \
    { float a=MX3(C0[0],C0[1],C1[0]),b=MX3(C0[2],C0[3],C1[1]); a=MX3(a,C1[2],C1[3]); \
      _Pragma("unroll") for(int r=4;r<16;r+=4){a=MX3(a,C0[r],C0[r+1]);b=MX3(b,C0[r+2],C0[r+3]);a=MX3(a,C1[r],C1[r+1]);b=MX3(b,C1[r+2],C1[r+3]);} \
      float rm=__builtin_fmaxf(a,b); { auto rr=__builtin_amdgcn_permlane32_swap(__float_as_uint(rm),__float_as_uint(rm),false,false); rm=__builtin_fmaxf(__uint_as_float(rr[0]),__uint_as_float(rr[1])); } \
      resc=false; \
      if(__builtin_expect(__any(rm>(float)THRL),0)){ const float dl=__builtin_fmaxf(rm,0.f); mhat+=dl; \
        _Pragma("unroll") for(int r=0;r<16;++r){C0[r]-=dl;C1[r]-=dl;} \
        _Pragma("unroll") for(int r=0;r<16;++r)negm[r]=-mhat; asm volatile("":"+v"(negm)); \
        const float f=__builtin_amdgcn_exp2f(-dl); l_reg*=f; if(hi==0)wsf[r32]=f; resc=true; } } \
    SBAR(); \
    GAPB(o[0]=__builtin_amdgcn_mfma_f32_32x32x16_bf16(PAF(0),VFR(0),o[0],0,0,0), C0,0); \
    GAPB(o[1]=__builtin_amdgcn_mfma_f32_32x32x16_bf16(PAF(0),VFR(4),o[1],0,0,0), C0,4); \
    KRD(GL,0); GAPB(o[0]=__builtin_amdgcn_mfma_f32_32x32x16_bf16(PAF(1),VFR(1),o[0],0,0,0), C0,8); \
    KRD(GL,1); GAPB(o[1]=__builtin_amdgcn_mfma_f32_32x32x16_bf16(PAF(1),VFR(5),o[1],0,0,0), C0,12); \
    KRD(GL,2); GAPB(o[0]=__builtin_amdgcn_mfma_f32_32x32x16_bf16(PAF(2),VFR(2),o[0],0,0,0), C1,0); \
    KRD(GL,3); GAPB(o[1]=__builtin_amdgcn_mfma_f32_32x32x16_bf16(PAF(2),VFR(6),o[1],0,0,0), C1,4); \
    GAPB(o[0]=__builtin_amdgcn_mfma_f32_32x32x16_bf16(PAF(3),VFR(3),o[0],0,0,0), C1,8); \
    GAPB(o[1]=__builtin_amdgcn_mfma_f32_32x32x16_bf16(PAF(3),VFR(7),o[1],0,0,0), C1,12); \
    }while(0)
  int t=1;
  for(;t+5<NT;t+=2){
    STEP(pB0,pB1,pA0,pA1,t,true,true,true);     WAIT_BAR(2); RESC(); ROT();
    STEP(pA0,pA1,pB0,pB1,t+1,true,true,true);   WAIT_BAR(2); RESC(); ROT();
  }
  #define ENDW(tt) do{ if((tt)+3<NT){WAIT_BAR(2);} else if((tt)+2<NT){WAIT_BAR(1);} else {WAIT_BAR(0);} }while(0)
  for(;t+1<NT;t+=2){
    STEP(pB0,pB1,pA0,pA1,t,(t+3<NT),(t+1<NT),(t+1<NT));       ENDW(t);   RESC(); ROT();
    STEP(pA0,pA1,pB0,pB1,t+1,(t+4<NT),(t+2<NT),(t+2<NT));     ENDW(t+1); RESC(); ROT();
  }
  STEP(pB0,pB1,pA0,pA1,NT-1,false,false,false); RESC();
  { float sacc=pB0[0]+pB0[1]; _Pragma("unroll") for(int r=2;r<16;++r)sacc+=pB0[r]; _Pragma("unroll") for(int r=0;r<16;++r)sacc+=pB1[r]; l_reg+=sacc;
    pw0=(u32x4){PKW(pB0,0),PKW(pB0,2),PKW(pB0,4),PKW(pB0,6)};pw1=(u32x4){PKW(pB0,8),PKW(pB0,10),PKW(pB0,12),PKW(pB0,14)};pw2=(u32x4){PKW(pB1,0),PKW(pB1,2),PKW(pB1,4),PKW(pB1,6)};pw3=(u32x4){PKW(pB1,8),PKW(pB1,10),PKW(pB1,12),PKW(pB1,14)};
    SBAR(); pv(o,vb0+sl_cur,PAF(0),PAF(1),PAF(2),PAF(3)); }
  #undef PKW
  #undef PAF
  #undef VFR
  #undef PIN
  #undef MX3
  #undef GAPA
  #undef GAPB
  #undef EX
  #undef VRD
  #undef KRD
  #undef STEP
  #undef ENDW
  {auto rr=__builtin_amdgcn_permlane32_swap(__float_as_uint(l_reg),__float_as_uint(l_reg),false,false);l_reg=__uint_as_float(rr[0])+__uint_as_float(rr[1]);}
  if(MODE==1)l_reg+=__builtin_amdgcn_exp2f(sink_l2-mhat);
  if(hi==0)wsf[32+r32]=l_reg;asm volatile("s_waitcnt lgkmcnt(0)":::"memory");
  float rli[16];
  #pragma unroll
  for(int r=0;r<16;++r)rli[r]=__builtin_amdgcn_rcpf(wsf[32+crow(r,hi)]);
  bf16*Ow=Ow0+(long)(wid*QBLK)*OP;
  { bf16*stg=(bf16*)(shm+LDS_OST)+wid*2048;
    #pragma unroll
    for(int r=0;r<16;++r){const int orow=crow(r,hi);
      #pragma unroll
      for(int d0=0;d0<2;++d0)stg[orow*64+d0*32+r32]=__float2bfloat16(o[d0][r]*rli[r]);}
    asm volatile("s_waitcnt lgkmcnt(0)":::"memory");
    #pragma unroll
    for(int i=0;i<4;++i){const int row=i*8+(lane>>3),ch=lane&7; const u32x4 v=*(const u32x4*)(stg+row*64+ch*8); ATTN_STORE16(Ow+(long)row*OP+ch*8,v);} }
  asm volatile("s_waitcnt lgkmcnt(0)\n\ts_barrier":::"memory");
  #undef DMA_K
  #undef TROW
  #undef DMA_V
  #undef CMASK
  #undef START
  #undef RESC
  #undef ROT
}
constexpr int ATTN_LDS_BYTES=LDS_BYTES;
#undef SBAR
#undef WAIT_BAR
}

typedef unsigned u32x2f __attribute__((ext_vector_type(2)));
constexpr int NWAVES = 8;
constexpr int LDS_BYTES = 147456;
__device__ __forceinline__ float wave_sum(float v) {
#pragma unroll
    for (int o = 1; o < 64; o <<= 1) v += __shfl_xor(v, o);
    return v;
}
__device__ __forceinline__ float bf2f(unsigned short h) { return __uint_as_float((unsigned)h << 16); }
__device__ __forceinline__ float silu_d(float v) { return v / (1.f + __expf(-v)); }

__device__ __forceinline__ void transpose_item(const float* Wsrc, int ldw, bf16* dst, int ldd, LAS float* scr, int lane) {
#pragma unroll 8
    for (int i = 0; i < 32; ++i) { const int kk = 2 * i + (lane >> 5); scr[kk * 33 + (lane & 31)] = Wsrc[(size_t)kk * ldw + (lane & 31)]; }
    LDS_WAIT(); asm volatile("" ::: "memory");
    const int c = lane & 7;
#pragma unroll
    for (int j = 0; j < 4; ++j) { const int n = (lane >> 3) + 8 * j; const LAS float* s = scr + (8 * c) * 33 + n;
        v4u o; o.x = pk2(s[0 * 33], s[1 * 33]); o.y = pk2(s[2 * 33], s[3 * 33]); o.z = pk2(s[4 * 33], s[5 * 33]); o.w = pk2(s[6 * 33], s[7 * 33]);
        *(GAS v4u*)(dst + (size_t)n * ldd + 8 * c) = o; }
    LDS_WAIT(); asm volatile("" ::: "memory");
}
__device__ __forceinline__ void moe_weight_item(int it, const float* wg, const float* wu, const float* wd, bf16* W13, bf16* W2, LAS float* scr, int lane) {
    const int e = it / 1536, rem = it % 1536, which = rem >> 9, item = rem & 511, kb = item >> 5, nb = item & 31;
    const float* W = which == 0 ? wg : which == 1 ? wu : wd;
    const float* src = W + ((size_t)e * 1024 + 64 * kb) * 1024 + 32 * nb;
    bf16* dst = which < 2 ? W13 + ((size_t)e * 2048 + (nb >> 2) * 256 + which * 128 + (nb & 3) * 32) * 1024 + 64 * kb
                          : W2 + ((size_t)e * 1024 + 32 * nb) * 1024 + 64 * kb;
    transpose_item(src, 1024, dst, 1024, scr, lane);
}

__device__ __forceinline__ void normmod_row(f32x4 (&v)[4], const float* g, const float* sc, const float* sh, int lane) {
    float s2 = 0.f;
#pragma unroll
    for (int j = 0; j < 4; ++j) s2 += (v[j].x * v[j].x + v[j].y * v[j].y) + (v[j].z * v[j].z + v[j].w * v[j].w);
    const float rstd = 1.f / sqrtf(wave_sum(s2) * (1.f / 1024.f) + EPS_);
#pragma unroll
    for (int j = 0; j < 4; ++j) { const f32x4 gv = *((const f32x4*)g + 64 * j + lane), scv = *((const f32x4*)sc + 64 * j + lane), shv = *((const f32x4*)sh + 64 * j + lane);
        v[j] = v[j] * rstd * gv * (1.f + scv) + shv; }
}
__device__ __forceinline__ void store_row_bf16(const f32x4 (&v)[4], bf16* orow, int lane) {
    GAS unsigned long long* o8 = (GAS unsigned long long*)orow + lane;
#pragma unroll
    for (int j = 0; j < 4; ++j) o8[64 * j] = (unsigned long long)pk2(v[j].x, v[j].y) | ((unsigned long long)pk2(v[j].z, v[j].w) << 32);
}
__device__ __forceinline__ void load_row_f32(f32x4 (&v)[4], const float* xrow, int lane) {
    const f32x4* xr = (const f32x4*)xrow + lane;
#pragma unroll
    for (int j = 0; j < 4; ++j) v[j] = xr[64 * j];
}
__device__ __forceinline__ void add_moe_rows(f32x4 (&v)[4], const bf16* y0, const bf16* y1, const float* gate, int lane) {
#pragma unroll
    for (int j = 0; j < 4; ++j) { const u32x2f a = *((const u32x2f*)y0 + 64 * j + lane), b = *((const u32x2f*)y1 + 64 * j + lane); const f32x4 gv = *((const f32x4*)gate + 64 * j + lane);
        f32x4 f; f.x = __uint_as_float(a.x << 16) + __uint_as_float(b.x << 16); f.y = __uint_as_float(a.x & 0xffff0000u) + __uint_as_float(b.x & 0xffff0000u);
        f.z = __uint_as_float(a.y << 16) + __uint_as_float(b.y << 16); f.w = __uint_as_float(a.y & 0xffff0000u) + __uint_as_float(b.y & 0xffff0000u);
        v[j] = v[j] + gv * f; }
}

typedef float f32x2g __attribute__((ext_vector_type(2)));
constexpr int HG_QI = 0, HG_QN = 17408, HG_KO = 34816, HG_VT = 52224, HG_SC = 70656, HG_ST = 79872, HG_SCR = 114688;
constexpr int HG_LDQ = 272, HG_LDT = 144;
typedef short hbf16x8 __attribute__((ext_vector_type(8)));
typedef float hf32x4 __attribute__((ext_vector_type(4)));
__device__ __forceinline__ int hg_chunk(int dir, int j) { return dir == 0 ? j : (j < 4 ? 3 - j : 135 - j); }
__device__ __forceinline__ void hg_scan(const float* lfp, int dir, int dk, int tq, LAS float* scr, float (&v)[16], float (&cum)[16], float& tot, float& ref) {
#pragma unroll
    for (int i = 0; i < 16; ++i) v[i] = lfp[(size_t)(16 * tq + i) * 512 + dk];
    float c[16]; float run = 0.f;
#pragma unroll
    for (int i = 0; i < 16; ++i) { run += v[i]; c[i] = run; }
    scr[tq * 128 + dk] = run;
    __syncthreads();
    const float q0 = scr[dk], q1 = scr[128 + dk], q2 = scr[256 + dk], q3 = scr[384 + dk];
    tot = (q0 + q1) + (q2 + q3);
    if (dir == 0) { const float off = (tq > 0 ? q0 : 0.f) + (tq > 1 ? q1 : 0.f) + (tq > 2 ? q2 : 0.f);
#pragma unroll
        for (int i = 0; i < 16; ++i) cum[i] = c[i] + off;
        ref = q0 + q1; }
    else { const float off = (tq < 3 ? q3 : 0.f) + (tq < 2 ? q2 : 0.f) + (tq < 1 ? q1 : 0.f);
#pragma unroll
        for (int i = 0; i < 16; ++i) cum[i] = (run - c[i] + v[i]) + off;
        ref = q2 + q3; }
    __syncthreads();
}
__device__ __forceinline__ void hg_load_vt(const bf16* ivp, LAS unsigned char* L, int tid) {
    const int dv = tid & 127, tq = tid >> 7; unsigned w[8];
#pragma unroll
    for (int i = 0; i < 8; ++i) { const unsigned lo = ivp[(size_t)(16 * tq + 2 * i) * 512 + dv], hi = ivp[(size_t)(16 * tq + 2 * i + 1) * 512 + dv]; w[i] = lo | (hi << 16); }
    LAS v4u* d = (LAS v4u*)(L + HG_VT + dv * HG_LDT + tq * 32);
    d[0] = (v4u){w[0], w[1], w[2], w[3]}; d[1] = (v4u){w[4], w[5], w[6], w[7]};
}
__device__ __forceinline__ void hgrn_pass1_unit(int u, const float* LFF, const float* LFB, const bf16* IV, bf16* U, float* TOT, LAS unsigned char* L, int tid, int wave, int lane) {
    const int j = u % NCHUNK, sq = u / NCHUNK, dir = sq >> 3, b = (sq >> 2) & 1, h = sq & 3;
    const int n = hg_chunk(dir, j); const size_t row0 = (size_t)b * SB + 64 * j;
    const int dk = tid & 127, tq = tid >> 7;
    float v[16], cum[16], tot, ref;
    hg_scan((dir ? LFB : LFF) + row0 * 512 + h * 128, dir, dk, tq, (LAS float*)(L + HG_SCR), v, cum, tot, ref);
    unsigned w[8];
#pragma unroll
    for (int i = 0; i < 8; ++i) { const float k0 = (1.f - __expf(v[2 * i])) * __expf(tot - cum[2 * i]), k1 = (1.f - __expf(v[2 * i + 1])) * __expf(tot - cum[2 * i + 1]); w[i] = pk2(k0, k1); }
    { LAS v4u* d = (LAS v4u*)(L + HG_QI + dk * HG_LDT + tq * 32); d[0] = (v4u){w[0], w[1], w[2], w[3]}; d[1] = (v4u){w[4], w[5], w[6], w[7]}; }
    if (tq == 0) TOT[((size_t)sq * NCHUNK + n) * 128 + dk] = tot;
    hg_load_vt(IV + row0 * 512 + h * 128, L, tid);
    __syncthreads();
    hf32x4 acc[8];
#pragma unroll
    for (int nt = 0; nt < 8; ++nt) acc[nt] = (hf32x4){0.f, 0.f, 0.f, 0.f};
    const int fr = lane & 15, fq = lane >> 4;
#pragma unroll
    for (int kk = 0; kk < 2; ++kk) { const hbf16x8 A = *(const LAS hbf16x8*)(L + HG_QI + (16 * wave + fr) * HG_LDT + kk * 64 + fq * 16);
#pragma unroll
        for (int nt = 0; nt < 8; ++nt) { const hbf16x8 B = *(const LAS hbf16x8*)(L + HG_VT + (16 * nt + fr) * HG_LDT + kk * 64 + fq * 16);
            acc[nt] = __builtin_amdgcn_mfma_f32_16x16x32_bf16(A, B, acc[nt], 0, 0, 0); } }
    bf16* up = U + ((size_t)sq * NCHUNK + n) * 16384 + 16 * wave + 4 * fq;
#pragma unroll
    for (int nt = 0; nt < 8; ++nt) { u32x2f o; o.x = pk2(acc[nt][0], acc[nt][1]); o.y = pk2(acc[nt][2], acc[nt][3]); *(u32x2f*)(up + (size_t)(16 * nt + fr) * 128) = o; }
    __syncthreads();
}
__device__ __forceinline__ void hgrn_pass2(const bf16* U, const float* TOT, bf16* S, int gtid, int nthreads) {
    for (int idx = gtid; idx < 16 * 8192; idx += nthreads) {
        const int sq = idx >> 13, p = idx & 8191;
        const unsigned* up = (const unsigned*)(U + (size_t)sq * NCHUNK * 16384) + p; unsigned* sp = (unsigned*)(S + (size_t)sq * NCHUNK * 16384) + p;
        const f32x2g* tp = (const f32x2g*)(TOT + (size_t)sq * NCHUNK * 128) + (p & 63);
        float s0 = 0.f, s1 = 0.f;
        for (int n = 0; n < NCHUNK; n += 4) {
            unsigned uu[4]; f32x2g tt[4];
#pragma unroll
            for (int k = 0; k < 4; ++k) { uu[k] = up[(size_t)(n + k) * 8192]; tt[k] = tp[(size_t)(n + k) * 64]; }
#pragma unroll
            for (int k = 0; k < 4; ++k) { sp[(size_t)(n + k) * 8192] = pk2(s0, s1);
                s0 = __expf(tt[k].x) * s0 + __uint_as_float(uu[k] << 16); s1 = __expf(tt[k].y) * s1 + __uint_as_float(uu[k] & 0xffff0000u); }
        }
    }
}
__device__ __forceinline__ void hgrn_pass3_unit(int u, const bf16* QH, const float* LFF, const float* LFB, const bf16* IV, const bf16* GG, const bf16* S, const float* onorm_g, bf16* Y,
                                                LAS unsigned char* L, int tid, int wave, int lane) {
    const int j = u % NCHUNK, bh = u / NCHUNK, b = bh >> 2, h = bh & 3;
    const size_t row0 = (size_t)b * SB + 64 * j;
    const int dk = tid & 127, tq = tid >> 7, fr = lane & 15, fq = lane >> 4;
    hg_load_vt(IV + row0 * 512 + h * 128, L, tid);
    float qv[16];
#pragma unroll
    for (int i = 0; i < 16; ++i) qv[i] = bf2f(QH[(row0 + 16 * tq + i) * 512 + h * 128 + dk]);
    hf32x4 acc[4];
#pragma unroll
    for (int nt = 0; nt < 4; ++nt) acc[nt] = (hf32x4){0.f, 0.f, 0.f, 0.f};
    const int mt_o = wave & 3, ntb = 4 * (wave >> 2);
    for (int dir = 0; dir < 2; ++dir) {
        const int n = hg_chunk(dir, j), sq = dir * 8 + bh;
        float v[16], cum[16], tot, ref;
        hg_scan((dir ? LFB : LFF) + row0 * 512 + h * 128, dir, dk, tq, (LAS float*)(L + HG_SCR), v, cum, tot, ref);
#pragma unroll
        for (int i = 0; i < 16; ++i) { const int t = 16 * tq + i;
            const float qi = qv[i] * __expf(cum[i] - ref), qn = qv[i] * __expf(cum[i]), ko = (1.f - __expf(v[i])) * __expf(ref - cum[i]);
            *(LAS unsigned short*)(L + HG_QI + t * HG_LDQ + dk * 2) = (unsigned short)f2bf(qi);
            *(LAS unsigned short*)(L + HG_QN + t * HG_LDQ + dk * 2) = (unsigned short)f2bf(qn);
            *(LAS unsigned short*)(L + HG_KO + t * HG_LDQ + dk * 2) = (unsigned short)f2bf(ko); }
        { const bf16* sp = S + ((size_t)sq * NCHUNK + n) * 16384 + (tid >> 2) * 128 + (tid & 3) * 32; LAS v4u* d = (LAS v4u*)(L + HG_ST + (tid >> 2) * HG_LDQ + (tid & 3) * 64);
#pragma unroll
            for (int k = 0; k < 4; ++k) d[k] = *((const GAS v4u*)sp + k); }
        __syncthreads();
        {
            const int mt = wave >> 1;
#pragma unroll
            for (int n2 = 0; n2 < 2; ++n2) { const int nt = 2 * (wave & 1) + n2; hf32x4 sc = {0.f, 0.f, 0.f, 0.f};
#pragma unroll
                for (int kk = 0; kk < 4; ++kk) { const hbf16x8 A = *(const LAS hbf16x8*)(L + HG_QI + (16 * mt + fr) * HG_LDQ + kk * 64 + fq * 16);
                    const hbf16x8 B = *(const LAS hbf16x8*)(L + HG_KO + (16 * nt + fr) * HG_LDQ + kk * 64 + fq * 16);
                    sc = __builtin_amdgcn_mfma_f32_16x16x32_bf16(A, B, sc, 0, 0, 0); }
#pragma unroll
                for (int r = 0; r < 4; ++r) { const int t = 16 * mt + 4 * fq + r, s = 16 * nt + fr; const bool keep = dir ? (s >= t) : (s <= t);
                    *(LAS unsigned short*)(L + HG_SC + t * HG_LDT + s * 2) = (unsigned short)f2bf(keep ? sc[r] : 0.f); } }
        }
        __syncthreads();
#pragma unroll
        for (int nt = 0; nt < 4; ++nt) {
#pragma unroll
            for (int kk = 0; kk < 2; ++kk) { const hbf16x8 A = *(const LAS hbf16x8*)(L + HG_SC + (16 * mt_o + fr) * HG_LDT + kk * 64 + fq * 16);
                const hbf16x8 B = *(const LAS hbf16x8*)(L + HG_VT + (16 * (ntb + nt) + fr) * HG_LDT + kk * 64 + fq * 16);
                acc[nt] = __builtin_amdgcn_mfma_f32_16x16x32_bf16(A, B, acc[nt], 0, 0, 0); }
#pragma unroll
            for (int kk = 0; kk < 4; ++kk) { const hbf16x8 A = *(const LAS hbf16x8*)(L + HG_QN + (16 * mt_o + fr) * HG_LDQ + kk * 64 + fq * 16);
                const hbf16x8 B = *(const LAS hbf16x8*)(L + HG_ST + (16 * (ntb + nt) + fr) * HG_LDQ + kk * 64 + fq * 16);
                acc[nt] = __builtin_amdgcn_mfma_f32_16x16x32_bf16(A, B, acc[nt], 0, 0, 0); }
        }
        __syncthreads();
    }
    LAS float* red = (LAS float*)(L + HG_SCR);
    float ss[4];
#pragma unroll
    for (int r = 0; r < 4; ++r) { float s = 0.f;
#pragma unroll
        for (int nt = 0; nt < 4; ++nt) s += acc[nt][r] * acc[nt][r];
        s += __shfl_xor(s, 1); s += __shfl_xor(s, 2); s += __shfl_xor(s, 4); s += __shfl_xor(s, 8); ss[r] = s; }
    if (fr == 0) {
#pragma unroll
        for (int r = 0; r < 4; ++r) red[(wave >> 2) * 64 + 16 * mt_o + 4 * fq + r] = ss[r]; }
    __syncthreads();
#pragma unroll
    for (int r = 0; r < 4; ++r) { const int t = 16 * mt_o + 4 * fq + r; const float rstd = 1.f / sqrtf((red[t] + red[64 + t]) * (1.f / 128.f) + EPS_);
#pragma unroll
        for (int nt = 0; nt < 4; ++nt) { const int dv = 16 * (ntb + nt) + fr; const float gg = bf2f(GG[(row0 + t) * 512 + h * 128 + dv]);
            Y[(row0 + t) * 1024 + h * 128 + dv] = (bf16)f2bf(acc[nt][r] * rstd * onorm_g[dv] * gg); } }
    __syncthreads();
}

struct KArgs { const float* in[23]; float* out; unsigned char* ws; int ph_lo, ph_hi, use_cg, pad; };
constexpr int N_PHASES = 21;
enum { I_X = 0, I_C, I_CTX, I_CCTX, I_ADAW, I_ADAB, I_NMIX, I_NFFN, I_EWIN, I_EWOUT, I_LBL, I_ONORM, I_DLAM, I_SUBLN, I_OWQKV, I_OWOUT, I_SINK, I_RW, I_RB, I_MG, I_MU, I_MD, I_FNG };

__device__ __forceinline__ void router_phase(const float* X, const float* gffn, const float* MODL, const float* rw, const float* rb, bf16* H2, int* EXPID, float* EXPW, int* RANK, int* CNT,
                                             bool latent_only, LAS unsigned char* L, int tid, int wave, int lane) {
    LAS float* rwT = (LAS float*)L;
    LAS int* cnt = (LAS int*)(L + 16 * 1028 * 4);
    for (int i = tid; i < 16384; i += 512) rwT[(i & 15) * 1028 + (i >> 4)] = rw[i];
    if (tid < 16) cnt[tid] = 0;
    __syncthreads();
    float rbv[16];
#pragma unroll
    for (int e = 0; e < 16; ++e) rbv[e] = rb[e];
    for (int rr = wave; rr < 66; rr += NWAVES) {
        const int r = blockIdx.x * 66 + rr, b = r / SB, s = r % SB;
        if (latent_only && s < 256) continue;
        const int vec = s < 256 ? 2 : b; const float* mp = MODL + vec * 6144;
        f32x4 v[4]; load_row_f32(v, X + (size_t)r * 1024, lane);
        normmod_row(v, gffn, mp + 4096, mp + 3072, lane);
        store_row_bf16(v, H2 + (size_t)r * 1024, lane);
        float lg[16];
#pragma unroll
        for (int e = 0; e < 16; ++e) { float a = 0.f;
#pragma unroll
            for (int j = 0; j < 4; ++j) { const f32x4 w = *(const LAS f32x4*)(rwT + e * 1028 + 256 * j + 4 * lane); a += (v[j].x * w.x + v[j].y * w.y) + (v[j].z * w.z + v[j].w * w.w); }
            lg[e] = wave_sum(a); }
        float aff[16], sel[16];
#pragma unroll
        for (int e = 0; e < 16; ++e) { aff[e] = 1.f / (1.f + __expf(-lg[e])); sel[e] = aff[e] + rbv[e]; }
        int grp = 0; float best = -1e30f;
#pragma unroll
        for (int g = 0; g < 4; ++g) { float m1 = -1e30f, m2 = -1e30f;
#pragma unroll
            for (int k = 0; k < 4; ++k) { const float x = sel[4 * g + k]; if (x > m1) { m2 = m1; m1 = x; } else if (x > m2) m2 = x; }
            const float sc = m1 + m2; if (sc > best) { best = sc; grp = g; } }
        float s4[4], a4[4];
#pragma unroll
        for (int k = 0; k < 4; ++k) { s4[k] = grp == 0 ? sel[k] : grp == 1 ? sel[4 + k] : grp == 2 ? sel[8 + k] : sel[12 + k]; a4[k] = grp == 0 ? aff[k] : grp == 1 ? aff[4 + k] : grp == 2 ? aff[8 + k] : aff[12 + k]; }
        int i1 = 0;
#pragma unroll
        for (int k = 1; k < 4; ++k) if (s4[k] > s4[i1]) i1 = k;
        int i2 = i1 == 0 ? 1 : 0;
#pragma unroll
        for (int k = 0; k < 4; ++k) if (k != i1 && k != i2 && s4[k] > s4[i2]) i2 = k;
        const float a1 = i1 == 0 ? a4[0] : i1 == 1 ? a4[1] : i1 == 2 ? a4[2] : a4[3], a2 = i2 == 0 ? a4[0] : i2 == 1 ? a4[1] : i2 == 2 ? a4[2] : a4[3];
        if (lane == 0) { const int e1 = 4 * grp + i1, e2 = 4 * grp + i2; const float inv = 1.f / (a1 + a2);
            const int r1 = __hip_atomic_fetch_add(cnt + e1, 1, __ATOMIC_RELAXED, __HIP_MEMORY_SCOPE_WORKGROUP), r2 = __hip_atomic_fetch_add(cnt + e2, 1, __ATOMIC_RELAXED, __HIP_MEMORY_SCOPE_WORKGROUP);
            EXPID[2 * r] = e1; EXPID[2 * r + 1] = e2; EXPW[2 * r] = a1 * inv; EXPW[2 * r + 1] = a2 * inv; RANK[2 * r] = r1; RANK[2 * r + 1] = r2; }
    }
    __syncthreads();
    if (tid < 16) CNT[blockIdx.x * 16 + tid] = cnt[tid];
    __syncthreads();
}
__device__ __forceinline__ void index_phase(const int* CNT, const int* EXPID, const float* EXPW, const int* RANK, const bf16* H2, int* TOKSLOT, float* ROWW, bf16* XS, int* META,
                                            bool latent_only, LAS unsigned char* L, int tid, int wave, int lane) {
    LAS int* part = (LAS int*)L;
    LAS int* base = part + 512;
    LAS int* pst = base + 16;
    { const int e = tid & 15, g = tid >> 4; int s = 0;
#pragma unroll
        for (int k = 0; k < 8; ++k) s += CNT[(8 * g + k) * 16 + e];
        part[g * 16 + e] = s; }
    __syncthreads();
    if (tid < 16) { const int e = tid; int tot = 0, off = 0; const int gb = blockIdx.x >> 3;
        for (int g = 0; g < 32; ++g) { const int p = part[g * 16 + e]; tot += p; if (g < gb) off += p; }
        for (int bb = gb * 8; bb < (int)blockIdx.x; ++bb) off += CNT[bb * 16 + e];
        base[e] = off; pst[e] = (tot + 255) >> 8; }
    __syncthreads();
    if (tid == 0) { int run = 0;
        for (int e = 0; e < 16; ++e) { const int nt = pst[e]; pst[e] = run * 256;
            if (blockIdx.x == 0) for (int k = 0; k < nt; ++k) META[16 + run + k] = e;
            run += nt; }
        pst[16] = run * 256; if (blockIdx.x == 0) META[0] = run; }
    __syncthreads();
    for (int a = wave; a < 132; a += NWAVES) {
        const int r = blockIdx.x * 66 + (a >> 1), k = a & 1;
        if (latent_only && (r % SB) < 256) continue;
        const int e = EXPID[2 * r + k]; const int dest = pst[e] + base[e] + RANK[2 * r + k];
        if (lane == 0) { TOKSLOT[2 * r + k] = dest; ROWW[dest] = EXPW[2 * r + k]; }
        const GAS v4u* src = (const GAS v4u*)(H2 + (size_t)r * 1024); GAS v4u* dst = (GAS v4u*)(XS + (size_t)dest * 1024);
        dst[lane] = src[lane]; dst[64 + lane] = src[64 + lane];
    }
    __syncthreads();
}

typedef const __attribute__((address_space(4))) KArgs KArgsC;
#define PROLOG \
    KArgsC* ka = ka0; asm volatile("" : "+s"(ka)); \
    unsigned char* const ws = ka->ws; \
    int tid = threadIdx.x; asm volatile("" : "+v"(tid)); \
    const int lane = tid & 63, wave = __builtin_amdgcn_readfirstlane(tid >> 6); \
    const int G = gridDim.x, bid = blockIdx.x, gw = bid * NWAVES + wave, NGW = G * NWAVES; \
    (void)lane; (void)gw; (void)NGW; (void)ws;
#define P_F32(off) ((float*)(ws + (off)))
#define P_I32(off) ((int*)(ws + (off)))
#define P_B16(off) ((bf16*)(ws + (off)))
__global__ void __launch_bounds__(NWAVES * 64, 2) dit_fwd(KArgs args_by_value) {
    extern __shared__ __attribute__((aligned(16))) unsigned char lds[];
    LAS unsigned char* L = (LAS unsigned char*)lds;
    KArgsC* ka0 = (KArgsC*)__builtin_amdgcn_kernarg_segment_ptr();
    const int lo = ka0->ph_lo, hi = ka0->ph_hi;
#define IN(k) (lo <= (k) && (k) < hi)
#define SEAM(k) do { if (IN(k) && IN((k) + 1)) { if (ka0->use_cg) cg::this_grid().sync(); } } while (0)
#define VCU ((G % 8 == 0) ? (bid % 8) * (G / 8) + bid / 8 : bid)

    if (IN(0)) { PROLOG
        LAS float* scr = (LAS float*)(L + wave * 16384);
        constexpr int ND = 2048 + 512 + 768 + 512, NM = 16 * 3 * 512;
        for (int it = gw; it < ND + NM; it += NGW) {
            if (it < ND) {
                int r = it;
                if (r < 2048) { const int kb = r >> 7, nb = r & 127; transpose_item(ka->in[I_EWIN] + (size_t)(64 * kb) * 4096 + 32 * nb, 4096, P_B16(WS_WIN) + (size_t)(32 * nb) * 1024 + 64 * kb, 1024, scr, lane); continue; } r -= 2048;
                if (r < 512) { const int kb = r >> 5, nb = r & 31; transpose_item(ka->in[I_EWOUT] + (size_t)(64 * kb) * 1024 + 32 * nb, 1024, P_B16(WS_WOE) + (size_t)(32 * nb) * 1024 + 64 * kb, 1024, scr, lane); continue; } r -= 512;
                if (r < 768) { const int kb = r / 48, nb = r % 48; transpose_item(ka->in[I_OWQKV] + (size_t)(64 * kb) * 1536 + 32 * nb, 1536, P_B16(WS_WQKV) + (size_t)(32 * nb) * 1024 + 64 * kb, 1024, scr, lane); continue; } r -= 768;
                { const int kb = r >> 5, nb = r & 31; transpose_item(ka->in[I_OWOUT] + (size_t)(64 * kb) * 1024 + 32 * nb, 1024, P_B16(WS_WOO) + (size_t)(32 * nb) * 1024 + 64 * kb, 1024, scr, lane); }
            } else moe_weight_item(it - ND, ka->in[I_MG], ka->in[I_MU], ka->in[I_MD], (bf16*)(ws + WS_MOE0_13), (bf16*)(ws + WS_MOE0_2), scr, lane);
        }
        __syncthreads();
        if (bid < 96) {
            const int l = bid / 48, cgp = bid % 48; const float* aw = ka->in[I_ADAW] + (size_t)l * 1024 * 6144 + 128 * cgp + 2 * lane;
            const float* c = ka->in[I_C]; const float* cc = ka->in[I_CCTX];
            float a0x = 0.f, a0y = 0.f, a1x = 0.f, a1y = 0.f, a2x = 0.f, a2y = 0.f;
#pragma unroll 8
            for (int i = 0; i < 128; ++i) { const int k = 128 * wave + i; const f32x2g w = *(const f32x2g*)(aw + (size_t)k * 6144);
                const float s0 = silu_d(c[k]), s1 = silu_d(c[1024 + k]), s2 = silu_d(cc[k]);
                a0x += s0 * w.x; a0y += s0 * w.y; a1x += s1 * w.x; a1y += s1 * w.y; a2x += s2 * w.x; a2y += s2 * w.y; }
            LAS float* red = (LAS float*)L;
            red[(wave * 3 + 0) * 128 + 2 * lane] = a0x; red[(wave * 3 + 0) * 128 + 2 * lane + 1] = a0y;
            red[(wave * 3 + 1) * 128 + 2 * lane] = a1x; red[(wave * 3 + 1) * 128 + 2 * lane + 1] = a1y;
            red[(wave * 3 + 2) * 128 + 2 * lane] = a2x; red[(wave * 3 + 2) * 128 + 2 * lane + 1] = a2y;
            __syncthreads();
            if (tid < 384) { const int v = tid >> 7, jj = tid & 127; float s = ka->in[I_ADAB][l * 6144 + 128 * cgp + jj];
#pragma unroll
                for (int w = 0; w < 8; ++w) s += red[(w * 3 + v) * 128 + jj];
                P_F32(WS_MOD)[(l * 3 + v) * 6144 + 128 * cgp + jj] = s; }
            __syncthreads();
        } else if (bid == 96) {
            for (int i = tid; i < 1024; i += 512) { const float* lg = ka->in[I_LBL]; const float l0 = lg[i], l1 = lg[1024 + i], l2 = lg[2048 + i]; const float m = fmaxf(l0, fmaxf(l1, l2));
                const float e0 = expf(l0 - m), e1 = expf(l1 - m), e2 = expf(l2 - m); P_F32(WS_LB)[i] = e0 / (e0 + e1 + e2); }
            if (wave == 0) { const float* lp = ka->in[I_DLAM]; const float s0 = wave_sum(lp[lane] * lp[64 + lane]), s1 = wave_sum(lp[128 + lane] * lp[192 + lane]);
                if (lane == 0) P_F32(WS_LAM)[0] = expf(s0) - expf(s1) + 0.2f; }
        } else if (bid == 97) {
            for (int i = tid; i < 2048; i += 512) { const int pos = i >> 4, jj = i & 15; const float inv = 1.0f / powf(10000.0f, (float)(2 * jj) / 32.0f); const float ang = (float)pos * inv;
                P_F32(WS_ROPE)[2 * i] = cosf(ang); P_F32(WS_ROPE)[2 * i + 1] = sinf(ang); }
        }
    }
    SEAM(0);
    if (IN(1)) { PROLOG
        for (int r = gw; r < MR; r += NGW) { const int b = r / SB, s = r % SB; const float* src = s < 256 ? ka->in[I_CTX] + ((size_t)b * 256 + s) * 1024 : ka->in[I_X] + ((size_t)b * 8192 + s - 256) * 1024;
            const float* mp = P_F32(WS_MOD) + (s < 256 ? 2 : b) * 6144; f32x4 v[4]; load_row_f32(v, src, lane); normmod_row(v, ka->in[I_NMIX], mp + 1024, mp, lane); store_row_bf16(v, P_B16(WS_H) + (size_t)r * 1024, lane); }
    }
    SEAM(1);
    if (IN(2)) { PROLOG
        pg8::Gemm g{P_B16(WS_H), P_B16(WS_WIN), MR, 4096, 1024, 0}; pg8::DenseOrder So; So.init(66, 16, G, bid, false);
        pg8::EpiInProj E{P_B16(WS_QH), P_B16(WS_IV), P_B16(WS_GG), P_B16(WS_DQ), P_B16(WS_DK), P_B16(WS_DV), P_F32(WS_LFF), P_F32(WS_LFB), P_F32(WS_LB), P_F32(WS_ROPE)};
        pg8::gemm_phase<pg8::EpiInProj, pg8::DenseOrder, true, true>(L, g, So, E);
    }
    SEAM(2);
    if (IN(3)) { PROLOG for (int u = bid; u < 16 * NCHUNK; u += G) hgrn_pass1_unit(u, P_F32(WS_LFF), P_F32(WS_LFB), P_B16(WS_IV), P_B16(WS_U), P_F32(WS_TOT), L, tid, wave, lane); }
    SEAM(3);
    if (IN(4)) { PROLOG hgrn_pass2(P_B16(WS_U), P_F32(WS_TOT), P_B16(WS_S), bid * 512 + tid, G * 512); }
    SEAM(4);
    if (IN(5)) { PROLOG
        for (int u = bid; u < 8 * NCHUNK; u += G) hgrn_pass3_unit(u, P_B16(WS_QH), P_F32(WS_LFF), P_F32(WS_LFB), P_B16(WS_IV), P_B16(WS_GG), P_B16(WS_S), ka->in[I_ONORM], P_B16(WS_H), L, tid, wave, lane);
        typedef attn_body::bf16 abf; const int vcu_ = VCU;
        if (vcu_ < 32) {
            const int b = vcu_ >> 4, h = (vcu_ >> 2) & 3, m = (vcu_ >> 1) & 1, vh = vcu_ & 1; const size_t rb = (size_t)b * SB;
            attn_body::attn_unit<8, 0>((const abf*)P_B16(WS_DQ) + rb * 512 + (h * 2 + m) * 64, 512, (const abf*)P_B16(WS_DK) + rb * 512 + (h * 2 + m) * 64, 512, (const abf*)P_B16(WS_DV) + rb * 512 + h * 128 + vh * 64, 512,
                                       (abf*)P_B16(WS_OATT) + (size_t)m * MR * 512 + rb * 512 + h * 128 + vh * 64, 512, 4, 0, 0.f, (char*)lds);
        }
        for (int i = 0; i < 4; ++i) {
            const int combo = vcu_ >> 3, qb = 4 * (vcu_ & 7) + i; if (combo >= 32) break;
            const int b = combo >> 4, h = (combo >> 2) & 3, m = (combo >> 1) & 1, vh = combo & 1; const size_t rb = (size_t)b * SB, rq = rb + 256 + 256 * qb;
            attn_body::attn_unit<8, 0>((const abf*)P_B16(WS_DQ) + rq * 512 + (h * 2 + m) * 64, 512, (const abf*)P_B16(WS_DK) + rb * 512 + (h * 2 + m) * 64, 512, (const abf*)P_B16(WS_DV) + rb * 512 + h * 128 + vh * 64, 512,
                                       (abf*)P_B16(WS_OATT) + (size_t)m * MR * 512 + rq * 512 + h * 128 + vh * 64, 512, NCHUNK, 0, 0.f, (char*)lds);
        }
    }
    SEAM(5);
    if (IN(6)) { PROLOG
        const float lam = P_F32(WS_LAM)[0]; const float* sg = ka->in[I_SUBLN] + 8 * (lane & 15);
        f32x4 g0 = *(const f32x4*)sg, g1 = *(const f32x4*)(sg + 4);
        for (int r = gw; r < MR; r += NGW) {
            const v4u a = *((const GAS v4u*)(P_B16(WS_OATT) + (size_t)r * 512) + lane), c = *((const GAS v4u*)(P_B16(WS_OATT) + (size_t)MR * 512 + (size_t)r * 512) + lane);
            float d[8];
            d[0] = __uint_as_float(a.x << 16) - lam * __uint_as_float(c.x << 16); d[1] = __uint_as_float(a.x & 0xffff0000u) - lam * __uint_as_float(c.x & 0xffff0000u);
            d[2] = __uint_as_float(a.y << 16) - lam * __uint_as_float(c.y << 16); d[3] = __uint_as_float(a.y & 0xffff0000u) - lam * __uint_as_float(c.y & 0xffff0000u);
            d[4] = __uint_as_float(a.z << 16) - lam * __uint_as_float(c.z << 16); d[5] = __uint_as_float(a.z & 0xffff0000u) - lam * __uint_as_float(c.z & 0xffff0000u);
            d[6] = __uint_as_float(a.w << 16) - lam * __uint_as_float(c.w << 16); d[7] = __uint_as_float(a.w & 0xffff0000u) - lam * __uint_as_float(c.w & 0xffff0000u);
            float ss = 0.f;
#pragma unroll
            for (int e = 0; e < 8; ++e) ss += d[e] * d[e];
            ss += __shfl_xor(ss, 1); ss += __shfl_xor(ss, 2); ss += __shfl_xor(ss, 4); ss += __shfl_xor(ss, 8);
            const float rs = 0.8f / sqrtf(ss * (1.f / 128.f) + EPS_);
            v4u o; o.x = pk2(d[0] * rs * g0.x, d[1] * rs * g0.y); o.y = pk2(d[2] * rs * g0.z, d[3] * rs * g0.w); o.z = pk2(d[4] * rs * g1.x, d[5] * rs * g1.y); o.w = pk2(d[6] * rs * g1.z, d[7] * rs * g1.w);
            *((GAS v4u*)(P_B16(WS_H) + (size_t)r * 1024 + 512) + lane) = o;
        }
    }
    SEAM(6);
    if (IN(7)) { PROLOG
        pg8::Gemm g{P_B16(WS_H), P_B16(WS_WOE), MR, 1024, 1024, 0}; pg8::DenseOrder So; So.init(66, 4, G, bid, false);
        pg8::EpiOut0 E{ka->in[I_X], ka->in[I_CTX], P_F32(WS_MOD), P_F32(WS_X)};
        pg8::gemm_phase<pg8::EpiOut0, pg8::DenseOrder, true, true>(L, g, So, E);
    }
    SEAM(7);
#define MOE_LAYER(P, LAYER, LATENT_ONLY) \
    if (IN(P)) { PROLOG router_phase(P_F32(WS_X), ka->in[I_NFFN] + (LAYER) * 1024, P_F32(WS_MOD) + (LAYER) * 3 * 6144, ka->in[I_RW], ka->in[I_RB], P_B16(WS_H), P_I32(WS_EXPID), P_F32(WS_EXPW), P_I32(WS_RANK), P_I32(WS_CNT), LATENT_ONLY, L, tid, wave, lane); } \
    SEAM(P); \
    if (IN((P) + 1)) { PROLOG index_phase(P_I32(WS_CNT), P_I32(WS_EXPID), P_F32(WS_EXPW), P_I32(WS_RANK), P_B16(WS_H), P_I32(WS_TOKSLOT), P_F32(WS_ROWW), P_B16(WS_XS), P_I32(WS_META), LATENT_ONLY, L, tid, wave, lane); \
        if ((LAYER) == 0) { LAS float* scr = (LAS float*)(L + wave * 16384); const size_t wo = (size_t)16 * 1024 * 1024; \
            for (int it = gw; it < 16 * 3 * 512; it += NGW) moe_weight_item(it, ka->in[I_MG] + wo, ka->in[I_MU] + wo, ka->in[I_MD] + wo, (bf16*)(ws + WS_MOE1_13), (bf16*)(ws + WS_MOE1_2), scr, lane); } } \
    SEAM((P) + 1); \
    if (IN((P) + 2)) { PROLOG const int ntile = __builtin_amdgcn_readfirstlane(P_I32(WS_META)[0]); \
        pg8::Gemm g{P_B16(WS_XS), (const bf16*)(ws + ((LAYER) == 0 ? WS_MOE0_13 : WS_MOE1_13)), ntile * 256, 2048, 1024, (size_t)2048 * 1024 * 2}; pg8::MoeOrder So; So.init(ntile, 8, G, bid, P_I32(WS_META) + 16); \
        pg8::EpiGateUp E{P_B16(WS_HID)}; pg8::gemm_phase<pg8::EpiGateUp, pg8::MoeOrder, true, true>(L, g, So, E); } \
    SEAM((P) + 2); \
    if (IN((P) + 3)) { PROLOG const int ntile = __builtin_amdgcn_readfirstlane(P_I32(WS_META)[0]); \
        pg8::Gemm g{P_B16(WS_HID), (const bf16*)(ws + ((LAYER) == 0 ? WS_MOE0_2 : WS_MOE1_2)), ntile * 256, 1024, 1024, (size_t)1024 * 1024 * 2}; pg8::MoeOrder So; So.init(ntile, 4, G, bid, P_I32(WS_META) + 16); \
        pg8::EpiDown E{P_B16(WS_XS), P_F32(WS_ROWW)}; pg8::gemm_phase<pg8::EpiDown, pg8::MoeOrder, true, true>(L, g, So, E); } \
    SEAM((P) + 3);
    MOE_LAYER(8, 0, false)
    if (IN(12)) { PROLOG
        for (int r = gw; r < MR; r += NGW) { const int b = r / SB, s = r % SB, vec = s < 256 ? 2 : b; f32x4 v[4]; load_row_f32(v, P_F32(WS_X) + (size_t)r * 1024, lane);
            add_moe_rows(v, P_B16(WS_XS) + (size_t)P_I32(WS_TOKSLOT)[2 * r] * 1024, P_B16(WS_XS) + (size_t)P_I32(WS_TOKSLOT)[2 * r + 1] * 1024, P_F32(WS_MOD) + vec * 6144 + 5120, lane);
            f32x4* xo = (f32x4*)(P_F32(WS_X) + (size_t)r * 1024) + lane;
#pragma unroll
            for (int j = 0; j < 4; ++j) xo[64 * j] = v[j];
            const float* mp = P_F32(WS_MOD) + (3 + vec) * 6144; normmod_row(v, ka->in[I_NMIX] + 1024, mp + 1024, mp, lane); store_row_bf16(v, P_B16(WS_H) + (size_t)r * 1024, lane); }
    }
    SEAM(12);
    if (IN(13)) { PROLOG
        pg8::Gemm g{P_B16(WS_H), P_B16(WS_WQKV), MR, 1536, 1024, 0}; pg8::DenseOrder So; So.init(66, 6, G, bid, false);
        pg8::EpiQKV1 E{P_B16(WS_Q1), P_B16(WS_K1), P_B16(WS_V1), P_F32(WS_ROPE)};
        pg8::gemm_phase<pg8::EpiQKV1, pg8::DenseOrder, true, true>(L, g, So, E);
    }
    SEAM(13);
    if (IN(14)) { PROLOG
        typedef attn_body::bf16 abf; const int vcu_ = VCU;
        for (int i = 0; i < 4; ++i) {
            const int combo = vcu_ >> 3, qb = 4 * (vcu_ & 7) + i; if (combo >= 32) break;
            const int b = combo >> 4, qh = combo & 15; const size_t rb = (size_t)b * SB, rq = rb + 256 + 256 * qb;
            attn_body::attn_unit<8, 1>((const abf*)P_B16(WS_Q1) + rq * 1024 + qh * 64, 1024, (const abf*)P_B16(WS_K1) + rb * 256 + (qh >> 2) * 64, 256, (const abf*)P_B16(WS_V1) + rb * 256 + (qh >> 2) * 64, 256,
                                       (abf*)P_B16(WS_H) + rq * 1024 + qh * 64, 1024, 12, 256 * qb, ka->in[I_SINK][qh] * LOG2E, (char*)lds);
        }
    }
    SEAM(14);
    if (IN(15)) { PROLOG
        pg8::Gemm g{P_B16(WS_H), P_B16(WS_WOO), MR, 1024, 1024, 0}; pg8::DenseOrder So; So.init(64, 4, G, bid, true);
        pg8::EpiOut1 E{P_F32(WS_MOD) + 3 * 6144, P_F32(WS_X)};
        pg8::gemm_phase<pg8::EpiOut1, pg8::DenseOrder, true, true>(L, g, So, E);
    }
    SEAM(15);
    MOE_LAYER(16, 1, true)
    if (IN(20)) { PROLOG
        for (int t = gw; t < NBATCH * TLAT; t += NGW) { const int b = t >> 13, tau = t & 8191; const size_t r = (size_t)b * SB + 256 + tau; f32x4 v[4]; load_row_f32(v, P_F32(WS_X) + r * 1024, lane);
            add_moe_rows(v, P_B16(WS_XS) + (size_t)P_I32(WS_TOKSLOT)[2 * r] * 1024, P_B16(WS_XS) + (size_t)P_I32(WS_TOKSLOT)[2 * r + 1] * 1024, P_F32(WS_MOD) + (3 + b) * 6144 + 5120, lane);
            float s2 = 0.f;
#pragma unroll
            for (int j = 0; j < 4; ++j) s2 += (v[j].x * v[j].x + v[j].y * v[j].y) + (v[j].z * v[j].z + v[j].w * v[j].w);
            const float rstd = 1.f / sqrtf(wave_sum(s2) * (1.f / 1024.f) + EPS_);
            f32x4* o = (f32x4*)(ka->out + (size_t)t * 1024) + lane;
#pragma unroll
            for (int j = 0; j < 4; ++j) o[64 * j] = v[j] * rstd * *((const f32x4*)ka->in[I_FNG] + 64 * j + lane); }
    }
#undef IN
#undef SEAM
#undef MOE_LAYER
}

#ifndef N_LAUNCHES
#define N_LAUNCHES 21
#endif
extern "C" void kernel_launch(void* const* d_in, const int* in_sizes, int n_in, void* d_out, int out_size, void* d_ws, size_t ws_size, hipStream_t stream) {
    static int grid = 0;
    if (grid == 0) {
        if (n_in != 23 || ws_size < WS_NEED) { fprintf(stderr, "kernel_launch: expected 23 inputs and >= %zu bytes of workspace (got %d, %zu)\n", (size_t)WS_NEED, n_in, ws_size); grid = -1; return; }
        int dev = 0, cus = 0, per_cu = 0;
        hipGetDevice(&dev); hipDeviceGetAttribute(&cus, hipDeviceAttributeMultiprocessorCount, dev);
        if (hipFuncSetAttribute((const void*)dit_fwd, hipFuncAttributeMaxDynamicSharedMemorySize, LDS_BYTES) != hipSuccess) { fprintf(stderr, "kernel_launch: hipFuncSetAttribute failed\n"); grid = -1; return; }
        if (hipOccupancyMaxActiveBlocksPerMultiprocessor(&per_cu, (const void*)dit_fwd, NWAVES * 64, LDS_BYTES) != hipSuccess || per_cu < 1) { fprintf(stderr, "kernel_launch: occupancy query says %d\n", per_cu); per_cu = 1; }
        (void)hipGetLastError();
        grid = cus;
        if (grid != 256) fprintf(stderr, "kernel_launch: %d CUs (built for 256)\n", grid);
    }
    if (grid < 0) return;
    (void)hipMemsetAsync((char*)d_ws + WS_CTL, 0, CTL_ZERO_BYTES, stream);
    KArgs a{};
    for (int i = 0; i < 23; ++i) a.in[i] = (const float*)d_in[i];
    a.out = (float*)d_out; a.ws = (unsigned char*)d_ws;
#if N_LAUNCHES == 1
    a.ph_lo = 0; a.ph_hi = N_PHASES; a.use_cg = 1;
    void* kargs[] = {&a};
    hipError_t e = hipLaunchCooperativeKernel((const void*)dit_fwd, dim3(grid), dim3(NWAVES * 64), kargs, LDS_BYTES, stream);
    if (e != hipSuccess) fprintf(stderr, "kernel_launch: cooperative launch failed: %s\n", hipGetErrorString(e));
#else
    for (int p = 0; p < N_PHASES; ++p) { a.ph_lo = p; a.ph_hi = p + 1; a.use_cg = 0;
        hipLaunchKernelGGL(dit_fwd, dim3(grid), dim3(NWAVES * 64), LDS_BYTES, stream, a); }
#endif
}
```

```cpp
#include <hip/hip_runtime.h>
#include <hip/hip_cooperative_groups.h>
#include <hip/hip_bf16.h>
#include <cstdio>
#include <cstdint>
#include <cmath>
namespace cg = cooperative_groups;

constexpr int DMODEL = 1024, NBATCH = 2, TLAT = 8192, TCTX = 256;
constexpr int SB = TLAT + TCTX;
constexpr int MR = NBATCH * SB;
constexpr int NEXP = 16;
constexpr int MOE_MAXT = 152;
constexpr float EPS_ = 1e-6f;
constexpr float LOG2E = 1.4426950408889634f;
constexpr float C2 = 0.125f * LOG2E;
constexpr int NCHUNK = SB / 64;

constexpr size_t MiB = 1u << 20;
constexpr size_t WS_CTL = 0, CTL_ZERO_BYTES = 64 * 1024;
constexpr size_t WS_MOD = 1 * MiB;
constexpr size_t WS_LB = WS_MOD + 256 * 1024;
constexpr size_t WS_LAM = WS_LB + 8 * 1024;
constexpr size_t WS_ROPE = WS_LAM + 1024;
constexpr size_t WS_EXPID = 2 * MiB;
constexpr size_t WS_EXPW = WS_EXPID + 256 * 1024;
constexpr size_t WS_RANK = WS_EXPW + 256 * 1024;
constexpr size_t WS_TOKSLOT = WS_RANK + 256 * 1024;
constexpr size_t WS_CNT = WS_TOKSLOT + 256 * 1024;
constexpr size_t WS_META = WS_CNT + 32 * 1024;
constexpr size_t WS_ROWW = 4 * MiB;
constexpr size_t WS_TOT = 5 * MiB;
constexpr size_t WS_WIN = 8 * MiB;
constexpr size_t WS_WOE = 16 * MiB;
constexpr size_t WS_WQKV = 18 * MiB;
constexpr size_t WS_WOO = 21 * MiB;
constexpr size_t WS_MOE0_13 = 24 * MiB;
constexpr size_t WS_MOE0_2 = 88 * MiB;
constexpr size_t WS_X = 120 * MiB;
constexpr size_t WS_H = 186 * MiB;
constexpr size_t WS_R = 219 * MiB;
constexpr size_t WS_QH = WS_R;
constexpr size_t WS_LFF = WS_QH + 33 * MiB / 2;
constexpr size_t WS_LFB = WS_LFF + 33 * MiB;
constexpr size_t WS_IV = WS_LFB + 33 * MiB;
constexpr size_t WS_GG = WS_IV + 33 * MiB / 2;
constexpr size_t WS_DQ = WS_GG + 33 * MiB / 2;
constexpr size_t WS_DK = WS_DQ + 33 * MiB / 2;
constexpr size_t WS_DV = WS_DK + 33 * MiB / 2;
constexpr size_t WS_U = WS_DV + 33 * MiB / 2;
constexpr size_t WS_S = WS_U + 66 * MiB;
constexpr size_t WS_OATT = WS_U;
constexpr size_t WS_END0 = WS_S + 66 * MiB;
constexpr size_t WS_MOE1_13 = WS_R;
constexpr size_t WS_MOE1_2 = WS_R + 64 * MiB;
constexpr size_t WS_XS = WS_R + 96 * MiB;
constexpr size_t WS_HID = WS_XS + 76 * MiB;
constexpr size_t WS_Q1 = WS_HID + 76 * MiB;
constexpr size_t WS_K1 = WS_Q1 + 33 * MiB;
constexpr size_t WS_V1 = WS_K1 + 33 * MiB / 4;
constexpr size_t WS_END1 = WS_V1 + 33 * MiB / 4;
constexpr size_t WS_NEED = (WS_END0 > WS_END1 ? WS_END0 : WS_END1);
static_assert(WS_NEED <= 553810048ull, "d_ws map exceeds the guaranteed workspace");
static_assert((size_t)MOE_MAXT * 256 * 1024 * 2 <= 76 * MiB, "XS size");

#define GAS __attribute__((address_space(1)))
#define LAS __attribute__((address_space(3)))
typedef unsigned short bf16;
typedef unsigned v4u __attribute__((ext_vector_type(4)));
typedef float f32x4 __attribute__((ext_vector_type(4)));
typedef short bf16x8 __attribute__((ext_vector_type(8)));
typedef GAS unsigned gu32;
typedef GAS unsigned long long gu64;
#define RLX_AGENT __ATOMIC_RELAXED, __HIP_MEMORY_SCOPE_AGENT
#define LDS_WAIT() asm volatile("s_waitcnt lgkmcnt(0)" ::: "memory")
#define VM_WAIT() asm volatile("s_waitcnt vmcnt(0)" ::: "memory")
__device__ __forceinline__ unsigned long long rt() { return __builtin_amdgcn_s_memrealtime(); }
typedef float f32x2c_t __attribute__((ext_vector_type(2))); typedef __bf16 bf16x2c_t __attribute__((ext_vector_type(2)));
__device__ __forceinline__ unsigned pk2(float lo, float hi) { f32x2c_t v = {lo, hi}; bf16x2c_t b = __builtin_convertvector(v, bf16x2c_t); return __builtin_bit_cast(unsigned, b); }
__device__ __forceinline__ unsigned f2bf(float f) { return pk2(f, 0.f) & 0xffffu; }
template <int CTRL> __device__ __forceinline__ float dpp_f(float v) { return __builtin_bit_cast(float, __builtin_amdgcn_update_dpp(0, __builtin_bit_cast(int, v), CTRL, 0xF, 0xF, true)); }
__device__ __forceinline__ float swap16_sum(float a, float b) { const auto r = __builtin_amdgcn_permlane16_swap(__float_as_uint(a), __float_as_uint(b), false, false); return __uint_as_float(r[0]) + __uint_as_float(r[1]); }
__device__ __forceinline__ float swap32_sum(float a, float b) { const auto r = __builtin_amdgcn_permlane32_swap(__float_as_uint(a), __float_as_uint(b), false, false); return __uint_as_float(r[0]) + __uint_as_float(r[1]); }

#define XB_TMO      128
#define XB_XCNT(j)  (256  + 64 * (j))
#define XB_XSUB(j)  (1280 + 64 * (j))
#define XB_XGEN(j)  (2304 + 64 * (j))
#define XB_TOP      3328
#define XB_TOPGEN   3392
#define XCD_BAR_WORDS 3456
#define XB_SPIN_CAP (1u << 18)

__device__ __forceinline__ unsigned xb_ld(unsigned* p)              { return __hip_atomic_load(p, __ATOMIC_RELAXED, __HIP_MEMORY_SCOPE_AGENT); }
__device__ __forceinline__ unsigned xb_add(unsigned* p, unsigned v) { return __hip_atomic_fetch_add(p, v, __ATOMIC_RELAXED, __HIP_MEMORY_SCOPE_AGENT); }
__device__ __forceinline__ unsigned xb_xcc_id() { return (unsigned)__builtin_amdgcn_s_getreg((3 << 11) | 20) & 0xFu; }
#define XB_SPIN(cond, bar) do { unsigned _sp = 0; while (cond) { __builtin_amdgcn_s_sleep(1); \
    if ((++_sp & 255u) == 0u) { if (xb_ld(&(bar)[XB_TMO])) break; if (_sp > XB_SPIN_CAP) { atomicAdd(&(bar)[XB_TMO], 1u); break; } } } } while (0)

struct XcdBarrier {
    unsigned* bar; unsigned x;
    volatile LAS unsigned* st;
};

__device__ __forceinline__ XcdBarrier xcd_barrier_post(unsigned* bar, volatile LAS unsigned* st) {
    XcdBarrier b; b.bar = bar; b.x = xb_xcc_id(); b.st = st;
    if (threadIdx.x == 0) (void)xb_add(&bar[XB_XCNT(b.x)], 1u);
    return b;
}
__device__ __forceinline__ void xcd_barrier_complete(unsigned* bar, unsigned x, unsigned& nloc, unsigned& nx) {
    const unsigned G = gridDim.x * gridDim.y * gridDim.z;
    unsigned sum, cnt, mine, sp = 0u;
    for (;;) {
        sum = 0u; cnt = 0u; mine = 0u;
#pragma unroll
        for (unsigned j = 0; j < 16; ++j) { const unsigned c = xb_ld(&bar[XB_XCNT(j)]); sum += c; cnt += (c > 0u) ? 1u : 0u; mine = (j == x) ? c : mine; }
        if (sum == G) break;
        __builtin_amdgcn_s_sleep(1);
        if ((++sp & 255u) == 0u) { if (xb_ld(&bar[XB_TMO])) break; if (sp > XB_SPIN_CAP) { atomicAdd(&bar[XB_TMO], 1u); break; } }
    }
    nloc = mine > 0u ? mine : 1u; nx = cnt > 0u ? cnt : 1u;
}

__device__ __forceinline__ void xcd_barrier(const XcdBarrier& b) {
    asm volatile("s_waitcnt vmcnt(0)" ::: "memory");
    __syncthreads();
    if (threadIdx.x == 0) {
        unsigned* bar = b.bar;
        __builtin_amdgcn_s_waitcnt(0);
        unsigned nloc = b.st[0], nx = b.st[1];
        if (nloc == 0u) { xcd_barrier_complete(bar, b.x, nloc, nx); b.st[0] = nloc; b.st[1] = nx; }
        const unsigned old = xb_add(&bar[XB_XSUB(b.x)], 1u);
        const unsigned gen = old / nloc;
        if (old + 1u == (gen + 1u) * nloc) {
            __builtin_amdgcn_fence(__ATOMIC_RELEASE, "agent");
            asm volatile("s_waitcnt vmcnt(0)" ::: "memory");
            const unsigned og = xb_add(&bar[XB_TOP], 1u);
            const unsigned tg = og / nx;
            if (og + 1u == (tg + 1u) * nx) xb_add(&bar[XB_TOPGEN], 1u);
            else XB_SPIN(xb_ld(&bar[XB_TOPGEN]) == tg, bar);
            __builtin_amdgcn_fence(__ATOMIC_ACQUIRE, "agent");
            xb_add(&bar[XB_XGEN(b.x)], 1u);
            asm volatile("s_waitcnt vmcnt(0)" ::: "memory");
        } else {
            XB_SPIN(xb_ld(&bar[XB_XGEN(b.x)]) == gen, bar);
            __builtin_amdgcn_fence(__ATOMIC_ACQUIRE, "agent");
            asm volatile("s_waitcnt vmcnt(0)" ::: "memory");
        }
    }
    __syncthreads();
}
namespace pg8 {
#define PG8_LAS __attribute__((address_space(3)))
typedef unsigned short bf16_t;
typedef short bf16x8 __attribute__((ext_vector_type(8)));
typedef float f32x4 __attribute__((ext_vector_type(4)));
typedef unsigned u32x4 __attribute__((ext_vector_type(4)));
constexpr int BM = 256, BK = 64, HALF = 128, HTB = HALF * BK * 2  , STAGE_BYTES = 8 * HTB, NXCD = 8, WGM = 8;

__host__ __device__ __forceinline__ int lds_byte(int r, int c) { const int st = (r >> 4) * 2 + (c >> 5), rr = r & 15, cc = c & 31, ob = rr * 64 + cc * 2; return st * 1024 + (ob ^ (((ob >> 9) & 1) << 5)); }
__host__ __device__ __forceinline__ void stage_rc(int b, int& R, int& C) { const int st = b / 1024, sb = b % 1024, swz = sb ^ (((sb >> 9) & 1) << 5); R = (st >> 1) * 16 + swz / 64; C = (st & 1) * 32 + (swz % 64) / 2; }
__host__ __device__ __forceinline__ int perm32(int rho) { const int n = rho >> 4, i = rho & 15; return 8 * (i >> 2) + 4 * n + (i & 3); }

struct Unit { int pm, pn, be, mask, qa, qb; };
struct Gemm { const bf16_t* A; const bf16_t* Bt; int M, N, K; size_t bes; };
__device__ __forceinline__ unsigned cvt_pk_bf16(float lo, float hi) { unsigned r; asm volatile("v_cvt_pk_bf16_f32 %0, %1, %2" : "=v"(r) : "v"(lo), "v"(hi)); return r; }
typedef float f32x2 __attribute__((ext_vector_type(2)));

__device__ __forceinline__ bool tail_deal(int L, int nwg, int G, int mode, int parts, int& idx, int& mask, int& qa, int& qb) {
    const int F = nwg / G, R = nwg - F * G; qa = 0; qb = 0; mask = 0xF;
    if (mode == 0) { if (L >= nwg) return false; idx = L; return true; }
    if (mode == 1) { if (L >= F * G) return false; idx = L; return true; }
    if (L >= R * parts) return false;
    idx = F * G + L / parts; const int p = L % parts;
    if (parts == 4) { qa = p >> 1; qb = p & 1; mask = 1; } else { qa = p; mask = 3; }
    return true;
}
struct DenseOrder {
    int nM, nN, nwg, G, c, mode, parts; bool skipctx;
    __device__ void init(int nM_, int nN_, int G_, int c_, bool skip_, int mode_ = 0, int parts_ = 1) { nM = nM_; nN = nN_; nwg = nM * nN; G = G_; c = c_; skipctx = skip_; mode = mode_; parts = parts_; }
    __device__ bool next(int i, Unit& u) const {
        int wgid; if (!tail_deal(i * G + c, nwg, G, mode, parts, wgid, u.mask, u.qa, u.qb)) return false;
        { const int q = nwg / NXCD, r = nwg % NXCD, xcd = wgid % NXCD, off = wgid / NXCD; wgid = (xcd < r ? xcd * (q + 1) : r * (q + 1) + (xcd - r) * q) + off; }
        const int nig = WGM * nN, gid = wgid / nig, fm = gid * WGM, gsz = (nM - fm) < WGM ? (nM - fm) : WGM;
        int pm = fm + ((wgid % nig) % gsz); u.pn = (wgid % nig) / gsz; u.be = 0;
        if (skipctx) pm = (pm >> 5) * 33 + 1 + (pm & 31);
        u.pm = pm; return true;
    }
    __device__ __forceinline__ void a_ready(const Unit&) const {}
    __device__ __forceinline__ void done(const Unit&) const {}
};
struct MoeOrder {
    int nM, nN, nwg, G, c, mode, parts; const PG8_LAS int* tile_e;
    __device__ void init(int nM_, int nN_, int G_, int c_, const PG8_LAS int* te, int mode_ = 0, int parts_ = 1) { nM = nM_; nN = nN_; nwg = nM * nN; G = G_; c = c_; tile_e = te; mode = mode_; parts = parts_; }
    __device__ bool next(int i, Unit& u) const {
        int wgid; if (!tail_deal(i * G + c, nwg, G, mode, parts, wgid, u.mask, u.qa, u.qb)) return false;
        { const int q = nwg / NXCD, r = nwg % NXCD, xcd = wgid % NXCD, off = wgid / NXCD; wgid = (xcd < r ? xcd * (q + 1) : r * (q + 1) + (xcd - r) * q) + off; }
        const int nig = WGM * nN, gid = wgid / nig, fm = gid * WGM, gsz = (nM - fm) < WGM ? (nM - fm) : WGM;
        u.pm = fm + ((wgid % nig) % gsz); u.pn = (wgid % nig) / gsz; u.be = __builtin_amdgcn_readfirstlane(tile_e[u.pm]); return true;
    }
    __device__ __forceinline__ void a_ready(const Unit&) const {}
    __device__ __forceinline__ void done(const Unit&) const {}
};

typedef unsigned u32x2 __attribute__((ext_vector_type(2)));
typedef float f32x2 __attribute__((ext_vector_type(2)));
__device__ __forceinline__ float silu_f(float v) { return v * __builtin_amdgcn_rcpf(1.f + __builtin_amdgcn_exp2f(__builtin_fminf(-v * 1.4426950408889634f, 80.f))); }
__device__ __forceinline__ float sigm_f(float v) { return __builtin_amdgcn_rcpf(1.f + __builtin_amdgcn_exp2f(__builtin_fminf(-v * 1.4426950408889634f, 80.f))); }
__device__ __forceinline__ float lfgate_f(float lb, float v) { const float e = __builtin_amdgcn_exp2f(__builtin_fminf(-v * 1.4426950408889634f, 80.f)); return __builtin_amdgcn_logf((1.f + lb * e) * __builtin_amdgcn_rcpf(1.f + e)) * 0.6931471805599453f; }
__device__ __forceinline__ u32x2 pk4(f32x4 v) { u32x2 w; w.x = cvt_pk_bf16(v[0], v[1]); w.y = cvt_pk_bf16(v[2], v[3]); return w; }

struct EpiInProj {
    static constexpr bool PERM = true, AFTER_DRAIN = false;
    bf16_t *QH, *IV, *GG, *DQ, *DK, *DV; _Float16 *LFF, *LFB; const float* LB;     const float* ROPE;
    __device__ __forceinline__ void operator()(const f32x4 (&acc)[2][2][4][2], const Unit& u, int wr, int wc, int fr, int fq) const {
        const int seg = u.pn >> 1;
        const int cb = (u.pn & 1) * 256 + u.qb * 128 + wc * 32 + 8 * fq;
        const int jt = u.pm % 33; const bool latent = jt != 0;
        const int s0 = jt * 256 + u.qa * 128 + wr * 64 + fr;
        const size_t row0 = (size_t)u.pm * 256 + u.qa * 128 + wr * 64 + fr;
        if (seg == 1 || seg == 2) {
            _Float16* LF = seg == 1 ? LFF : LFB; typedef _Float16 h16x8 __attribute__((ext_vector_type(8))); const float* lbp = LB + (seg - 1) * 512;
#pragma unroll
            for (int bj = 0; bj < 2; ++bj) { const int col = cb + bj * 128; const f32x4 lb0 = *(const f32x4*)(lbp + col), lb1 = *(const f32x4*)(lbp + col + 4);
#pragma unroll
                for (int ai = 0; ai < 2; ++ai)
#pragma unroll
                    for (int m = 0; m < 4; ++m) { if (!(u.mask & (1 << (ai * 2 + bj)))) continue; const f32x4 v0 = acc[ai][bj][m][0], v1 = acc[ai][bj][m][1]; h16x8 o;
#pragma unroll
                        for (int e = 0; e < 4; ++e) { o[e] = (_Float16)lfgate_f(lb0[e], v0[e]); o[4 + e] = (_Float16)lfgate_f(lb1[e], v1[e]); }
                        *(h16x8*)(LF + (row0 + ai * 128 + m * 16) * 512 + col) = o; } }
        } else if (seg == 5 || seg == 6) {
            bf16_t* O = seg == 5 ? DQ : DK; const float sc = seg == 5 ? C2 : 1.f; const float sgn = fq < 2 ? -1.f : 1.f;
#pragma unroll
            for (int ai = 0; ai < 2; ++ai)
#pragma unroll
                for (int m = 0; m < 4; ++m) {
                    float co[8], si[8];
#pragma unroll
                    for (int e = 0; e < 8; ++e) { co[e] = 1.f; si[e] = 0.f; }
                    if (latent) { const int tau = s0 + ai * 128 + m * 16 - 256; const int pos = (wc & 1) ? (tau & 63) : (tau >> 6);
                        const float* rp = ROPE + (pos * 16 + 8 * (fq & 1)) * 2;
#pragma unroll
                        for (int k = 0; k < 4; ++k) { const f32x4 t4 = *(const f32x4*)(rp + 4 * k); co[2 * k] = t4[0]; si[2 * k] = t4[1]; co[2 * k + 1] = t4[2]; si[2 * k + 1] = t4[3]; } }
#pragma unroll
                    for (int bj = 0; bj < 2; ++bj) { if (!(u.mask & (1 << (ai * 2 + bj)))) continue; float x[8], o[8];
#pragma unroll
                        for (int e = 0; e < 4; ++e) { x[e] = acc[ai][bj][m][0][e]; x[4 + e] = acc[ai][bj][m][1][e]; }
#pragma unroll
                        for (int e = 0; e < 8; ++e) { const auto rr = __builtin_amdgcn_permlane32_swap(__float_as_uint(x[e]), __float_as_uint(x[e]), false, false);
                            const float pr = __uint_as_float(fq < 2 ? rr[1] : rr[0]); o[e] = (x[e] * co[e] + sgn * pr * si[e]) * sc; }
                        u32x4 w; w.x = cvt_pk_bf16(o[0], o[1]); w.y = cvt_pk_bf16(o[2], o[3]); w.z = cvt_pk_bf16(o[4], o[5]); w.w = cvt_pk_bf16(o[6], o[7]);
                        *(u32x4*)(O + (row0 + ai * 128 + m * 16) * 512 + cb + bj * 128) = w; } }
        } else {
            bf16_t* O = seg == 0 ? QH : seg == 3 ? IV : seg == 4 ? GG : DV;
#pragma unroll
            for (int ai = 0; ai < 2; ++ai)
#pragma unroll
                for (int m = 0; m < 4; ++m)
#pragma unroll
                    for (int bj = 0; bj < 2; ++bj) { if (!(u.mask & (1 << (ai * 2 + bj)))) continue; f32x4 v0 = acc[ai][bj][m][0], v1 = acc[ai][bj][m][1];
                        if (seg == 0) {
#pragma unroll
                            for (int e = 0; e < 4; ++e) { v0[e] = silu_f(v0[e]) * 0.08838834764831845f; v1[e] = silu_f(v1[e]) * 0.08838834764831845f; } }
                        else if (seg == 4) {
#pragma unroll
                            for (int e = 0; e < 4; ++e) { v0[e] = silu_f(v0[e]); v1[e] = silu_f(v1[e]); } }
                        u32x4 w; w.x = cvt_pk_bf16(v0[0], v0[1]); w.y = cvt_pk_bf16(v0[2], v0[3]); w.z = cvt_pk_bf16(v1[0], v1[1]); w.w = cvt_pk_bf16(v1[2], v1[3]);
                        *(u32x4*)(O + (row0 + ai * 128 + m * 16) * 512 + cb + bj * 128) = w; }
        }
    }
};
#ifndef EPISEL
#define EPISEL (-1)
#endif
template <class E> struct EpiTwice {
    static constexpr bool PERM = E::PERM, AFTER_DRAIN = false; E e;
    __device__ __forceinline__ void operator()(const f32x4 (&acc)[2][2][4][2], const Unit& u, int wr, int wc, int fr, int fq) const { e(acc, u, wr, wc, fr, fq); asm volatile("" ::: "memory");
        if (EPISEL < 0 || (u.pn >> 1) == EPISEL) e(acc, u, wr, wc, fr, fq); }
};

struct EpiOut0 {
    static constexpr bool PERM = false, AFTER_DRAIN = false;
    const float* x; const float* ctx; const float* MODL; bf16_t* X;
    __device__ __forceinline__ void operator()(const f32x4 (&acc)[2][2][4][2], const Unit& u, int wr, int wc, int fr, int fq) const {
        const int b = u.pm / 33, jt = u.pm % 33; const int vec = jt == 0 ? 2 : b;
        const int col0 = u.pn * 256 + u.qb * 128 + wc * 32 + 4 * fq; const float* gp = MODL + vec * 6144 + 2048 + col0;
        f32x4 gv[2][2];
#pragma unroll
        for (int bj = 0; bj < 2; ++bj)
#pragma unroll
            for (int n = 0; n < 2; ++n) gv[bj][n] = *(const f32x4*)(gp + bj * 128 + n * 16);
#pragma unroll
        for (int ai = 0; ai < 2; ++ai)
#pragma unroll
            for (int m = 0; m < 4; ++m) { const int sl = (ai + u.qa) * 128 + wr * 64 + m * 16 + fr;
                const float* src = jt == 0 ? ctx + ((size_t)b * 256 + sl) * 1024 : x + ((size_t)b * 8192 + (jt - 1) * 256 + sl) * 1024;
                bf16_t* dst = X + ((size_t)u.pm * 256 + sl) * 1024;
#pragma unroll
                for (int bj = 0; bj < 2; ++bj)
#pragma unroll
                    for (int n = 0; n < 2; ++n) { if (!(u.mask & (1 << (ai * 2 + bj)))) continue; const int c = col0 + bj * 128 + n * 16; *(u32x2*)(dst + c) = pk4(*(const f32x4*)(src + c) + gv[bj][n] * acc[ai][bj][m][n]); } }
    }
};
struct EpiOut1 {
    static constexpr bool PERM = false, AFTER_DRAIN = false;
    const float* MODL; bf16_t* X;
    __device__ __forceinline__ void operator()(const f32x4 (&acc)[2][2][4][2], const Unit& u, int wr, int wc, int fr, int fq) const {
        const int b = u.pm / 33; const int col0 = u.pn * 256 + u.qb * 128 + wc * 32 + 4 * fq; const float* gp = MODL + b * 6144 + 2048 + col0;
        f32x4 gv[2][2];
#pragma unroll
        for (int bj = 0; bj < 2; ++bj)
#pragma unroll
            for (int n = 0; n < 2; ++n) gv[bj][n] = *(const f32x4*)(gp + bj * 128 + n * 16);
#pragma unroll
        for (int ai = 0; ai < 2; ++ai)
#pragma unroll
            for (int m = 0; m < 4; ++m) { bf16_t* dst = X + ((size_t)u.pm * 256 + (ai + u.qa) * 128 + wr * 64 + m * 16 + fr) * 1024;
#pragma unroll
                for (int bj = 0; bj < 2; ++bj)
#pragma unroll
                    for (int n = 0; n < 2; ++n) { if (!(u.mask & (1 << (ai * 2 + bj)))) continue; const int c = col0 + bj * 128 + n * 16; const u32x2 xw = *(const u32x2*)(dst + c); f32x4 xv; xv[0] = __uint_as_float(xw.x << 16); xv[1] = __uint_as_float(xw.x & 0xffff0000u); xv[2] = __uint_as_float(xw.y << 16); xv[3] = __uint_as_float(xw.y & 0xffff0000u); *(u32x2*)(dst + c) = pk4(xv + gv[bj][n] * acc[ai][bj][m][n]); } }
    }
};
__device__ __forceinline__ unsigned pk4_fp8(float a, float b, float c, float d) {
    a = __builtin_fminf(__builtin_fmaxf(a, -448.f), 448.f); b = __builtin_fminf(__builtin_fmaxf(b, -448.f), 448.f); c = __builtin_fminf(__builtin_fmaxf(c, -448.f), 448.f); d = __builtin_fminf(__builtin_fmaxf(d, -448.f), 448.f);
    int p = __builtin_amdgcn_cvt_pk_fp8_f32(a, b, 0, false); p = __builtin_amdgcn_cvt_pk_fp8_f32(c, d, p, true); return (unsigned)p;
}
constexpr float W8_SCALE = 64.f, W8_INV = 1.f / 64.f;
struct EpiGateUp8 {
    static constexpr bool PERM = false, AFTER_DRAIN = false;
    unsigned char* HID;
    __device__ __forceinline__ void operator()(const f32x4 (&acc)[2][2][4][2], const Unit& u, int wr, int wc, int fr, int fq) const {
        const int col0 = u.pn * 128 + wc * 32 + 4 * fq;
#pragma unroll
        for (int ai = 0; ai < 2; ++ai)
#pragma unroll
            for (int m = 0; m < 4; ++m) { if (!(u.mask & (3 << (2 * ai)))) continue; f32x4 h0, h1;
#pragma unroll
                for (int e = 0; e < 4; ++e) { h0[e] = silu_f(acc[ai][0][m][0][e] * W8_INV) * (acc[ai][1][m][0][e] * W8_INV); h1[e] = silu_f(acc[ai][0][m][1][e] * W8_INV) * (acc[ai][1][m][1][e] * W8_INV); }
                unsigned char* p = HID + ((size_t)u.pm * 256 + (ai + u.qa) * 128 + wr * 64 + m * 16 + fr) * 1024 + col0;
                *(unsigned*)p = pk4_fp8(h0[0], h0[1], h0[2], h0[3]); *(unsigned*)(p + 16) = pk4_fp8(h1[0], h1[1], h1[2], h1[3]); }
    }
};
struct EpiGateUp {
    static constexpr bool PERM = true, AFTER_DRAIN = false;
    bf16_t* HID;
    __device__ __forceinline__ void operator()(const f32x4 (&acc)[2][2][4][2], const Unit& u, int wr, int wc, int fr, int fq) const {
        const int col0 = u.pn * 128 + wc * 32 + 8 * fq;
#pragma unroll
        for (int ai = 0; ai < 2; ++ai)
#pragma unroll
            for (int m = 0; m < 4; ++m) { if (!(u.mask & (3 << (2 * ai)))) continue; f32x4 h0, h1;
#pragma unroll
                for (int e = 0; e < 4; ++e) { h0[e] = silu_f(acc[ai][0][m][0][e]) * acc[ai][1][m][0][e]; h1[e] = silu_f(acc[ai][0][m][1][e]) * acc[ai][1][m][1][e]; }
                u32x4 w; w.x = cvt_pk_bf16(h0[0], h0[1]); w.y = cvt_pk_bf16(h0[2], h0[3]); w.z = cvt_pk_bf16(h1[0], h1[1]); w.w = cvt_pk_bf16(h1[2], h1[3]);
                *(u32x4*)(HID + ((size_t)u.pm * 256 + (ai + u.qa) * 128 + wr * 64 + m * 16 + fr) * 1024 + col0) = w; }
    }
};
struct EpiDown {
    static constexpr bool PERM = true, AFTER_DRAIN = false;
    bf16_t* YB; const float* ROWW; float oscale;
    __device__ __forceinline__ void operator()(const f32x4 (&acc)[2][2][4][2], const Unit& u, int wr, int wc, int fr, int fq) const {
        const int col0 = u.pn * 256 + u.qb * 128 + wc * 32 + 8 * fq;
#pragma unroll
        for (int ai = 0; ai < 2; ++ai)
#pragma unroll
            for (int m = 0; m < 4; ++m) { const size_t row = (size_t)u.pm * 256 + (ai + u.qa) * 128 + wr * 64 + m * 16 + fr; const float w_ = ROWW[row] * oscale;
#pragma unroll
                for (int bj = 0; bj < 2; ++bj) { if (!(u.mask & (1 << (ai * 2 + bj)))) continue; const f32x4 v0 = acc[ai][bj][m][0] * w_, v1 = acc[ai][bj][m][1] * w_;
                    u32x4 w; w.x = cvt_pk_bf16(v0[0], v0[1]); w.y = cvt_pk_bf16(v0[2], v0[3]); w.z = cvt_pk_bf16(v1[0], v1[1]); w.w = cvt_pk_bf16(v1[2], v1[3]);
                    *(u32x4*)(YB + row * 1024 + col0 + bj * 128) = w; } }
    }
};
struct EpiDown8 {
    static constexpr bool PERM = false, AFTER_DRAIN = false;
    bf16_t* YB; const float* ROWW;
    __device__ __forceinline__ void operator()(const f32x4 (&acc)[2][2][4][2], const Unit& u, int wr, int wc, int fr, int fq) const {
        const int col0 = u.pn * 256 + u.qb * 128 + wc * 32 + 4 * fq;
#pragma unroll
        for (int ai = 0; ai < 2; ++ai)
#pragma unroll
            for (int m = 0; m < 4; ++m) { const size_t row = (size_t)u.pm * 256 + (ai + u.qa) * 128 + wr * 64 + m * 16 + fr; const float w_ = ROWW[row] * W8_INV;
#pragma unroll
                for (int bj = 0; bj < 2; ++bj)
#pragma unroll
                    for (int n = 0; n < 2; ++n) { if (!(u.mask & (1 << (ai * 2 + bj)))) continue; *(u32x2*)(YB + row * 1024 + col0 + bj * 128 + n * 16) = pk4(acc[ai][bj][m][n] * w_); } }
    }
};
struct EpiQKV1 {
    static constexpr bool PERM = false, AFTER_DRAIN = false;
    bf16_t *Q1, *K1, *V1; const float* ROPE;
    __device__ __forceinline__ void operator()(const f32x4 (&acc)[2][2][4][2], const Unit& u, int wr, int wc, int fr, int fq) const {
        const int jt = u.pm % 33; const bool latent = jt != 0;
        const int s0 = jt * 256 + u.qa * 128 + wr * 64 + fr; const size_t row0 = (size_t)u.pm * 256 + u.qa * 128 + wr * 64 + fr;
        const int cb = u.qb * 128 + wc * 32 + 4 * fq;
        if (u.pn == 5) {
#pragma unroll
            for (int ai = 0; ai < 2; ++ai)
#pragma unroll
                for (int m = 0; m < 4; ++m)
#pragma unroll
                    for (int bj = 0; bj < 2; ++bj)
#pragma unroll
                        for (int n = 0; n < 2; ++n) { if (!(u.mask & (1 << (ai * 2 + bj)))) continue; *(u32x2*)(V1 + (row0 + ai * 128 + m * 16) * 256 + cb + bj * 128 + n * 16) = pk4(acc[ai][bj][m][n]); }
        } else {
            const bool isq = u.pn < 4; bf16_t* O = isq ? Q1 + u.pn * 256 : K1; const int pitch = isq ? 1024 : 256; const float sc = isq ? C2 : 1.f;
#pragma unroll
            for (int ai = 0; ai < 2; ++ai)
#pragma unroll
                for (int m = 0; m < 4; ++m) {
                    f32x4 cs0 = {1.f, 0.f, 1.f, 0.f}, cs1 = {1.f, 0.f, 1.f, 0.f};
                    if (latent) { const int tau = s0 + ai * 128 + m * 16 - 256; const int pos = (wc & 1) ? (tau & 63) : (tau >> 6);
                        const float* rp = ROPE + (pos * 16 + 4 * fq) * 2; cs0 = *(const f32x4*)rp; cs1 = *(const f32x4*)(rp + 4); }
                    const float co[4] = {cs0[0], cs0[2], cs1[0], cs1[2]}, si[4] = {cs0[1], cs0[3], cs1[1], cs1[3]};
#pragma unroll
                    for (int bj = 0; bj < 2; ++bj) { if (!(u.mask & (1 << (ai * 2 + bj)))) continue; const f32x4 a0 = acc[ai][bj][m][0], a1 = acc[ai][bj][m][1]; f32x4 o0, o1;
#pragma unroll
                        for (int e = 0; e < 4; ++e) { o0[e] = (a0[e] * co[e] - a1[e] * si[e]) * sc; o1[e] = (a1[e] * co[e] + a0[e] * si[e]) * sc; }
                        bf16_t* p = O + (row0 + ai * 128 + m * 16) * pitch + cb + bj * 128;
                        *(u32x2*)p = pk4(o0); *(u32x2*)(p + 16) = pk4(o1); } }
        }
    }
};
template <class Epi, class Sched, bool ALIGN_EPI = false, bool SP2 = false, int TMASK = 0xF, bool F8 = false>
__device__ __forceinline__ void gemm_phase(PG8_LAS unsigned char* lds, const Gemm g, const Sched& S, const Epi& E) {
    int tid_ = threadIdx.x; asm volatile("" : "+v"(tid_));
    const int tid = tid_, wid = __builtin_amdgcn_readfirstlane(tid >> 6), lane = tid & 63, wr = wid >> 2, wc = wid & 3, fr = lane & 15, fq = lane >> 4;
    const int K = g.K, nt = K / BK;
    unsigned voffA, voffB;
    { int R, C; stage_rc(tid * 16, R, C); const int Rb = Epi::PERM ? ((R & ~31) + perm32(R & 31)) : R;
        voffA = (unsigned)(R * K + C) * 2u; voffB = (unsigned)(Rb * K + C) * 2u; }
#define voffB (*(Epi::PERM ? &voffB : &voffA))
    const size_t kstep = (size_t)(BK * 2);
    const size_t hstep = (size_t)HALF * K * 2;
    const size_t tstep = 2 * hstep;
    const unsigned ldsw = (unsigned)wid * 1024u;
    const int aoff = lds_byte(wr * 64 + fr, F8 ? fq * 16 : fq * 8), boff = lds_byte(wc * 32 + fr, F8 ? fq * 16 : fq * 8);
    typedef int v8i_t __attribute__((ext_vector_type(8))); typedef int v4i_t __attribute__((ext_vector_type(4)));
#define PG8_SA(b, h) (((b) * 2 + (h)) * HTB)
#define PG8_SB(b, h) ((4 + (b) * 2 + (h)) * HTB)
#define PG8_STAGE(bufoff, gbase, voff) do { _Pragma("unroll") for (int _i = 0; _i < 2; ++_i) \
        __builtin_amdgcn_global_load_lds((const unsigned*)((const char*)(gbase) + (size_t)_i * 128 * K + (voff)), (PG8_LAS unsigned*)(lds + (bufoff) + ldsw + _i * 8192), 16, 0, 0); } while (0)
#define PG8_LD8(base) __builtin_shufflevector(*(const PG8_LAS v4i_t*)(base), *(const PG8_LAS v4i_t*)((base) + 16), 0, 1, 2, 3, 4, 5, 6, 7)
#define PG8_LDA(dst, b, h) do { if (!((TMASK >> (2 * (h))) & 3)) break; \
        if constexpr (F8) { _Pragma("unroll") for (int m = 0; m < 4; ++m) dst##8[m] = PG8_LD8(lds + PG8_SA(b, h) + aoff + m * 2048); } \
        else { _Pragma("unroll") for (int m = 0; m < 4; ++m) _Pragma("unroll") for (int k = 0; k < 2; ++k) dst[m][k] = *(const PG8_LAS bf16x8*)(lds + PG8_SA(b, h) + aoff + m * 2048 + k * 1024); } } while (0)
#define PG8_LDB(dst, b, h) do { if (!(TMASK & (5 << (h)))) break; \
        if constexpr (F8) { _Pragma("unroll") for (int n = 0; n < 2; ++n) dst##8[n] = PG8_LD8(lds + PG8_SB(b, h) + boff + n * 2048); } \
        else { _Pragma("unroll") for (int n = 0; n < 2; ++n) _Pragma("unroll") for (int k = 0; k < 2; ++k) dst[n][k] = *(const PG8_LAS bf16x8*)(lds + PG8_SB(b, h) + boff + n * 2048 + k * 1024); } } while (0)
#define PG8_MMA(ai, bj, At, Bt) do { if (!((TMASK >> ((ai) * 2 + (bj))) & 1)) break; __builtin_amdgcn_s_setprio(1); \
        if constexpr (F8) { _Pragma("unroll") for (int m = 0; m < 4; ++m) _Pragma("unroll") for (int n = 0; n < 2; ++n) \
            acc[ai][bj][m][n] = __builtin_amdgcn_mfma_scale_f32_16x16x128_f8f6f4(Bt##8[n], At##8[m], acc[ai][bj][m][n], 0, 0, 0, 0x7f7f7f7f, 0, 0x7f7f7f7f); } \
        else { _Pragma("unroll") for (int m = 0; m < 4; ++m) _Pragma("unroll") for (int n = 0; n < 2; ++n) _Pragma("unroll") for (int k = 0; k < 2; ++k) \
            acc[ai][bj][m][n] = __builtin_amdgcn_mfma_f32_16x16x32_bf16(Bt[n][k], At[m][k], acc[ai][bj][m][n], 0, 0, 0); } \
        __builtin_amdgcn_s_setprio(0); } while (0)
#define PG8_WAIT_V(n) asm volatile("s_waitcnt vmcnt(" #n ")" ::: "memory")
#define PG8_WAIT_L(n) asm volatile("s_waitcnt lgkmcnt(" #n ")" ::: "memory")
#define PG8_BAR __builtin_amdgcn_s_barrier()
#define PG8_SCHED __builtin_amdgcn_sched_barrier(0)
    Unit cur, nxt; int ui = 0;
    if (!S.next(0, cur)) return;
    f32x4 acc[2][2][4][2];
#pragma unroll
    for (int a = 0; a < 2; ++a)
#pragma unroll
        for (int b = 0; b < 2; ++b)
#pragma unroll
            for (int m = 0; m < 4; ++m)
#pragma unroll
                for (int n = 0; n < 2; ++n) acc[a][b][m][n] = (f32x4){0.f, 0.f, 0.f, 0.f};
    bf16x8 At[4][2], B0[2][2], B1[2][2];
    v8i_t At8[4], B08[2], B18[2];
    const char* cA = (const char*)g.A + (size_t)cur.pm * tstep + (size_t)cur.qa * hstep; const char* cB = (const char*)g.Bt + (size_t)cur.be * g.bes + (size_t)cur.pn * tstep + (size_t)cur.qb * hstep;
    S.a_ready(cur);
    if constexpr (SP2) {
        PG8_STAGE(PG8_SB(0, 0), cB, voffB); PG8_STAGE(PG8_SB(0, 1), cB + hstep, voffB); PG8_STAGE(PG8_SA(0, 0), cA, voffA); PG8_STAGE(PG8_SA(0, 1), cA + hstep, voffA);
        if (wr == 1) PG8_BAR;
        PG8_WAIT_V(2); PG8_BAR;
        PG8_STAGE(PG8_SB(1, 0), cB + kstep, voffB); PG8_STAGE(PG8_SA(1, 0), cA + kstep, voffA); PG8_STAGE(PG8_SB(1, 1), cB + hstep + kstep, voffB);
        PG8_WAIT_V(6); PG8_BAR;
    } else {
        PG8_STAGE(PG8_SB(0, 0), cB, voffB); PG8_STAGE(PG8_SA(0, 0), cA, voffA); PG8_STAGE(PG8_SB(0, 1), cB + hstep, voffB); PG8_STAGE(PG8_SA(0, 1), cA + hstep, voffA);
        if (wr == 1) PG8_BAR;
        PG8_WAIT_V(4); PG8_BAR;
        PG8_STAGE(PG8_SB(1, 0), cB + kstep, voffB); PG8_STAGE(PG8_SA(1, 0), cA + kstep, voffA); PG8_STAGE(PG8_SB(1, 1), cB + hstep + kstep, voffB);
        PG8_WAIT_V(6); PG8_BAR;
    }
    for (;;) {
        const bool has_next = S.next(ui + 1, nxt);
        const char* nA = has_next ? (const char*)g.A + (size_t)nxt.pm * tstep + (size_t)nxt.qa * hstep : cA; const char* nB = has_next ? (const char*)g.Bt + (size_t)nxt.be * g.bes + (size_t)nxt.pn * tstep + (size_t)nxt.qb * hstep : cB;
#pragma unroll 1
        for (int t = 0; t < nt; t += 2) {
            const bool last = (t == nt - 2);
            const char* a1 = cA + (size_t)(t + 1) * kstep;
            const char* a2 = last ? nA : cA + (size_t)(t + 2) * kstep; const char* b2 = last ? nB : cB + (size_t)(t + 2) * kstep;
            const char* a3 = a2 + kstep; const char* b3 = b2 + kstep;
            if (last && has_next) S.a_ready(nxt);
            if constexpr (SP2) {
            PG8_LDB(B0, 0, 0); PG8_LDB(B1, 0, 1); PG8_SCHED; PG8_LDA(At, 0, 0); PG8_STAGE(PG8_SA(1, 1), a1 + hstep, voffA);
            PG8_WAIT_V(8); PG8_WAIT_L(0); PG8_BAR; PG8_MMA(0, 0, At, B0); PG8_MMA(0, 1, At, B1); PG8_BAR; PG8_SCHED;
            PG8_LDA(At, 0, 1); PG8_STAGE(PG8_SB(0, 0), b2, voffB); PG8_STAGE(PG8_SB(0, 1), b2 + hstep, voffB); PG8_STAGE(PG8_SA(0, 0), a2, voffA);
            PG8_WAIT_V(8); PG8_WAIT_L(0); PG8_BAR; PG8_MMA(1, 0, At, B0); PG8_MMA(1, 1, At, B1); PG8_BAR; PG8_SCHED;
            PG8_LDB(B0, 1, 0); PG8_LDB(B1, 1, 1); PG8_SCHED; PG8_LDA(At, 1, 0); PG8_STAGE(PG8_SA(0, 1), a2 + hstep, voffA);
            PG8_WAIT_V(8); PG8_WAIT_L(0); PG8_BAR; PG8_MMA(0, 0, At, B0); PG8_MMA(0, 1, At, B1); PG8_BAR; PG8_SCHED;
            PG8_LDA(At, 1, 1); PG8_STAGE(PG8_SB(1, 0), b3, voffB); PG8_STAGE(PG8_SB(1, 1), b3 + hstep, voffB); PG8_STAGE(PG8_SA(1, 0), a3, voffA);
            PG8_WAIT_V(8); PG8_WAIT_L(0); PG8_BAR; PG8_MMA(1, 0, At, B0); PG8_MMA(1, 1, At, B1); PG8_BAR; PG8_SCHED;
            } else {
            PG8_LDB(B0, 0, 0); PG8_SCHED; PG8_LDA(At, 0, 0); PG8_STAGE(PG8_SA(1, 1), a1 + hstep, voffA);
            PG8_WAIT_L(8); PG8_BAR; PG8_WAIT_L(0); PG8_MMA(0, 0, At, B0); PG8_BAR; PG8_SCHED;
            PG8_LDB(B1, 0, 1); PG8_STAGE(PG8_SB(0, 0), b2, voffB);
            PG8_BAR; PG8_WAIT_L(0); PG8_MMA(0, 1, At, B1); PG8_BAR;
            PG8_LDA(At, 0, 1); PG8_STAGE(PG8_SA(0, 0), a2, voffA);
            PG8_BAR; PG8_WAIT_L(0); PG8_MMA(1, 0, At, B0); PG8_BAR; PG8_SCHED;
            PG8_STAGE(PG8_SB(0, 1), b2 + hstep, voffB);
            PG8_WAIT_V(6); PG8_BAR; PG8_MMA(1, 1, At, B1); PG8_BAR;
            PG8_LDB(B0, 1, 0); PG8_SCHED; PG8_LDA(At, 1, 0); PG8_STAGE(PG8_SA(0, 1), a2 + hstep, voffA);
            PG8_WAIT_L(8); PG8_BAR; PG8_WAIT_L(0); PG8_MMA(0, 0, At, B0); PG8_BAR; PG8_SCHED;
            PG8_LDB(B1, 1, 1); PG8_STAGE(PG8_SB(1, 0), b3, voffB);
            PG8_BAR; PG8_WAIT_L(0); PG8_MMA(0, 1, At, B1); PG8_BAR;
            PG8_LDA(At, 1, 1); PG8_STAGE(PG8_SA(1, 0), a3, voffA);
            PG8_BAR; PG8_WAIT_L(0); PG8_MMA(1, 0, At, B0); PG8_BAR; PG8_SCHED;
            PG8_STAGE(PG8_SB(1, 1), b3 + hstep, voffB);
            PG8_WAIT_V(6); PG8_BAR; PG8_MMA(1, 1, At, B1); PG8_BAR;
            }
        }
        if constexpr (ALIGN_EPI) { if (wr == 0) PG8_BAR; }
        if constexpr (!Epi::AFTER_DRAIN) { int t_e = threadIdx.x; asm volatile("" : "+v"(t_e)); const int fr_e = t_e & 15, fq_e = (t_e >> 4) & 3;
            E(acc, cur, wr, wc, fr_e, fq_e); S.done(cur); }
        if (!has_next) break;
#pragma unroll
        for (int a = 0; a < 2; ++a)
#pragma unroll
            for (int b = 0; b < 2; ++b)
#pragma unroll
                for (int m = 0; m < 4; ++m)
#pragma unroll
                    for (int n = 0; n < 2; ++n) acc[a][b][m][n] = (f32x4){0.f, 0.f, 0.f, 0.f};
        cur = nxt; cA = nA; cB = nB; ++ui;
        if constexpr (ALIGN_EPI) { if (wr == 1) PG8_BAR; }
    }
    PG8_WAIT_V(0);
    if constexpr (!ALIGN_EPI) { if (wr == 0) PG8_BAR; }
    PG8_BAR;
    if constexpr (Epi::AFTER_DRAIN) { E.fused(acc, cur, wr, wc, fr, fq, lds, wid, lane); S.done(cur); }
#undef PG8_SA
#undef PG8_SB
#undef PG8_STAGE
#undef voffB
#undef PG8_LDA
#undef PG8_LDB
#undef PG8_MMA
#undef PG8_LD8
#undef PG8_WAIT_V
#undef PG8_WAIT_L
#undef PG8_BAR
#undef PG8_SCHED
}
}
namespace attn_body {
using bf16=__hip_bfloat16;
using bf16x8=__attribute__((ext_vector_type(8)))short;
using s16x4=__attribute__((ext_vector_type(4)))short;
using f32x16=__attribute__((ext_vector_type(16)))float;
using u32x4=__attribute__((ext_vector_type(4)))unsigned;
constexpr int D=64;
constexpr int NW=8,QBLK=32,QB=QBLK*NW,KVBLK=64;
constexpr int ATTN_UNIT_ROWS=QB;
__device__ __forceinline__ int crow(int r,int hi){return (r&3)+8*(r>>2)+4*hi;}
#define SBAR() __builtin_amdgcn_sched_barrier(0)
__device__ __forceinline__ void swamask(f32x16&p0,f32x16&p1,int dq0,bool tin,int hi){
  const float NEG=-INFINITY;
  #pragma unroll
  for(int r=0;r<16;++r){const int kv=4*hi+(r&3)+8*(r>>2); const int d0=dq0-kv, d1=d0-32;
    if(!(tin&&d0>=-128&&d0<=128))p0[r]=NEG; if(!(tin&&d1>=-128&&d1<=128))p1[r]=NEG;}
}

constexpr int NSLOT=3, SLOTB=8192;
constexpr int LDS_K=0, LDS_V=NSLOT*SLOTB, LDS_WS=2*NSLOT*SLOTB, LDS_OST=LDS_WS+NW*64*4, LDS_BYTES=LDS_OST+NW*4096;
constexpr float C2A=0.125f*1.4426950408889634f;
__device__ __forceinline__ void glds16(const void*gsrc,unsigned lds_dst){unsigned keep;
  asm volatile("s_mov_b32 %0, m0\n\ts_mov_b32 m0, %2\n\ts_nop 0\n\tglobal_load_lds_dwordx4 %1, off\n\ts_mov_b32 m0, %0":"=&s"(keep):"v"(gsrc),"s"(lds_dst):"memory");}
__device__ __forceinline__ float max3f(float a,float b,float c){float r;asm("v_max3_f32 %0, %1, %2, %3":"=v"(r):"v"(a),"v"(b),"v"(c));return r;}
__device__ __forceinline__ float max2f(float a,float b){float r;asm("v_max_f32_e32 %0, %1, %2":"=v"(r):"v"(a),"v"(b));return r;}
__device__ __forceinline__ float fadd_s(float a,float b){float r;asm("v_add_f32_e32 %0, %1, %2":"=v"(r):"v"(a),"v"(b));return r;}
__device__ __forceinline__ float fsub_s(float a,float b){float r;asm("v_sub_f32_e32 %0, %1, %2":"=v"(r):"v"(a),"v"(b));return r;}
typedef float f32x2_t __attribute__((ext_vector_type(2))); typedef __bf16 bf16x2_t __attribute__((ext_vector_type(2)));
__device__ __forceinline__ unsigned cvtpk_s(float lo,float hi){f32x2_t v={lo,hi};bf16x2_t b=__builtin_convertvector(v,bf16x2_t);return __builtin_bit_cast(unsigned,b);}
#define WAIT_BAR(N) asm volatile("s_waitcnt vmcnt(" #N ") lgkmcnt(0)\n\ts_barrier":::"memory")

__device__ __forceinline__ void qkt(f32x16&p0,f32x16&p1,const char*Kslot,const bf16x8*qr,const f32x16&negm,int r32,int hi){
  const char*kb=Kslot+hi*1024+r32*16;
  #pragma unroll
  for(int d0=0;d0<4;++d0){
    const bf16x8 b0=*reinterpret_cast<const bf16x8*>(kb+d0*2048);
    const bf16x8 b1=*reinterpret_cast<const bf16x8*>(kb+d0*2048+512);
    if(d0==0){p0=__builtin_amdgcn_mfma_f32_32x32x16_bf16(b0,qr[0],negm,0,0,0);p1=__builtin_amdgcn_mfma_f32_32x32x16_bf16(b1,qr[0],negm,0,0,0);}
    else{p0=__builtin_amdgcn_mfma_f32_32x32x16_bf16(b0,qr[d0],p0,0,0,0);p1=__builtin_amdgcn_mfma_f32_32x32x16_bf16(b1,qr[d0],p1,0,0,0);}}
}
typedef __attribute__((address_space(3))) const char* lds_cptr;
typedef short v4i16_t __attribute__((ext_vector_type(4)));
__device__ __forceinline__ void kload8(bf16x8*kf,lds_cptr kp){
  kf[0]=*(const __attribute__((address_space(3))) bf16x8*)(kp);      kf[1]=*(const __attribute__((address_space(3))) bf16x8*)(kp+512);
  kf[2]=*(const __attribute__((address_space(3))) bf16x8*)(kp+2048); kf[3]=*(const __attribute__((address_space(3))) bf16x8*)(kp+2560);
  kf[4]=*(const __attribute__((address_space(3))) bf16x8*)(kp+4096); kf[5]=*(const __attribute__((address_space(3))) bf16x8*)(kp+4608);
  kf[6]=*(const __attribute__((address_space(3))) bf16x8*)(kp+6144); kf[7]=*(const __attribute__((address_space(3))) bf16x8*)(kp+6656);
}
__device__ __forceinline__ void kload2(bf16x8*kf,lds_cptr kp,int j){ kf[2*j]=*(const __attribute__((address_space(3))) bf16x8*)(kp+j*2048); kf[2*j+1]=*(const __attribute__((address_space(3))) bf16x8*)(kp+j*2048+512); }
__device__ __forceinline__ s16x4 vtr(lds_cptr p){ return __builtin_bit_cast(s16x4,__builtin_amdgcn_ds_read_tr16_b64_v4i16((__attribute__((address_space(3))) v4i16_t*)p)); }
__device__ __forceinline__ float rowmax(const f32x16&p0,const f32x16&p1){
  float a=max3f(p0[0],p0[1],p1[0]),b=max3f(p0[2],p0[3],p1[1]);a=max3f(a,p1[2],p1[3]);
  #pragma unroll
  for(int r=4;r<16;r+=4){a=max3f(a,p0[r],p0[r+1]);b=max3f(b,p0[r+2],p0[r+3]);a=max3f(a,p1[r],p1[r+1]);b=max3f(b,p1[r+2],p1[r+3]);}
  const float m=max2f(a,b);
  auto rr=__builtin_amdgcn_permlane32_swap(__float_as_uint(m),__float_as_uint(m),false,false);
  return max2f(__uint_as_float(rr[0]),__uint_as_float(rr[1]));
}
__device__ __forceinline__ void pv(f32x16*o,int vb,bf16x8 pa0,bf16x8 pa1,bf16x8 pa2,bf16x8 pa3){
  #pragma unroll
  for(int d0=0;d0<2;++d0){s16x4 lo[4],hi[4];
    #pragma unroll
    for(int ks=0;ks<4;++ks){
      asm volatile("ds_read_b64_tr_b16 %0,%1 offset:%c2":"=&v"(lo[ks]):"v"(vb),"i"(d0*4096+ks*1024):"memory");
      asm volatile("ds_read_b64_tr_b16 %0,%1 offset:%c2":"=&v"(hi[ks]):"v"(vb),"i"(d0*4096+ks*1024+512):"memory");}
    asm volatile("s_waitcnt lgkmcnt(0)":::"memory");SBAR();
    #define PK(k) (bf16x8){lo[k][0],lo[k][1],lo[k][2],lo[k][3],hi[k][0],hi[k][1],hi[k][2],hi[k][3]}
    o[d0]=__builtin_amdgcn_mfma_f32_32x32x16_bf16(pa0,PK(0),o[d0],0,0,0);
    o[d0]=__builtin_amdgcn_mfma_f32_32x32x16_bf16(pa1,PK(1),o[d0],0,0,0);
    o[d0]=__builtin_amdgcn_mfma_f32_32x32x16_bf16(pa2,PK(2),o[d0],0,0,0);
    o[d0]=__builtin_amdgcn_mfma_f32_32x32x16_bf16(pa3,PK(3),o[d0],0,0,0);
    #undef PK
  }
}

#ifndef ATTN_STORE16
#define ATTN_STORE16(p,v) (*(u32x4*)(p)=(v))
#endif
template<int THRL,int MODE> __device__ __forceinline__ void attn_unit(const bf16*Qw0,int QP,const bf16*__restrict__ Kh,int KP,const bf16*__restrict__ Vh,int VP,bf16*Ow0,int OP,int NT,int tau0,const float*sinkp,char*shm){
  const int tid=threadIdx.x,lane=tid&63,r32=lane&31,hi=lane>>5; const int wid=__builtin_amdgcn_readfirstlane(tid>>6);
  const int wrow=(MODE==1)?(wid&1)*QBLK:wid*QBLK, wcol=(MODE==1)?(wid>>1)*64:0;
  const float sink_l2=(MODE==1)?sinkp[wid>>1]*1.4426950408889634f:0.f;
  const bf16*Qw=Qw0+(long)wrow*QP+wcol;
  const unsigned lds0=(unsigned)(uintptr_t)shm;
  float*wsf=(float*)(shm+LDS_WS)+wid*64;
  const bf16*ksrc=Kh+(long)lane*KP+wid*8;
  const bf16*vsrc=Vh+(long)(16*(wid&3)+(lane>>2))*VP+(wid>>2)*32+(lane&3)*8;
  const unsigned kdst=lds0+LDS_K+wid*1024, vdst=lds0+LDS_V+wid*1024;
  #define TROW(t) ((MODE==0||(t)<4)?(long)(t)*KVBLK:(long)(256+min(max(tau0-128+64*((t)-4),0),8192-64)))
  #define DMA_K(t,slot) glds16(ksrc+TROW(t)*KP,(unsigned)__builtin_amdgcn_readfirstlane(kdst+(slot)))
  #define DMA_V(t,slot) glds16(vsrc+TROW(t)*VP,(unsigned)__builtin_amdgcn_readfirstlane(vdst+(slot)))
  const int vb0=(int)(lds0+LDS_V)+((lane>>4)&1)*32+(lane&3)*8+(4*hi+((lane&15)>>2))*64;
  const char*Kbase=shm+LDS_K; bf16x8 kf[8];
  const lds_cptr shm3=(lds_cptr)shm; const lds_cptr kp0=shm3+LDS_K+hi*1024+r32*16; const lds_cptr vp0=shm3+LDS_V+((lane>>4)&1)*32+(lane&3)*8+(4*hi+((lane&15)>>2))*64;
  DMA_K(0,0);DMA_V(0,0);DMA_K(1,SLOTB);
  bf16x8 qr[4];
  #pragma unroll
  for(int d0=0;d0<4;++d0)qr[d0]=*reinterpret_cast<const bf16x8*>(&Qw[(long)r32*QP+d0*16+hi*8]);
  float mhat=0.f,l_reg=0.f;f32x16 o[2];o[0]=f32x16{};o[1]=f32x16{};f32x16 negm=f32x16{};asm volatile("":"+v"(negm));
  const int qrel=wrow+r32;
  #define CMASK(P0,P1,t) do{ if(MODE==1){ if((t)>=4){ const int ts_=tau0-128+64*((t)-4); swamask(P0,P1,qrel+128-64*((t)-4),(ts_>=0&&ts_<8192),hi);} } }while(0)
  bool resc=false;
  #define START(P0,P1) do{ const float rm=rowmax(P0,P1); resc=false; \
    { const float dl=rm; mhat=fadd_s(mhat,dl); \
      _Pragma("unroll") for(int r=0;r<16;++r){P0[r]=fsub_s(P0[r],dl);P1[r]=fsub_s(P1[r],dl);} \
      _Pragma("unroll") for(int r=0;r<16;++r)negm[r]=-mhat; asm volatile("":"+v"(negm)); } \
    _Pragma("unroll") for(int r=0;r<16;++r)P0[r]=__builtin_amdgcn_exp2f(P0[r]); }while(0)
  #define RESC() do{ if(resc){ asm volatile("s_waitcnt lgkmcnt(0)":::"memory"); \
      _Pragma("unroll") for(int d_=0;d_<2;++d_) _Pragma("unroll") for(int r=0;r<16;++r)o[d_][r]*=wsf[crow(r,hi)]; } }while(0)
  f32x16 pA0,pA1,pB0,pB1;
  int sl_prev=0,sl_cur=0,sl_next=SLOTB;
  #define ROT() do{sl_prev=sl_cur;sl_cur=sl_next;sl_next=(sl_next==(NSLOT-1)*SLOTB)?0:sl_next+SLOTB;}while(0)
  DMA_K(2,2*SLOTB);
  WAIT_BAR(3);
  qkt(pA0,pA1,Kbase,qr,negm,r32,hi);asm volatile("s_nop 15\n\ts_nop 7":"+v"(pA0),"+v"(pA1));CMASK(pA0,pA1,0);
  START(pA0,pA1);
  _Pragma("unroll") for(int r=0;r<16;++r)pA1[r]=__builtin_amdgcn_exp2f(pA1[r]);
  WAIT_BAR(0);
  DMA_K(3,0);DMA_V(1,SLOTB);
  ROT();
  kload8(kf,kp0+sl_cur);
  WAIT_BAR(2);
  s16x4 vlo[8],vhi[8]; u32x4 pw0,pw1,pw2,pw3;
  #define PKW(P,B) cvtpk_s(P[B],P[B+1])
  #define PAF(k) __builtin_bit_cast(bf16x8,pw##k)
  #define VFR(i) (bf16x8){vlo[i][0],vlo[i][1],vlo[i][2],vlo[i][3],vhi[i][0],vhi[i][1],vhi[i][2],vhi[i][3]}
  #define PIN(x) asm volatile("":"+v"(x))
  #define MX3(a,b,c) __builtin_fmaxf(__builtin_fmaxf((a),(b)),(c))
  #define GAPA(MF,A0,A1,A2,A3,W0,W1,PW) do{ MF; sacc+=A0; sacc+=A1; sacc+=A2; sacc+=A3; PIN(sacc); W0; W1; PIN(PW); SBAR(); }while(0)
  #define EX(v) __builtin_amdgcn_exp2f(v)
  #define GAPB(MF,X,B) do{ MF; X[B]=EX(X[B]); X[B+1]=EX(X[B+1]); X[B+2]=EX(X[B+2]); X[B+3]=EX(X[B+3]); PIN(X); SBAR(); }while(0)
  #define VRD(i) do{ vlo[i]=vtr(vp_+(((i)>>2)*4096+((i)&3)*1024)); vhi[i]=vtr(vp_+(((i)>>2)*4096+((i)&3)*1024+512)); }while(0)
  #define KRD(G,j) do{ if(G){ kload2(kf,kp0+sl_next,j); SBAR(); } }while(0)
  #define STEP(C0,C1,P0,P1,t,GK,GV,GL) do{ SBAR(); \
    const lds_cptr vp_=vp0+sl_prev; \
    VRD(0); SBAR(); float sacc=(P0[0]+P0[1]); \
    GAPA(C0=__builtin_amdgcn_mfma_f32_32x32x16_bf16(kf[0],qr[0],negm,0,0,0), P0[2],P0[3],P0[4],P0[5],     pw0[0]=PKW(P0,0), pw0[1]=PKW(P0,2), pw0); \
    VRD(4); SBAR(); GAPA(C1=__builtin_amdgcn_mfma_f32_32x32x16_bf16(kf[1],qr[0],negm,0,0,0), P0[6],P0[7],P0[8],P0[9],     pw0[2]=PKW(P0,4), pw0[3]=PKW(P0,6), pw0); \
    VRD(1); SBAR(); GAPA(C0=__builtin_amdgcn_mfma_f32_32x32x16_bf16(kf[2],qr[1],C0,0,0,0),   P0[10],P0[11],P0[12],P0[13], pw1[0]=PKW(P0,8), pw1[1]=PKW(P0,10), pw1); \
    VRD(5); SBAR(); GAPA(C1=__builtin_amdgcn_mfma_f32_32x32x16_bf16(kf[3],qr[1],C1,0,0,0),   P0[14],P0[15],P1[0],P1[1],   pw1[2]=PKW(P0,12),pw1[3]=PKW(P0,14), pw1); \
    VRD(2); SBAR(); GAPA(C0=__builtin_amdgcn_mfma_f32_32x32x16_bf16(kf[4],qr[2],C0,0,0,0),   P1[2],P1[3],P1[4],P1[5],     pw2[0]=PKW(P1,0), pw2[1]=PKW(P1,2), pw2); \
    VRD(6); SBAR(); GAPA(C1=__builtin_amdgcn_mfma_f32_32x32x16_bf16(kf[5],qr[2],C1,0,0,0),   P1[6],P1[7],P1[8],P1[9],     pw2[2]=PKW(P1,4), pw2[3]=PKW(P1,6), pw2); \
    VRD(3); SBAR(); GAPA(C0=__builtin_amdgcn_mfma_f32_32x32x16_bf16(kf[6],qr[3],C0,0,0,0),   P1[10],P1[11],P1[12],P1[13], pw3[0]=PKW(P1,8), pw3[1]=PKW(P1,10), pw3); \
    VRD(7); SBAR(); GAPA(C1=__builtin_amdgcn_mfma_f32_32x32x16_bf16(kf[7],qr[3],C1,0,0,0),   P1[14],P1[15],0.f,0.f,       pw3[2]=PKW(P1,12),pw3[3]=PKW(P1,14), pw3); \
    l_reg+=sacc; \
    if(GK){DMA_K((t)+3,sl_cur);} if(GV){DMA_V((t)+1,sl_next);} \
    CMASK(C0,C1,t); \
    { float a=MX3(C0[0],C0[1],C1[0]),b=MX3(C0[2],C0[3],C1[1]); a=MX3(a,C1[2],C1[3]); \
      _Pragma("unroll") for(int r=4;r<16;r+=4){a=MX3(a,C0[r],C0[r+1]);b=MX3(b,C0[r+2],C0[r+3]);a=MX3(a,C1[r],C1[r+1]);b=MX3(b,C1[r+2],C1[r+3]);} \
      float rm=__builtin_fmaxf(a,b); { auto rr=__builtin_amdgcn_permlane32_swap(__float_as_uint(rm),__float_as_uint(rm),false,false); rm=__builtin_fmaxf(__uint_as_float(rr[0]),__uint_as_float(rr[1])); } \
      resc=false; \
      if(__builtin_expect(__any(rm>(float)THRL),0)){ const float dl=__builtin_fmaxf(rm,0.f); mhat+=dl; \
        _Pragma("unroll") for(int r=0;r<16;++r){C0[r]-=dl;C1[r]-=dl;} \
        _Pragma("unroll") for(int r=0;r<16;++r)negm[r]=-mhat; asm volatile("":"+v"(negm)); \
        const float f=__builtin_amdgcn_exp2f(-dl); l_reg*=f; if(hi==0)wsf[r32]=f; resc=true; } } \
    SBAR(); \
    GAPB(o[0]=__builtin_amdgcn_mfma_f32_32x32x16_bf16(PAF(0),VFR(0),o[0],0,0,0), C0,0); \
    GAPB(o[1]=__builtin_amdgcn_mfma_f32_32x32x16_bf16(PAF(0),VFR(4),o[1],0,0,0), C0,4); \
    KRD(GL,0); GAPB(o[0]=__builtin_amdgcn_mfma_f32_32x32x16_bf16(PAF(1),VFR(1),o[0],0,0,0), C0,8); \
    KRD(GL,1); GAPB(o[1]=__builtin_amdgcn_mfma_f32_32x32x16_bf16(PAF(1),VFR(5),o[1],0,0,0), C0,12); \
    KRD(GL,2); GAPB(o[0]=__builtin_amdgcn_mfma_f32_32x32x16_bf16(PAF(2),VFR(2),o[0],0,0,0), C1,0); \
    KRD(GL,3); GAPB(o[1]=__builtin_amdgcn_mfma_f32_32x32x16_bf16(PAF(2),VFR(6),o[1],0,0,0), C1,4); \
    GAPB(o[0]=__builtin_amdgcn_mfma_f32_32x32x16_bf16(PAF(3),VFR(3),o[0],0,0,0), C1,8); \
    GAPB(o[1]=__builtin_amdgcn_mfma_f32_32x32x16_bf16(PAF(3),VFR(7),o[1],0,0,0), C1,12); \
    }while(0)
  int t=1;
  for(;t+5<NT;t+=2){
    STEP(pB0,pB1,pA0,pA1,t,true,true,true);     WAIT_BAR(2); RESC(); ROT();
    STEP(pA0,pA1,pB0,pB1,t+1,true,true,true);   WAIT_BAR(2); RESC(); ROT();
  }
  #define ENDW(tt) do{ if((tt)+3<NT){WAIT_BAR(2);} else if((tt)+2<NT){WAIT_BAR(1);} else {WAIT_BAR(0);} }while(0)
  #define DRAIN(X0,X1) do{ float sacc=X0[0]+X0[1]; _Pragma("unroll") for(int r=2;r<16;++r)sacc+=X0[r]; _Pragma("unroll") for(int r=0;r<16;++r)sacc+=X1[r]; l_reg+=sacc; \
    pw0=(u32x4){PKW(X0,0),PKW(X0,2),PKW(X0,4),PKW(X0,6)};pw1=(u32x4){PKW(X0,8),PKW(X0,10),PKW(X0,12),PKW(X0,14)};pw2=(u32x4){PKW(X1,0),PKW(X1,2),PKW(X1,4),PKW(X1,6)};pw3=(u32x4){PKW(X1,8),PKW(X1,10),PKW(X1,12),PKW(X1,14)}; \
    SBAR(); pv(o,vb0+sl_cur,PAF(0),PAF(1),PAF(2),PAF(3)); }while(0)
  if(NT&1){
    for(;t+2<NT;t+=2){
      STEP(pB0,pB1,pA0,pA1,t,(t+3<NT),(t+1<NT),(t+1<NT));       ENDW(t);   RESC(); ROT();
      STEP(pA0,pA1,pB0,pB1,t+1,(t+4<NT),(t+2<NT),(t+2<NT));     ENDW(t+1); RESC(); ROT();
    }
    STEP(pB0,pB1,pA0,pA1,t,false,true,true); ENDW(t); RESC(); ROT();
    STEP(pA0,pA1,pB0,pB1,NT-1,false,false,false); RESC();
    DRAIN(pA0,pA1);
  } else {
  for(;t+1<NT;t+=2){
    STEP(pB0,pB1,pA0,pA1,t,(t+3<NT),(t+1<NT),(t+1<NT));       ENDW(t);   RESC(); ROT();
    STEP(pA0,pA1,pB0,pB1,t+1,(t+4<NT),(t+2<NT),(t+2<NT));     ENDW(t+1); RESC(); ROT();
  }
  STEP(pB0,pB1,pA0,pA1,NT-1,false,false,false); RESC();
  DRAIN(pB0,pB1);
  }
  #undef DRAIN
  #undef PKW
  #undef PAF
  #undef VFR
  #undef PIN
  #undef MX3
  #undef GAPA
  #undef GAPB
  #undef EX
  #undef VRD
  #undef KRD
  #undef STEP
  #undef ENDW
  {auto rr=__builtin_amdgcn_permlane32_swap(__float_as_uint(l_reg),__float_as_uint(l_reg),false,false);l_reg=__uint_as_float(rr[0])+__uint_as_float(rr[1]);}
  if(MODE==1)l_reg+=__builtin_amdgcn_exp2f(sink_l2-mhat);
  if(hi==0)wsf[32+r32]=l_reg;asm volatile("s_waitcnt lgkmcnt(0)":::"memory");
  float rli[16];
  #pragma unroll
  for(int r=0;r<16;++r)rli[r]=__builtin_amdgcn_rcpf(wsf[32+crow(r,hi)]);
  bf16*Ow=Ow0+(long)wrow*OP+wcol;
  { bf16*stg=(bf16*)(shm+LDS_OST)+wid*2048;
    #pragma unroll
    for(int r=0;r<16;++r){const int orow=crow(r,hi);
      #pragma unroll
      for(int d0=0;d0<2;++d0)stg[orow*64+d0*32+r32]=__float2bfloat16(o[d0][r]*rli[r]);}
    asm volatile("s_waitcnt lgkmcnt(0)":::"memory");
    #pragma unroll
    for(int i=0;i<4;++i){const int row=i*8+(lane>>3),ch=lane&7; const u32x4 v=*(const u32x4*)(stg+row*64+ch*8); ATTN_STORE16(Ow+(long)row*OP+ch*8,v);} }
  asm volatile("s_waitcnt lgkmcnt(0)\n\ts_barrier":::"memory");
  #undef DMA_K
  #undef TROW
  #undef DMA_V
  #undef CMASK
  #undef START
  #undef RESC
  #undef ROT
}
constexpr int ATTN_LDS_BYTES=LDS_BYTES;
#undef SBAR
#undef WAIT_BAR
}
namespace attn_body {
constexpr int X_K=0, X_V=3*8192, X_WS=X_V+3*16384, X_OST=X_WS+NW*64*4, X_BYTES=X_OST+NW*8192;
#define SBAR() __builtin_amdgcn_sched_barrier(0)
#define WAIT_BAR(N) asm volatile("s_waitcnt vmcnt(" #N ") lgkmcnt(0)\n\ts_barrier":::"memory")
__device__ __forceinline__ void pv128(f32x16*o,int vb,bf16x8 pa0,bf16x8 pa1,bf16x8 pa2,bf16x8 pa3){
  #pragma unroll
  for(int d0=0;d0<4;++d0){s16x4 lo[4],hi[4];
    #pragma unroll
    for(int ks=0;ks<4;++ks){
      asm volatile("ds_read_b64_tr_b16 %0,%1 offset:%c2":"=&v"(lo[ks]):"v"(vb),"i"(d0*4096+ks*1024):"memory");
      asm volatile("ds_read_b64_tr_b16 %0,%1 offset:%c2":"=&v"(hi[ks]):"v"(vb),"i"(d0*4096+ks*1024+512):"memory");}
    asm volatile("s_waitcnt lgkmcnt(0)":::"memory");SBAR();
    #define PK(k) (bf16x8){lo[k][0],lo[k][1],lo[k][2],lo[k][3],hi[k][0],hi[k][1],hi[k][2],hi[k][3]}
    o[d0]=__builtin_amdgcn_mfma_f32_32x32x16_bf16(pa0,PK(0),o[d0],0,0,0);
    o[d0]=__builtin_amdgcn_mfma_f32_32x32x16_bf16(pa1,PK(1),o[d0],0,0,0);
    o[d0]=__builtin_amdgcn_mfma_f32_32x32x16_bf16(pa2,PK(2),o[d0],0,0,0);
    o[d0]=__builtin_amdgcn_mfma_f32_32x32x16_bf16(pa3,PK(3),o[d0],0,0,0);
    #undef PK
  }
}
template<int THRL,int EPI> __device__ __forceinline__ void attn_unit128(const bf16*Qw0,int QP,const bf16*__restrict__ Kh,int KP,const bf16*__restrict__ Vh,int VP,bf16*Ow0,int OP,int NT,float lam,const float*gsub,char*shm){
  const int tid=threadIdx.x,lane=tid&63,r32=lane&31,hi=lane>>5; const int wid=__builtin_amdgcn_readfirstlane(tid>>6);
  const bf16*Qw=Qw0+(long)(wid*QBLK)*QP;
  const unsigned lds0=(unsigned)(uintptr_t)shm;
  float*wsf=(float*)(shm+X_WS)+wid*64;
  const bf16*ksrc=Kh+(long)lane*KP+wid*8;
  const bf16*vsrc=Vh+(long)(16*(wid&3)+(lane>>2))*VP+(wid>>2)*32+(lane&3)*8;
  const unsigned kdst=lds0+X_K+wid*1024, vdst=lds0+X_V+wid*1024;
  #define DMA_K(t,slot) glds16(ksrc+(long)(t)*KVBLK*KP,(unsigned)__builtin_amdgcn_readfirstlane(kdst+(slot)))
  #define DMA_V(t,slot) do{ glds16(vsrc+(long)(t)*KVBLK*VP,(unsigned)__builtin_amdgcn_readfirstlane(vdst+2*(slot))); glds16(vsrc+(long)(t)*KVBLK*VP+64,(unsigned)__builtin_amdgcn_readfirstlane(vdst+2*(slot)+8192)); }while(0)
  const char*Kbase=shm+X_K; bf16x8 kf[8];
  const lds_cptr shm3=(lds_cptr)shm; const lds_cptr kp0=shm3+X_K+hi*1024+r32*16; const lds_cptr vp0=shm3+X_V+((lane>>4)&1)*32+(lane&3)*8+(4*hi+((lane&15)>>2))*64;
  DMA_K(0,0);DMA_V(0,0);DMA_K(1,SLOTB);
  bf16x8 qr[4];
  #pragma unroll
  for(int d0=0;d0<4;++d0)qr[d0]=*reinterpret_cast<const bf16x8*>(&Qw[(long)r32*QP+d0*16+hi*8]);
  float mhat=0.f,l_reg=0.f;f32x16 o[4];o[0]=f32x16{};o[1]=f32x16{};o[2]=f32x16{};o[3]=f32x16{};f32x16 negm=f32x16{};asm volatile("":"+v"(negm));
  bool resc=false;
  #define START(P0,P1) do{ const float rm=rowmax(P0,P1); resc=false; \
    { const float dl=rm; mhat=fadd_s(mhat,dl); \
      _Pragma("unroll") for(int r=0;r<16;++r){P0[r]=fsub_s(P0[r],dl);P1[r]=fsub_s(P1[r],dl);} \
      _Pragma("unroll") for(int r=0;r<16;++r)negm[r]=-mhat; asm volatile("":"+v"(negm)); } \
    _Pragma("unroll") for(int r=0;r<16;++r)P0[r]=__builtin_amdgcn_exp2f(P0[r]); }while(0)
  #define RESC() do{ if(resc){ asm volatile("s_waitcnt lgkmcnt(0)":::"memory"); \
      _Pragma("unroll") for(int d_=0;d_<4;++d_) _Pragma("unroll") for(int r=0;r<16;++r)o[d_][r]*=wsf[crow(r,hi)]; } }while(0)
  f32x16 pC0,pC1;
  int sl_prev=0,sl_cur=0,sl_next=SLOTB;
  #define ROT() do{sl_prev=sl_cur;sl_cur=sl_next;sl_next=(sl_next==(NSLOT-1)*SLOTB)?0:sl_next+SLOTB;}while(0)
  DMA_K(2,2*SLOTB);
  WAIT_BAR(3);
  s16x4 vlo[6],vhi[6]; u32x4 pw0,pw1,pw2,pw3;
  #define PKW(P,B) cvtpk_s(P[B],P[B+1])
  #define PAF(k) __builtin_bit_cast(bf16x8,pw##k)
  #define VFR(i) (bf16x8){vlo[i][0],vlo[i][1],vlo[i][2],vlo[i][3],vhi[i][0],vhi[i][1],vhi[i][2],vhi[i][3]}
  #define PIN(x) asm volatile("":"+v"(x))
  #define MX3(a,b,c) __builtin_fmaxf(__builtin_fmaxf((a),(b)),(c))
  #define EX(v) __builtin_amdgcn_exp2f(v)
  qkt(pC0,pC1,Kbase,qr,negm,r32,hi);asm volatile("s_nop 15\n\ts_nop 7":"+v"(pC0),"+v"(pC1));
  START(pC0,pC1);
  _Pragma("unroll") for(int r=0;r<16;++r)pC1[r]=__builtin_amdgcn_exp2f(pC1[r]);
  { float sacc=pC0[0]+pC0[1]; _Pragma("unroll") for(int r=2;r<16;++r)sacc+=pC0[r]; _Pragma("unroll") for(int r=0;r<16;++r)sacc+=pC1[r]; l_reg+=sacc;
    pw0=(u32x4){PKW(pC0,0),PKW(pC0,2),PKW(pC0,4),PKW(pC0,6)};pw1=(u32x4){PKW(pC0,8),PKW(pC0,10),PKW(pC0,12),PKW(pC0,14)};pw2=(u32x4){PKW(pC1,0),PKW(pC1,2),PKW(pC1,4),PKW(pC1,6)};pw3=(u32x4){PKW(pC1,8),PKW(pC1,10),PKW(pC1,12),PKW(pC1,14)}; }
  WAIT_BAR(0);
  DMA_K(3,0);DMA_V(1,SLOTB);
  ROT();
  kload8(kf,kp0+sl_cur);
  WAIT_BAR(3);
  #define VRDG(i,ks,d0) do{ vlo[i]=vtr(vp_+((d0)*4096+(ks)*1024)); vhi[i]=vtr(vp_+((d0)*4096+(ks)*1024+512)); }while(0)
  #define KRD(G,j) do{ if(G){ kload2(kf,kp0+sl_next,j); } }while(0)
  #define GA(i,ks,d0,MF) do{ VRDG(i,ks,d0); SBAR(); MF; SBAR(); }while(0)
  #define GN(MF) do{ MF; SBAR(); }while(0)
  #define GB0(MF,X,B,RL) do{ MF; X[B]=EX(X[B]); X[B+1]=EX(X[B+1]); PIN(X); RL; SBAR(); }while(0)
  #define GB1(MF,X,B,Y,C,PW,J,RL) do{ MF; X[B]=EX(X[B]); X[B+1]=EX(X[B+1]); PIN(X); sacc+=Y[C]; sacc+=Y[C+1]; PIN(sacc); PW[J]=PKW(Y,C); PIN(PW); RL; SBAR(); }while(0)
  #define PVM(d0,k,i) o[d0]=__builtin_amdgcn_mfma_f32_32x32x16_bf16(PAF(k),VFR(i),o[d0],0,0,0)
  #define STEP(t,GK,GV,GL) do{ SBAR(); \
    const lds_cptr vp_=vp0+2*sl_prev; \
    GN(pC0=__builtin_amdgcn_mfma_f32_32x32x16_bf16(kf[0],qr[0],negm,0,0,0)); \
    GN(pC1=__builtin_amdgcn_mfma_f32_32x32x16_bf16(kf[1],qr[0],negm,0,0,0)); \
    GA(0,0,0,pC0=__builtin_amdgcn_mfma_f32_32x32x16_bf16(kf[2],qr[1],pC0,0,0,0)); \
    GA(1,0,1,pC1=__builtin_amdgcn_mfma_f32_32x32x16_bf16(kf[3],qr[1],pC1,0,0,0)); \
    GA(2,0,2,pC0=__builtin_amdgcn_mfma_f32_32x32x16_bf16(kf[4],qr[2],pC0,0,0,0)); \
    GA(3,0,3,pC1=__builtin_amdgcn_mfma_f32_32x32x16_bf16(kf[5],qr[2],pC1,0,0,0)); \
    GA(4,1,0,pC0=__builtin_amdgcn_mfma_f32_32x32x16_bf16(kf[6],qr[3],pC0,0,0,0)); \
    GA(5,1,1,pC1=__builtin_amdgcn_mfma_f32_32x32x16_bf16(kf[7],qr[3],pC1,0,0,0)); \
    if(GK){DMA_K((t)+3,sl_cur);} if(GV){DMA_V((t)+1,sl_next);} \
    { float a=MX3(pC0[0],pC0[1],pC1[0]),b=MX3(pC0[2],pC0[3],pC1[1]); a=MX3(a,pC1[2],pC1[3]); \
      _Pragma("unroll") for(int r=4;r<16;r+=4){a=MX3(a,pC0[r],pC0[r+1]);b=MX3(b,pC0[r+2],pC0[r+3]);a=MX3(a,pC1[r],pC1[r+1]);b=MX3(b,pC1[r+2],pC1[r+3]);} \
      float rm=__builtin_fmaxf(a,b); { auto rr=__builtin_amdgcn_permlane32_swap(__float_as_uint(rm),__float_as_uint(rm),false,false); rm=__builtin_fmaxf(__uint_as_float(rr[0]),__uint_as_float(rr[1])); } \
      resc=false; \
      if(__builtin_expect(__any(rm>(float)THRL),0)){ const float dl=__builtin_fmaxf(rm,0.f); mhat+=dl; \
        _Pragma("unroll") for(int r=0;r<16;++r){pC0[r]-=dl;pC1[r]-=dl;} \
        _Pragma("unroll") for(int r=0;r<16;++r)negm[r]=-mhat; asm volatile("":"+v"(negm)); \
        const float f=__builtin_amdgcn_exp2f(-dl); l_reg*=f; if(hi==0)wsf[r32]=f; resc=true; } } \
    SBAR(); \
    float sacc=0.f; \
    GB0(PVM(0,0,0),pC0,0, VRDG(0,1,2)); \
    GB0(PVM(1,0,1),pC0,2, VRDG(1,1,3)); \
    GB0(PVM(2,0,2),pC0,4, VRDG(2,2,0)); \
    GB0(PVM(3,0,3),pC0,6, VRDG(3,2,1)); \
    GB1(PVM(0,1,4),pC0,8, pC0,0,pw0,0, VRDG(4,2,2)); \
    GB1(PVM(1,1,5),pC0,10, pC0,2,pw0,1, VRDG(5,2,3)); \
    GB1(PVM(2,1,0),pC0,12, pC0,4,pw0,2, VRDG(0,3,0)); \
    GB1(PVM(3,1,1),pC0,14, pC0,6,pw0,3, VRDG(1,3,1)); \
    GB1(PVM(0,2,2),pC1,0, pC0,8,pw1,0, VRDG(2,3,2)); \
    GB1(PVM(1,2,3),pC1,2, pC0,10,pw1,1, VRDG(3,3,3)); \
    GB1(PVM(2,2,4),pC1,4, pC0,12,pw1,2, (void)0); \
    GB1(PVM(3,2,5),pC1,6, pC0,14,pw1,3, (void)0); \
    GB1(PVM(0,3,0),pC1,8, pC1,0,pw2,0, KRD(GL,0)); \
    GB1(PVM(1,3,1),pC1,10, pC1,2,pw2,1, KRD(GL,1)); \
    GB1(PVM(2,3,2),pC1,12, pC1,4,pw2,2, KRD(GL,2)); \
    GB1(PVM(3,3,3),pC1,14, pC1,6,pw2,3, KRD(GL,3)); \
    sacc+=pC1[8];sacc+=pC1[9];pw3[0]=PKW(pC1,8); sacc+=pC1[10];sacc+=pC1[11];pw3[1]=PKW(pC1,10); sacc+=pC1[12];sacc+=pC1[13];pw3[2]=PKW(pC1,12); sacc+=pC1[14];sacc+=pC1[15];pw3[3]=PKW(pC1,14); \
    l_reg+=sacc; PIN(pw3); \
    }while(0)
  int t=1;
  for(;t+5<NT;t+=2){
    STEP(t,true,true,true);     WAIT_BAR(3); RESC(); ROT();
    STEP(t+1,true,true,true);   WAIT_BAR(3); RESC(); ROT();
  }
  #define ENDW(tt) do{ if((tt)+3<NT){WAIT_BAR(3);} else if((tt)+2<NT){WAIT_BAR(2);} else {WAIT_BAR(0);} }while(0)
  for(;t+1<NT;t+=2){
    STEP(t,(t+3<NT),(t+1<NT),(t+1<NT));       ENDW(t);   RESC(); ROT();
    STEP(t+1,(t+4<NT),(t+2<NT),(t+2<NT));     ENDW(t+1); RESC(); ROT();
  }
  STEP(NT-1,false,false,false); RESC();
  SBAR(); pv128(o,(int)(unsigned)(uintptr_t)vp0+2*sl_cur,PAF(0),PAF(1),PAF(2),PAF(3));
  #undef PKW
  #undef PAF
  #undef VFR
  #undef PIN
  #undef MX3
  #undef EX
  #undef VRDG
  #undef KRD
  #undef GA
  #undef GN
  #undef GB0
  #undef GB1
  #undef PVM
  #undef STEP
  #undef ENDW
  {auto rr=__builtin_amdgcn_permlane32_swap(__float_as_uint(l_reg),__float_as_uint(l_reg),false,false);l_reg=__uint_as_float(rr[0])+__uint_as_float(rr[1]);}
  if(hi==0)wsf[32+r32]=l_reg;asm volatile("s_waitcnt lgkmcnt(0)":::"memory");
  float rli[16];
  #pragma unroll
  for(int r=0;r<16;++r)rli[r]=__builtin_amdgcn_rcpf(wsf[32+crow(r,hi)]);
  bf16*Ow=Ow0+(long)(wid*QBLK)*OP;
  { bf16*stg=(bf16*)(shm+X_OST)+wid*4096;
    if(EPI==2){
      float gl[4];
      #pragma unroll
      for(int d0=0;d0<4;++d0)gl[d0]=gsub[d0*32+r32];
      #pragma unroll
      for(int r=0;r<16;++r){const int orow=crow(r,hi); float ss=0.f;
        #pragma unroll
        for(int d0=0;d0<4;++d0){const float dd=__bfloat162float(stg[orow*128+d0*32+r32])-lam*(o[d0][r]*rli[r]); o[d0][r]=dd; ss+=dd*dd;}
        ss+=dpp_f<0xB1>(ss);ss+=dpp_f<0x4E>(ss);ss+=dpp_f<0x141>(ss);ss+=dpp_f<0x140>(ss);ss=swap16_sum(ss,ss);
        const float rs=0.8f/sqrtf(ss*(1.f/128.f)+1e-6f);
        #pragma unroll
        for(int d0=0;d0<4;++d0)stg[orow*128+d0*32+r32]=__float2bfloat16(o[d0][r]*rs*gl[d0]);}
    } else {
    #pragma unroll
    for(int r=0;r<16;++r){const int orow=crow(r,hi);
      #pragma unroll
      for(int d0=0;d0<4;++d0)stg[orow*128+d0*32+r32]=__float2bfloat16(o[d0][r]*rli[r]);}
    }
    asm volatile("s_waitcnt lgkmcnt(0)":::"memory");
    if(EPI!=1){
    #pragma unroll
    for(int i=0;i<8;++i){const int row=i*4+(lane>>4),ch=lane&15; const u32x4 v=*(const u32x4*)(stg+row*128+ch*8); ATTN_STORE16(Ow+(long)row*OP+ch*8,v);} } }
  asm volatile("s_waitcnt lgkmcnt(0)\n\ts_barrier":::"memory");
  #undef DMA_K
  #undef DMA_V
  #undef START
  #undef RESC
  #undef ROT
}
#undef SBAR
#undef WAIT_BAR
}

typedef unsigned u32x2f __attribute__((ext_vector_type(2)));
constexpr int NWAVES = 8;
constexpr int LDS_BYTES = 147456;
__device__ __forceinline__ float wave_sum(float v) {
    v += dpp_f<0xB1>(v);
    v += dpp_f<0x4E>(v);
    v += dpp_f<0x141>(v);
    v += dpp_f<0x140>(v);
    v = swap16_sum(v, v); v = swap32_sum(v, v);
    return v;
}
__device__ __forceinline__ float bf2f(unsigned short h) { return __uint_as_float((unsigned)h << 16); }
__device__ __forceinline__ float silu_d(float v) { return v / (1.f + __expf(-v)); }

__device__ __forceinline__ void titem_load(const float* src, int ldw, f32x4 (&r)[8], int lane) {
#pragma unroll
    for (int i = 0; i < 8; ++i) r[i] = *(const GAS f32x4*)(src + (size_t)(8 * i + (lane >> 3)) * ldw + 4 * (lane & 7));
}
__device__ __forceinline__ void titem_finish(const f32x4 (&r)[8], bf16* dst, LAS float* scr, int lane) {
#pragma unroll
    for (int i = 0; i < 8; ++i) { LAS float* p = scr + (8 * i + (lane >> 3)) * 33 + 4 * (lane & 7); p[0] = r[i].x; p[1] = r[i].y; p[2] = r[i].z; p[3] = r[i].w; }
    LDS_WAIT(); asm volatile("" ::: "memory");
    const int c = lane & 7;
#pragma unroll
    for (int j = 0; j < 4; ++j) { const int n = (lane >> 3) + 8 * j; const LAS float* q = scr + (8 * c) * 33 + n;
        v4u o; o.x = pk2(q[0 * 33], q[1 * 33]); o.y = pk2(q[2 * 33], q[3 * 33]); o.z = pk2(q[4 * 33], q[5 * 33]); o.w = pk2(q[6 * 33], q[7 * 33]);
        *(GAS v4u*)(dst + (size_t)n * 1024 + 8 * c) = o; }
    LDS_WAIT(); asm volatile("" ::: "memory");
}
__device__ __forceinline__ void titem_finish8(const f32x4 (&r)[8], unsigned char* dst8, LAS float* scr, int lane) {
#pragma unroll
    for (int i = 0; i < 8; ++i) { LAS float* p = scr + (8 * i + (lane >> 3)) * 33 + 4 * (lane & 7); p[0] = r[i].x; p[1] = r[i].y; p[2] = r[i].z; p[3] = r[i].w; }
    LDS_WAIT(); asm volatile("" ::: "memory");
    const int c = lane & 7;
#pragma unroll
    for (int j = 0; j < 4; ++j) { const int n = (lane >> 3) + 8 * j; const LAS float* q = scr + (8 * c) * 33 + n;
        u32x2f o; o.x = pg8::pk4_fp8(q[0 * 33] * pg8::W8_SCALE, q[1 * 33] * pg8::W8_SCALE, q[2 * 33] * pg8::W8_SCALE, q[3 * 33] * pg8::W8_SCALE);
        o.y = pg8::pk4_fp8(q[4 * 33] * pg8::W8_SCALE, q[5 * 33] * pg8::W8_SCALE, q[6 * 33] * pg8::W8_SCALE, q[7 * 33] * pg8::W8_SCALE);
        *(GAS u32x2f*)(dst8 + (size_t)n * 1024 + 8 * c) = o; }
    LDS_WAIT(); asm volatile("" ::: "memory");
}
constexpr int CONV_ND = 2048 + 512 + 768 + 512, CONV_NM = 16 * 3 * 512;
#define CONV_DESC(MODE, it, src, ldw, dst) do { int r_ = (it); \
    if ((MODE) == 0) { \
        if (r_ < 2048) { const int kb = r_ >> 7, nb = r_ & 127; src = win + (size_t)(64 * kb) * 4096 + 32 * nb; ldw = 4096; dst = (bf16*)(ws + WS_WIN) + (size_t)(32 * nb) * 1024 + 64 * kb; } \
        else if (r_ < 2560) { r_ -= 2048; const int kb = r_ >> 5, nb = r_ & 31; src = wout0 + (size_t)(64 * kb) * 1024 + 32 * nb; ldw = 1024; dst = (bf16*)(ws + WS_WOE) + (size_t)(32 * nb) * 1024 + 64 * kb; } \
        else if (r_ < 3328) { r_ -= 2560; const int kb = r_ / 48, nb = r_ % 48; src = wqkv + (size_t)(64 * kb) * 1536 + 32 * nb; ldw = 1536; dst = (bf16*)(ws + WS_WQKV) + (size_t)(32 * nb) * 1024 + 64 * kb; } \
        else { r_ -= 3328; const int kb = r_ >> 5, nb = r_ & 31; src = wout1 + (size_t)(64 * kb) * 1024 + 32 * nb; ldw = 1024; dst = (bf16*)(ws + WS_WOO) + (size_t)(32 * nb) * 1024 + 64 * kb; } \
    } else { const int im = r_; const size_t wo = (MODE) == 3 ? 0 : (size_t)16 * 1024 * 1024; \
        const int e = im / 1536, rem = im % 1536, which = rem >> 9, item = rem & 511, kb = item >> 5, nb = item & 31; \
        const float* W = (which == 0 ? mg : which == 1 ? mu : md) + wo; \
        src = W + ((size_t)e * 1024 + 64 * kb) * 1024 + 32 * nb; ldw = 1024; \
        unsigned char* W13 = ws + ((MODE) == 3 ? WS_MOE0_13 : WS_MOE1_13); unsigned char* W2 = ws + ((MODE) == 3 ? WS_MOE0_2 : WS_MOE1_2);     \
        dst = (bf16*)(which < 2 ? W13 + ((size_t)e * 2048 + (nb >> 2) * 256 + which * 128 + (nb & 3) * 32) * 1024 + 64 * kb : W2 + ((size_t)e * 1024 + 32 * nb) * 1024 + 64 * kb); } } while (0)
template <int MODE> __device__ __forceinline__ void conv_loop(const float* win, const float* wout0, const float* wqkv, const float* wout1, const float* mg, const float* mu, const float* md,
                                                            unsigned char* ws, int first, int stride, LAS float* scr, int lane) {
    const int total = MODE == 0 ? CONV_ND : CONV_NM; int it = first; if (it >= total) return;
    f32x4 r0[8], r1[8], r2[8], r3[8]; const float* s_; int ldw; bf16 *d0, *d1, *d2, *d3;
#define CONV_ISSUE(R, D, idx) do { if ((idx) < total) { CONV_DESC(MODE, (idx), s_, ldw, D); titem_load(s_, ldw, R, lane); } } while (0)
#define CONV_FIN(R, D) do { if constexpr (MODE == 0) titem_finish(R, D, scr, lane); else titem_finish8(R, (unsigned char*)D, scr, lane); } while (0)
    CONV_ISSUE(r0, d0, it); CONV_ISSUE(r1, d1, it + stride); CONV_ISSUE(r2, d2, it + 2 * stride);
    for (;;) {
        CONV_ISSUE(r3, d3, it + 3 * stride); CONV_FIN(r0, d0); if (it + stride >= total) break;
        CONV_ISSUE(r0, d0, it + 4 * stride); CONV_FIN(r1, d1); if (it + 2 * stride >= total) break;
        CONV_ISSUE(r1, d1, it + 5 * stride); CONV_FIN(r2, d2); if (it + 3 * stride >= total) break;
        CONV_ISSUE(r2, d2, it + 6 * stride); CONV_FIN(r3, d3); if (it + 4 * stride >= total) break;
        it += 4 * stride;
    }
#undef CONV_ISSUE
#undef CONV_FIN
}

__device__ __forceinline__ void normmod_row(f32x4 (&v)[4], const float* g, const float* sc, const float* sh, int lane) {
    float s2 = 0.f;
#pragma unroll
    for (int j = 0; j < 4; ++j) s2 += (v[j].x * v[j].x + v[j].y * v[j].y) + (v[j].z * v[j].z + v[j].w * v[j].w);
    const float rstd = __builtin_amdgcn_rsqf(wave_sum(s2) * (1.f / 1024.f) + EPS_);
#pragma unroll
    for (int j = 0; j < 4; ++j) { const f32x4 gv = *((const f32x4*)g + 64 * j + lane), scv = *((const f32x4*)sc + 64 * j + lane), shv = *((const f32x4*)sh + 64 * j + lane);
        v[j] = v[j] * rstd * gv * (1.f + scv) + shv; }
}
__device__ __forceinline__ void store_row_bf16(const f32x4 (&v)[4], bf16* orow, int lane) {
    GAS unsigned long long* o8 = (GAS unsigned long long*)orow + lane;
#pragma unroll
    for (int j = 0; j < 4; ++j) o8[64 * j] = (unsigned long long)pk2(v[j].x, v[j].y) | ((unsigned long long)pk2(v[j].z, v[j].w) << 32);
}
__device__ __forceinline__ void load_row_b16(f32x4 (&v)[4], const bf16* xrow, int lane) {
    const u32x2f* xr = (const u32x2f*)xrow + lane;
#pragma unroll
    for (int j = 0; j < 4; ++j) { const u32x2f w = xr[64 * j]; v[j].x = __uint_as_float(w.x << 16); v[j].y = __uint_as_float(w.x & 0xffff0000u); v[j].z = __uint_as_float(w.y << 16); v[j].w = __uint_as_float(w.y & 0xffff0000u); }
}
__device__ __forceinline__ void load_row_f32(f32x4 (&v)[4], const float* xrow, int lane) {
    const f32x4* xr = (const f32x4*)xrow + lane;
#pragma unroll
    for (int j = 0; j < 4; ++j) v[j] = xr[64 * j];
}
__device__ __forceinline__ void add_moe_rows(f32x4 (&v)[4], const bf16* y0, const bf16* y1, const float* gate, int lane) {
#pragma unroll
    for (int j = 0; j < 4; ++j) { const u32x2f a = *((const u32x2f*)y0 + 64 * j + lane), b = *((const u32x2f*)y1 + 64 * j + lane); const f32x4 gv = *((const f32x4*)gate + 64 * j + lane);
        f32x4 f; f.x = __uint_as_float(a.x << 16) + __uint_as_float(b.x << 16); f.y = __uint_as_float(a.x & 0xffff0000u) + __uint_as_float(b.x & 0xffff0000u);
        f.z = __uint_as_float(a.y << 16) + __uint_as_float(b.y << 16); f.w = __uint_as_float(a.y & 0xffff0000u) + __uint_as_float(b.y & 0xffff0000u);
        v[j] = v[j] + gv * f; }
}

typedef float f32x2g __attribute__((ext_vector_type(2)));
typedef float f32x4g __attribute__((ext_vector_type(4)));
constexpr int HG_QI = 0, HG_QN = 17408, HG_KO = 34816, HG_VT = 52224, HG_SC = 70656, HG_ST = 79872, HG_SCR = 114688;
constexpr int HG_LDQ = 272, HG_LDT = 144;
typedef short hbf16x8 __attribute__((ext_vector_type(8)));
typedef float hf32x4 __attribute__((ext_vector_type(4)));
__device__ __forceinline__ int hg_chunk(int dir, int j) { return dir == 0 ? j : (j < 4 ? 3 - j : 135 - j); }
__device__ __forceinline__ void hg_scan(int dir, int dk, int tq, LAS float* scr, const float (&v)[16], float (&cum)[16], float& tot, float& ref) {
    float c[16]; float run = 0.f;
#pragma unroll
    for (int i = 0; i < 16; ++i) { run += v[i]; c[i] = run; }
    scr[tq * 128 + dk] = run;
    __syncthreads();
    const float q0 = scr[dk], q1 = scr[128 + dk], q2 = scr[256 + dk], q3 = scr[384 + dk];
    tot = (q0 + q1) + (q2 + q3);
    if (dir == 0) { const float off = (tq > 0 ? q0 : 0.f) + (tq > 1 ? q1 : 0.f) + (tq > 2 ? q2 : 0.f);
#pragma unroll
        for (int i = 0; i < 16; ++i) cum[i] = c[i] + off;
        ref = q0 + q1; }
    else { const float off = (tq < 3 ? q3 : 0.f) + (tq < 2 ? q2 : 0.f) + (tq < 1 ? q1 : 0.f);
#pragma unroll
        for (int i = 0; i < 16; ++i) cum[i] = (run - c[i] + v[i]) + off;
        ref = q2 + q3; }
    __syncthreads();
}
__device__ __forceinline__ void hg_ld16(const unsigned short* p, int tid, unsigned (&w)[8]) {
    const int c = tid & 127, tq = tid >> 7;
#pragma unroll
    for (int i = 0; i < 8; ++i) { const unsigned lo = p[(size_t)(16 * tq + 2 * i) * 512 + c], hi = p[(size_t)(16 * tq + 2 * i + 1) * 512 + c]; w[i] = lo | (hi << 16); }
}
__device__ __forceinline__ float h2f(unsigned short h) { return (float)__builtin_bit_cast(_Float16, h); }
__device__ __forceinline__ void hg_store_vt(const unsigned (&w)[8], LAS unsigned char* L, int tid) {
    const int dv = tid & 127, tq = tid >> 7;
    LAS v4u* d = (LAS v4u*)(L + HG_VT + dv * HG_LDT + tq * 32);
    d[0] = (v4u){w[0], w[1], w[2], w[3]}; d[1] = (v4u){w[4], w[5], w[6], w[7]};
}
__device__ __forceinline__ void hgrn_pass1(int first, int stride, int total, const _Float16* LFF, const _Float16* LFB, const bf16* IV, unsigned char* U, float* TOT, LAS unsigned char* L, int tid, int wave, int lane) {
    const int dk = tid & 127, tq = tid >> 7, fr = lane & 15, fq = lane >> 4;
    unsigned nlf[8], niv[8];
#define HG1_LOAD(u_) do { const int j_ = (u_) % NCHUNK, sq_ = (u_) / NCHUNK, dir_ = sq_ >> 3, b_ = (sq_ >> 2) & 1, h_ = sq_ & 3; const size_t r0_ = (size_t)b_ * SB + 64 * j_; \
        hg_ld16((const unsigned short*)((dir_ ? LFB : LFF) + r0_ * 512 + h_ * 128), tid, nlf); hg_ld16(IV + r0_ * 512 + h_ * 128, tid, niv); } while (0)
    if (first < total) HG1_LOAD(first);
    for (int u = first; u < total; u += stride) {
        const int j = u % NCHUNK, sq = u / NCHUNK, dir = sq >> 3;
        const int n = hg_chunk(dir, j);
        float v[16]; unsigned iv[8];
#pragma unroll
        for (int i = 0; i < 8; ++i) { v[2 * i] = h2f((unsigned short)(nlf[i] & 0xffffu)); v[2 * i + 1] = h2f((unsigned short)(nlf[i] >> 16)); iv[i] = niv[i]; }
        if (u + stride < total) HG1_LOAD(u + stride);
        float cum[16], tot, ref;
        hg_scan(dir, dk, tq, (LAS float*)(L + HG_SCR), v, cum, tot, ref);
        unsigned w[8];
#pragma unroll
        for (int i = 0; i < 8; ++i) { const float k0 = (1.f - __expf(v[2 * i])) * __expf(tot - cum[2 * i]), k1 = (1.f - __expf(v[2 * i + 1])) * __expf(tot - cum[2 * i + 1]); w[i] = pk2(k0, k1); }
        { LAS v4u* d = (LAS v4u*)(L + HG_QI + dk * HG_LDT + tq * 32); d[0] = (v4u){w[0], w[1], w[2], w[3]}; d[1] = (v4u){w[4], w[5], w[6], w[7]}; }
        if (tq == 0) TOT[((size_t)sq * NCHUNK + n) * 128 + dk] = tot;
        hg_store_vt(iv, L, tid);
        __syncthreads();
        hf32x4 acc[8];
#pragma unroll
        for (int nt = 0; nt < 8; ++nt) acc[nt] = (hf32x4){0.f, 0.f, 0.f, 0.f};
#pragma unroll
        for (int kk = 0; kk < 2; ++kk) { const hbf16x8 A = *(const LAS hbf16x8*)(L + HG_QI + (16 * wave + fr) * HG_LDT + kk * 64 + fq * 16);
#pragma unroll
            for (int nt = 0; nt < 8; ++nt) { const hbf16x8 B = *(const LAS hbf16x8*)(L + HG_VT + (16 * nt + fr) * HG_LDT + kk * 64 + fq * 16);
                acc[nt] = __builtin_amdgcn_mfma_f32_16x16x32_bf16(A, B, acc[nt], 0, 0, 0); } }
        unsigned char* up = U + ((size_t)sq * NCHUNK + n) * 16384 + 16 * wave + 4 * fq;
#pragma unroll
        for (int nt = 0; nt < 8; ++nt) *(unsigned*)(up + (size_t)(16 * nt + fr) * 128) = pg8::pk4_fp8(acc[nt][0], acc[nt][1], acc[nt][2], acc[nt][3]);
        __syncthreads();
    }
#undef HG1_LOAD
}
__device__ __forceinline__ void hgrn_pass2(const unsigned char* U, const float* TOT, unsigned char* S, int gtid, int nthreads) {
    for (int idx = gtid; idx < 16 * 4096; idx += nthreads) {
        const int sq = idx >> 12, p = idx & 4095;
        const unsigned* up = (const unsigned*)(U + (size_t)sq * NCHUNK * 16384) + p; unsigned* sp = (unsigned*)(S + (size_t)sq * NCHUNK * 16384) + p;
        const f32x4g* tp = (const f32x4g*)(TOT + (size_t)sq * NCHUNK * 128) + (p & 31);
        float s0 = 0.f, s1 = 0.f, s2 = 0.f, s3 = 0.f;
        for (int n = 0; n < NCHUNK; n += 22) {
            unsigned uu[22]; f32x4g tt[22];
#pragma unroll
            for (int k = 0; k < 22; ++k) { uu[k] = up[(size_t)(n + k) * 4096]; tt[k] = tp[(size_t)(n + k) * 32]; }
#pragma unroll
            for (int k = 0; k < 22; ++k) { sp[(size_t)(n + k) * 4096] = pg8::pk4_fp8(s0, s1, s2, s3);
                const f32x2g lo = __builtin_amdgcn_cvt_pk_f32_fp8((int)uu[k], false), hi = __builtin_amdgcn_cvt_pk_f32_fp8((int)uu[k], true);
                s0 = __expf(tt[k].x) * s0 + lo.x; s1 = __expf(tt[k].y) * s1 + lo.y; s2 = __expf(tt[k].z) * s2 + hi.x; s3 = __expf(tt[k].w) * s3 + hi.y; }
        }
    }
}
__device__ __forceinline__ void hg3_dir(int dir, const float (&v)[16], const float (&qv)[16], const v4u (&st)[2], hf32x4 (&acc)[4], LAS unsigned char* L, int tid, int wave, int lane) {
    const int dk = tid & 127, tq = tid >> 7, fr = lane & 15, fq = lane >> 4, mt_o = wave & 3, ntb = 4 * (wave >> 2);
    float cum[16], tot, ref;
    hg_scan(dir, dk, tq, (LAS float*)(L + HG_SCR), v, cum, tot, ref);
#pragma unroll
    for (int i = 0; i < 16; ++i) { const int t = 16 * tq + i;
        const float qi = qv[i] * __expf(cum[i] - ref), qn = qv[i] * __expf(cum[i]), ko = (1.f - __expf(v[i])) * __expf(ref - cum[i]);
        *(LAS unsigned short*)(L + HG_QI + t * HG_LDQ + dk * 2) = (unsigned short)f2bf(qi);
        *(LAS unsigned short*)(L + HG_QN + t * HG_LDQ + dk * 2) = (unsigned short)f2bf(qn);
        *(LAS unsigned short*)(L + HG_KO + t * HG_LDQ + dk * 2) = (unsigned short)f2bf(ko); }
    { LAS v4u* d = (LAS v4u*)(L + HG_ST + (tid >> 2) * HG_LDQ + (tid & 3) * 64);
#pragma unroll
        for (int k = 0; k < 4; ++k) { unsigned w[4];
#pragma unroll
            for (int c = 0; c < 2; ++c) { const int x = (int)st[k >> 1][2 * (k & 1) + c]; const f32x2g lo = __builtin_amdgcn_cvt_pk_f32_fp8(x, false), hi = __builtin_amdgcn_cvt_pk_f32_fp8(x, true);
                w[2 * c] = pk2(lo.x, lo.y); w[2 * c + 1] = pk2(hi.x, hi.y); }
            d[k] = (v4u){w[0], w[1], w[2], w[3]}; } }
    __syncthreads();
    {
        const int mt = wave >> 1;
#pragma unroll
        for (int n2 = 0; n2 < 2; ++n2) { const int nt = 2 * (wave & 1) + n2; hf32x4 sc = {0.f, 0.f, 0.f, 0.f};
#pragma unroll
            for (int kk = 0; kk < 4; ++kk) { const hbf16x8 A = *(const LAS hbf16x8*)(L + HG_QI + (16 * mt + fr) * HG_LDQ + kk * 64 + fq * 16);
                const hbf16x8 B = *(const LAS hbf16x8*)(L + HG_KO + (16 * nt + fr) * HG_LDQ + kk * 64 + fq * 16);
                sc = __builtin_amdgcn_mfma_f32_16x16x32_bf16(A, B, sc, 0, 0, 0); }
#pragma unroll
            for (int r = 0; r < 4; ++r) { const int t = 16 * mt + 4 * fq + r, s_ = 16 * nt + fr; const bool keep = dir ? (s_ >= t) : (s_ <= t);
                *(LAS unsigned short*)(L + HG_SC + t * HG_LDT + s_ * 2) = (unsigned short)f2bf(keep ? sc[r] : 0.f); } }
    }
    __syncthreads();
#pragma unroll
    for (int nt = 0; nt < 4; ++nt) {
#pragma unroll
        for (int kk = 0; kk < 2; ++kk) { const hbf16x8 A = *(const LAS hbf16x8*)(L + HG_SC + (16 * mt_o + fr) * HG_LDT + kk * 64 + fq * 16);
            const hbf16x8 B = *(const LAS hbf16x8*)(L + HG_VT + (16 * (ntb + nt) + fr) * HG_LDT + kk * 64 + fq * 16);
            acc[nt] = __builtin_amdgcn_mfma_f32_16x16x32_bf16(A, B, acc[nt], 0, 0, 0); }
#pragma unroll
        for (int kk = 0; kk < 4; ++kk) { const hbf16x8 A = *(const LAS hbf16x8*)(L + HG_QN + (16 * mt_o + fr) * HG_LDQ + kk * 64 + fq * 16);
            const hbf16x8 B = *(const LAS hbf16x8*)(L + HG_ST + (16 * (ntb + nt) + fr) * HG_LDQ + kk * 64 + fq * 16);
            acc[nt] = __builtin_amdgcn_mfma_f32_16x16x32_bf16(A, B, acc[nt], 0, 0, 0); }
    }
    __syncthreads();
}
__device__ __forceinline__ void hgrn_pass3_unit(int u, const bf16* QH, const _Float16* LFF, const _Float16* LFB, const bf16* IV, const bf16* GG, const unsigned char* S, const float* onorm_g, bf16* Y,
                                                LAS unsigned char* L, int tid, int wave, int lane) {
    const int j = u % NCHUNK, bh = u / NCHUNK, b = bh >> 2, h = bh & 3;
    const size_t row0 = (size_t)b * SB + 64 * j;
    const int fr = lane & 15, fq = lane >> 4;
    unsigned wf[8], wb[8], wq[8], wi[8]; v4u stf[2], stb[2];
    hg_ld16((const unsigned short*)(LFF + row0 * 512 + h * 128), tid, wf); hg_ld16((const unsigned short*)(LFB + row0 * 512 + h * 128), tid, wb);
    hg_ld16(QH + row0 * 512 + h * 128, tid, wq); hg_ld16(IV + row0 * 512 + h * 128, tid, wi);
    { const unsigned char* sp = S + ((size_t)bh * NCHUNK + hg_chunk(0, j)) * 16384 + (tid >> 2) * 128 + (tid & 3) * 32; const unsigned char* sq_ = S + ((size_t)(8 + bh) * NCHUNK + hg_chunk(1, j)) * 16384 + (tid >> 2) * 128 + (tid & 3) * 32;
#pragma unroll
        for (int k = 0; k < 2; ++k) { stf[k] = *((const GAS v4u*)sp + k); stb[k] = *((const GAS v4u*)sq_ + k); } }
    hg_store_vt(wi, L, tid);
    float vf[16], vb[16], qv[16];
#pragma unroll
    for (int i = 0; i < 8; ++i) { vf[2 * i] = h2f((unsigned short)(wf[i] & 0xffffu)); vf[2 * i + 1] = h2f((unsigned short)(wf[i] >> 16)); vb[2 * i] = h2f((unsigned short)(wb[i] & 0xffffu)); vb[2 * i + 1] = h2f((unsigned short)(wb[i] >> 16));
        qv[2 * i] = __uint_as_float(wq[i] << 16); qv[2 * i + 1] = __uint_as_float(wq[i] & 0xffff0000u); }
    hf32x4 acc[4];
#pragma unroll
    for (int nt = 0; nt < 4; ++nt) acc[nt] = (hf32x4){0.f, 0.f, 0.f, 0.f};
    const int mt_o = wave & 3, ntb = 4 * (wave >> 2);
    hg3_dir(0, vf, qv, stf, acc, L, tid, wave, lane);
    hg3_dir(1, vb, qv, stb, acc, L, tid, wave, lane);
    LAS float* red = (LAS float*)(L + HG_SCR);
    float ss[4];
#pragma unroll
    for (int r = 0; r < 4; ++r) { float s = 0.f;
#pragma unroll
        for (int nt = 0; nt < 4; ++nt) s += acc[nt][r] * acc[nt][r];
        s += dpp_f<0xB1>(s); s += dpp_f<0x4E>(s); s += dpp_f<0x141>(s); s += dpp_f<0x140>(s); ss[r] = s; }
    if (fr == 0) {
#pragma unroll
        for (int r = 0; r < 4; ++r) red[(wave >> 2) * 64 + 16 * mt_o + 4 * fq + r] = ss[r]; }
    __syncthreads();
#pragma unroll
    for (int r = 0; r < 4; ++r) { const int t = 16 * mt_o + 4 * fq + r; const float rstd = __builtin_amdgcn_rsqf((red[t] + red[64 + t]) * (1.f / 128.f) + EPS_);
#pragma unroll
        for (int nt = 0; nt < 4; ++nt) { const int dv = 16 * (ntb + nt) + fr; const float gg = bf2f(GG[(row0 + t) * 512 + h * 128 + dv]);
            Y[(row0 + t) * 1024 + h * 128 + dv] = (bf16)f2bf(acc[nt][r] * rstd * onorm_g[dv] * gg); } }
    __syncthreads();
}

#ifndef TS_PHASE
#define TS_PHASE (-1)
#endif
struct KArgs { const float* in[23]; float* out; unsigned char* ws; int ph_lo, ph_hi, use_cg, pad; };
constexpr int N_PHASES = 21;
enum { I_X = 0, I_C, I_CTX, I_CCTX, I_ADAW, I_ADAB, I_NMIX, I_NFFN, I_EWIN, I_EWOUT, I_LBL, I_ONORM, I_DLAM, I_SUBLN, I_OWQKV, I_OWOUT, I_SINK, I_RW, I_RB, I_MG, I_MU, I_MD, I_FNG };

__device__ __forceinline__ float xreduce16(const float (&a)[16], int lane) {
    const bool b3 = (lane & 8) != 0, b2 = (lane & 4) != 0;
    float b[8], c[4], d[2];
#pragma unroll
    for (int e = 0; e < 8; ++e) b[e] = swap32_sum(a[e], a[e + 8]);
#pragma unroll
    for (int e = 0; e < 4; ++e) c[e] = swap16_sum(b[e], b[e + 4]);
#pragma unroll
    for (int e = 0; e < 2; ++e) { const float keep = b3 ? c[e + 2] : c[e], send = b3 ? c[e] : c[e + 2]; d[e] = keep + dpp_f<0x140>(send); }
    float x; { const float keep = b2 ? d[1] : d[0], send = b2 ? d[0] : d[1]; x = keep + dpp_f<0x141>(send); }
    x += dpp_f<0x4E>(x); x += dpp_f<0xB1>(x);
    return x;
}
__device__ __forceinline__ void load_row_raw(u32x2f (&w)[4], const bf16* xrow, int lane) {
    const u32x2f* xr = (const u32x2f*)xrow + lane;
#pragma unroll
    for (int j = 0; j < 4; ++j) w[j] = xr[64 * j];
}
__device__ __forceinline__ void raw_to_f32(f32x4 (&v)[4], const u32x2f (&w)[4]) {
#pragma unroll
    for (int j = 0; j < 4; ++j) { v[j].x = __uint_as_float(w[j].x << 16); v[j].y = __uint_as_float(w[j].x & 0xffff0000u); v[j].z = __uint_as_float(w[j].y << 16); v[j].w = __uint_as_float(w[j].y & 0xffff0000u); }
}
__device__ __forceinline__ void router_phase(const bf16* X, const float* gffn, const float* MODL, const float* rw, const float* rb, bf16* H2, int* EXPID, float* EXPW, int* RANK, int* CNT,
                                             bool latent_only, LAS unsigned char* L, int tid, int wave, int lane) {
    LAS float* rwT = (LAS float*)L;
    LAS int* cnt = (LAS int*)(L + 16 * 1028 * 4);
    LAS float* LG = (LAS float*)(L + 16 * 1028 * 4 + 64);
    for (int i = tid; i < 16384; i += 512) rwT[(i & 15) * 1028 + (i >> 4)] = rw[i];
    if (tid < 16) cnt[tid] = 0;
    __syncthreads();
    const int base = blockIdx.x * 66;
    u32x2f n0[4], n1[4];
    load_row_raw(n0, X + (size_t)(base + wave) * 1024, lane); load_row_raw(n1, X + (size_t)(base + wave + 8) * 1024, lane);
    for (int rr = wave; rr < 66; rr += 16) {
        f32x4 v0[4], v1[4]; raw_to_f32(v0, n0); raw_to_f32(v1, n1);
        if (rr + 16 < 66) load_row_raw(n0, X + (size_t)(base + rr + 16) * 1024, lane);
        if (rr + 24 < 66) load_row_raw(n1, X + (size_t)(base + rr + 24) * 1024, lane);
        const int r0 = base + rr, r1 = r0 + 8, b0 = r0 / SB, s0 = r0 % SB, b1 = r1 / SB, s1 = r1 % SB;
        const bool do0 = !(latent_only && s0 < 256), do1 = (rr + 8 < 66) && !(latent_only && s1 < 256);
        if (!do0 && !do1) continue;
        if (do0) { const float* mp = MODL + (s0 < 256 ? 2 : b0) * 6144; normmod_row(v0, gffn, mp + 4096, mp + 3072, lane);
            GAS unsigned* o4 = (GAS unsigned*)((unsigned char*)H2 + (size_t)r0 * 1024) + lane;
#pragma unroll
            for (int j = 0; j < 4; ++j) o4[64 * j] = pg8::pk4_fp8(v0[j].x, v0[j].y, v0[j].z, v0[j].w); }
        if (do1) { const float* mp = MODL + (s1 < 256 ? 2 : b1) * 6144; normmod_row(v1, gffn, mp + 4096, mp + 3072, lane);
            GAS unsigned* o4 = (GAS unsigned*)((unsigned char*)H2 + (size_t)r1 * 1024) + lane;
#pragma unroll
            for (int j = 0; j < 4; ++j) o4[64 * j] = pg8::pk4_fp8(v1[j].x, v1[j].y, v1[j].z, v1[j].w); }
        float a0[16], a1[16];
#pragma unroll
        for (int e = 0; e < 16; ++e) { float x0 = 0.f, x1 = 0.f;
#pragma unroll
            for (int j = 0; j < 4; ++j) { const f32x4 w = *(const LAS f32x4*)(rwT + e * 1028 + 256 * j + 4 * lane);
                x0 += (v0[j].x * w.x + v0[j].y * w.y) + (v0[j].z * w.z + v0[j].w * w.w); x1 += (v1[j].x * w.x + v1[j].y * w.y) + (v1[j].z * w.z + v1[j].w * w.w); }
            a0[e] = x0; a1[e] = x1; }
        const float l0 = xreduce16(a0, lane), l1 = xreduce16(a1, lane);
        if ((lane & 3) == 0) { if (do0) LG[rr * 17 + (lane >> 2)] = l0; if (do1) LG[(rr + 8) * 17 + (lane >> 2)] = l1; }
    }
    __syncthreads();
    if (tid < 66) {
        const int r = base + tid, s = r % SB;
        if (!(latent_only && s < 256)) {
            float aff[16], sel[16];
#pragma unroll
            for (int e = 0; e < 16; ++e) { aff[e] = 1.f / (1.f + __expf(-LG[tid * 17 + e])); sel[e] = aff[e] + rb[e]; }
            int grp = 0; float best = -1e30f;
#pragma unroll
            for (int g = 0; g < 4; ++g) { float m1 = -1e30f, m2 = -1e30f;
#pragma unroll
                for (int k = 0; k < 4; ++k) { const float x = sel[4 * g + k]; if (x > m1) { m2 = m1; m1 = x; } else if (x > m2) m2 = x; }
                const float sc = m1 + m2; if (sc > best) { best = sc; grp = g; } }
            float s4[4], a4[4];
#pragma unroll
            for (int k = 0; k < 4; ++k) { s4[k] = grp == 0 ? sel[k] : grp == 1 ? sel[4 + k] : grp == 2 ? sel[8 + k] : sel[12 + k]; a4[k] = grp == 0 ? aff[k] : grp == 1 ? aff[4 + k] : grp == 2 ? aff[8 + k] : aff[12 + k]; }
            int i1 = 0;
#pragma unroll
            for (int k = 1; k < 4; ++k) if (s4[k] > s4[i1]) i1 = k;
            int i2 = i1 == 0 ? 1 : 0;
#pragma unroll
            for (int k = 0; k < 4; ++k) if (k != i1 && k != i2 && s4[k] > s4[i2]) i2 = k;
            const float a1 = i1 == 0 ? a4[0] : i1 == 1 ? a4[1] : i1 == 2 ? a4[2] : a4[3], a2 = i2 == 0 ? a4[0] : i2 == 1 ? a4[1] : i2 == 2 ? a4[2] : a4[3];
            const int e1 = 4 * grp + i1, e2 = 4 * grp + i2; const float inv = 1.f / (a1 + a2);
            const int r1 = __hip_atomic_fetch_add(cnt + e1, 1, __ATOMIC_RELAXED, __HIP_MEMORY_SCOPE_WORKGROUP), r2 = __hip_atomic_fetch_add(cnt + e2, 1, __ATOMIC_RELAXED, __HIP_MEMORY_SCOPE_WORKGROUP);
            EXPID[2 * r] = e1; EXPID[2 * r + 1] = e2; EXPW[2 * r] = a1 * inv; EXPW[2 * r + 1] = a2 * inv; RANK[2 * r] = r1; RANK[2 * r + 1] = r2;
        }
    }
    __syncthreads();
    if (tid < 16) CNT[blockIdx.x * 16 + tid] = cnt[tid];
    __syncthreads();
}
__device__ __forceinline__ void index_phase(const int* CNT, const int* EXPID, const float* EXPW, const int* RANK, const bf16* H2, int* TOKSLOT, float* ROWW, bf16* XS, int* META,
                                            bool latent_only, LAS unsigned char* L, int tid, int wave, int lane) {
    LAS int* part = (LAS int*)L;
    LAS int* base = part + 512;
    LAS int* pst = base + 16;
    { const int e = tid & 15, g = tid >> 4; int s = 0;
#pragma unroll
        for (int k = 0; k < 8; ++k) s += CNT[(8 * g + k) * 16 + e];
        part[g * 16 + e] = s; }
    __syncthreads();
    if (tid < 16) { const int e = tid; int tot = 0, off = 0; const int gb = blockIdx.x >> 3;
        for (int g = 0; g < 32; ++g) { const int p = part[g * 16 + e]; tot += p; if (g < gb) off += p; }
        for (int bb = gb * 8; bb < (int)blockIdx.x; ++bb) off += CNT[bb * 16 + e];
        base[e] = off; pst[e] = (tot + 255) >> 8; }
    __syncthreads();
    if (tid == 0) { int run = 0;
        for (int e = 0; e < 16; ++e) { const int nt = pst[e]; pst[e] = run * 256;
            if (blockIdx.x == 0) for (int k = 0; k < nt; ++k) META[16 + run + k] = e;
            run += nt; }
        pst[16] = run * 256; if (blockIdx.x == 0) META[0] = run; }
    __syncthreads();
    int dest = -1;
    { const int a = wave + 8 * lane, r = blockIdx.x * 66 + (a >> 1), k = a & 1;
      if (lane < 17 && a < 132 && !(latent_only && (r % SB) < 256)) { const int e = EXPID[2 * r + k]; dest = pst[e] + base[e] + RANK[2 * r + k]; TOKSLOT[2 * r + k] = dest; ROWW[dest] = EXPW[2 * r + k]; } }
    for (int i0 = 0; i0 < 20; i0 += 4) {
        v4u va[4]; int d[4];
#pragma unroll
        for (int q = 0; q < 4; ++q) { d[q] = __shfl(dest, (i0 + q) & 63); const int a = wave + 8 * (i0 + q); if (i0 + q >= 17 || a >= 132) d[q] = -1;
            if (d[q] >= 0) va[q] = *((const GAS v4u*)((const unsigned char*)H2 + (size_t)(blockIdx.x * 66 + (a >> 1)) * 1024) + lane); }
#pragma unroll
        for (int q = 0; q < 4; ++q) if (d[q] >= 0) *((GAS v4u*)((unsigned char*)XS + (size_t)d[q] * 1024) + lane) = va[q];
    }
    __syncthreads();
}

typedef const __attribute__((address_space(4))) KArgs KArgsC;
#define PROLOG \
    KArgsC* ka = ka0; asm volatile("" : "+s"(ka)); \
    unsigned char* const ws = ka->ws; \
    int tid = threadIdx.x; asm volatile("" : "+v"(tid)); \
    const int lane = tid & 63, wave = __builtin_amdgcn_readfirstlane(tid >> 6); \
    const int G = gridDim.x, bid = blockIdx.x, gw = bid * NWAVES + wave, NGW = G * NWAVES; \
    (void)lane; (void)gw; (void)NGW; (void)ws;
#define P_F32(off) ((float*)(ws + (off)))
#define P_I32(off) ((int*)(ws + (off)))
#define P_B16(off) ((bf16*)(ws + (off)))
#define P_U8(off) ((unsigned char*)(ws + (off)))
__global__ void __launch_bounds__(NWAVES * 64, 2) dit_fwd(KArgs args_by_value) {
    extern __shared__ __attribute__((aligned(16))) unsigned char lds[];
    LAS unsigned char* L = (LAS unsigned char*)lds;
    KArgsC* ka0 = (KArgsC*)__builtin_amdgcn_kernarg_segment_ptr();
    const int lo = ka0->ph_lo, hi = ka0->ph_hi;
    volatile LAS unsigned* bst = (volatile LAS unsigned*)(L + LDS_BYTES - 64);
    if (threadIdx.x < 2) bst[threadIdx.x] = 0u;
    __syncthreads();
    if (ka0->use_cg) (void)xcd_barrier_post((unsigned*)(ka0->ws + WS_CTL) + 1024, bst);
    if (TS_PHASE == 0 && blockIdx.x == 0 && threadIdx.x == 0) *(volatile LAS unsigned long long*)(L + LDS_BYTES - 32) = __builtin_amdgcn_s_memrealtime();
#define IN(k) (lo <= (k) && (k) < hi)
#ifndef REP_MASK
#define REP_MASK 0
#endif
#define PHASE(k) for (int rep_ = IN(k) ? 0 : 99; rep_ < 1 + (int)((REP_MASK >> (k)) & 1); ++rep_)
#define TS_MARK(k) do { if (TS_PHASE >= 0 && blockIdx.x == 0 && threadIdx.x == 0) { volatile LAS unsigned long long* tw_ = (volatile LAS unsigned long long*)(L + LDS_BYTES - 32); \
        if ((k) + 1 == TS_PHASE) tw_[0] = __builtin_amdgcn_s_memrealtime(); \
        if ((k) == TS_PHASE) { const unsigned long long t1_ = __builtin_amdgcn_s_memrealtime(), d_ = 4ull * (t1_ - tw_[0]); while (__builtin_amdgcn_s_memrealtime() - t1_ < d_) __builtin_amdgcn_s_sleep(8); } } } while (0)
#define SEAM(k) do { if (IN(k) && IN((k) + 1) && ka0->use_cg) { for (int sr_ = 0; sr_ < 1 + (int)((REP_MASK >> 27) & 1); ++sr_) { \
        XcdBarrier xb_; xb_.bar = (unsigned*)(ka0->ws + WS_CTL) + 1024; xb_.x = xb_xcc_id(); xb_.st = bst; xcd_barrier(xb_); } TS_MARK(k); } } while (0)
#define VCU ((G % 8 == 0) ? (bid % 8) * (G / 8) + bid / 8 : bid)

    PHASE(0) { PROLOG
        for (int r24_ = 0; r24_ < 1 + (int)((REP_MASK >> 24) & 1); ++r24_) { LAS float* scr = (LAS float*)(L + wave * 16384);
          conv_loop<0>(ka->in[I_EWIN], ka->in[I_EWOUT], ka->in[I_OWQKV], ka->in[I_OWOUT], ka->in[I_MG], ka->in[I_MU], ka->in[I_MD], ws, gw, NGW, scr, lane); }
        __syncthreads();
        for (int r25_ = 0; r25_ < 1 + (int)((REP_MASK >> 25) & 1); ++r25_) {
            const int l = bid >> 7, col0 = 48 * (bid & 127);
            LAS float* sl = (LAS float*)L;
            LAS float* red = sl + 3072;
            for (int i = tid; i < 3072; i += 512) sl[i] = silu_d(i < 2048 ? ka->in[I_C][i] : ka->in[I_CCTX][i - 2048]);
            __syncthreads();
            const int r = lane >> 4, cs = lane & 15;
            const float* aw = ka->in[I_ADAW] + ((size_t)l * 1024 + 128 * wave + r) * 6144 + col0 + 3 * cs;
            const LAS float* sp = sl + 128 * wave + r;
            float a[3][3];
#pragma unroll
            for (int v = 0; v < 3; ++v) { a[v][0] = 0.f; a[v][1] = 0.f; a[v][2] = 0.f; }
#pragma unroll 1
            for (int i0 = 0; i0 < 32; i0 += 16) { float w0[16], w1[16], w2[16];
#pragma unroll
                for (int i = 0; i < 16; ++i) { const float* p = aw + (size_t)(4 * (i0 + i)) * 6144; w0[i] = p[0]; w1[i] = p[1]; w2[i] = p[2]; }
#pragma unroll
                for (int i = 0; i < 16; ++i) {
#pragma unroll
                    for (int v = 0; v < 3; ++v) { const float sv = sp[1024 * v + 4 * (i0 + i)]; a[v][0] += sv * w0[i]; a[v][1] += sv * w1[i]; a[v][2] += sv * w2[i]; } } }
#pragma unroll
            for (int v = 0; v < 3; ++v) {
#pragma unroll
                for (int j = 0; j < 3; ++j) { float x = a[v][j]; x += __shfl_xor(x, 16); x += __shfl_xor(x, 32); a[v][j] = x; } }
            if (r == 0) {
#pragma unroll
                for (int v = 0; v < 3; ++v) { red[(wave * 3 + v) * 48 + 3 * cs] = a[v][0]; red[(wave * 3 + v) * 48 + 3 * cs + 1] = a[v][1]; red[(wave * 3 + v) * 48 + 3 * cs + 2] = a[v][2]; } }
            __syncthreads();
            if (tid < 144) { const int v = tid / 48, jj = tid % 48; float x = ka->in[I_ADAB][l * 6144 + col0 + jj];
#pragma unroll
                for (int w = 0; w < 8; ++w) x += red[(w * 3 + v) * 48 + jj];
                P_F32(WS_MOD)[(l * 3 + v) * 6144 + col0 + jj] = x; }
            __syncthreads();
        }
        if (bid == 96) {
            for (int i = tid; i < 1024; i += 512) { const float* lg = ka->in[I_LBL]; const float l0 = lg[i], l1 = lg[1024 + i], l2 = lg[2048 + i]; const float m = fmaxf(l0, fmaxf(l1, l2));
                const float e0 = expf(l0 - m), e1 = expf(l1 - m), e2 = expf(l2 - m); P_F32(WS_LB)[i] = e0 / (e0 + e1 + e2); }
            if (wave == 0) { const float* lp = ka->in[I_DLAM]; const float s0 = wave_sum(lp[lane] * lp[64 + lane]), s1 = wave_sum(lp[128 + lane] * lp[192 + lane]);
                if (lane == 0) P_F32(WS_LAM)[0] = expf(s0) - expf(s1) + 0.2f; }
        } else if (bid == 97) {
            for (int i = tid; i < 2048; i += 512) { const int pos = i >> 4, jj = i & 15; const float inv = 1.0f / powf(10000.0f, (float)(2 * jj) / 32.0f); const float ang = (float)pos * inv;
                P_F32(WS_ROPE)[2 * i] = cosf(ang); P_F32(WS_ROPE)[2 * i + 1] = sinf(ang); }
        }
    }
    SEAM(0);
    PHASE(1) { PROLOG
        for (int r = gw; r < MR; r += 2 * NGW) { const int r2 = r + NGW; const bool h2 = r2 < MR;
            const int b = r / SB, s_ = r % SB, b2 = h2 ? r2 / SB : b, s2_ = h2 ? r2 % SB : s_;
            const float* srcA = s_ < 256 ? ka->in[I_CTX] + ((size_t)b * 256 + s_) * 1024 : ka->in[I_X] + ((size_t)b * 8192 + s_ - 256) * 1024;
            const float* srcB = s2_ < 256 ? ka->in[I_CTX] + ((size_t)b2 * 256 + s2_) * 1024 : ka->in[I_X] + ((size_t)b2 * 8192 + s2_ - 256) * 1024;
            f32x4 va[4], vb[4]; load_row_f32(va, srcA, lane); load_row_f32(vb, srcB, lane);
            const float* mpA = P_F32(WS_MOD) + (s_ < 256 ? 2 : b) * 6144; const float* mpB = P_F32(WS_MOD) + (s2_ < 256 ? 2 : b2) * 6144;
            normmod_row(va, ka->in[I_NMIX], mpA + 1024, mpA, lane); store_row_bf16(va, P_B16(WS_H) + (size_t)r * 1024, lane);
            if (h2) { normmod_row(vb, ka->in[I_NMIX], mpB + 1024, mpB, lane); store_row_bf16(vb, P_B16(WS_H) + (size_t)r2 * 1024, lane); } }
    }
    SEAM(1);
    PHASE(2) { PROLOG
        pg8::Gemm g{P_B16(WS_H), P_B16(WS_WIN), MR, 4096, 1024, 0}; pg8::DenseOrder So; So.init(66, 16, G, bid, false, G == 256 ? 1 : 0);
        pg8::EpiInProj E{P_B16(WS_QH), P_B16(WS_IV), P_B16(WS_GG), P_B16(WS_DQ), P_B16(WS_DK), P_B16(WS_DV), (_Float16*)P_F32(WS_LFF), (_Float16*)P_F32(WS_LFB), P_F32(WS_LB), P_F32(WS_ROPE)};
#if (REP_MASK >> 28) & 1
        { pg8::EpiTwice<pg8::EpiInProj> E2{E}; pg8::gemm_phase<pg8::EpiTwice<pg8::EpiInProj>, pg8::DenseOrder, true, true>(L, g, So, E2); }
#else
        pg8::gemm_phase<pg8::EpiInProj, pg8::DenseOrder, true, true>(L, g, So, E);
#endif
        if (G == 256) { pg8::DenseOrder St; St.init(66, 16, G, bid, false, 2, 4); pg8::gemm_phase<pg8::EpiInProj, pg8::DenseOrder, true, true, 0x1>(L, g, St, E); }
    }
    SEAM(2);
    PHASE(3) { PROLOG hgrn_pass1(bid, G, 16 * NCHUNK, (_Float16*)P_F32(WS_LFF), (_Float16*)P_F32(WS_LFB), P_B16(WS_IV), P_U8(WS_U), P_F32(WS_TOT), L, tid, wave, lane); }
    SEAM(3);
    PHASE(4) { PROLOG if (tid < 256) hgrn_pass2(P_U8(WS_U), P_F32(WS_TOT), P_U8(WS_S), bid * 256 + tid, G * 256); }
    SEAM(4);
    PHASE(5) { PROLOG
#define CONV_L0() do { LAS float* scr_ = (LAS float*)(L + wave * 16384); conv_loop<3>(ka->in[I_EWIN], ka->in[I_EWOUT], ka->in[I_OWQKV], ka->in[I_OWOUT], ka->in[I_MG], ka->in[I_MU], ka->in[I_MD], ws, gw, NGW, scr_, lane); __syncthreads(); } while (0)
        const int cgrp_ = bid % 3;
        if (cgrp_ == 0) CONV_L0();
        for (int r4_ = 0; r4_ < 1 + (int)((REP_MASK >> 23) & 1); ++r4_) for (int u = bid; u < 8 * NCHUNK; u += G) hgrn_pass3_unit(u, P_B16(WS_QH), (_Float16*)P_F32(WS_LFF), (_Float16*)P_F32(WS_LFB), P_B16(WS_IV), P_B16(WS_GG), P_U8(WS_S), ka->in[I_ONORM], P_B16(WS_H), L, tid, wave, lane);
        typedef attn_body::bf16 abf; const int vcu_ = VCU;
        const float lam = P_F32(WS_LAM)[0]; const float* gsub = ka->in[I_SUBLN];
        if (bid >= 64 && bid < 72) {
            const int bh = bid - 64, b = bh >> 2, h = bh & 3; const size_t rb = (size_t)b * SB;
            attn_body::attn_unit128<8, 1>((const abf*)P_B16(WS_DQ) + rb * 512 + (h * 2) * 64, 512, (const abf*)P_B16(WS_DK) + rb * 512 + (h * 2) * 64, 512, (const abf*)P_B16(WS_DV) + rb * 512 + h * 128, 512,
                                          (abf*)nullptr, 0, 4, 0.f, gsub, (char*)lds);
            attn_body::attn_unit128<8, 2>((const abf*)P_B16(WS_DQ) + rb * 512 + (h * 2 + 1) * 64, 512, (const abf*)P_B16(WS_DK) + rb * 512 + (h * 2 + 1) * 64, 512, (const abf*)P_B16(WS_DV) + rb * 512 + h * 128, 512,
                                          (abf*)P_B16(WS_H) + rb * 1024 + 512 + h * 128, 1024, 4, lam, gsub, (char*)lds);
        }
        if (vcu_ < 256) {
            const int bh = vcu_ >> 5, qb = vcu_ & 31, b = bh >> 2, h = bh & 3; const size_t rb = (size_t)b * SB, rq = rb + 256 + 256 * qb;
            attn_body::attn_unit128<8, 1>((const abf*)P_B16(WS_DQ) + rq * 512 + (h * 2) * 64, 512, (const abf*)P_B16(WS_DK) + rb * 512 + (h * 2) * 64, 512, (const abf*)P_B16(WS_DV) + rb * 512 + h * 128, 512,
                                          (abf*)nullptr, 0, NCHUNK, 0.f, gsub, (char*)lds);
            if (cgrp_ == 1) { LAS float* scr_ = (LAS float*)(L + wave * 8448);
                conv_loop<3>(ka->in[I_EWIN], ka->in[I_EWOUT], ka->in[I_OWQKV], ka->in[I_OWOUT], ka->in[I_MG], ka->in[I_MU], ka->in[I_MD], ws, gw, NGW, scr_, lane); __syncthreads(); }
            attn_body::attn_unit128<8, 2>((const abf*)P_B16(WS_DQ) + rq * 512 + (h * 2 + 1) * 64, 512, (const abf*)P_B16(WS_DK) + rb * 512 + (h * 2 + 1) * 64, 512, (const abf*)P_B16(WS_DV) + rb * 512 + h * 128, 512,
                                          (abf*)P_B16(WS_H) + rq * 1024 + 512 + h * 128, 1024, NCHUNK, lam, gsub, (char*)lds);
        }
        if (cgrp_ == 2) CONV_L0();
#undef CONV_L0
    }
    SEAM(5);
    PHASE(7) { PROLOG
        pg8::Gemm g{P_B16(WS_H), P_B16(WS_WOE), MR, 1024, 1024, 0}; pg8::DenseOrder So; So.init(66, 4, G, bid, false, G == 256 ? 1 : 0);
        pg8::EpiOut0 E{ka->in[I_X], ka->in[I_CTX], P_F32(WS_MOD), P_B16(WS_X)};
        pg8::gemm_phase<pg8::EpiOut0, pg8::DenseOrder, true, true>(L, g, So, E);
        if (G == 256) { pg8::DenseOrder St; St.init(66, 4, G, bid, false, 2, 4); pg8::gemm_phase<pg8::EpiOut0, pg8::DenseOrder, true, true, 0x1>(L, g, St, E); }
    }
    SEAM(7);
#define MOE_LAYER(P, LAYER, LATENT_ONLY) \
    PHASE(P) { PROLOG router_phase(P_B16(WS_X), ka->in[I_NFFN] + (LAYER) * 1024, P_F32(WS_MOD) + (LAYER) * 3 * 6144, ka->in[I_RW], ka->in[I_RB], P_B16(WS_H), P_I32(WS_EXPID), P_F32(WS_EXPW), P_I32(WS_RANK), P_I32(WS_CNT), LATENT_ONLY, L, tid, wave, lane); } \
    SEAM(P); \
    PHASE((P) + 1) { PROLOG for (int r2_ = 0; r2_ < 1 + (int)((REP_MASK >> 21) & 1); ++r2_) index_phase(P_I32(WS_CNT), P_I32(WS_EXPID), P_F32(WS_EXPW), P_I32(WS_RANK), P_B16(WS_H), P_I32(WS_TOKSLOT), P_F32(WS_ROWW), P_B16(WS_XS), P_I32(WS_META), LATENT_ONLY, L, tid, wave, lane); \
        } \
    SEAM((P) + 1); \
    PHASE((P) + 2) { PROLOG const int ntile = __builtin_amdgcn_readfirstlane(P_I32(WS_META)[0]); \
        LAS int* te_ = (LAS int*)(L + 131072); for (int i_ = tid; i_ < ntile; i_ += 512) te_[i_] = P_I32(WS_META)[16 + i_]; __syncthreads(); \
        pg8::Gemm g{P_B16(WS_XS), (const bf16*)(ws + ((LAYER) == 0 ? WS_MOE0_13 : WS_MOE1_13)), ntile * 256, 2048, 512  , (size_t)2048 * 1024}; const int rem_ = (ntile * 8) % G; const bool split_ = rem_ > 0 && 2 * rem_ <= G; \
        pg8::MoeOrder So; So.init(ntile, 8, G, bid, te_, split_ ? 1 : 0); \
        pg8::EpiGateUp8 E{(unsigned char*)P_B16(WS_HID)}; pg8::gemm_phase<pg8::EpiGateUp8, pg8::MoeOrder, true, true, 0xF, true>(L, g, So, E); \
        if (split_) { pg8::MoeOrder St; St.init(ntile, 8, G, bid, te_, 2, 2); pg8::gemm_phase<pg8::EpiGateUp8, pg8::MoeOrder, true, true, 0x3, true>(L, g, St, E); } \
        } \
    SEAM((P) + 2); \
    PHASE((P) + 3) { PROLOG const int ntile = __builtin_amdgcn_readfirstlane(P_I32(WS_META)[0]); \
        LAS int* te_ = (LAS int*)(L + 131072); for (int i_ = tid; i_ < ntile; i_ += 512) te_[i_] = P_I32(WS_META)[16 + i_]; __syncthreads(); \
        pg8::Gemm g{P_B16(WS_HID), (const bf16*)(ws + ((LAYER) == 0 ? WS_MOE0_2 : WS_MOE1_2)), ntile * 256, 1024, 512  , (size_t)1024 * 1024}; const int rem_ = (ntile * 4) % G; const bool split_ = rem_ > 0 && 4 * rem_ <= G; \
        pg8::MoeOrder So; So.init(ntile, 4, G, bid, te_, split_ ? 1 : 0); \
        pg8::EpiDown8 E{P_B16(WS_XS), P_F32(WS_ROWW)}; pg8::gemm_phase<pg8::EpiDown8, pg8::MoeOrder, true, true, 0xF, true>(L, g, So, E); \
        if (split_) { pg8::MoeOrder St; St.init(ntile, 4, G, bid, te_, 2, 4); pg8::gemm_phase<pg8::EpiDown8, pg8::MoeOrder, true, true, 0x1, true>(L, g, St, E); } } \
    SEAM((P) + 3);
    MOE_LAYER(8, 0, false)
    PHASE(12) { PROLOG
        for (int r = gw; r < MR; r += 2 * NGW) { const int r2 = r + NGW; const bool h2 = r2 < MR; const int rb_ = h2 ? r2 : r;
            const int sa0 = P_I32(WS_TOKSLOT)[2 * r], sa1 = P_I32(WS_TOKSLOT)[2 * r + 1], sb0 = P_I32(WS_TOKSLOT)[2 * rb_], sb1 = P_I32(WS_TOKSLOT)[2 * rb_ + 1];
            const int vecA = (r % SB) < 256 ? 2 : r / SB, vecB = (rb_ % SB) < 256 ? 2 : rb_ / SB;
            f32x4 va[4], vb[4]; load_row_b16(va, P_B16(WS_X) + (size_t)r * 1024, lane); load_row_b16(vb, P_B16(WS_X) + (size_t)rb_ * 1024, lane);
            add_moe_rows(va, P_B16(WS_XS) + (size_t)sa0 * 1024, P_B16(WS_XS) + (size_t)sa1 * 1024, P_F32(WS_MOD) + vecA * 6144 + 5120, lane);
            add_moe_rows(vb, P_B16(WS_XS) + (size_t)sb0 * 1024, P_B16(WS_XS) + (size_t)sb1 * 1024, P_F32(WS_MOD) + vecB * 6144 + 5120, lane);
            { store_row_bf16(va, P_B16(WS_X) + (size_t)r * 1024, lane);
              const float* mp = P_F32(WS_MOD) + (3 + vecA) * 6144; normmod_row(va, ka->in[I_NMIX] + 1024, mp + 1024, mp, lane); store_row_bf16(va, P_B16(WS_H) + (size_t)r * 1024, lane); }
            if (h2) { store_row_bf16(vb, P_B16(WS_X) + (size_t)r2 * 1024, lane);
              const float* mp = P_F32(WS_MOD) + (3 + vecB) * 6144; normmod_row(vb, ka->in[I_NMIX] + 1024, mp + 1024, mp, lane); store_row_bf16(vb, P_B16(WS_H) + (size_t)r2 * 1024, lane); } }
    }
    SEAM(12);
    PHASE(13) { PROLOG
        pg8::Gemm g{P_B16(WS_H), P_B16(WS_WQKV), MR, 1536, 1024, 0}; pg8::DenseOrder So; So.init(66, 6, G, bid, false);
        pg8::EpiQKV1 E{P_B16(WS_Q1), P_B16(WS_K1), P_B16(WS_V1), P_F32(WS_ROPE)};
        pg8::gemm_phase<pg8::EpiQKV1, pg8::DenseOrder, true, true>(L, g, So, E);
    }
    SEAM(13);
    PHASE(14) { PROLOG
#define CONV_L1() do { __syncthreads(); LAS float* scr_ = (LAS float*)(L + wave * 16384); conv_loop<1>(ka->in[I_EWIN], ka->in[I_EWOUT], ka->in[I_OWQKV], ka->in[I_OWOUT], ka->in[I_MG], ka->in[I_MU], ka->in[I_MD], ws, gw, NGW, scr_, lane); __syncthreads(); } while (0)
#define SWA_UNITS(i0) do { typedef attn_body::bf16 abf; const int vcu_ = VCU; for (int i = (i0); i < (i0) + 2; ++i) { const int combo = vcu_ >> 5, qb = 4 * (vcu_ & 31) + i; if (combo >= 8) break; \
            const int b = combo >> 2, kvh = combo & 3; const size_t rb = (size_t)b * SB, rq = rb + 256 + 64 * qb; \
            attn_body::attn_unit<8, 1>((const abf*)P_B16(WS_Q1) + rq * 1024 + kvh * 256, 1024, (const abf*)P_B16(WS_K1) + rb * 256 + kvh * 64, 256, (const abf*)P_B16(WS_V1) + rb * 256 + kvh * 64, 256, \
                                       (abf*)P_B16(WS_H) + rq * 1024 + kvh * 256, 1024, 9, 64 * qb, ka->in[I_SINK] + 4 * kvh, (char*)lds); } } while (0)
        const int turn_ = bid % 3;
        if (turn_ == 0) CONV_L1();
        SWA_UNITS(0);
        if (turn_ == 1) CONV_L1();
        SWA_UNITS(2);
        if (turn_ == 2) CONV_L1();
#undef SWA_UNITS
#undef CONV_L1
    }
    SEAM(14);
    PHASE(15) { PROLOG
        pg8::Gemm g{P_B16(WS_H), P_B16(WS_WOO), MR, 1024, 1024, 0}; pg8::DenseOrder So; So.init(64, 4, G, bid, true);
        pg8::EpiOut1 E{P_F32(WS_MOD) + 3 * 6144, P_B16(WS_X)};
        pg8::gemm_phase<pg8::EpiOut1, pg8::DenseOrder, true, true>(L, g, So, E);
    }
    SEAM(15);
    MOE_LAYER(16, 1, true)
    PHASE(20) { PROLOG
        for (int t = gw; t < NBATCH * TLAT; t += 2 * NGW) { const int t2 = (t + NGW < NBATCH * TLAT) ? t + NGW : t; const bool h2 = t2 != t;
            const size_t rA = (size_t)(t >> 13) * SB + 256 + (t & 8191), rB = (size_t)(t2 >> 13) * SB + 256 + (t2 & 8191);
            const int sa0 = P_I32(WS_TOKSLOT)[2 * rA], sa1 = P_I32(WS_TOKSLOT)[2 * rA + 1], sb0 = P_I32(WS_TOKSLOT)[2 * rB], sb1 = P_I32(WS_TOKSLOT)[2 * rB + 1];
            f32x4 va[4], vb[4]; load_row_b16(va, P_B16(WS_X) + rA * 1024, lane); load_row_b16(vb, P_B16(WS_X) + rB * 1024, lane);
            add_moe_rows(va, P_B16(WS_XS) + (size_t)sa0 * 1024, P_B16(WS_XS) + (size_t)sa1 * 1024, P_F32(WS_MOD) + (3 + (t >> 13)) * 6144 + 5120, lane);
            add_moe_rows(vb, P_B16(WS_XS) + (size_t)sb0 * 1024, P_B16(WS_XS) + (size_t)sb1 * 1024, P_F32(WS_MOD) + (3 + (t2 >> 13)) * 6144 + 5120, lane);
            float s2a = 0.f, s2b = 0.f;
#pragma unroll
            for (int j = 0; j < 4; ++j) { s2a += (va[j].x * va[j].x + va[j].y * va[j].y) + (va[j].z * va[j].z + va[j].w * va[j].w); s2b += (vb[j].x * vb[j].x + vb[j].y * vb[j].y) + (vb[j].z * vb[j].z + vb[j].w * vb[j].w); }
            const float rsa = __builtin_amdgcn_rsqf(wave_sum(s2a) * (1.f / 1024.f) + EPS_), rsb = __builtin_amdgcn_rsqf(wave_sum(s2b) * (1.f / 1024.f) + EPS_);
            f32x4* oa = (f32x4*)(ka->out + (size_t)t * 1024) + lane; f32x4* ob = (f32x4*)(ka->out + (size_t)t2 * 1024) + lane;
#pragma unroll
            for (int j = 0; j < 4; ++j) { const f32x4 g = *((const f32x4*)ka->in[I_FNG] + 64 * j + lane); oa[64 * j] = va[j] * rsa * g; if (h2) ob[64 * j] = vb[j] * rsb * g; } }
    }
#undef IN
#undef SEAM
#undef MOE_LAYER
}

#ifndef N_LAUNCHES
#define N_LAUNCHES 1
#endif
extern "C" void kernel_launch(void* const* d_in, const int* in_sizes, int n_in, void* d_out, int out_size, void* d_ws, size_t ws_size, hipStream_t stream) {
    static int grid = 0;
    if (grid == 0) {
        if (n_in != 23 || ws_size < WS_NEED) { fprintf(stderr, "kernel_launch: expected 23 inputs and >= %zu bytes of workspace (got %d, %zu)\n", (size_t)WS_NEED, n_in, ws_size); grid = -1; return; }
        int dev = 0, cus = 0, per_cu = 0;
        hipGetDevice(&dev); hipDeviceGetAttribute(&cus, hipDeviceAttributeMultiprocessorCount, dev);
        if (hipFuncSetAttribute((const void*)dit_fwd, hipFuncAttributeMaxDynamicSharedMemorySize, LDS_BYTES) != hipSuccess) { fprintf(stderr, "kernel_launch: hipFuncSetAttribute failed\n"); grid = -1; return; }
        if (hipOccupancyMaxActiveBlocksPerMultiprocessor(&per_cu, (const void*)dit_fwd, NWAVES * 64, LDS_BYTES) != hipSuccess || per_cu < 1) { fprintf(stderr, "kernel_launch: occupancy query says %d\n", per_cu); per_cu = 1; }
        (void)hipGetLastError();
        grid = cus;
        if (grid != 256) fprintf(stderr, "kernel_launch: %d CUs (built for 256)\n", grid);
    }
    if (grid < 0) return;
    (void)hipMemsetAsync((char*)d_ws + WS_CTL, 0, CTL_ZERO_BYTES, stream);
    KArgs a{};
    for (int i = 0; i < 23; ++i) a.in[i] = (const float*)d_in[i];
    a.out = (float*)d_out; a.ws = (unsigned char*)d_ws;
#if N_LAUNCHES == 1
    a.ph_lo = 0; a.ph_hi = N_PHASES; a.use_cg = 1;
    void* kargs[] = {&a};
    hipError_t e = hipLaunchCooperativeKernel((const void*)dit_fwd, dim3(grid), dim3(NWAVES * 64), kargs, LDS_BYTES, stream);
    if (e != hipSuccess) fprintf(stderr, "kernel_launch: cooperative launch failed: %s\n", hipGetErrorString(e));
#else
    for (int p = 0; p < N_PHASES; ++p) { a.ph_lo = p; a.ph_hi = p + 1; a.use_cg = 0;
        hipLaunchKernelGGL(dit_fwd, dim3(grid), dim3(NWAVES * 64), LDS_BYTES, stream, a); }
#endif
}
```

```cpp
#include <hip/hip_runtime.h>
#include <hip/hip_cooperative_groups.h>
#include <hip/hip_bf16.h>
#include <cstdio>
#include <cstdint>
#include <cmath>
namespace cg = cooperative_groups;

constexpr int DMODEL = 1024, NBATCH = 2, TLAT = 8192, TCTX = 256;
constexpr int SB = TLAT + TCTX;
constexpr int MR = NBATCH * SB;
constexpr int NEXP = 16;
constexpr int MOE_MAXT = 152;
constexpr float EPS_ = 1e-6f;
constexpr float LOG2E = 1.4426950408889634f;
constexpr float C2 = 0.125f * LOG2E;
constexpr int NCHUNK = SB / 64;

constexpr size_t MiB = 1u << 20;
constexpr size_t WS_CTL = 0, CTL_ZERO_BYTES = 64 * 1024;
constexpr size_t WS_MOD = 1 * MiB;
constexpr size_t WS_LB = WS_MOD + 256 * 1024;
constexpr size_t WS_LAM = WS_LB + 8 * 1024;
constexpr size_t WS_ROPE = WS_LAM + 1024;
constexpr size_t WS_EXPID = 2 * MiB;
constexpr size_t WS_EXPW = WS_EXPID + 256 * 1024;
constexpr size_t WS_RANK = WS_EXPW + 256 * 1024;
constexpr size_t WS_TOKSLOT = WS_RANK + 256 * 1024;
constexpr size_t WS_CNT = WS_TOKSLOT + 256 * 1024;
constexpr size_t WS_META = WS_CNT + 32 * 1024;
constexpr size_t WS_ROWW = 4 * MiB;
constexpr size_t WS_TOT = 5 * MiB;
constexpr size_t WS_WIN = 8 * MiB;
constexpr size_t WS_WOE = 16 * MiB;
constexpr size_t WS_WQKV = 18 * MiB;
constexpr size_t WS_WOO = 21 * MiB;
constexpr size_t WS_MOE0_13 = 24 * MiB;
constexpr size_t WS_MOE0_2 = 88 * MiB;
constexpr size_t WS_X = 120 * MiB;
constexpr size_t WS_H = 186 * MiB;
constexpr size_t WS_R = 219 * MiB;
constexpr size_t WS_QH = WS_R;
constexpr size_t WS_LFF = WS_QH + 33 * MiB / 2;
constexpr size_t WS_LFB = WS_LFF + 33 * MiB;
constexpr size_t WS_IV = WS_LFB + 33 * MiB;
constexpr size_t WS_GG = WS_IV + 33 * MiB / 2;
constexpr size_t WS_DQ = WS_GG + 33 * MiB / 2;
constexpr size_t WS_DK = WS_DQ + 33 * MiB / 2;
constexpr size_t WS_DV = WS_DK + 33 * MiB / 2;
constexpr size_t WS_U = WS_DV + 33 * MiB / 2;
constexpr size_t WS_S = WS_U + 66 * MiB;
constexpr size_t WS_OATT = WS_U;
constexpr size_t WS_END0 = WS_S + 66 * MiB;
constexpr size_t WS_MOE1_13 = WS_R;
constexpr size_t WS_MOE1_2 = WS_R + 64 * MiB;
constexpr size_t WS_XS = WS_R + 96 * MiB;
constexpr size_t WS_HID = WS_XS + 76 * MiB;
constexpr size_t WS_Q1 = WS_HID + 76 * MiB;
constexpr size_t WS_K1 = WS_Q1 + 33 * MiB;
constexpr size_t WS_V1 = WS_K1 + 33 * MiB / 4;
constexpr size_t WS_END1 = WS_V1 + 33 * MiB / 4;
constexpr size_t WS_NEED = (WS_END0 > WS_END1 ? WS_END0 : WS_END1);
static_assert(WS_NEED <= 553810048ull, "d_ws map exceeds the guaranteed workspace");
static_assert((size_t)MOE_MAXT * 256 * 1024 * 2 <= 76 * MiB, "XS size");

#define GAS __attribute__((address_space(1)))
#define LAS __attribute__((address_space(3)))
typedef unsigned short bf16;
typedef unsigned v4u __attribute__((ext_vector_type(4)));
typedef float f32x4 __attribute__((ext_vector_type(4)));
typedef short bf16x8 __attribute__((ext_vector_type(8)));
typedef GAS unsigned gu32;
typedef GAS unsigned long long gu64;
#define RLX_AGENT __ATOMIC_RELAXED, __HIP_MEMORY_SCOPE_AGENT
#define LDS_WAIT() asm volatile("s_waitcnt lgkmcnt(0)" ::: "memory")
#define VM_WAIT() asm volatile("s_waitcnt vmcnt(0)" ::: "memory")
__device__ __forceinline__ unsigned long long rt() { return __builtin_amdgcn_s_memrealtime(); }
typedef float f32x2c_t __attribute__((ext_vector_type(2))); typedef __bf16 bf16x2c_t __attribute__((ext_vector_type(2)));
__device__ __forceinline__ unsigned pk2(float lo, float hi) { f32x2c_t v = {lo, hi}; bf16x2c_t b = __builtin_convertvector(v, bf16x2c_t); return __builtin_bit_cast(unsigned, b); }
__device__ __forceinline__ unsigned f2bf(float f) { return pk2(f, 0.f) & 0xffffu; }
template <int CTRL> __device__ __forceinline__ float dpp_f(float v) { return __builtin_bit_cast(float, __builtin_amdgcn_update_dpp(0, __builtin_bit_cast(int, v), CTRL, 0xF, 0xF, true)); }
__device__ __forceinline__ float swap16_sum(float a, float b) { const auto r = __builtin_amdgcn_permlane16_swap(__float_as_uint(a), __float_as_uint(b), false, false); return __uint_as_float(r[0]) + __uint_as_float(r[1]); }
__device__ __forceinline__ float swap32_sum(float a, float b) { const auto r = __builtin_amdgcn_permlane32_swap(__float_as_uint(a), __float_as_uint(b), false, false); return __uint_as_float(r[0]) + __uint_as_float(r[1]); }

#define XB_TMO      128
#define XB_XCNT(j)  (256  + 64 * (j))
#define XB_XSUB(j)  (1280 + 64 * (j))
#define XB_XGEN(j)  (2304 + 64 * (j))
#define XB_TOP      3328
#define XB_TOPGEN   3392
#define XCD_BAR_WORDS 3456
#define XB_SPIN_CAP (1u << 18)

__device__ __forceinline__ unsigned xb_ld(unsigned* p)              { return __hip_atomic_load(p, __ATOMIC_RELAXED, __HIP_MEMORY_SCOPE_AGENT); }
__device__ __forceinline__ unsigned xb_add(unsigned* p, unsigned v) { return __hip_atomic_fetch_add(p, v, __ATOMIC_RELAXED, __HIP_MEMORY_SCOPE_AGENT); }
__device__ __forceinline__ unsigned xb_xcc_id() { return (unsigned)__builtin_amdgcn_s_getreg((3 << 11) | 20) & 0xFu; }
#define XB_SPIN(cond, bar) do { unsigned _sp = 0; while (cond) { __builtin_amdgcn_s_sleep(1); \
    if ((++_sp & 255u) == 0u) { if (xb_ld(&(bar)[XB_TMO])) break; if (_sp > XB_SPIN_CAP) { atomicAdd(&(bar)[XB_TMO], 1u); break; } } } } while (0)

struct XcdBarrier {
    unsigned* bar; unsigned x;
    volatile LAS unsigned* st;
};

__device__ __forceinline__ XcdBarrier xcd_barrier_post(unsigned* bar, volatile LAS unsigned* st) {
    XcdBarrier b; b.bar = bar; b.x = xb_xcc_id(); b.st = st;
    if (threadIdx.x == 0) (void)xb_add(&bar[XB_XCNT(b.x)], 1u);
    return b;
}
__device__ __forceinline__ void xcd_barrier_complete(unsigned* bar, unsigned x, unsigned& nloc, unsigned& nx) {
    const unsigned G = gridDim.x * gridDim.y * gridDim.z;
    unsigned sum, cnt, mine, sp = 0u;
    for (;;) {
        sum = 0u; cnt = 0u; mine = 0u;
#pragma unroll
        for (unsigned j = 0; j < 16; ++j) { const unsigned c = xb_ld(&bar[XB_XCNT(j)]); sum += c; cnt += (c > 0u) ? 1u : 0u; mine = (j == x) ? c : mine; }
        if (sum == G) break;
        __builtin_amdgcn_s_sleep(1);
        if ((++sp & 255u) == 0u) { if (xb_ld(&bar[XB_TMO])) break; if (sp > XB_SPIN_CAP) { atomicAdd(&bar[XB_TMO], 1u); break; } }
    }
    nloc = mine > 0u ? mine : 1u; nx = cnt > 0u ? cnt : 1u;
}

__device__ __forceinline__ void xcd_barrier(const XcdBarrier& b) {
    asm volatile("s_waitcnt vmcnt(0)" ::: "memory");
    __syncthreads();
    if (threadIdx.x == 0) {
        unsigned* bar = b.bar;
        __builtin_amdgcn_s_waitcnt(0);
        unsigned nloc = b.st[0], nx = b.st[1];
        if (nloc == 0u) { xcd_barrier_complete(bar, b.x, nloc, nx); b.st[0] = nloc; b.st[1] = nx; }
        const unsigned old = xb_add(&bar[XB_XSUB(b.x)], 1u);
        const unsigned gen = old / nloc;
        if (old + 1u == (gen + 1u) * nloc) {
            __builtin_amdgcn_fence(__ATOMIC_RELEASE, "agent");
            asm volatile("s_waitcnt vmcnt(0)" ::: "memory");
            const unsigned og = xb_add(&bar[XB_TOP], 1u);
            const unsigned tg = og / nx;
            if (og + 1u == (tg + 1u) * nx) xb_add(&bar[XB_TOPGEN], 1u);
            else XB_SPIN(xb_ld(&bar[XB_TOPGEN]) == tg, bar);
            __builtin_amdgcn_fence(__ATOMIC_ACQUIRE, "agent");
            xb_add(&bar[XB_XGEN(b.x)], 1u);
            asm volatile("s_waitcnt vmcnt(0)" ::: "memory");
        } else {
            XB_SPIN(xb_ld(&bar[XB_XGEN(b.x)]) == gen, bar);
            __builtin_amdgcn_fence(__ATOMIC_ACQUIRE, "agent");
            asm volatile("s_waitcnt vmcnt(0)" ::: "memory");
        }
    }
    __syncthreads();
}
namespace pg8 {
#define PG8_LAS __attribute__((address_space(3)))
typedef unsigned short bf16_t;
typedef short bf16x8 __attribute__((ext_vector_type(8)));
typedef float f32x4 __attribute__((ext_vector_type(4)));
typedef unsigned u32x4 __attribute__((ext_vector_type(4)));
constexpr int BM = 256, BK = 64, HALF = 128, HTB = HALF * BK * 2  , STAGE_BYTES = 8 * HTB, NXCD = 8, WGM = 8;

__host__ __device__ __forceinline__ int lds_byte(int r, int c) { const int st = (r >> 4) * 2 + (c >> 5), rr = r & 15, cc = c & 31, ob = rr * 64 + cc * 2; return st * 1024 + (ob ^ (((ob >> 9) & 1) << 5)); }
__host__ __device__ __forceinline__ void stage_rc(int b, int& R, int& C) { const int st = b / 1024, sb = b % 1024, swz = sb ^ (((sb >> 9) & 1) << 5); R = (st >> 1) * 16 + swz / 64; C = (st & 1) * 32 + (swz % 64) / 2; }
__host__ __device__ __forceinline__ int perm32(int rho) { const int n = rho >> 4, i = rho & 15; return 8 * (i >> 2) + 4 * n + (i & 3); }

struct Unit { int pm, pn, be, mask, qa, qb; };
struct Gemm { const bf16_t* A; const bf16_t* Bt; int M, N, K; size_t bes; };
__device__ __forceinline__ unsigned cvt_pk_bf16(float lo, float hi) { unsigned r; asm volatile("v_cvt_pk_bf16_f32 %0, %1, %2" : "=v"(r) : "v"(lo), "v"(hi)); return r; }
typedef float f32x2 __attribute__((ext_vector_type(2)));

__device__ __forceinline__ bool tail_deal(int L, int nwg, int G, int mode, int parts, int& idx, int& mask, int& qa, int& qb) {
    const int F = nwg / G, R = nwg - F * G; qa = 0; qb = 0; mask = 0xF;
    if (mode == 0) { if (L >= nwg) return false; idx = L; return true; }
    if (mode == 1) { if (L >= F * G) return false; idx = L; return true; }
    if (L >= R * parts) return false;
    idx = F * G + L / parts; const int p = L % parts;
    if (parts == 4) { qa = p >> 1; qb = p & 1; mask = 1; } else { qa = p; mask = 3; }
    return true;
}
struct DenseOrder {
    int nM, nN, nwg, G, c, mode, parts; bool skipctx;
    __device__ void init(int nM_, int nN_, int G_, int c_, bool skip_, int mode_ = 0, int parts_ = 1) { nM = nM_; nN = nN_; nwg = nM * nN; G = G_; c = c_; skipctx = skip_; mode = mode_; parts = parts_; }
    __device__ bool next(int i, Unit& u) const {
        int wgid; if (!tail_deal(i * G + c, nwg, G, mode, parts, wgid, u.mask, u.qa, u.qb)) return false;
        { const int q = nwg / NXCD, r = nwg % NXCD, xcd = wgid % NXCD, off = wgid / NXCD; wgid = (xcd < r ? xcd * (q + 1) : r * (q + 1) + (xcd - r) * q) + off; }
        const int nig = WGM * nN, gid = wgid / nig, fm = gid * WGM, gsz = (nM - fm) < WGM ? (nM - fm) : WGM;
        int pm = fm + ((wgid % nig) % gsz); u.pn = (wgid % nig) / gsz; u.be = 0;
        if (skipctx) pm = (pm >> 5) * 33 + 1 + (pm & 31);
        u.pm = pm; return true;
    }
    __device__ __forceinline__ void a_ready(const Unit&) const {}
    __device__ __forceinline__ void done(const Unit&) const {}
};
struct MoeOrder {
    int nM, nN, nwg, G, c, mode, parts; const PG8_LAS int* tile_e;
    __device__ void init(int nM_, int nN_, int G_, int c_, const PG8_LAS int* te, int mode_ = 0, int parts_ = 1) { nM = nM_; nN = nN_; nwg = nM * nN; G = G_; c = c_; tile_e = te; mode = mode_; parts = parts_; }
    __device__ bool next(int i, Unit& u) const {
        int wgid; if (!tail_deal(i * G + c, nwg, G, mode, parts, wgid, u.mask, u.qa, u.qb)) return false;
        { const int q = nwg / NXCD, r = nwg % NXCD, xcd = wgid % NXCD, off = wgid / NXCD; wgid = (xcd < r ? xcd * (q + 1) : r * (q + 1) + (xcd - r) * q) + off; }
        const int nig = WGM * nN, gid = wgid / nig, fm = gid * WGM, gsz = (nM - fm) < WGM ? (nM - fm) : WGM;
        u.pm = fm + ((wgid % nig) % gsz); u.pn = (wgid % nig) / gsz; u.be = __builtin_amdgcn_readfirstlane(tile_e[u.pm]); return true;
    }
    __device__ __forceinline__ void a_ready(const Unit&) const {}
    __device__ __forceinline__ void done(const Unit&) const {}
};

typedef unsigned u32x2 __attribute__((ext_vector_type(2)));
typedef float f32x2 __attribute__((ext_vector_type(2)));
__device__ __forceinline__ float silu_f(float v) { return v * __builtin_amdgcn_rcpf(1.f + __builtin_amdgcn_exp2f(__builtin_fminf(-v * 1.4426950408889634f, 80.f))); }
__device__ __forceinline__ float sigm_f(float v) { return __builtin_amdgcn_rcpf(1.f + __builtin_amdgcn_exp2f(__builtin_fminf(-v * 1.4426950408889634f, 80.f))); }
__device__ __forceinline__ float lfgate_f(float lb, float v) { const float e = __builtin_amdgcn_exp2f(__builtin_fminf(-v * 1.4426950408889634f, 80.f)); return __builtin_amdgcn_logf((1.f + lb * e) * __builtin_amdgcn_rcpf(1.f + e)) * 0.6931471805599453f; }
__device__ __forceinline__ u32x2 pk4(f32x4 v) { u32x2 w; w.x = cvt_pk_bf16(v[0], v[1]); w.y = cvt_pk_bf16(v[2], v[3]); return w; }
__device__ __forceinline__ u32x4 pair16(u32x2 a, u32x2 b) {
    const auto r0 = __builtin_amdgcn_permlane16_swap(a.x, b.x, false, false), r1 = __builtin_amdgcn_permlane16_swap(a.y, b.y, false, false);
    u32x4 w; w.x = r0[0]; w.y = r1[0]; w.z = r0[1]; w.w = r1[1]; return w;
}

struct EpiInProj {
    static constexpr bool PERM = true, AFTER_DRAIN = false;
    bf16_t *QH, *IV, *GG, *DQ, *DK, *DV; _Float16 *LFF, *LFB; const float* LB;     const float* ROPE;
    __device__ __forceinline__ void operator()(const f32x4 (&acc)[2][2][4][2], const Unit& u, int wr, int wc, int fr, int fq) const {
        const int seg = u.pn >> 1;
        const int cb = (u.pn & 1) * 256 + u.qb * 128 + wc * 32 + 8 * fq;
        const int jt = u.pm % 33; const bool latent = jt != 0;
        const int s0 = jt * 256 + u.qa * 128 + wr * 64 + fr;
        const size_t row0 = (size_t)u.pm * 256 + u.qa * 128 + wr * 64 + fr;
        if (seg == 1 || seg == 2) {
            _Float16* LF = seg == 1 ? LFF : LFB; typedef _Float16 h16x8 __attribute__((ext_vector_type(8))); const float* lbp = LB + (seg - 1) * 512;
#pragma unroll
            for (int bj = 0; bj < 2; ++bj) { const int col = cb + bj * 128; const f32x4 lb0 = *(const f32x4*)(lbp + col), lb1 = *(const f32x4*)(lbp + col + 4);
#pragma unroll
                for (int ai = 0; ai < 2; ++ai)
#pragma unroll
                    for (int m = 0; m < 4; ++m) { if (!(u.mask & (1 << (ai * 2 + bj)))) continue; const f32x4 v0 = acc[ai][bj][m][0], v1 = acc[ai][bj][m][1]; h16x8 o;
#pragma unroll
                        for (int e = 0; e < 4; ++e) { o[e] = (_Float16)lfgate_f(lb0[e], v0[e]); o[4 + e] = (_Float16)lfgate_f(lb1[e], v1[e]); }
                        *(h16x8*)(LF + (row0 + ai * 128 + m * 16) * 512 + col) = o; } }
        } else if (seg == 5 || seg == 6) {
            bf16_t* O = seg == 5 ? DQ : DK; const float sc = seg == 5 ? C2 : 1.f; const float sgn = fq < 2 ? -1.f : 1.f;
#pragma unroll
            for (int ai = 0; ai < 2; ++ai)
#pragma unroll
                for (int m = 0; m < 4; ++m) {
                    float co[8], si[8];
#pragma unroll
                    for (int e = 0; e < 8; ++e) { co[e] = 1.f; si[e] = 0.f; }
                    if (latent) { const int tau = s0 + ai * 128 + m * 16 - 256; const int pos = (wc & 1) ? (tau & 63) : (tau >> 6);
                        const float* rp = ROPE + (pos * 16 + 8 * (fq & 1)) * 2;
#pragma unroll
                        for (int k = 0; k < 4; ++k) { const f32x4 t4 = *(const f32x4*)(rp + 4 * k); co[2 * k] = t4[0]; si[2 * k] = t4[1]; co[2 * k + 1] = t4[2]; si[2 * k + 1] = t4[3]; } }
#pragma unroll
                    for (int bj = 0; bj < 2; ++bj) { if (!(u.mask & (1 << (ai * 2 + bj)))) continue; float x[8], o[8];
#pragma unroll
                        for (int e = 0; e < 4; ++e) { x[e] = acc[ai][bj][m][0][e]; x[4 + e] = acc[ai][bj][m][1][e]; }
#pragma unroll
                        for (int e = 0; e < 8; ++e) { const auto rr = __builtin_amdgcn_permlane32_swap(__float_as_uint(x[e]), __float_as_uint(x[e]), false, false);
                            const float pr = __uint_as_float(fq < 2 ? rr[1] : rr[0]); o[e] = (x[e] * co[e] + sgn * pr * si[e]) * sc; }
                        u32x4 w; w.x = cvt_pk_bf16(o[0], o[1]); w.y = cvt_pk_bf16(o[2], o[3]); w.z = cvt_pk_bf16(o[4], o[5]); w.w = cvt_pk_bf16(o[6], o[7]);
                        *(u32x4*)(O + (row0 + ai * 128 + m * 16) * 512 + cb + bj * 128) = w; } }
        } else {
            bf16_t* O = seg == 0 ? QH : seg == 3 ? IV : seg == 4 ? GG : DV;
#pragma unroll
            for (int ai = 0; ai < 2; ++ai)
#pragma unroll
                for (int m = 0; m < 4; ++m)
#pragma unroll
                    for (int bj = 0; bj < 2; ++bj) { if (!(u.mask & (1 << (ai * 2 + bj)))) continue; f32x4 v0 = acc[ai][bj][m][0], v1 = acc[ai][bj][m][1];
                        if (seg == 0) {
#pragma unroll
                            for (int e = 0; e < 4; ++e) { v0[e] = silu_f(v0[e]) * 0.08838834764831845f; v1[e] = silu_f(v1[e]) * 0.08838834764831845f; } }
                        else if (seg == 4) {
#pragma unroll
                            for (int e = 0; e < 4; ++e) { v0[e] = silu_f(v0[e]); v1[e] = silu_f(v1[e]); } }
                        u32x4 w; w.x = cvt_pk_bf16(v0[0], v0[1]); w.y = cvt_pk_bf16(v0[2], v0[3]); w.z = cvt_pk_bf16(v1[0], v1[1]); w.w = cvt_pk_bf16(v1[2], v1[3]);
                        *(u32x4*)(O + (row0 + ai * 128 + m * 16) * 512 + cb + bj * 128) = w; }
        }
    }
};
#ifndef EPISEL
#define EPISEL (-1)
#endif
template <class E> struct EpiTwice {
    static constexpr bool PERM = E::PERM, AFTER_DRAIN = false; E e;
    __device__ __forceinline__ void operator()(const f32x4 (&acc)[2][2][4][2], const Unit& u, int wr, int wc, int fr, int fq) const { e(acc, u, wr, wc, fr, fq); asm volatile("" ::: "memory");
        if (EPISEL < 0 || (u.pn >> 1) == EPISEL) e(acc, u, wr, wc, fr, fq); }
};

struct EpiOut0 {
    static constexpr bool PERM = false, AFTER_DRAIN = false;
    const float* x; const float* ctx; const float* MODL; bf16_t* X;
    __device__ __forceinline__ void operator()(const f32x4 (&acc)[2][2][4][2], const Unit& u, int wr, int wc, int fr, int fq) const {
        const int b = u.pm / 33, jt = u.pm % 33; const int vec = jt == 0 ? 2 : b;
        const int col0 = u.pn * 256 + u.qb * 128 + wc * 32 + 4 * fq; const float* gp = MODL + vec * 6144 + 2048 + col0;
        f32x4 gv[2][2];
#pragma unroll
        for (int bj = 0; bj < 2; ++bj)
#pragma unroll
            for (int n = 0; n < 2; ++n) gv[bj][n] = *(const f32x4*)(gp + bj * 128 + n * 16);
#pragma unroll
        for (int ai = 0; ai < 2; ++ai)
#pragma unroll
            for (int m = 0; m < 4; ++m) { const int sl = (ai + u.qa) * 128 + wr * 64 + m * 16 + fr;
                const float* src = jt == 0 ? ctx + ((size_t)b * 256 + sl) * 1024 : x + ((size_t)b * 8192 + (jt - 1) * 256 + sl) * 1024;
                bf16_t* dst = X + ((size_t)u.pm * 256 + sl) * 1024;
#pragma unroll
                for (int bj = 0; bj < 2; ++bj) { if (!(u.mask & (1 << (ai * 2 + bj)))) continue; const int c = col0 + bj * 128;
                    *(u32x4*)(dst + c + ((fq & 1) ? 12 : 0)) = pair16(pk4(*(const f32x4*)(src + c) + gv[bj][0] * acc[ai][bj][m][0]), pk4(*(const f32x4*)(src + c + 16) + gv[bj][1] * acc[ai][bj][m][1])); } }
    }
};
struct EpiOut1 {
    static constexpr bool PERM = false, AFTER_DRAIN = false;
    const float* MODL; bf16_t* X;
    __device__ __forceinline__ void operator()(const f32x4 (&acc)[2][2][4][2], const Unit& u, int wr, int wc, int fr, int fq) const {
        const int b = u.pm / 33; const int col0 = u.pn * 256 + u.qb * 128 + wc * 32 + 4 * fq; const float* gp = MODL + b * 6144 + 2048 + col0;
        f32x4 gv[2][2];
#pragma unroll
        for (int bj = 0; bj < 2; ++bj)
#pragma unroll
            for (int n = 0; n < 2; ++n) gv[bj][n] = *(const f32x4*)(gp + bj * 128 + n * 16);
#pragma unroll
        for (int ai = 0; ai < 2; ++ai)
#pragma unroll
            for (int m = 0; m < 4; ++m) { bf16_t* dst = X + ((size_t)u.pm * 256 + (ai + u.qa) * 128 + wr * 64 + m * 16 + fr) * 1024;
#pragma unroll
                for (int bj = 0; bj < 2; ++bj) { if (!(u.mask & (1 << (ai * 2 + bj)))) continue; const int c = col0 + bj * 128; u32x2 o2[2];
#pragma unroll
                    for (int n = 0; n < 2; ++n) { const u32x2 xw = *(const u32x2*)(dst + c + n * 16); f32x4 xv; xv[0] = __uint_as_float(xw.x << 16); xv[1] = __uint_as_float(xw.x & 0xffff0000u); xv[2] = __uint_as_float(xw.y << 16); xv[3] = __uint_as_float(xw.y & 0xffff0000u);
                        o2[n] = pk4(xv + gv[bj][n] * acc[ai][bj][m][n]); }
                    *(u32x4*)(dst + c + ((fq & 1) ? 12 : 0)) = pair16(o2[0], o2[1]); } }
    }
};
__device__ __forceinline__ unsigned pk4_fp8(float a, float b, float c, float d) {
    a = __builtin_fminf(__builtin_fmaxf(a, -448.f), 448.f); b = __builtin_fminf(__builtin_fmaxf(b, -448.f), 448.f); c = __builtin_fminf(__builtin_fmaxf(c, -448.f), 448.f); d = __builtin_fminf(__builtin_fmaxf(d, -448.f), 448.f);
    int p = __builtin_amdgcn_cvt_pk_fp8_f32(a, b, 0, false); p = __builtin_amdgcn_cvt_pk_fp8_f32(c, d, p, true); return (unsigned)p;
}
constexpr float W8_SCALE = 64.f, W8_INV = 1.f / 64.f;
struct EpiGateUp8 {
    static constexpr bool PERM = false, AFTER_DRAIN = false;
    unsigned char* HID;
    __device__ __forceinline__ void operator()(const f32x4 (&acc)[2][2][4][2], const Unit& u, int wr, int wc, int fr, int fq) const {
        const int col0 = u.pn * 128 + wc * 32 + 4 * fq;
#pragma unroll
        for (int ai = 0; ai < 2; ++ai)
#pragma unroll
            for (int m = 0; m < 4; ++m) { if (!(u.mask & (3 << (2 * ai)))) continue; f32x4 h0, h1;
#pragma unroll
                for (int e = 0; e < 4; ++e) { h0[e] = silu_f(acc[ai][0][m][0][e] * W8_INV) * (acc[ai][1][m][0][e] * W8_INV); h1[e] = silu_f(acc[ai][0][m][1][e] * W8_INV) * (acc[ai][1][m][1][e] * W8_INV); }
                unsigned char* p = HID + ((size_t)u.pm * 256 + (ai + u.qa) * 128 + wr * 64 + m * 16 + fr) * 1024 + col0;
                *(unsigned*)p = pk4_fp8(h0[0], h0[1], h0[2], h0[3]); *(unsigned*)(p + 16) = pk4_fp8(h1[0], h1[1], h1[2], h1[3]); }
    }
};
struct EpiGateUp {
    static constexpr bool PERM = true, AFTER_DRAIN = false;
    bf16_t* HID;
    __device__ __forceinline__ void operator()(const f32x4 (&acc)[2][2][4][2], const Unit& u, int wr, int wc, int fr, int fq) const {
        const int col0 = u.pn * 128 + wc * 32 + 8 * fq;
#pragma unroll
        for (int ai = 0; ai < 2; ++ai)
#pragma unroll
            for (int m = 0; m < 4; ++m) { if (!(u.mask & (3 << (2 * ai)))) continue; f32x4 h0, h1;
#pragma unroll
                for (int e = 0; e < 4; ++e) { h0[e] = silu_f(acc[ai][0][m][0][e]) * acc[ai][1][m][0][e]; h1[e] = silu_f(acc[ai][0][m][1][e]) * acc[ai][1][m][1][e]; }
                u32x4 w; w.x = cvt_pk_bf16(h0[0], h0[1]); w.y = cvt_pk_bf16(h0[2], h0[3]); w.z = cvt_pk_bf16(h1[0], h1[1]); w.w = cvt_pk_bf16(h1[2], h1[3]);
                *(u32x4*)(HID + ((size_t)u.pm * 256 + (ai + u.qa) * 128 + wr * 64 + m * 16 + fr) * 1024 + col0) = w; }
    }
};
struct EpiDown {
    static constexpr bool PERM = true, AFTER_DRAIN = false;
    bf16_t* YB; const float* ROWW; float oscale;
    __device__ __forceinline__ void operator()(const f32x4 (&acc)[2][2][4][2], const Unit& u, int wr, int wc, int fr, int fq) const {
        const int col0 = u.pn * 256 + u.qb * 128 + wc * 32 + 8 * fq;
#pragma unroll
        for (int ai = 0; ai < 2; ++ai)
#pragma unroll
            for (int m = 0; m < 4; ++m) { const size_t row = (size_t)u.pm * 256 + (ai + u.qa) * 128 + wr * 64 + m * 16 + fr; const float w_ = ROWW[row] * oscale;
#pragma unroll
                for (int bj = 0; bj < 2; ++bj) { if (!(u.mask & (1 << (ai * 2 + bj)))) continue; const f32x4 v0 = acc[ai][bj][m][0] * w_, v1 = acc[ai][bj][m][1] * w_;
                    u32x4 w; w.x = cvt_pk_bf16(v0[0], v0[1]); w.y = cvt_pk_bf16(v0[2], v0[3]); w.z = cvt_pk_bf16(v1[0], v1[1]); w.w = cvt_pk_bf16(v1[2], v1[3]);
                    *(u32x4*)(YB + row * 1024 + col0 + bj * 128) = w; } }
    }
};
struct EpiDown8 {
    static constexpr bool PERM = false, AFTER_DRAIN = false;
    bf16_t* YB; const float* ROWW;
    __device__ __forceinline__ void operator()(const f32x4 (&acc)[2][2][4][2], const Unit& u, int wr, int wc, int fr, int fq) const {
        const int col0 = u.pn * 256 + u.qb * 128 + wc * 32 + 4 * fq;
#pragma unroll
        for (int ai = 0; ai < 2; ++ai)
#pragma unroll
            for (int m = 0; m < 4; ++m) { const size_t row = (size_t)u.pm * 256 + (ai + u.qa) * 128 + wr * 64 + m * 16 + fr; const float w_ = ROWW[row] * W8_INV;
#pragma unroll
                for (int bj = 0; bj < 2; ++bj)
#pragma unroll
                    for (int n = 0; n < 2; ++n) { if (!(u.mask & (1 << (ai * 2 + bj)))) continue; *(u32x2*)(YB + row * 1024 + col0 + bj * 128 + n * 16) = pk4(acc[ai][bj][m][n] * w_); } }
    }
};
struct EpiQKV1 {
    static constexpr bool PERM = false, AFTER_DRAIN = false;
    bf16_t *Q1, *K1, *V1; const float* ROPE;
    __device__ __forceinline__ void operator()(const f32x4 (&acc)[2][2][4][2], const Unit& u, int wr, int wc, int fr, int fq) const {
        const int jt = u.pm % 33; const bool latent = jt != 0;
        const int s0 = jt * 256 + u.qa * 128 + wr * 64 + fr; const size_t row0 = (size_t)u.pm * 256 + u.qa * 128 + wr * 64 + fr;
        const int cb = u.qb * 128 + wc * 32 + 4 * fq;
        if (u.pn == 5) {
#pragma unroll
            for (int ai = 0; ai < 2; ++ai)
#pragma unroll
                for (int m = 0; m < 4; ++m)
#pragma unroll
                    for (int bj = 0; bj < 2; ++bj) { if (!(u.mask & (1 << (ai * 2 + bj)))) continue; *(u32x4*)(V1 + (row0 + ai * 128 + m * 16) * 256 + cb + bj * 128 + ((fq & 1) ? 12 : 0)) = pair16(pk4(acc[ai][bj][m][0]), pk4(acc[ai][bj][m][1])); }
        } else {
            const bool isq = u.pn < 4; bf16_t* O = isq ? Q1 + u.pn * 256 : K1; const int pitch = isq ? 1024 : 256; const float sc = isq ? C2 : 1.f;
#pragma unroll
            for (int ai = 0; ai < 2; ++ai)
#pragma unroll
                for (int m = 0; m < 4; ++m) {
                    f32x4 cs0 = {1.f, 0.f, 1.f, 0.f}, cs1 = {1.f, 0.f, 1.f, 0.f};
                    if (latent) { const int tau = s0 + ai * 128 + m * 16 - 256; const int pos = (wc & 1) ? (tau & 63) : (tau >> 6);
                        const float* rp = ROPE + (pos * 16 + 4 * fq) * 2; cs0 = *(const f32x4*)rp; cs1 = *(const f32x4*)(rp + 4); }
                    const float co[4] = {cs0[0], cs0[2], cs1[0], cs1[2]}, si[4] = {cs0[1], cs0[3], cs1[1], cs1[3]};
#pragma unroll
                    for (int bj = 0; bj < 2; ++bj) { if (!(u.mask & (1 << (ai * 2 + bj)))) continue; const f32x4 a0 = acc[ai][bj][m][0], a1 = acc[ai][bj][m][1]; f32x4 o0, o1;
#pragma unroll
                        for (int e = 0; e < 4; ++e) { o0[e] = (a0[e] * co[e] - a1[e] * si[e]) * sc; o1[e] = (a1[e] * co[e] + a0[e] * si[e]) * sc; }
                        bf16_t* p = O + (row0 + ai * 128 + m * 16) * pitch + cb + bj * 128;
                        *(u32x4*)(p + ((fq & 1) ? 12 : 0)) = pair16(pk4(o0), pk4(o1)); } }
        }
    }
};
template <class Epi, class Sched, bool ALIGN_EPI = false, bool SP2 = false, int TMASK = 0xF, bool F8 = false>
__device__ __forceinline__ void gemm_phase(PG8_LAS unsigned char* lds, const Gemm g, const Sched& S, const Epi& E) {
    int tid_ = threadIdx.x; asm volatile("" : "+v"(tid_));
    const int tid = tid_, wid = __builtin_amdgcn_readfirstlane(tid >> 6), lane = tid & 63, wr = wid >> 2, wc = wid & 3, fr = lane & 15, fq = lane >> 4;
    const int K = g.K, nt = K / BK;
    unsigned voffA, voffB;
    { int R, C; stage_rc(tid * 16, R, C); const int Rb = Epi::PERM ? ((R & ~31) + perm32(R & 31)) : R;
        voffA = (unsigned)(R * K + C) * 2u; voffB = (unsigned)(Rb * K + C) * 2u; }
#define voffB (*(Epi::PERM ? &voffB : &voffA))
    const size_t kstep = (size_t)(BK * 2);
    const size_t hstep = (size_t)HALF * K * 2;
    const size_t tstep = 2 * hstep;
    const unsigned ldsw = (unsigned)wid * 1024u;
    const int aoff = lds_byte(wr * 64 + fr, F8 ? fq * 16 : fq * 8), boff = lds_byte(wc * 32 + fr, F8 ? fq * 16 : fq * 8);
    typedef int v8i_t __attribute__((ext_vector_type(8))); typedef int v4i_t __attribute__((ext_vector_type(4)));
#define PG8_SA(b, h) (((b) * 2 + (h)) * HTB)
#define PG8_SB(b, h) ((4 + (b) * 2 + (h)) * HTB)
#define PG8_STAGE(bufoff, gbase, voff) do { _Pragma("unroll") for (int _i = 0; _i < 2; ++_i) \
        __builtin_amdgcn_global_load_lds((const unsigned*)((const char*)(gbase) + (size_t)_i * 128 * K + (voff)), (PG8_LAS unsigned*)(lds + (bufoff) + ldsw + _i * 8192), 16, 0, 0); } while (0)
#define PG8_LD8(base) __builtin_shufflevector(*(const PG8_LAS v4i_t*)(base), *(const PG8_LAS v4i_t*)((base) + 16), 0, 1, 2, 3, 4, 5, 6, 7)
#define PG8_LDA(dst, b, h) do { if (!((TMASK >> (2 * (h))) & 3)) break; \
        if constexpr (F8) { _Pragma("unroll") for (int m = 0; m < 4; ++m) dst##8[m] = PG8_LD8(lds + PG8_SA(b, h) + aoff + m * 2048); } \
        else { _Pragma("unroll") for (int m = 0; m < 4; ++m) _Pragma("unroll") for (int k = 0; k < 2; ++k) dst[m][k] = *(const PG8_LAS bf16x8*)(lds + PG8_SA(b, h) + aoff + m * 2048 + k * 1024); } } while (0)
#define PG8_LDB(dst, b, h) do { if (!(TMASK & (5 << (h)))) break; \
        if constexpr (F8) { _Pragma("unroll") for (int n = 0; n < 2; ++n) dst##8[n] = PG8_LD8(lds + PG8_SB(b, h) + boff + n * 2048); } \
        else { _Pragma("unroll") for (int n = 0; n < 2; ++n) _Pragma("unroll") for (int k = 0; k < 2; ++k) dst[n][k] = *(const PG8_LAS bf16x8*)(lds + PG8_SB(b, h) + boff + n * 2048 + k * 1024); } } while (0)
#define PG8_MMA(ai, bj, At, Bt) do { if (!((TMASK >> ((ai) * 2 + (bj))) & 1)) break; __builtin_amdgcn_s_setprio(1); \
        if constexpr (F8) { _Pragma("unroll") for (int m = 0; m < 4; ++m) _Pragma("unroll") for (int n = 0; n < 2; ++n) \
            acc[ai][bj][m][n] = __builtin_amdgcn_mfma_scale_f32_16x16x128_f8f6f4(Bt##8[n], At##8[m], acc[ai][bj][m][n], 0, 0, 0, 0x7f7f7f7f, 0, 0x7f7f7f7f); } \
        else { _Pragma("unroll") for (int m = 0; m < 4; ++m) _Pragma("unroll") for (int n = 0; n < 2; ++n) _Pragma("unroll") for (int k = 0; k < 2; ++k) \
            acc[ai][bj][m][n] = __builtin_amdgcn_mfma_f32_16x16x32_bf16(Bt[n][k], At[m][k], acc[ai][bj][m][n], 0, 0, 0); } \
        __builtin_amdgcn_s_setprio(0); } while (0)
#define PG8_WAIT_V(n) asm volatile("s_waitcnt vmcnt(" #n ")" ::: "memory")
#define PG8_WAIT_L(n) asm volatile("s_waitcnt lgkmcnt(" #n ")" ::: "memory")
#define PG8_BAR __builtin_amdgcn_s_barrier()
#define PG8_SCHED __builtin_amdgcn_sched_barrier(0)
    Unit cur, nxt; int ui = 0;
    if (!S.next(0, cur)) return;
    f32x4 acc[2][2][4][2];
#pragma unroll
    for (int a = 0; a < 2; ++a)
#pragma unroll
        for (int b = 0; b < 2; ++b)
#pragma unroll
            for (int m = 0; m < 4; ++m)
#pragma unroll
                for (int n = 0; n < 2; ++n) acc[a][b][m][n] = (f32x4){0.f, 0.f, 0.f, 0.f};
    bf16x8 At[4][2], B0[2][2], B1[2][2];
    v8i_t At8[4], B08[2], B18[2];
    const char* cA = (const char*)g.A + (size_t)cur.pm * tstep + (size_t)cur.qa * hstep; const char* cB = (const char*)g.Bt + (size_t)cur.be * g.bes + (size_t)cur.pn * tstep + (size_t)cur.qb * hstep;
    S.a_ready(cur);
    if constexpr (SP2) {
        PG8_STAGE(PG8_SB(0, 0), cB, voffB); PG8_STAGE(PG8_SB(0, 1), cB + hstep, voffB); PG8_STAGE(PG8_SA(0, 0), cA, voffA); PG8_STAGE(PG8_SA(0, 1), cA + hstep, voffA);
        if (wr == 1) PG8_BAR;
        PG8_WAIT_V(2); PG8_BAR;
        PG8_STAGE(PG8_SB(1, 0), cB + kstep, voffB); PG8_STAGE(PG8_SA(1, 0), cA + kstep, voffA); PG8_STAGE(PG8_SB(1, 1), cB + hstep + kstep, voffB);
        PG8_WAIT_V(6); PG8_BAR;
    } else {
        PG8_STAGE(PG8_SB(0, 0), cB, voffB); PG8_STAGE(PG8_SA(0, 0), cA, voffA); PG8_STAGE(PG8_SB(0, 1), cB + hstep, voffB); PG8_STAGE(PG8_SA(0, 1), cA + hstep, voffA);
        if (wr == 1) PG8_BAR;
        PG8_WAIT_V(4); PG8_BAR;
        PG8_STAGE(PG8_SB(1, 0), cB + kstep, voffB); PG8_STAGE(PG8_SA(1, 0), cA + kstep, voffA); PG8_STAGE(PG8_SB(1, 1), cB + hstep + kstep, voffB);
        PG8_WAIT_V(6); PG8_BAR;
    }
    for (;;) {
        const bool has_next = S.next(ui + 1, nxt);
        const char* nA = has_next ? (const char*)g.A + (size_t)nxt.pm * tstep + (size_t)nxt.qa * hstep : cA; const char* nB = has_next ? (const char*)g.Bt + (size_t)nxt.be * g.bes + (size_t)nxt.pn * tstep + (size_t)nxt.qb * hstep : cB;
#pragma unroll 1
        for (int t = 0; t < nt; t += 2) {
            const bool last = (t == nt - 2);
            const char* a1 = cA + (size_t)(t + 1) * kstep;
            const char* a2 = last ? nA : cA + (size_t)(t + 2) * kstep; const char* b2 = last ? nB : cB + (size_t)(t + 2) * kstep;
            const char* a3 = a2 + kstep; const char* b3 = b2 + kstep;
            if (last && has_next) S.a_ready(nxt);
            if constexpr (SP2) {
            PG8_LDB(B0, 0, 0); PG8_LDB(B1, 0, 1); PG8_SCHED; PG8_LDA(At, 0, 0); PG8_STAGE(PG8_SA(1, 1), a1 + hstep, voffA);
            PG8_WAIT_V(8); PG8_WAIT_L(0); PG8_BAR; PG8_MMA(0, 0, At, B0); PG8_MMA(0, 1, At, B1); PG8_BAR; PG8_SCHED;
            PG8_LDA(At, 0, 1); PG8_STAGE(PG8_SB(0, 0), b2, voffB); PG8_STAGE(PG8_SB(0, 1), b2 + hstep, voffB); PG8_STAGE(PG8_SA(0, 0), a2, voffA);
            PG8_WAIT_V(8); PG8_WAIT_L(0); PG8_BAR; PG8_MMA(1, 0, At, B0); PG8_MMA(1, 1, At, B1); PG8_BAR; PG8_SCHED;
            PG8_LDB(B0, 1, 0); PG8_LDB(B1, 1, 1); PG8_SCHED; PG8_LDA(At, 1, 0); PG8_STAGE(PG8_SA(0, 1), a2 + hstep, voffA);
            PG8_WAIT_V(8); PG8_WAIT_L(0); PG8_BAR; PG8_MMA(0, 0, At, B0); PG8_MMA(0, 1, At, B1); PG8_BAR; PG8_SCHED;
            PG8_LDA(At, 1, 1); PG8_STAGE(PG8_SB(1, 0), b3, voffB); PG8_STAGE(PG8_SB(1, 1), b3 + hstep, voffB); PG8_STAGE(PG8_SA(1, 0), a3, voffA);
            PG8_WAIT_V(8); PG8_WAIT_L(0); PG8_BAR; PG8_MMA(1, 0, At, B0); PG8_MMA(1, 1, At, B1); PG8_BAR; PG8_SCHED;
            } else {
            PG8_LDB(B0, 0, 0); PG8_SCHED; PG8_LDA(At, 0, 0); PG8_STAGE(PG8_SA(1, 1), a1 + hstep, voffA);
            PG8_WAIT_L(8); PG8_BAR; PG8_WAIT_L(0); PG8_MMA(0, 0, At, B0); PG8_BAR; PG8_SCHED;
            PG8_LDB(B1, 0, 1); PG8_STAGE(PG8_SB(0, 0), b2, voffB);
            PG8_BAR; PG8_WAIT_L(0); PG8_MMA(0, 1, At, B1); PG8_BAR;
            PG8_LDA(At, 0, 1); PG8_STAGE(PG8_SA(0, 0), a2, voffA);
            PG8_BAR; PG8_WAIT_L(0); PG8_MMA(1, 0, At, B0); PG8_BAR; PG8_SCHED;
            PG8_STAGE(PG8_SB(0, 1), b2 + hstep, voffB);
            PG8_WAIT_V(6); PG8_BAR; PG8_MMA(1, 1, At, B1); PG8_BAR;
            PG8_LDB(B0, 1, 0); PG8_SCHED; PG8_LDA(At, 1, 0); PG8_STAGE(PG8_SA(0, 1), a2 + hstep, voffA);
            PG8_WAIT_L(8); PG8_BAR; PG8_WAIT_L(0); PG8_MMA(0, 0, At, B0); PG8_BAR; PG8_SCHED;
            PG8_LDB(B1, 1, 1); PG8_STAGE(PG8_SB(1, 0), b3, voffB);
            PG8_BAR; PG8_WAIT_L(0); PG8_MMA(0, 1, At, B1); PG8_BAR;
            PG8_LDA(At, 1, 1); PG8_STAGE(PG8_SA(1, 0), a3, voffA);
            PG8_BAR; PG8_WAIT_L(0); PG8_MMA(1, 0, At, B0); PG8_BAR; PG8_SCHED;
            PG8_STAGE(PG8_SB(1, 1), b3 + hstep, voffB);
            PG8_WAIT_V(6); PG8_BAR; PG8_MMA(1, 1, At, B1); PG8_BAR;
            }
        }
        if constexpr (ALIGN_EPI) { if (wr == 0) PG8_BAR; }
        if constexpr (!Epi::AFTER_DRAIN) { int t_e = threadIdx.x; asm volatile("" : "+v"(t_e)); const int fr_e = t_e & 15, fq_e = (t_e >> 4) & 3;
            E(acc, cur, wr, wc, fr_e, fq_e); S.done(cur); }
        if (!has_next) break;
#pragma unroll
        for (int a = 0; a < 2; ++a)
#pragma unroll
            for (int b = 0; b < 2; ++b)
#pragma unroll
                for (int m = 0; m < 4; ++m)
#pragma unroll
                    for (int n = 0; n < 2; ++n) acc[a][b][m][n] = (f32x4){0.f, 0.f, 0.f, 0.f};
        cur = nxt; cA = nA; cB = nB; ++ui;
        if constexpr (ALIGN_EPI) { if (wr == 1) PG8_BAR; }
    }
    PG8_WAIT_V(0);
    if constexpr (!ALIGN_EPI) { if (wr == 0) PG8_BAR; }
    PG8_BAR;
    if constexpr (Epi::AFTER_DRAIN) { E.fused(acc, cur, wr, wc, fr, fq, lds, wid, lane); S.done(cur); }
#undef PG8_SA
#undef PG8_SB
#undef PG8_STAGE
#undef voffB
#undef PG8_LDA
#undef PG8_LDB
#undef PG8_MMA
#undef PG8_LD8
#undef PG8_WAIT_V
#undef PG8_WAIT_L
#undef PG8_BAR
#undef PG8_SCHED
}
}
namespace attn_body {
using bf16=__hip_bfloat16;
using bf16x8=__attribute__((ext_vector_type(8)))short;
using s16x4=__attribute__((ext_vector_type(4)))short;
using f32x16=__attribute__((ext_vector_type(16)))float;
using u32x4=__attribute__((ext_vector_type(4)))unsigned;
constexpr int D=64;
constexpr int NW=8,QBLK=32,QB=QBLK*NW,KVBLK=64;
constexpr int ATTN_UNIT_ROWS=QB;
__device__ __forceinline__ int crow(int r,int hi){return (r&3)+8*(r>>2)+4*hi;}
#define SBAR() __builtin_amdgcn_sched_barrier(0)
__device__ __forceinline__ void swamask(f32x16&p0,f32x16&p1,int dq0,bool tin,int hi){
  const float NEG=-INFINITY;
  #pragma unroll
  for(int r=0;r<16;++r){const int kv=4*hi+(r&3)+8*(r>>2); const int d0=dq0-kv, d1=d0-32;
    if(!(tin&&d0>=-128&&d0<=128))p0[r]=NEG; if(!(tin&&d1>=-128&&d1<=128))p1[r]=NEG;}
}

constexpr int NSLOT=3, SLOTB=8192;
constexpr int LDS_K=0, LDS_V=NSLOT*SLOTB, LDS_WS=2*NSLOT*SLOTB, LDS_OST=LDS_WS+NW*64*4, LDS_BYTES=LDS_OST+NW*4096;
constexpr float C2A=0.125f*1.4426950408889634f;
__device__ __forceinline__ void glds16(const void*gsrc,unsigned lds_dst){unsigned keep;
  asm volatile("s_mov_b32 %0, m0\n\ts_mov_b32 m0, %2\n\ts_nop 0\n\tglobal_load_lds_dwordx4 %1, off\n\ts_mov_b32 m0, %0":"=&s"(keep):"v"(gsrc),"s"(lds_dst):"memory");}
__device__ __forceinline__ float max3f(float a,float b,float c){float r;asm("v_max3_f32 %0, %1, %2, %3":"=v"(r):"v"(a),"v"(b),"v"(c));return r;}
__device__ __forceinline__ float max2f(float a,float b){float r;asm("v_max_f32_e32 %0, %1, %2":"=v"(r):"v"(a),"v"(b));return r;}
__device__ __forceinline__ float fadd_s(float a,float b){float r;asm("v_add_f32_e32 %0, %1, %2":"=v"(r):"v"(a),"v"(b));return r;}
__device__ __forceinline__ float fsub_s(float a,float b){float r;asm("v_sub_f32_e32 %0, %1, %2":"=v"(r):"v"(a),"v"(b));return r;}
typedef float f32x2_t __attribute__((ext_vector_type(2))); typedef __bf16 bf16x2_t __attribute__((ext_vector_type(2)));
__device__ __forceinline__ unsigned cvtpk_s(float lo,float hi){f32x2_t v={lo,hi};bf16x2_t b=__builtin_convertvector(v,bf16x2_t);return __builtin_bit_cast(unsigned,b);}
#define WAIT_BAR(N) asm volatile("s_waitcnt vmcnt(" #N ") lgkmcnt(0)\n\ts_barrier":::"memory")

__device__ __forceinline__ void qkt(f32x16&p0,f32x16&p1,const char*Kslot,const bf16x8*qr,const f32x16&negm,int r32,int hi){
  const char*kb=Kslot+hi*1024+r32*16;
  #pragma unroll
  for(int d0=0;d0<4;++d0){
    const bf16x8 b0=*reinterpret_cast<const bf16x8*>(kb+d0*2048);
    const bf16x8 b1=*reinterpret_cast<const bf16x8*>(kb+d0*2048+512);
    if(d0==0){p0=__builtin_amdgcn_mfma_f32_32x32x16_bf16(b0,qr[0],negm,0,0,0);p1=__builtin_amdgcn_mfma_f32_32x32x16_bf16(b1,qr[0],negm,0,0,0);}
    else{p0=__builtin_amdgcn_mfma_f32_32x32x16_bf16(b0,qr[d0],p0,0,0,0);p1=__builtin_amdgcn_mfma_f32_32x32x16_bf16(b1,qr[d0],p1,0,0,0);}}
}
typedef __attribute__((address_space(3))) const char* lds_cptr;
typedef short v4i16_t __attribute__((ext_vector_type(4)));
__device__ __forceinline__ void kload8(bf16x8*kf,lds_cptr kp){
  kf[0]=*(const __attribute__((address_space(3))) bf16x8*)(kp);      kf[1]=*(const __attribute__((address_space(3))) bf16x8*)(kp+512);
  kf[2]=*(const __attribute__((address_space(3))) bf16x8*)(kp+2048); kf[3]=*(const __attribute__((address_space(3))) bf16x8*)(kp+2560);
  kf[4]=*(const __attribute__((address_space(3))) bf16x8*)(kp+4096); kf[5]=*(const __attribute__((address_space(3))) bf16x8*)(kp+4608);
  kf[6]=*(const __attribute__((address_space(3))) bf16x8*)(kp+6144); kf[7]=*(const __attribute__((address_space(3))) bf16x8*)(kp+6656);
}
__device__ __forceinline__ void kload2(bf16x8*kf,lds_cptr kp,int j){ kf[2*j]=*(const __attribute__((address_space(3))) bf16x8*)(kp+j*2048); kf[2*j+1]=*(const __attribute__((address_space(3))) bf16x8*)(kp+j*2048+512); }
__device__ __forceinline__ s16x4 vtr(lds_cptr p){ return __builtin_bit_cast(s16x4,__builtin_amdgcn_ds_read_tr16_b64_v4i16((__attribute__((address_space(3))) v4i16_t*)p)); }
__device__ __forceinline__ float rowmax(const f32x16&p0,const f32x16&p1){
  float a=max3f(p0[0],p0[1],p1[0]),b=max3f(p0[2],p0[3],p1[1]);a=max3f(a,p1[2],p1[3]);
  #pragma unroll
  for(int r=4;r<16;r+=4){a=max3f(a,p0[r],p0[r+1]);b=max3f(b,p0[r+2],p0[r+3]);a=max3f(a,p1[r],p1[r+1]);b=max3f(b,p1[r+2],p1[r+3]);}
  const float m=max2f(a,b);
  auto rr=__builtin_amdgcn_permlane32_swap(__float_as_uint(m),__float_as_uint(m),false,false);
  return max2f(__uint_as_float(rr[0]),__uint_as_float(rr[1]));
}
__device__ __forceinline__ void pv(f32x16*o,int vb,bf16x8 pa0,bf16x8 pa1,bf16x8 pa2,bf16x8 pa3){
  #pragma unroll
  for(int d0=0;d0<2;++d0){s16x4 lo[4],hi[4];
    #pragma unroll
    for(int ks=0;ks<4;++ks){
      asm volatile("ds_read_b64_tr_b16 %0,%1 offset:%c2":"=&v"(lo[ks]):"v"(vb),"i"(d0*4096+ks*1024):"memory");
      asm volatile("ds_read_b64_tr_b16 %0,%1 offset:%c2":"=&v"(hi[ks]):"v"(vb),"i"(d0*4096+ks*1024+512):"memory");}
    asm volatile("s_waitcnt lgkmcnt(0)":::"memory");SBAR();
    #define PK(k) (bf16x8){lo[k][0],lo[k][1],lo[k][2],lo[k][3],hi[k][0],hi[k][1],hi[k][2],hi[k][3]}
    o[d0]=__builtin_amdgcn_mfma_f32_32x32x16_bf16(pa0,PK(0),o[d0],0,0,0);
    o[d0]=__builtin_amdgcn_mfma_f32_32x32x16_bf16(pa1,PK(1),o[d0],0,0,0);
    o[d0]=__builtin_amdgcn_mfma_f32_32x32x16_bf16(pa2,PK(2),o[d0],0,0,0);
    o[d0]=__builtin_amdgcn_mfma_f32_32x32x16_bf16(pa3,PK(3),o[d0],0,0,0);
    #undef PK
  }
}

#ifndef ATTN_STORE16
#define ATTN_STORE16(p,v) (*(u32x4*)(p)=(v))
#endif
template<int THRL,int MODE> __device__ __forceinline__ void attn_unit(const bf16*Qw0,int QP,const bf16*__restrict__ Kh,int KP,const bf16*__restrict__ Vh,int VP,bf16*Ow0,int OP,int NT,int tau0,const float*sinkp,char*shm){
  const int tid=threadIdx.x,lane=tid&63,r32=lane&31,hi=lane>>5; const int wid=__builtin_amdgcn_readfirstlane(tid>>6);
  const int wrow=(MODE==1)?(wid&1)*QBLK:wid*QBLK, wcol=(MODE==1)?(wid>>1)*64:0;
  const float sink_l2=(MODE==1)?sinkp[wid>>1]*1.4426950408889634f:0.f;
  const bf16*Qw=Qw0+(long)wrow*QP+wcol;
  const unsigned lds0=(unsigned)(uintptr_t)shm;
  float*wsf=(float*)(shm+LDS_WS)+wid*64;
  const bf16*ksrc=Kh+(long)lane*KP+wid*8;
  const bf16*vsrc=Vh+(long)(16*(wid&3)+(lane>>2))*VP+(wid>>2)*32+(lane&3)*8;
  const unsigned kdst=lds0+LDS_K+wid*1024, vdst=lds0+LDS_V+wid*1024;
  #define TROW(t) ((MODE==0||(t)<4)?(long)(t)*KVBLK:(long)(256+min(max(tau0-128+64*((t)-4),0),8192-64)))
  #define DMA_K(t,slot) glds16(ksrc+TROW(t)*KP,(unsigned)__builtin_amdgcn_readfirstlane(kdst+(slot)))
  #define DMA_V(t,slot) glds16(vsrc+TROW(t)*VP,(unsigned)__builtin_amdgcn_readfirstlane(vdst+(slot)))
  const int vb0=(int)(lds0+LDS_V)+((lane>>4)&1)*32+(lane&3)*8+(4*hi+((lane&15)>>2))*64;
  const char*Kbase=shm+LDS_K; bf16x8 kf[8];
  const lds_cptr shm3=(lds_cptr)shm; const lds_cptr kp0=shm3+LDS_K+hi*1024+r32*16; const lds_cptr vp0=shm3+LDS_V+((lane>>4)&1)*32+(lane&3)*8+(4*hi+((lane&15)>>2))*64;
  DMA_K(0,0);DMA_V(0,0);DMA_K(1,SLOTB);
  bf16x8 qr[4];
  #pragma unroll
  for(int d0=0;d0<4;++d0)qr[d0]=*reinterpret_cast<const bf16x8*>(&Qw[(long)r32*QP+d0*16+hi*8]);
  float mhat=0.f,l_reg=0.f;f32x16 o[2];o[0]=f32x16{};o[1]=f32x16{};f32x16 negm=f32x16{};asm volatile("":"+v"(negm));
  const int qrel=wrow+r32;
  #define CMASK(P0,P1,t) do{ if(MODE==1){ if((t)>=4){ const int ts_=tau0-128+64*((t)-4); swamask(P0,P1,qrel+128-64*((t)-4),(ts_>=0&&ts_<8192),hi);} } }while(0)
  bool resc=false;
  #define START(P0,P1) do{ const float rm=rowmax(P0,P1); resc=false; \
    { const float dl=rm; mhat=fadd_s(mhat,dl); \
      _Pragma("unroll") for(int r=0;r<16;++r){P0[r]=fsub_s(P0[r],dl);P1[r]=fsub_s(P1[r],dl);} \
      _Pragma("unroll") for(int r=0;r<16;++r)negm[r]=-mhat; asm volatile("":"+v"(negm)); } \
    _Pragma("unroll") for(int r=0;r<16;++r)P0[r]=__builtin_amdgcn_exp2f(P0[r]); }while(0)
  #define RESC() do{ if(resc){ asm volatile("s_waitcnt lgkmcnt(0)":::"memory"); \
      _Pragma("unroll") for(int d_=0;d_<2;++d_) _Pragma("unroll") for(int r=0;r<16;++r)o[d_][r]*=wsf[crow(r,hi)]; } }while(0)
  f32x16 pA0,pA1,pB0,pB1;
  int sl_prev=0,sl_cur=0,sl_next=SLOTB;
  #define ROT() do{sl_prev=sl_cur;sl_cur=sl_next;sl_next=(sl_next==(NSLOT-1)*SLOTB)?0:sl_next+SLOTB;}while(0)
  DMA_K(2,2*SLOTB);
  WAIT_BAR(3);
  qkt(pA0,pA1,Kbase,qr,negm,r32,hi);asm volatile("s_nop 15\n\ts_nop 7":"+v"(pA0),"+v"(pA1));CMASK(pA0,pA1,0);
  START(pA0,pA1);
  _Pragma("unroll") for(int r=0;r<16;++r)pA1[r]=__builtin_amdgcn_exp2f(pA1[r]);
  WAIT_BAR(0);
  DMA_K(3,0);DMA_V(1,SLOTB);
  ROT();
  kload8(kf,kp0+sl_cur);
  WAIT_BAR(2);
  s16x4 vlo[8],vhi[8]; u32x4 pw0,pw1,pw2,pw3;
  #define PKW(P,B) cvtpk_s(P[B],P[B+1])
  #define PAF(k) __builtin_bit_cast(bf16x8,pw##k)
  #define VFR(i) (bf16x8){vlo[i][0],vlo[i][1],vlo[i][2],vlo[i][3],vhi[i][0],vhi[i][1],vhi[i][2],vhi[i][3]}
  #define PIN(x) asm volatile("":"+v"(x))
  #define MX3(a,b,c) __builtin_fmaxf(__builtin_fmaxf((a),(b)),(c))
  #define GAPA(MF,A0,A1,A2,A3,W0,W1,PW) do{ MF; sacc+=A0; sacc+=A1; sacc+=A2; sacc+=A3; PIN(sacc); W0; W1; PIN(PW); SBAR(); }while(0)
  #define EX(v) __builtin_amdgcn_exp2f(v)
  #define GAPB(MF,X,B) do{ MF; X[B]=EX(X[B]); X[B+1]=EX(X[B+1]); X[B+2]=EX(X[B+2]); X[B+3]=EX(X[B+3]); PIN(X); SBAR(); }while(0)
  #define VRD(i) do{ vlo[i]=vtr(vp_+(((i)>>2)*4096+((i)&3)*1024)); vhi[i]=vtr(vp_+(((i)>>2)*4096+((i)&3)*1024+512)); }while(0)
  #define KRD(G,j) do{ if(G){ kload2(kf,kp0+sl_next,j); SBAR(); } }while(0)
  #define STEP(C0,C1,P0,P1,t,GK,GV,GL) do{ SBAR(); \
    const lds_cptr vp_=vp0+sl_prev; \
    VRD(0); SBAR(); float sacc=(P0[0]+P0[1]); \
    GAPA(C0=__builtin_amdgcn_mfma_f32_32x32x16_bf16(kf[0],qr[0],negm,0,0,0), P0[2],P0[3],P0[4],P0[5],     pw0[0]=PKW(P0,0), pw0[1]=PKW(P0,2), pw0); \
    VRD(4); SBAR(); GAPA(C1=__builtin_amdgcn_mfma_f32_32x32x16_bf16(kf[1],qr[0],negm,0,0,0), P0[6],P0[7],P0[8],P0[9],     pw0[2]=PKW(P0,4), pw0[3]=PKW(P0,6), pw0); \
    VRD(1); SBAR(); GAPA(C0=__builtin_amdgcn_mfma_f32_32x32x16_bf16(kf[2],qr[1],C0,0,0,0),   P0[10],P0[11],P0[12],P0[13], pw1[0]=PKW(P0,8), pw1[1]=PKW(P0,10), pw1); \
    VRD(5); SBAR(); GAPA(C1=__builtin_amdgcn_mfma_f32_32x32x16_bf16(kf[3],qr[1],C1,0,0,0),   P0[14],P0[15],P1[0],P1[1],   pw1[2]=PKW(P0,12),pw1[3]=PKW(P0,14), pw1); \
    VRD(2); SBAR(); GAPA(C0=__builtin_amdgcn_mfma_f32_32x32x16_bf16(kf[4],qr[2],C0,0,0,0),   P1[2],P1[3],P1[4],P1[5],     pw2[0]=PKW(P1,0), pw2[1]=PKW(P1,2), pw2); \
    VRD(6); SBAR(); GAPA(C1=__builtin_amdgcn_mfma_f32_32x32x16_bf16(kf[5],qr[2],C1,0,0,0),   P1[6],P1[7],P1[8],P1[9],     pw2[2]=PKW(P1,4), pw2[3]=PKW(P1,6), pw2); \
    VRD(3); SBAR(); GAPA(C0=__builtin_amdgcn_mfma_f32_32x32x16_bf16(kf[6],qr[3],C0,0,0,0),   P1[10],P1[11],P1[12],P1[13], pw3[0]=PKW(P1,8), pw3[1]=PKW(P1,10), pw3); \
    VRD(7); SBAR(); GAPA(C1=__builtin_amdgcn_mfma_f32_32x32x16_bf16(kf[7],qr[3],C1,0,0,0),   P1[14],P1[15],0.f,0.f,       pw3[2]=PKW(P1,12),pw3[3]=PKW(P1,14), pw3); \
    l_reg+=sacc; \
    if(GK){DMA_K((t)+3,sl_cur);} if(GV){DMA_V((t)+1,sl_next);} \
    CMASK(C0,C1,t); \
    { float a=MX3(C0[0],C0[1],C1[0]),b=MX3(C0[2],C0[3],C1[1]); a=MX3(a,C1[2],C1[3]); \
      _Pragma("unroll") for(int r=4;r<16;r+=4){a=MX3(a,C0[r],C0[r+1]);b=MX3(b,C0[r+2],C0[r+3]);a=MX3(a,C1[r],C1[r+1]);b=MX3(b,C1[r+2],C1[r+3]);} \
      float rm=__builtin_fmaxf(a,b); { auto rr=__builtin_amdgcn_permlane32_swap(__float_as_uint(rm),__float_as_uint(rm),false,false); rm=__builtin_fmaxf(__uint_as_float(rr[0]),__uint_as_float(rr[1])); } \
      resc=false; \
      if(__builtin_expect(__any(rm>(float)THRL),0)){ const float dl=__builtin_fmaxf(rm,0.f); mhat+=dl; \
        _Pragma("unroll") for(int r=0;r<16;++r){C0[r]-=dl;C1[r]-=dl;} \
        _Pragma("unroll") for(int r=0;r<16;++r)negm[r]=-mhat; asm volatile("":"+v"(negm)); \
        const float f=__builtin_amdgcn_exp2f(-dl); l_reg*=f; if(hi==0)wsf[r32]=f; resc=true; } } \
    SBAR(); \
    GAPB(o[0]=__builtin_amdgcn_mfma_f32_32x32x16_bf16(PAF(0),VFR(0),o[0],0,0,0), C0,0); \
    GAPB(o[1]=__builtin_amdgcn_mfma_f32_32x32x16_bf16(PAF(0),VFR(4),o[1],0,0,0), C0,4); \
    KRD(GL,0); GAPB(o[0]=__builtin_amdgcn_mfma_f32_32x32x16_bf16(PAF(1),VFR(1),o[0],0,0,0), C0,8); \
    KRD(GL,1); GAPB(o[1]=__builtin_amdgcn_mfma_f32_32x32x16_bf16(PAF(1),VFR(5),o[1],0,0,0), C0,12); \
    KRD(GL,2); GAPB(o[0]=__builtin_amdgcn_mfma_f32_32x32x16_bf16(PAF(2),VFR(2),o[0],0,0,0), C1,0); \
    KRD(GL,3); GAPB(o[1]=__builtin_amdgcn_mfma_f32_32x32x16_bf16(PAF(2),VFR(6),o[1],0,0,0), C1,4); \
    GAPB(o[0]=__builtin_amdgcn_mfma_f32_32x32x16_bf16(PAF(3),VFR(3),o[0],0,0,0), C1,8); \
    GAPB(o[1]=__builtin_amdgcn_mfma_f32_32x32x16_bf16(PAF(3),VFR(7),o[1],0,0,0), C1,12); \
    }while(0)
  int t=1;
  for(;t+5<NT;t+=2){
    STEP(pB0,pB1,pA0,pA1,t,true,true,true);     WAIT_BAR(2); RESC(); ROT();
    STEP(pA0,pA1,pB0,pB1,t+1,true,true,true);   WAIT_BAR(2); RESC(); ROT();
  }
  #define ENDW(tt) do{ if((tt)+3<NT){WAIT_BAR(2);} else if((tt)+2<NT){WAIT_BAR(1);} else {WAIT_BAR(0);} }while(0)
  #define DRAIN(X0,X1) do{ float sacc=X0[0]+X0[1]; _Pragma("unroll") for(int r=2;r<16;++r)sacc+=X0[r]; _Pragma("unroll") for(int r=0;r<16;++r)sacc+=X1[r]; l_reg+=sacc; \
    pw0=(u32x4){PKW(X0,0),PKW(X0,2),PKW(X0,4),PKW(X0,6)};pw1=(u32x4){PKW(X0,8),PKW(X0,10),PKW(X0,12),PKW(X0,14)};pw2=(u32x4){PKW(X1,0),PKW(X1,2),PKW(X1,4),PKW(X1,6)};pw3=(u32x4){PKW(X1,8),PKW(X1,10),PKW(X1,12),PKW(X1,14)}; \
    SBAR(); pv(o,vb0+sl_cur,PAF(0),PAF(1),PAF(2),PAF(3)); }while(0)
  if(NT&1){
    for(;t+2<NT;t+=2){
      STEP(pB0,pB1,pA0,pA1,t,(t+3<NT),(t+1<NT),(t+1<NT));       ENDW(t);   RESC(); ROT();
      STEP(pA0,pA1,pB0,pB1,t+1,(t+4<NT),(t+2<NT),(t+2<NT));     ENDW(t+1); RESC(); ROT();
    }
    STEP(pB0,pB1,pA0,pA1,t,false,true,true); ENDW(t); RESC(); ROT();
    STEP(pA0,pA1,pB0,pB1,NT-1,false,false,false); RESC();
    DRAIN(pA0,pA1);
  } else {
  for(;t+1<NT;t+=2){
    STEP(pB0,pB1,pA0,pA1,t,(t+3<NT),(t+1<NT),(t+1<NT));       ENDW(t);   RESC(); ROT();
    STEP(pA0,pA1,pB0,pB1,t+1,(t+4<NT),(t+2<NT),(t+2<NT));     ENDW(t+1); RESC(); ROT();
  }
  STEP(pB0,pB1,pA0,pA1,NT-1,false,false,false); RESC();
  DRAIN(pB0,pB1);
  }
  #undef DRAIN
  #undef PKW
  #undef PAF
  #undef VFR
  #undef PIN
  #undef MX3
  #undef GAPA
  #undef GAPB
  #undef EX
  #undef VRD
  #undef KRD
  #undef STEP
  #undef ENDW
  {auto rr=__builtin_amdgcn_permlane32_swap(__float_as_uint(l_reg),__float_as_uint(l_reg),false,false);l_reg=__uint_as_float(rr[0])+__uint_as_float(rr[1]);}
  if(MODE==1)l_reg+=__builtin_amdgcn_exp2f(sink_l2-mhat);
  if(hi==0)wsf[32+r32]=l_reg;asm volatile("s_waitcnt lgkmcnt(0)":::"memory");
  float rli[16];
  #pragma unroll
  for(int r=0;r<16;++r)rli[r]=__builtin_amdgcn_rcpf(wsf[32+crow(r,hi)]);
  bf16*Ow=Ow0+(long)wrow*OP+wcol;
  { bf16*stg=(bf16*)(shm+LDS_OST)+wid*2048;
    #pragma unroll
    for(int r=0;r<16;++r){const int orow=crow(r,hi);
      #pragma unroll
      for(int d0=0;d0<2;++d0)stg[orow*64+d0*32+r32]=__float2bfloat16(o[d0][r]*rli[r]);}
    asm volatile("s_waitcnt lgkmcnt(0)":::"memory");
    #pragma unroll
    for(int i=0;i<4;++i){const int row=i*8+(lane>>3),ch=lane&7; const u32x4 v=*(const u32x4*)(stg+row*64+ch*8); ATTN_STORE16(Ow+(long)row*OP+ch*8,v);} }
  asm volatile("s_waitcnt lgkmcnt(0)\n\ts_barrier":::"memory");
  #undef DMA_K
  #undef TROW
  #undef DMA_V
  #undef CMASK
  #undef START
  #undef RESC
  #undef ROT
}
constexpr int ATTN_LDS_BYTES=LDS_BYTES;
#undef SBAR
#undef WAIT_BAR
}
namespace attn_body {
constexpr int X_K=0, X_V=3*8192, X_WS=X_V+3*16384, X_OST=X_WS+NW*64*4, X_BYTES=X_OST+NW*8192;
#define SBAR() __builtin_amdgcn_sched_barrier(0)
#define WAIT_BAR(N) asm volatile("s_waitcnt vmcnt(" #N ") lgkmcnt(0)\n\ts_barrier":::"memory")
__device__ __forceinline__ void pv128(f32x16*o,int vb,bf16x8 pa0,bf16x8 pa1,bf16x8 pa2,bf16x8 pa3){
  #pragma unroll
  for(int d0=0;d0<4;++d0){s16x4 lo[4],hi[4];
    #pragma unroll
    for(int ks=0;ks<4;++ks){
      asm volatile("ds_read_b64_tr_b16 %0,%1 offset:%c2":"=&v"(lo[ks]):"v"(vb),"i"(d0*4096+ks*1024):"memory");
      asm volatile("ds_read_b64_tr_b16 %0,%1 offset:%c2":"=&v"(hi[ks]):"v"(vb),"i"(d0*4096+ks*1024+512):"memory");}
    asm volatile("s_waitcnt lgkmcnt(0)":::"memory");SBAR();
    #define PK(k) (bf16x8){lo[k][0],lo[k][1],lo[k][2],lo[k][3],hi[k][0],hi[k][1],hi[k][2],hi[k][3]}
    o[d0]=__builtin_amdgcn_mfma_f32_32x32x16_bf16(pa0,PK(0),o[d0],0,0,0);
    o[d0]=__builtin_amdgcn_mfma_f32_32x32x16_bf16(pa1,PK(1),o[d0],0,0,0);
    o[d0]=__builtin_amdgcn_mfma_f32_32x32x16_bf16(pa2,PK(2),o[d0],0,0,0);
    o[d0]=__builtin_amdgcn_mfma_f32_32x32x16_bf16(pa3,PK(3),o[d0],0,0,0);
    #undef PK
  }
}
template<int THRL,int EPI> __device__ __forceinline__ void attn_unit128(const bf16*Qw0,int QP,const bf16*__restrict__ Kh,int KP,const bf16*__restrict__ Vh,int VP,bf16*Ow0,int OP,int NT,float lam,const float*gsub,char*shm){
  const int tid=threadIdx.x,lane=tid&63,r32=lane&31,hi=lane>>5; const int wid=__builtin_amdgcn_readfirstlane(tid>>6);
  const bf16*Qw=Qw0+(long)(wid*QBLK)*QP;
  const unsigned lds0=(unsigned)(uintptr_t)shm;
  float*wsf=(float*)(shm+X_WS)+wid*64;
  const bf16*ksrc=Kh+(long)lane*KP+wid*8;
  const bf16*vsrc=Vh+(long)(16*(wid&3)+(lane>>2))*VP+(wid>>2)*32+(lane&3)*8;
  const unsigned kdst=lds0+X_K+wid*1024, vdst=lds0+X_V+wid*1024;
  #define DMA_K(t,slot) glds16(ksrc+(long)(t)*KVBLK*KP,(unsigned)__builtin_amdgcn_readfirstlane(kdst+(slot)))
  #define DMA_V(t,slot) do{ glds16(vsrc+(long)(t)*KVBLK*VP,(unsigned)__builtin_amdgcn_readfirstlane(vdst+2*(slot))); glds16(vsrc+(long)(t)*KVBLK*VP+64,(unsigned)__builtin_amdgcn_readfirstlane(vdst+2*(slot)+8192)); }while(0)
  const char*Kbase=shm+X_K; bf16x8 kf[8];
  const lds_cptr shm3=(lds_cptr)shm; const lds_cptr kp0=shm3+X_K+hi*1024+r32*16; const lds_cptr vp0=shm3+X_V+((lane>>4)&1)*32+(lane&3)*8+(4*hi+((lane&15)>>2))*64;
  DMA_K(0,0);DMA_V(0,0);DMA_K(1,SLOTB);
  bf16x8 qr[4];
  #pragma unroll
  for(int d0=0;d0<4;++d0)qr[d0]=*reinterpret_cast<const bf16x8*>(&Qw[(long)r32*QP+d0*16+hi*8]);
  float mhat=0.f,l_reg=0.f;f32x16 o[4];o[0]=f32x16{};o[1]=f32x16{};o[2]=f32x16{};o[3]=f32x16{};f32x16 negm=f32x16{};asm volatile("":"+v"(negm));
  bool resc=false;
  #define START(P0,P1) do{ const float rm=rowmax(P0,P1); resc=false; \
    { const float dl=rm; mhat=fadd_s(mhat,dl); \
      _Pragma("unroll") for(int r=0;r<16;++r){P0[r]=fsub_s(P0[r],dl);P1[r]=fsub_s(P1[r],dl);} \
      _Pragma("unroll") for(int r=0;r<16;++r)negm[r]=-mhat; asm volatile("":"+v"(negm)); } \
    _Pragma("unroll") for(int r=0;r<16;++r)P0[r]=__builtin_amdgcn_exp2f(P0[r]); }while(0)
  #define RESC() do{ if(resc){ asm volatile("s_waitcnt lgkmcnt(0)":::"memory"); \
      _Pragma("unroll") for(int d_=0;d_<4;++d_) _Pragma("unroll") for(int r=0;r<16;++r)o[d_][r]*=wsf[crow(r,hi)]; } }while(0)
  f32x16 pC0,pC1;
  int sl_prev=0,sl_cur=0,sl_next=SLOTB;
  #define ROT() do{sl_prev=sl_cur;sl_cur=sl_next;sl_next=(sl_next==(NSLOT-1)*SLOTB)?0:sl_next+SLOTB;}while(0)
  DMA_K(2,2*SLOTB);
  WAIT_BAR(3);
  s16x4 vlo[6],vhi[6]; u32x4 pw0,pw1,pw2,pw3;
  #define PKW(P,B) cvtpk_s(P[B],P[B+1])
  #define PAF(k) __builtin_bit_cast(bf16x8,pw##k)
  #define VFR(i) (bf16x8){vlo[i][0],vlo[i][1],vlo[i][2],vlo[i][3],vhi[i][0],vhi[i][1],vhi[i][2],vhi[i][3]}
  #define PIN(x) asm volatile("":"+v"(x))
  #define MX3(a,b,c) __builtin_fmaxf(__builtin_fmaxf((a),(b)),(c))
  #define EX(v) __builtin_amdgcn_exp2f(v)
  qkt(pC0,pC1,Kbase,qr,negm,r32,hi);asm volatile("s_nop 15\n\ts_nop 7":"+v"(pC0),"+v"(pC1));
  START(pC0,pC1);
  _Pragma("unroll") for(int r=0;r<16;++r)pC1[r]=__builtin_amdgcn_exp2f(pC1[r]);
  { float sacc=pC0[0]+pC0[1]; _Pragma("unroll") for(int r=2;r<16;++r)sacc+=pC0[r]; _Pragma("unroll") for(int r=0;r<16;++r)sacc+=pC1[r]; l_reg+=sacc;
    pw0=(u32x4){PKW(pC0,0),PKW(pC0,2),PKW(pC0,4),PKW(pC0,6)};pw1=(u32x4){PKW(pC0,8),PKW(pC0,10),PKW(pC0,12),PKW(pC0,14)};pw2=(u32x4){PKW(pC1,0),PKW(pC1,2),PKW(pC1,4),PKW(pC1,6)};pw3=(u32x4){PKW(pC1,8),PKW(pC1,10),PKW(pC1,12),PKW(pC1,14)}; }
  WAIT_BAR(0);
  DMA_K(3,0);DMA_V(1,SLOTB);
  ROT();
  kload8(kf,kp0+sl_cur);
  WAIT_BAR(3);
  #define VRDG(i,ks,d0) do{ vlo[i]=vtr(vp_+((d0)*4096+(ks)*1024)); vhi[i]=vtr(vp_+((d0)*4096+(ks)*1024+512)); }while(0)
  #define KRD(G,j) do{ if(G){ kload2(kf,kp0+sl_next,j); } }while(0)
  #define GA(i,ks,d0,MF) do{ VRDG(i,ks,d0); SBAR(); MF; SBAR(); }while(0)
  #define GN(MF) do{ MF; SBAR(); }while(0)
  #define GB0(MF,X,B,RL) do{ MF; X[B]=EX(X[B]); X[B+1]=EX(X[B+1]); PIN(X); RL; SBAR(); }while(0)
  #define GB1(MF,X,B,Y,C,PW,J,RL) do{ MF; X[B]=EX(X[B]); X[B+1]=EX(X[B+1]); PIN(X); sacc+=Y[C]; sacc+=Y[C+1]; PIN(sacc); PW[J]=PKW(Y,C); PIN(PW); RL; SBAR(); }while(0)
  #define PVM(d0,k,i) o[d0]=__builtin_amdgcn_mfma_f32_32x32x16_bf16(PAF(k),VFR(i),o[d0],0,0,0)
  #define STEP(t,GK,GV,GL) do{ SBAR(); \
    const lds_cptr vp_=vp0+2*sl_prev; \
    GN(pC0=__builtin_amdgcn_mfma_f32_32x32x16_bf16(kf[0],qr[0],negm,0,0,0)); \
    GN(pC1=__builtin_amdgcn_mfma_f32_32x32x16_bf16(kf[1],qr[0],negm,0,0,0)); \
    GA(0,0,0,pC0=__builtin_amdgcn_mfma_f32_32x32x16_bf16(kf[2],qr[1],pC0,0,0,0)); \
    GA(1,0,1,pC1=__builtin_amdgcn_mfma_f32_32x32x16_bf16(kf[3],qr[1],pC1,0,0,0)); \
    GA(2,0,2,pC0=__builtin_amdgcn_mfma_f32_32x32x16_bf16(kf[4],qr[2],pC0,0,0,0)); \
    GA(3,0,3,pC1=__builtin_amdgcn_mfma_f32_32x32x16_bf16(kf[5],qr[2],pC1,0,0,0)); \
    GA(4,1,0,pC0=__builtin_amdgcn_mfma_f32_32x32x16_bf16(kf[6],qr[3],pC0,0,0,0)); \
    GA(5,1,1,pC1=__builtin_amdgcn_mfma_f32_32x32x16_bf16(kf[7],qr[3],pC1,0,0,0)); \
    if(GK){DMA_K((t)+3,sl_cur);} if(GV){DMA_V((t)+1,sl_next);} \
    { float a=MX3(pC0[0],pC0[1],pC1[0]),b=MX3(pC0[2],pC0[3],pC1[1]); a=MX3(a,pC1[2],pC1[3]); \
      _Pragma("unroll") for(int r=4;r<16;r+=4){a=MX3(a,pC0[r],pC0[r+1]);b=MX3(b,pC0[r+2],pC0[r+3]);a=MX3(a,pC1[r],pC1[r+1]);b=MX3(b,pC1[r+2],pC1[r+3]);} \
      float rm=__builtin_fmaxf(a,b); { auto rr=__builtin_amdgcn_permlane32_swap(__float_as_uint(rm),__float_as_uint(rm),false,false); rm=__builtin_fmaxf(__uint_as_float(rr[0]),__uint_as_float(rr[1])); } \
      resc=false; \
      if(__builtin_expect(__any(rm>(float)THRL),0)){ const float dl=__builtin_fmaxf(rm,0.f); mhat+=dl; \
        _Pragma("unroll") for(int r=0;r<16;++r){pC0[r]-=dl;pC1[r]-=dl;} \
        _Pragma("unroll") for(int r=0;r<16;++r)negm[r]=-mhat; asm volatile("":"+v"(negm)); \
        const float f=__builtin_amdgcn_exp2f(-dl); l_reg*=f; if(hi==0)wsf[r32]=f; resc=true; } } \
    SBAR(); \
    float sacc=0.f; \
    GB0(PVM(0,0,0),pC0,0, VRDG(0,1,2)); \
    GB0(PVM(1,0,1),pC0,2, VRDG(1,1,3)); \
    GB0(PVM(2,0,2),pC0,4, VRDG(2,2,0)); \
    GB0(PVM(3,0,3),pC0,6, VRDG(3,2,1)); \
    GB1(PVM(0,1,4),pC0,8, pC0,0,pw0,0, VRDG(4,2,2)); \
    GB1(PVM(1,1,5),pC0,10, pC0,2,pw0,1, VRDG(5,2,3)); \
    GB1(PVM(2,1,0),pC0,12, pC0,4,pw0,2, VRDG(0,3,0)); \
    GB1(PVM(3,1,1),pC0,14, pC0,6,pw0,3, VRDG(1,3,1)); \
    GB1(PVM(0,2,2),pC1,0, pC0,8,pw1,0, VRDG(2,3,2)); \
    GB1(PVM(1,2,3),pC1,2, pC0,10,pw1,1, VRDG(3,3,3)); \
    GB1(PVM(2,2,4),pC1,4, pC0,12,pw1,2, (void)0); \
    GB1(PVM(3,2,5),pC1,6, pC0,14,pw1,3, (void)0); \
    GB1(PVM(0,3,0),pC1,8, pC1,0,pw2,0, KRD(GL,0)); \
    GB1(PVM(1,3,1),pC1,10, pC1,2,pw2,1, KRD(GL,1)); \
    GB1(PVM(2,3,2),pC1,12, pC1,4,pw2,2, KRD(GL,2)); \
    GB1(PVM(3,3,3),pC1,14, pC1,6,pw2,3, KRD(GL,3)); \
    sacc+=pC1[8];sacc+=pC1[9];pw3[0]=PKW(pC1,8); sacc+=pC1[10];sacc+=pC1[11];pw3[1]=PKW(pC1,10); sacc+=pC1[12];sacc+=pC1[13];pw3[2]=PKW(pC1,12); sacc+=pC1[14];sacc+=pC1[15];pw3[3]=PKW(pC1,14); \
    l_reg+=sacc; PIN(pw3); \
    }while(0)
  int t=1;
  for(;t+5<NT;t+=2){
    STEP(t,true,true,true);     WAIT_BAR(3); RESC(); ROT();
    STEP(t+1,true,true,true);   WAIT_BAR(3); RESC(); ROT();
  }
  #define ENDW(tt) do{ if((tt)+3<NT){WAIT_BAR(3);} else if((tt)+2<NT){WAIT_BAR(2);} else {WAIT_BAR(0);} }while(0)
  for(;t+1<NT;t+=2){
    STEP(t,(t+3<NT),(t+1<NT),(t+1<NT));       ENDW(t);   RESC(); ROT();
    STEP(t+1,(t+4<NT),(t+2<NT),(t+2<NT));     ENDW(t+1); RESC(); ROT();
  }
  STEP(NT-1,false,false,false); RESC();
  SBAR(); pv128(o,(int)(unsigned)(uintptr_t)vp0+2*sl_cur,PAF(0),PAF(1),PAF(2),PAF(3));
  #undef PKW
  #undef PAF
  #undef VFR
  #undef PIN
  #undef MX3
  #undef EX
  #undef VRDG
  #undef KRD
  #undef GA
  #undef GN
  #undef GB0
  #undef GB1
  #undef PVM
  #undef STEP
  #undef ENDW
  {auto rr=__builtin_amdgcn_permlane32_swap(__float_as_uint(l_reg),__float_as_uint(l_reg),false,false);l_reg=__uint_as_float(rr[0])+__uint_as_float(rr[1]);}
  if(hi==0)wsf[32+r32]=l_reg;asm volatile("s_waitcnt lgkmcnt(0)":::"memory");
  float rli[16];
  #pragma unroll
  for(int r=0;r<16;++r)rli[r]=__builtin_amdgcn_rcpf(wsf[32+crow(r,hi)]);
  bf16*Ow=Ow0+(long)(wid*QBLK)*OP;
  { bf16*stg=(bf16*)(shm+X_OST)+wid*4096;
    if(EPI==2){
      float gl[4];
      #pragma unroll
      for(int d0=0;d0<4;++d0)gl[d0]=gsub[d0*32+r32];
      #pragma unroll
      for(int r=0;r<16;++r){const int orow=crow(r,hi); float ss=0.f;
        #pragma unroll
        for(int d0=0;d0<4;++d0){const float dd=__bfloat162float(stg[orow*128+d0*32+r32])-lam*(o[d0][r]*rli[r]); o[d0][r]=dd; ss+=dd*dd;}
        ss+=dpp_f<0xB1>(ss);ss+=dpp_f<0x4E>(ss);ss+=dpp_f<0x141>(ss);ss+=dpp_f<0x140>(ss);ss=swap16_sum(ss,ss);
        const float rs=0.8f/sqrtf(ss*(1.f/128.f)+1e-6f);
        #pragma unroll
        for(int d0=0;d0<4;++d0)stg[orow*128+d0*32+r32]=__float2bfloat16(o[d0][r]*rs*gl[d0]);}
    } else {
    #pragma unroll
    for(int r=0;r<16;++r){const int orow=crow(r,hi);
      #pragma unroll
      for(int d0=0;d0<4;++d0)stg[orow*128+d0*32+r32]=__float2bfloat16(o[d0][r]*rli[r]);}
    }
    asm volatile("s_waitcnt lgkmcnt(0)":::"memory");
    if(EPI!=1){
    #pragma unroll
    for(int i=0;i<8;++i){const int row=i*4+(lane>>4),ch=lane&15; const u32x4 v=*(const u32x4*)(stg+row*128+ch*8); ATTN_STORE16(Ow+(long)row*OP+ch*8,v);} } }
  asm volatile("s_waitcnt lgkmcnt(0)\n\ts_barrier":::"memory");
  #undef DMA_K
  #undef DMA_V
  #undef START
  #undef RESC
  #undef ROT
}
#undef SBAR
#undef WAIT_BAR
}

typedef unsigned u32x2f __attribute__((ext_vector_type(2)));
constexpr int NWAVES = 8;
constexpr int LDS_BYTES = 147456;
__device__ __forceinline__ float wave_sum(float v) {
    v += dpp_f<0xB1>(v);
    v += dpp_f<0x4E>(v);
    v += dpp_f<0x141>(v);
    v += dpp_f<0x140>(v);
    v = swap16_sum(v, v); v = swap32_sum(v, v);
    return v;
}
__device__ __forceinline__ float bf2f(unsigned short h) { return __uint_as_float((unsigned)h << 16); }
__device__ __forceinline__ float silu_d(float v) { return v / (1.f + __expf(-v)); }

__device__ __forceinline__ void titem_load(const float* src, int ldw, f32x4 (&r)[8], int lane) {
#pragma unroll
    for (int i = 0; i < 8; ++i) r[i] = *(const GAS f32x4*)(src + (size_t)(8 * i + (lane >> 3)) * ldw + 4 * (lane & 7));
}
__device__ __forceinline__ void titem_finish(const f32x4 (&r)[8], bf16* dst, LAS float* scr, int lane) {
#pragma unroll
    for (int i = 0; i < 8; ++i) { LAS float* p = scr + (8 * i + (lane >> 3)) * 33 + 4 * (lane & 7); p[0] = r[i].x; p[1] = r[i].y; p[2] = r[i].z; p[3] = r[i].w; }
    LDS_WAIT(); asm volatile("" ::: "memory");
    const int c = lane & 7;
#pragma unroll
    for (int j = 0; j < 4; ++j) { const int n = (lane >> 3) + 8 * j; const LAS float* q = scr + (8 * c) * 33 + n;
        v4u o; o.x = pk2(q[0 * 33], q[1 * 33]); o.y = pk2(q[2 * 33], q[3 * 33]); o.z = pk2(q[4 * 33], q[5 * 33]); o.w = pk2(q[6 * 33], q[7 * 33]);
        *(GAS v4u*)(dst + (size_t)n * 1024 + 8 * c) = o; }
    LDS_WAIT(); asm volatile("" ::: "memory");
}
__device__ __forceinline__ void titem_finish8(const f32x4 (&r)[8], unsigned char* dst8, LAS float* scr, int lane) {
#pragma unroll
    for (int i = 0; i < 8; ++i) { LAS float* p = scr + (8 * i + (lane >> 3)) * 33 + 4 * (lane & 7); p[0] = r[i].x; p[1] = r[i].y; p[2] = r[i].z; p[3] = r[i].w; }
    LDS_WAIT(); asm volatile("" ::: "memory");
    const int c = lane & 7;
#pragma unroll
    for (int j = 0; j < 4; ++j) { const int n = (lane >> 3) + 8 * j; const LAS float* q = scr + (8 * c) * 33 + n;
        u32x2f o; o.x = pg8::pk4_fp8(q[0 * 33] * pg8::W8_SCALE, q[1 * 33] * pg8::W8_SCALE, q[2 * 33] * pg8::W8_SCALE, q[3 * 33] * pg8::W8_SCALE);
        o.y = pg8::pk4_fp8(q[4 * 33] * pg8::W8_SCALE, q[5 * 33] * pg8::W8_SCALE, q[6 * 33] * pg8::W8_SCALE, q[7 * 33] * pg8::W8_SCALE);
        *(GAS u32x2f*)(dst8 + (size_t)n * 1024 + 8 * c) = o; }
    LDS_WAIT(); asm volatile("" ::: "memory");
}
constexpr int CONV_ND = 2048 + 512 + 768 + 512, CONV_NM = 16 * 3 * 512;
#define CONV_DESC(MODE, it, src, ldw, dst) do { int r_ = (it); \
    if ((MODE) == 0) { \
        if (r_ < 2048) { const int kb = r_ >> 7, nb = r_ & 127; src = win + (size_t)(64 * kb) * 4096 + 32 * nb; ldw = 4096; dst = (bf16*)(ws + WS_WIN) + (size_t)(32 * nb) * 1024 + 64 * kb; } \
        else if (r_ < 2560) { r_ -= 2048; const int kb = r_ >> 5, nb = r_ & 31; src = wout0 + (size_t)(64 * kb) * 1024 + 32 * nb; ldw = 1024; dst = (bf16*)(ws + WS_WOE) + (size_t)(32 * nb) * 1024 + 64 * kb; } \
        else if (r_ < 3328) { r_ -= 2560; const int kb = r_ / 48, nb = r_ % 48; src = wqkv + (size_t)(64 * kb) * 1536 + 32 * nb; ldw = 1536; dst = (bf16*)(ws + WS_WQKV) + (size_t)(32 * nb) * 1024 + 64 * kb; } \
        else { r_ -= 3328; const int kb = r_ >> 5, nb = r_ & 31; src = wout1 + (size_t)(64 * kb) * 1024 + 32 * nb; ldw = 1024; dst = (bf16*)(ws + WS_WOO) + (size_t)(32 * nb) * 1024 + 64 * kb; } \
    } else { const int im = r_; const size_t wo = (MODE) == 3 ? 0 : (size_t)16 * 1024 * 1024; \
        const int e = im / 1536, rem = im % 1536, which = rem >> 9, item = rem & 511, kb = item >> 5, nb = item & 31; \
        const float* W = (which == 0 ? mg : which == 1 ? mu : md) + wo; \
        src = W + ((size_t)e * 1024 + 64 * kb) * 1024 + 32 * nb; ldw = 1024; \
        unsigned char* W13 = ws + ((MODE) == 3 ? WS_MOE0_13 : WS_MOE1_13); unsigned char* W2 = ws + ((MODE) == 3 ? WS_MOE0_2 : WS_MOE1_2);     \
        dst = (bf16*)(which < 2 ? W13 + ((size_t)e * 2048 + (nb >> 2) * 256 + which * 128 + (nb & 3) * 32) * 1024 + 64 * kb : W2 + ((size_t)e * 1024 + 32 * nb) * 1024 + 64 * kb); } } while (0)
template <int MODE> __device__ __forceinline__ void conv_loop(const float* win, const float* wout0, const float* wqkv, const float* wout1, const float* mg, const float* mu, const float* md,
                                                            unsigned char* ws, int first, int stride, LAS float* scr, int lane) {
    const int total = MODE == 0 ? CONV_ND : CONV_NM; int it = first; if (it >= total) return;
    f32x4 r0[8], r1[8], r2[8], r3[8]; const float* s_; int ldw; bf16 *d0, *d1, *d2, *d3;
#define CONV_ISSUE(R, D, idx) do { if ((idx) < total) { CONV_DESC(MODE, (idx), s_, ldw, D); titem_load(s_, ldw, R, lane); } } while (0)
#define CONV_FIN(R, D) do { if constexpr (MODE == 0) titem_finish(R, D, scr, lane); else titem_finish8(R, (unsigned char*)D, scr, lane); } while (0)
    CONV_ISSUE(r0, d0, it); CONV_ISSUE(r1, d1, it + stride); CONV_ISSUE(r2, d2, it + 2 * stride);
    for (;;) {
        CONV_ISSUE(r3, d3, it + 3 * stride); CONV_FIN(r0, d0); if (it + stride >= total) break;
        CONV_ISSUE(r0, d0, it + 4 * stride); CONV_FIN(r1, d1); if (it + 2 * stride >= total) break;
        CONV_ISSUE(r1, d1, it + 5 * stride); CONV_FIN(r2, d2); if (it + 3 * stride >= total) break;
        CONV_ISSUE(r2, d2, it + 6 * stride); CONV_FIN(r3, d3); if (it + 4 * stride >= total) break;
        it += 4 * stride;
    }
#undef CONV_ISSUE
#undef CONV_FIN
}

__device__ __forceinline__ void normmod_row(f32x4 (&v)[4], const float* g, const float* sc, const float* sh, int lane) {
    float s2 = 0.f;
#pragma unroll
    for (int j = 0; j < 4; ++j) s2 += (v[j].x * v[j].x + v[j].y * v[j].y) + (v[j].z * v[j].z + v[j].w * v[j].w);
    const float rstd = __builtin_amdgcn_rsqf(wave_sum(s2) * (1.f / 1024.f) + EPS_);
#pragma unroll
    for (int j = 0; j < 4; ++j) { const f32x4 gv = *((const f32x4*)g + 64 * j + lane), scv = *((const f32x4*)sc + 64 * j + lane), shv = *((const f32x4*)sh + 64 * j + lane);
        v[j] = v[j] * rstd * gv * (1.f + scv) + shv; }
}
__device__ __forceinline__ void store_row_bf16(const f32x4 (&v)[4], bf16* orow, int lane) {
    GAS unsigned long long* o8 = (GAS unsigned long long*)orow + lane;
#pragma unroll
    for (int j = 0; j < 4; ++j) o8[64 * j] = (unsigned long long)pk2(v[j].x, v[j].y) | ((unsigned long long)pk2(v[j].z, v[j].w) << 32);
}
__device__ __forceinline__ void load_row_b16(f32x4 (&v)[4], const bf16* xrow, int lane) {
    const u32x2f* xr = (const u32x2f*)xrow + lane;
#pragma unroll
    for (int j = 0; j < 4; ++j) { const u32x2f w = xr[64 * j]; v[j].x = __uint_as_float(w.x << 16); v[j].y = __uint_as_float(w.x & 0xffff0000u); v[j].z = __uint_as_float(w.y << 16); v[j].w = __uint_as_float(w.y & 0xffff0000u); }
}
__device__ __forceinline__ void load_row_f32(f32x4 (&v)[4], const float* xrow, int lane) {
    const f32x4* xr = (const f32x4*)xrow + lane;
#pragma unroll
    for (int j = 0; j < 4; ++j) v[j] = xr[64 * j];
}
__device__ __forceinline__ void add_moe_rows(f32x4 (&v)[4], const bf16* y0, const bf16* y1, const float* gate, int lane) {
#pragma unroll
    for (int j = 0; j < 4; ++j) { const u32x2f a = *((const u32x2f*)y0 + 64 * j + lane), b = *((const u32x2f*)y1 + 64 * j + lane); const f32x4 gv = *((const f32x4*)gate + 64 * j + lane);
        f32x4 f; f.x = __uint_as_float(a.x << 16) + __uint_as_float(b.x << 16); f.y = __uint_as_float(a.x & 0xffff0000u) + __uint_as_float(b.x & 0xffff0000u);
        f.z = __uint_as_float(a.y << 16) + __uint_as_float(b.y << 16); f.w = __uint_as_float(a.y & 0xffff0000u) + __uint_as_float(b.y & 0xffff0000u);
        v[j] = v[j] + gv * f; }
}

typedef float f32x2g __attribute__((ext_vector_type(2)));
typedef float f32x4g __attribute__((ext_vector_type(4)));
constexpr int HG_QI = 0, HG_QN = 17408, HG_KO = 34816, HG_VT = 52224, HG_SC = 70656, HG_ST = 79872, HG_SCR = 114688;
constexpr int HG_LDQ = 272, HG_LDT = 144;
typedef short hbf16x8 __attribute__((ext_vector_type(8)));
typedef float hf32x4 __attribute__((ext_vector_type(4)));
__device__ __forceinline__ int hg_chunk(int dir, int j) { return dir == 0 ? j : (j < 4 ? 3 - j : 135 - j); }
__device__ __forceinline__ void hg_scan(int dir, int dk, int tq, LAS float* scr, const float (&v)[16], float (&cum)[16], float& tot, float& ref) {
    float c[16]; float run = 0.f;
#pragma unroll
    for (int i = 0; i < 16; ++i) { run += v[i]; c[i] = run; }
    scr[tq * 128 + dk] = run;
    __syncthreads();
    const float q0 = scr[dk], q1 = scr[128 + dk], q2 = scr[256 + dk], q3 = scr[384 + dk];
    tot = (q0 + q1) + (q2 + q3);
    if (dir == 0) { const float off = (tq > 0 ? q0 : 0.f) + (tq > 1 ? q1 : 0.f) + (tq > 2 ? q2 : 0.f);
#pragma unroll
        for (int i = 0; i < 16; ++i) cum[i] = c[i] + off;
        ref = q0 + q1; }
    else { const float off = (tq < 3 ? q3 : 0.f) + (tq < 2 ? q2 : 0.f) + (tq < 1 ? q1 : 0.f);
#pragma unroll
        for (int i = 0; i < 16; ++i) cum[i] = (run - c[i] + v[i]) + off;
        ref = q2 + q3; }
    __syncthreads();
}
__device__ __forceinline__ void hg_ld16(const unsigned short* p, int tid, unsigned (&w)[8]) {
    const int c = tid & 127, tq = tid >> 7;
#pragma unroll
    for (int i = 0; i < 8; ++i) { const unsigned lo = p[(size_t)(16 * tq + 2 * i) * 512 + c], hi = p[(size_t)(16 * tq + 2 * i + 1) * 512 + c]; w[i] = lo | (hi << 16); }
}
__device__ __forceinline__ float h2f(unsigned short h) { return (float)__builtin_bit_cast(_Float16, h); }
__device__ __forceinline__ void hg_store_vt(const unsigned (&w)[8], LAS unsigned char* L, int tid) {
    const int dv = tid & 127, tq = tid >> 7;
    LAS v4u* d = (LAS v4u*)(L + HG_VT + dv * HG_LDT + tq * 32);
    d[0] = (v4u){w[0], w[1], w[2], w[3]}; d[1] = (v4u){w[4], w[5], w[6], w[7]};
}
__device__ __forceinline__ void hgrn_pass1(int first, int stride, int total, const _Float16* LFF, const _Float16* LFB, const bf16* IV, unsigned char* U, float* TOT, LAS unsigned char* L, int tid, int wave, int lane) {
    const int dk = tid & 127, tq = tid >> 7, fr = lane & 15, fq = lane >> 4;
    unsigned nlf[8], niv[8];
#define HG1_LOAD(u_) do { const int j_ = (u_) % NCHUNK, sq_ = (u_) / NCHUNK, dir_ = sq_ >> 3, b_ = (sq_ >> 2) & 1, h_ = sq_ & 3; const size_t r0_ = (size_t)b_ * SB + 64 * j_; \
        hg_ld16((const unsigned short*)((dir_ ? LFB : LFF) + r0_ * 512 + h_ * 128), tid, nlf); hg_ld16(IV + r0_ * 512 + h_ * 128, tid, niv); } while (0)
    if (first < total) HG1_LOAD(first);
    for (int u = first; u < total; u += stride) {
        const int j = u % NCHUNK, sq = u / NCHUNK, dir = sq >> 3;
        const int n = hg_chunk(dir, j);
        float v[16]; unsigned iv[8];
#pragma unroll
        for (int i = 0; i < 8; ++i) { v[2 * i] = h2f((unsigned short)(nlf[i] & 0xffffu)); v[2 * i + 1] = h2f((unsigned short)(nlf[i] >> 16)); iv[i] = niv[i]; }
        if (u + stride < total) HG1_LOAD(u + stride);
        float cum[16], tot, ref;
        hg_scan(dir, dk, tq, (LAS float*)(L + HG_SCR), v, cum, tot, ref);
        unsigned w[8];
#pragma unroll
        for (int i = 0; i < 8; ++i) { const float k0 = (1.f - __expf(v[2 * i])) * __expf(tot - cum[2 * i]), k1 = (1.f - __expf(v[2 * i + 1])) * __expf(tot - cum[2 * i + 1]); w[i] = pk2(k0, k1); }
        { LAS v4u* d = (LAS v4u*)(L + HG_QI + dk * HG_LDT + tq * 32); d[0] = (v4u){w[0], w[1], w[2], w[3]}; d[1] = (v4u){w[4], w[5], w[6], w[7]}; }
        if (tq == 0) TOT[((size_t)sq * NCHUNK + n) * 128 + dk] = tot;
        hg_store_vt(iv, L, tid);
        __syncthreads();
        hf32x4 acc[8];
#pragma unroll
        for (int nt = 0; nt < 8; ++nt) acc[nt] = (hf32x4){0.f, 0.f, 0.f, 0.f};
#pragma unroll
        for (int kk = 0; kk < 2; ++kk) { const hbf16x8 A = *(const LAS hbf16x8*)(L + HG_QI + (16 * wave + fr) * HG_LDT + kk * 64 + fq * 16);
#pragma unroll
            for (int nt = 0; nt < 8; ++nt) { const hbf16x8 B = *(const LAS hbf16x8*)(L + HG_VT + (16 * nt + fr) * HG_LDT + kk * 64 + fq * 16);
                acc[nt] = __builtin_amdgcn_mfma_f32_16x16x32_bf16(A, B, acc[nt], 0, 0, 0); } }
        unsigned char* up = U + ((size_t)sq * NCHUNK + n) * 16384 + 16 * wave + 4 * fq;
#pragma unroll
        for (int nt = 0; nt < 8; ++nt) *(unsigned*)(up + (size_t)(16 * nt + fr) * 128) = pg8::pk4_fp8(acc[nt][0], acc[nt][1], acc[nt][2], acc[nt][3]);
        __syncthreads();
    }
#undef HG1_LOAD
}
__device__ __forceinline__ void hgrn_pass2(const unsigned char* U, const float* TOT, unsigned char* S, int gtid, int nthreads) {
    for (int idx = gtid; idx < 16 * 4096; idx += nthreads) {
        const int sq = idx >> 12, p = idx & 4095;
        const unsigned* up = (const unsigned*)(U + (size_t)sq * NCHUNK * 16384) + p; unsigned* sp = (unsigned*)(S + (size_t)sq * NCHUNK * 16384) + p;
        const f32x4g* tp = (const f32x4g*)(TOT + (size_t)sq * NCHUNK * 128) + (p & 31);
        float s0 = 0.f, s1 = 0.f, s2 = 0.f, s3 = 0.f;
        for (int n = 0; n < NCHUNK; n += 22) {
            unsigned uu[22]; f32x4g tt[22];
#pragma unroll
            for (int k = 0; k < 22; ++k) { uu[k] = up[(size_t)(n + k) * 4096]; tt[k] = tp[(size_t)(n + k) * 32]; }
#pragma unroll
            for (int k = 0; k < 22; ++k) { sp[(size_t)(n + k) * 4096] = pg8::pk4_fp8(s0, s1, s2, s3);
                const f32x2g lo = __builtin_amdgcn_cvt_pk_f32_fp8((int)uu[k], false), hi = __builtin_amdgcn_cvt_pk_f32_fp8((int)uu[k], true);
                s0 = __expf(tt[k].x) * s0 + lo.x; s1 = __expf(tt[k].y) * s1 + lo.y; s2 = __expf(tt[k].z) * s2 + hi.x; s3 = __expf(tt[k].w) * s3 + hi.y; }
        }
    }
}
__device__ __forceinline__ void hg3_dir(int dir, const float (&v)[16], const float (&qv)[16], const v4u (&st)[2], hf32x4 (&acc)[4], LAS unsigned char* L, int tid, int wave, int lane) {
    const int dk = tid & 127, tq = tid >> 7, fr = lane & 15, fq = lane >> 4, mt_o = wave & 3, ntb = 4 * (wave >> 2);
    float cum[16], tot, ref;
    hg_scan(dir, dk, tq, (LAS float*)(L + HG_SCR), v, cum, tot, ref);
#pragma unroll
    for (int i = 0; i < 16; ++i) { const int t = 16 * tq + i;
        const float qi = qv[i] * __expf(cum[i] - ref), qn = qv[i] * __expf(cum[i]), ko = (1.f - __expf(v[i])) * __expf(ref - cum[i]);
        *(LAS unsigned short*)(L + HG_QI + t * HG_LDQ + dk * 2) = (unsigned short)f2bf(qi);
        *(LAS unsigned short*)(L + HG_QN + t * HG_LDQ + dk * 2) = (unsigned short)f2bf(qn);
        *(LAS unsigned short*)(L + HG_KO + t * HG_LDQ + dk * 2) = (unsigned short)f2bf(ko); }
    { LAS v4u* d = (LAS v4u*)(L + HG_ST + (tid >> 2) * HG_LDQ + (tid & 3) * 64);
#pragma unroll
        for (int k = 0; k < 4; ++k) { unsigned w[4];
#pragma unroll
            for (int c = 0; c < 2; ++c) { const int x = (int)st[k >> 1][2 * (k & 1) + c]; const f32x2g lo = __builtin_amdgcn_cvt_pk_f32_fp8(x, false), hi = __builtin_amdgcn_cvt_pk_f32_fp8(x, true);
                w[2 * c] = pk2(lo.x, lo.y); w[2 * c + 1] = pk2(hi.x, hi.y); }
            d[k] = (v4u){w[0], w[1], w[2], w[3]}; } }
    __syncthreads();
    {
        const int mt = wave >> 1;
#pragma unroll
        for (int n2 = 0; n2 < 2; ++n2) { const int nt = 2 * (wave & 1) + n2; hf32x4 sc = {0.f, 0.f, 0.f, 0.f};
#pragma unroll
            for (int kk = 0; kk < 4; ++kk) { const hbf16x8 A = *(const LAS hbf16x8*)(L + HG_QI + (16 * mt + fr) * HG_LDQ + kk * 64 + fq * 16);
                const hbf16x8 B = *(const LAS hbf16x8*)(L + HG_KO + (16 * nt + fr) * HG_LDQ + kk * 64 + fq * 16);
                sc = __builtin_amdgcn_mfma_f32_16x16x32_bf16(A, B, sc, 0, 0, 0); }
#pragma unroll
            for (int r = 0; r < 4; ++r) { const int t = 16 * mt + 4 * fq + r, s_ = 16 * nt + fr; const bool keep = dir ? (s_ >= t) : (s_ <= t);
                *(LAS unsigned short*)(L + HG_SC + t * HG_LDT + s_ * 2) = (unsigned short)f2bf(keep ? sc[r] : 0.f); } }
    }
    __syncthreads();
#pragma unroll
    for (int nt = 0; nt < 4; ++nt) {
#pragma unroll
        for (int kk = 0; kk < 2; ++kk) { const hbf16x8 A = *(const LAS hbf16x8*)(L + HG_SC + (16 * mt_o + fr) * HG_LDT + kk * 64 + fq * 16);
            const hbf16x8 B = *(const LAS hbf16x8*)(L + HG_VT + (16 * (ntb + nt) + fr) * HG_LDT + kk * 64 + fq * 16);
            acc[nt] = __builtin_amdgcn_mfma_f32_16x16x32_bf16(A, B, acc[nt], 0, 0, 0); }
#pragma unroll
        for (int kk = 0; kk < 4; ++kk) { const hbf16x8 A = *(const LAS hbf16x8*)(L + HG_QN + (16 * mt_o + fr) * HG_LDQ + kk * 64 + fq * 16);
            const hbf16x8 B = *(const LAS hbf16x8*)(L + HG_ST + (16 * (ntb + nt) + fr) * HG_LDQ + kk * 64 + fq * 16);
            acc[nt] = __builtin_amdgcn_mfma_f32_16x16x32_bf16(A, B, acc[nt], 0, 0, 0); }
    }
    __syncthreads();
}
__device__ __forceinline__ void hgrn_pass3_unit(int u, const bf16* QH, const _Float16* LFF, const _Float16* LFB, const bf16* IV, const bf16* GG, const unsigned char* S, const float* onorm_g, bf16* Y,
                                                LAS unsigned char* L, int tid, int wave, int lane) {
    const int j = u % NCHUNK, bh = u / NCHUNK, b = bh >> 2, h = bh & 3;
    const size_t row0 = (size_t)b * SB + 64 * j;
    const int fr = lane & 15, fq = lane >> 4;
    unsigned wf[8], wb[8], wq[8], wi[8]; v4u stf[2], stb[2];
    hg_ld16((const unsigned short*)(LFF + row0 * 512 + h * 128), tid, wf); hg_ld16((const unsigned short*)(LFB + row0 * 512 + h * 128), tid, wb);
    hg_ld16(QH + row0 * 512 + h * 128, tid, wq); hg_ld16(IV + row0 * 512 + h * 128, tid, wi);
    { const unsigned char* sp = S + ((size_t)bh * NCHUNK + hg_chunk(0, j)) * 16384 + (tid >> 2) * 128 + (tid & 3) * 32; const unsigned char* sq_ = S + ((size_t)(8 + bh) * NCHUNK + hg_chunk(1, j)) * 16384 + (tid >> 2) * 128 + (tid & 3) * 32;
#pragma unroll
        for (int k = 0; k < 2; ++k) { stf[k] = *((const GAS v4u*)sp + k); stb[k] = *((const GAS v4u*)sq_ + k); } }
    hg_store_vt(wi, L, tid);
    float vf[16], vb[16], qv[16];
#pragma unroll
    for (int i = 0; i < 8; ++i) { vf[2 * i] = h2f((unsigned short)(wf[i] & 0xffffu)); vf[2 * i + 1] = h2f((unsigned short)(wf[i] >> 16)); vb[2 * i] = h2f((unsigned short)(wb[i] & 0xffffu)); vb[2 * i + 1] = h2f((unsigned short)(wb[i] >> 16));
        qv[2 * i] = __uint_as_float(wq[i] << 16); qv[2 * i + 1] = __uint_as_float(wq[i] & 0xffff0000u); }
    hf32x4 acc[4];
#pragma unroll
    for (int nt = 0; nt < 4; ++nt) acc[nt] = (hf32x4){0.f, 0.f, 0.f, 0.f};
    const int mt_o = wave & 3, ntb = 4 * (wave >> 2);
    hg3_dir(0, vf, qv, stf, acc, L, tid, wave, lane);
    hg3_dir(1, vb, qv, stb, acc, L, tid, wave, lane);
    LAS float* red = (LAS float*)(L + HG_SCR);
    float ss[4];
#pragma unroll
    for (int r = 0; r < 4; ++r) { float s = 0.f;
#pragma unroll
        for (int nt = 0; nt < 4; ++nt) s += acc[nt][r] * acc[nt][r];
        s += dpp_f<0xB1>(s); s += dpp_f<0x4E>(s); s += dpp_f<0x141>(s); s += dpp_f<0x140>(s); ss[r] = s; }
    if (fr == 0) {
#pragma unroll
        for (int r = 0; r < 4; ++r) red[(wave >> 2) * 64 + 16 * mt_o + 4 * fq + r] = ss[r]; }
    __syncthreads();
#pragma unroll
    for (int r = 0; r < 4; ++r) { const int t = 16 * mt_o + 4 * fq + r; const float rstd = __builtin_amdgcn_rsqf((red[t] + red[64 + t]) * (1.f / 128.f) + EPS_);
#pragma unroll
        for (int nt = 0; nt < 4; ++nt) { const int dv = 16 * (ntb + nt) + fr; const float gg = bf2f(GG[(row0 + t) * 512 + h * 128 + dv]);
            Y[(row0 + t) * 1024 + h * 128 + dv] = (bf16)f2bf(acc[nt][r] * rstd * onorm_g[dv] * gg); } }
    __syncthreads();
}

#ifndef TS_PHASE
#define TS_PHASE (-1)
#endif
struct KArgs { const float* in[23]; float* out; unsigned char* ws; int ph_lo, ph_hi, use_cg, pad; };
constexpr int N_PHASES = 21;
enum { I_X = 0, I_C, I_CTX, I_CCTX, I_ADAW, I_ADAB, I_NMIX, I_NFFN, I_EWIN, I_EWOUT, I_LBL, I_ONORM, I_DLAM, I_SUBLN, I_OWQKV, I_OWOUT, I_SINK, I_RW, I_RB, I_MG, I_MU, I_MD, I_FNG };

__device__ __forceinline__ float xreduce16(const float (&a)[16], int lane) {
    const bool b3 = (lane & 8) != 0, b2 = (lane & 4) != 0;
    float b[8], c[4], d[2];
#pragma unroll
    for (int e = 0; e < 8; ++e) b[e] = swap32_sum(a[e], a[e + 8]);
#pragma unroll
    for (int e = 0; e < 4; ++e) c[e] = swap16_sum(b[e], b[e + 4]);
#pragma unroll
    for (int e = 0; e < 2; ++e) { const float keep = b3 ? c[e + 2] : c[e], send = b3 ? c[e] : c[e + 2]; d[e] = keep + dpp_f<0x140>(send); }
    float x; { const float keep = b2 ? d[1] : d[0], send = b2 ? d[0] : d[1]; x = keep + dpp_f<0x141>(send); }
    x += dpp_f<0x4E>(x); x += dpp_f<0xB1>(x);
    return x;
}
__device__ __forceinline__ void load_row_raw(u32x2f (&w)[4], const bf16* xrow, int lane) {
    const u32x2f* xr = (const u32x2f*)xrow + lane;
#pragma unroll
    for (int j = 0; j < 4; ++j) w[j] = xr[64 * j];
}
__device__ __forceinline__ void raw_to_f32(f32x4 (&v)[4], const u32x2f (&w)[4]) {
#pragma unroll
    for (int j = 0; j < 4; ++j) { v[j].x = __uint_as_float(w[j].x << 16); v[j].y = __uint_as_float(w[j].x & 0xffff0000u); v[j].z = __uint_as_float(w[j].y << 16); v[j].w = __uint_as_float(w[j].y & 0xffff0000u); }
}
__device__ __forceinline__ void router_phase(const bf16* X, const float* gffn, const float* MODL, const float* rw, const float* rb, bf16* H2, int* EXPID, float* EXPW, int* RANK, int* CNT,
                                             bool latent_only, LAS unsigned char* L, int tid, int wave, int lane) {
    LAS float* rwT = (LAS float*)L;
    LAS int* cnt = (LAS int*)(L + 16 * 1028 * 4);
    LAS float* LG = (LAS float*)(L + 16 * 1028 * 4 + 64);
    for (int i = tid; i < 16384; i += 512) rwT[(i & 15) * 1028 + (i >> 4)] = rw[i];
    if (tid < 16) cnt[tid] = 0;
    __syncthreads();
    const int base = blockIdx.x * 66;
    u32x2f n0[4], n1[4];
    load_row_raw(n0, X + (size_t)(base + wave) * 1024, lane); load_row_raw(n1, X + (size_t)(base + wave + 8) * 1024, lane);
    for (int rr = wave; rr < 66; rr += 16) {
        f32x4 v0[4], v1[4]; raw_to_f32(v0, n0); raw_to_f32(v1, n1);
        if (rr + 16 < 66) load_row_raw(n0, X + (size_t)(base + rr + 16) * 1024, lane);
        if (rr + 24 < 66) load_row_raw(n1, X + (size_t)(base + rr + 24) * 1024, lane);
        const int r0 = base + rr, r1 = r0 + 8, b0 = r0 / SB, s0 = r0 % SB, b1 = r1 / SB, s1 = r1 % SB;
        const bool do0 = !(latent_only && s0 < 256), do1 = (rr + 8 < 66) && !(latent_only && s1 < 256);
        if (!do0 && !do1) continue;
        if (do0) { const float* mp = MODL + (s0 < 256 ? 2 : b0) * 6144; normmod_row(v0, gffn, mp + 4096, mp + 3072, lane);
            GAS unsigned* o4 = (GAS unsigned*)((unsigned char*)H2 + (size_t)r0 * 1024) + lane;
#pragma unroll
            for (int j = 0; j < 4; ++j) o4[64 * j] = pg8::pk4_fp8(v0[j].x, v0[j].y, v0[j].z, v0[j].w); }
        if (do1) { const float* mp = MODL + (s1 < 256 ? 2 : b1) * 6144; normmod_row(v1, gffn, mp + 4096, mp + 3072, lane);
            GAS unsigned* o4 = (GAS unsigned*)((unsigned char*)H2 + (size_t)r1 * 1024) + lane;
#pragma unroll
            for (int j = 0; j < 4; ++j) o4[64 * j] = pg8::pk4_fp8(v1[j].x, v1[j].y, v1[j].z, v1[j].w); }
        float a0[16], a1[16];
#pragma unroll
        for (int e = 0; e < 16; ++e) { float x0 = 0.f, x1 = 0.f;
#pragma unroll
            for (int j = 0; j < 4; ++j) { const f32x4 w = *(const LAS f32x4*)(rwT + e * 1028 + 256 * j + 4 * lane);
                x0 += (v0[j].x * w.x + v0[j].y * w.y) + (v0[j].z * w.z + v0[j].w * w.w); x1 += (v1[j].x * w.x + v1[j].y * w.y) + (v1[j].z * w.z + v1[j].w * w.w); }
            a0[e] = x0; a1[e] = x1; }
        const float l0 = xreduce16(a0, lane), l1 = xreduce16(a1, lane);
        if ((lane & 3) == 0) { if (do0) LG[rr * 17 + (lane >> 2)] = l0; if (do1) LG[(rr + 8) * 17 + (lane >> 2)] = l1; }
    }
    __syncthreads();
    if (tid < 66) {
        const int r = base + tid, s = r % SB;
        if (!(latent_only && s < 256)) {
            float aff[16], sel[16];
#pragma unroll
            for (int e = 0; e < 16; ++e) { aff[e] = 1.f / (1.f + __expf(-LG[tid * 17 + e])); sel[e] = aff[e] + rb[e]; }
            int grp = 0; float best = -1e30f;
#pragma unroll
            for (int g = 0; g < 4; ++g) { float m1 = -1e30f, m2 = -1e30f;
#pragma unroll
                for (int k = 0; k < 4; ++k) { const float x = sel[4 * g + k]; if (x > m1) { m2 = m1; m1 = x; } else if (x > m2) m2 = x; }
                const float sc = m1 + m2; if (sc > best) { best = sc; grp = g; } }
            float s4[4], a4[4];
#pragma unroll
            for (int k = 0; k < 4; ++k) { s4[k] = grp == 0 ? sel[k] : grp == 1 ? sel[4 + k] : grp == 2 ? sel[8 + k] : sel[12 + k]; a4[k] = grp == 0 ? aff[k] : grp == 1 ? aff[4 + k] : grp == 2 ? aff[8 + k] : aff[12 + k]; }
            int i1 = 0;
#pragma unroll
            for (int k = 1; k < 4; ++k) if (s4[k] > s4[i1]) i1 = k;
            int i2 = i1 == 0 ? 1 : 0;
#pragma unroll
            for (int k = 0; k < 4; ++k) if (k != i1 && k != i2 && s4[k] > s4[i2]) i2 = k;
            const float a1 = i1 == 0 ? a4[0] : i1 == 1 ? a4[1] : i1 == 2 ? a4[2] : a4[3], a2 = i2 == 0 ? a4[0] : i2 == 1 ? a4[1] : i2 == 2 ? a4[2] : a4[3];
            const int e1 = 4 * grp + i1, e2 = 4 * grp + i2; const float inv = 1.f / (a1 + a2);
            const int r1 = __hip_atomic_fetch_add(cnt + e1, 1, __ATOMIC_RELAXED, __HIP_MEMORY_SCOPE_WORKGROUP), r2 = __hip_atomic_fetch_add(cnt + e2, 1, __ATOMIC_RELAXED, __HIP_MEMORY_SCOPE_WORKGROUP);
            EXPID[2 * r] = e1; EXPID[2 * r + 1] = e2; EXPW[2 * r] = a1 * inv; EXPW[2 * r + 1] = a2 * inv; RANK[2 * r] = r1; RANK[2 * r + 1] = r2;
        }
    }
    __syncthreads();
    if (tid < 16) CNT[blockIdx.x * 16 + tid] = cnt[tid];
    __syncthreads();
}
__device__ __forceinline__ void index_phase(const int* CNT, const int* EXPID, const float* EXPW, const int* RANK, const bf16* H2, int* TOKSLOT, float* ROWW, bf16* XS, int* META,
                                            bool latent_only, LAS unsigned char* L, int tid, int wave, int lane) {
    LAS int* part = (LAS int*)L;
    LAS int* base = part + 512;
    LAS int* pst = base + 16;
    { const int e = tid & 15, g = tid >> 4; int s = 0;
#pragma unroll
        for (int k = 0; k < 8; ++k) s += CNT[(8 * g + k) * 16 + e];
        part[g * 16 + e] = s; }
    __syncthreads();
    if (tid < 16) { const int e = tid; int tot = 0, off = 0; const int gb = blockIdx.x >> 3;
        for (int g = 0; g < 32; ++g) { const int p = part[g * 16 + e]; tot += p; if (g < gb) off += p; }
        for (int bb = gb * 8; bb < (int)blockIdx.x; ++bb) off += CNT[bb * 16 + e];
        base[e] = off; pst[e] = (tot + 255) >> 8; }
    __syncthreads();
    if (tid == 0) { int run = 0;
        for (int e = 0; e < 16; ++e) { const int nt = pst[e]; pst[e] = run * 256;
            if (blockIdx.x == 0) for (int k = 0; k < nt; ++k) META[16 + run + k] = e;
            run += nt; }
        pst[16] = run * 256; if (blockIdx.x == 0) META[0] = run; }
    __syncthreads();
    int dest = -1;
    { const int a = wave + 8 * lane, r = blockIdx.x * 66 + (a >> 1), k = a & 1;
      if (lane < 17 && a < 132 && !(latent_only && (r % SB) < 256)) { const int e = EXPID[2 * r + k]; dest = pst[e] + base[e] + RANK[2 * r + k]; TOKSLOT[2 * r + k] = dest; ROWW[dest] = EXPW[2 * r + k]; } }
    for (int i0 = 0; i0 < 20; i0 += 4) {
        v4u va[4]; int d[4];
#pragma unroll
        for (int q = 0; q < 4; ++q) { d[q] = __shfl(dest, (i0 + q) & 63); const int a = wave + 8 * (i0 + q); if (i0 + q >= 17 || a >= 132) d[q] = -1;
            if (d[q] >= 0) va[q] = *((const GAS v4u*)((const unsigned char*)H2 + (size_t)(blockIdx.x * 66 + (a >> 1)) * 1024) + lane); }
#pragma unroll
        for (int q = 0; q < 4; ++q) if (d[q] >= 0) *((GAS v4u*)((unsigned char*)XS + (size_t)d[q] * 1024) + lane) = va[q];
    }
    __syncthreads();
}

typedef const __attribute__((address_space(4))) KArgs KArgsC;
#define PROLOG \
    KArgsC* ka = ka0; asm volatile("" : "+s"(ka)); \
    unsigned char* const ws = ka->ws; \
    int tid = threadIdx.x; asm volatile("" : "+v"(tid)); \
    const int lane = tid & 63, wave = __builtin_amdgcn_readfirstlane(tid >> 6); \
    const int G = gridDim.x, bid = blockIdx.x, gw = bid * NWAVES + wave, NGW = G * NWAVES; \
    (void)lane; (void)gw; (void)NGW; (void)ws;
#define P_F32(off) ((float*)(ws + (off)))
#define P_I32(off) ((int*)(ws + (off)))
#define P_B16(off) ((bf16*)(ws + (off)))
#define P_U8(off) ((unsigned char*)(ws + (off)))
__global__ void __launch_bounds__(NWAVES * 64, 2) dit_fwd(KArgs args_by_value) {
    extern __shared__ __attribute__((aligned(16))) unsigned char lds[];
    LAS unsigned char* L = (LAS unsigned char*)lds;
    KArgsC* ka0 = (KArgsC*)__builtin_amdgcn_kernarg_segment_ptr();
    const int lo = ka0->ph_lo, hi = ka0->ph_hi;
    volatile LAS unsigned* bst = (volatile LAS unsigned*)(L + LDS_BYTES - 64);
    if (threadIdx.x < 2) bst[threadIdx.x] = 0u;
    __syncthreads();
    if (ka0->use_cg) (void)xcd_barrier_post((unsigned*)(ka0->ws + WS_CTL) + 1024, bst);
    if (TS_PHASE == 0 && blockIdx.x == 0 && threadIdx.x == 0) *(volatile LAS unsigned long long*)(L + LDS_BYTES - 32) = __builtin_amdgcn_s_memrealtime();
#define IN(k) (lo <= (k) && (k) < hi)
#ifndef REP_MASK
#define REP_MASK 0
#endif
#define PHASE(k) for (int rep_ = IN(k) ? 0 : 99; rep_ < 1 + (int)((REP_MASK >> (k)) & 1); ++rep_)
#define TS_MARK(k) do { if (TS_PHASE >= 0 && blockIdx.x == 0 && threadIdx.x == 0) { volatile LAS unsigned long long* tw_ = (volatile LAS unsigned long long*)(L + LDS_BYTES - 32); \
        if ((k) + 1 == TS_PHASE) tw_[0] = __builtin_amdgcn_s_memrealtime(); \
        if ((k) == TS_PHASE) { const unsigned long long t1_ = __builtin_amdgcn_s_memrealtime(), d_ = 4ull * (t1_ - tw_[0]); while (__builtin_amdgcn_s_memrealtime() - t1_ < d_) __builtin_amdgcn_s_sleep(8); } } } while (0)
#define SEAM(k) do { if (IN(k) && IN((k) + 1) && ka0->use_cg) { for (int sr_ = 0; sr_ < 1 + (int)((REP_MASK >> 27) & 1); ++sr_) { \
        XcdBarrier xb_; xb_.bar = (unsigned*)(ka0->ws + WS_CTL) + 1024; xb_.x = xb_xcc_id(); xb_.st = bst; xcd_barrier(xb_); } TS_MARK(k); } } while (0)
#define VCU ((G % 8 == 0) ? (bid % 8) * (G / 8) + bid / 8 : bid)

    PHASE(0) { PROLOG
        for (int r24_ = 0; r24_ < 1 + (int)((REP_MASK >> 24) & 1); ++r24_) { LAS float* scr = (LAS float*)(L + wave * 16384);
          conv_loop<0>(ka->in[I_EWIN], ka->in[I_EWOUT], ka->in[I_OWQKV], ka->in[I_OWOUT], ka->in[I_MG], ka->in[I_MU], ka->in[I_MD], ws, gw, NGW, scr, lane); }
        __syncthreads();
        for (int r25_ = 0; r25_ < 1 + (int)((REP_MASK >> 25) & 1); ++r25_) {
            const int l = bid >> 7, col0 = 48 * (bid & 127);
            LAS float* sl = (LAS float*)L;
            LAS float* red = sl + 3072;
            for (int i = tid; i < 3072; i += 512) sl[i] = silu_d(i < 2048 ? ka->in[I_C][i] : ka->in[I_CCTX][i - 2048]);
            __syncthreads();
            const int r = lane >> 4, cs = lane & 15;
            const float* aw = ka->in[I_ADAW] + ((size_t)l * 1024 + 128 * wave + r) * 6144 + col0 + 3 * cs;
            const LAS float* sp = sl + 128 * wave + r;
            float a[3][3];
#pragma unroll
            for (int v = 0; v < 3; ++v) { a[v][0] = 0.f; a[v][1] = 0.f; a[v][2] = 0.f; }
#pragma unroll 1
            for (int i0 = 0; i0 < 32; i0 += 16) { float w0[16], w1[16], w2[16];
#pragma unroll
                for (int i = 0; i < 16; ++i) { const float* p = aw + (size_t)(4 * (i0 + i)) * 6144; w0[i] = p[0]; w1[i] = p[1]; w2[i] = p[2]; }
#pragma unroll
                for (int i = 0; i < 16; ++i) {
#pragma unroll
                    for (int v = 0; v < 3; ++v) { const float sv = sp[1024 * v + 4 * (i0 + i)]; a[v][0] += sv * w0[i]; a[v][1] += sv * w1[i]; a[v][2] += sv * w2[i]; } } }
#pragma unroll
            for (int v = 0; v < 3; ++v) {
#pragma unroll
                for (int j = 0; j < 3; ++j) { float x = a[v][j]; x += __shfl_xor(x, 16); x += __shfl_xor(x, 32); a[v][j] = x; } }
            if (r == 0) {
#pragma unroll
                for (int v = 0; v < 3; ++v) { red[(wave * 3 + v) * 48 + 3 * cs] = a[v][0]; red[(wave * 3 + v) * 48 + 3 * cs + 1] = a[v][1]; red[(wave * 3 + v) * 48 + 3 * cs + 2] = a[v][2]; } }
            __syncthreads();
            if (tid < 144) { const int v = tid / 48, jj = tid % 48; float x = ka->in[I_ADAB][l * 6144 + col0 + jj];
#pragma unroll
                for (int w = 0; w < 8; ++w) x += red[(w * 3 + v) * 48 + jj];
                P_F32(WS_MOD)[(l * 3 + v) * 6144 + col0 + jj] = x; }
            __syncthreads();
        }
        if (bid == 96) {
            for (int i = tid; i < 1024; i += 512) { const float* lg = ka->in[I_LBL]; const float l0 = lg[i], l1 = lg[1024 + i], l2 = lg[2048 + i]; const float m = fmaxf(l0, fmaxf(l1, l2));
                const float e0 = expf(l0 - m), e1 = expf(l1 - m), e2 = expf(l2 - m); P_F32(WS_LB)[i] = e0 / (e0 + e1 + e2); }
            if (wave == 0) { const float* lp = ka->in[I_DLAM]; const float s0 = wave_sum(lp[lane] * lp[64 + lane]), s1 = wave_sum(lp[128 + lane] * lp[192 + lane]);
                if (lane == 0) P_F32(WS_LAM)[0] = expf(s0) - expf(s1) + 0.2f; }
        } else if (bid == 97) {
            for (int i = tid; i < 2048; i += 512) { const int pos = i >> 4, jj = i & 15; const float inv = 1.0f / powf(10000.0f, (float)(2 * jj) / 32.0f); const float ang = (float)pos * inv;
                P_F32(WS_ROPE)[2 * i] = cosf(ang); P_F32(WS_ROPE)[2 * i + 1] = sinf(ang); }
        }
    }
    SEAM(0);
    PHASE(1) { PROLOG
        for (int r = gw; r < MR; r += 2 * NGW) { const int r2 = r + NGW; const bool h2 = r2 < MR;
            const int b = r / SB, s_ = r % SB, b2 = h2 ? r2 / SB : b, s2_ = h2 ? r2 % SB : s_;
            const float* srcA = s_ < 256 ? ka->in[I_CTX] + ((size_t)b * 256 + s_) * 1024 : ka->in[I_X] + ((size_t)b * 8192 + s_ - 256) * 1024;
            const float* srcB = s2_ < 256 ? ka->in[I_CTX] + ((size_t)b2 * 256 + s2_) * 1024 : ka->in[I_X] + ((size_t)b2 * 8192 + s2_ - 256) * 1024;
            f32x4 va[4], vb[4]; load_row_f32(va, srcA, lane); load_row_f32(vb, srcB, lane);
            const float* mpA = P_F32(WS_MOD) + (s_ < 256 ? 2 : b) * 6144; const float* mpB = P_F32(WS_MOD) + (s2_ < 256 ? 2 : b2) * 6144;
            normmod_row(va, ka->in[I_NMIX], mpA + 1024, mpA, lane); store_row_bf16(va, P_B16(WS_H) + (size_t)r * 1024, lane);
            if (h2) { normmod_row(vb, ka->in[I_NMIX], mpB + 1024, mpB, lane); store_row_bf16(vb, P_B16(WS_H) + (size_t)r2 * 1024, lane); } }
    }
    SEAM(1);
    PHASE(2) { PROLOG
        pg8::Gemm g{P_B16(WS_H), P_B16(WS_WIN), MR, 4096, 1024, 0}; pg8::DenseOrder So; So.init(66, 16, G, bid, false, G == 256 ? 1 : 0);
        pg8::EpiInProj E{P_B16(WS_QH), P_B16(WS_IV), P_B16(WS_GG), P_B16(WS_DQ), P_B16(WS_DK), P_B16(WS_DV), (_Float16*)P_F32(WS_LFF), (_Float16*)P_F32(WS_LFB), P_F32(WS_LB), P_F32(WS_ROPE)};
#if (REP_MASK >> 28) & 1
        { pg8::EpiTwice<pg8::EpiInProj> E2{E}; pg8::gemm_phase<pg8::EpiTwice<pg8::EpiInProj>, pg8::DenseOrder, true, true>(L, g, So, E2); }
#else
        pg8::gemm_phase<pg8::EpiInProj, pg8::DenseOrder, true, true>(L, g, So, E);
#endif
        if (G == 256) { pg8::DenseOrder St; St.init(66, 16, G, bid, false, 2, 4); pg8::gemm_phase<pg8::EpiInProj, pg8::DenseOrder, true, true, 0x1>(L, g, St, E); }
    }
    SEAM(2);
    PHASE(3) { PROLOG hgrn_pass1(bid, G, 16 * NCHUNK, (_Float16*)P_F32(WS_LFF), (_Float16*)P_F32(WS_LFB), P_B16(WS_IV), P_U8(WS_U), P_F32(WS_TOT), L, tid, wave, lane); }
    SEAM(3);
    PHASE(4) { PROLOG if (tid < 256) hgrn_pass2(P_U8(WS_U), P_F32(WS_TOT), P_U8(WS_S), bid * 256 + tid, G * 256); }
    SEAM(4);
    PHASE(5) { PROLOG
#define CONV_L0() do { LAS float* scr_ = (LAS float*)(L + wave * 16384); conv_loop<3>(ka->in[I_EWIN], ka->in[I_EWOUT], ka->in[I_OWQKV], ka->in[I_OWOUT], ka->in[I_MG], ka->in[I_MU], ka->in[I_MD], ws, gw, NGW, scr_, lane); __syncthreads(); } while (0)
        const int cgrp_ = bid % 3;
        if (cgrp_ == 0) CONV_L0();
        for (int r4_ = 0; r4_ < 1 + (int)((REP_MASK >> 23) & 1); ++r4_) for (int u = bid; u < 8 * NCHUNK; u += G) hgrn_pass3_unit(u, P_B16(WS_QH), (_Float16*)P_F32(WS_LFF), (_Float16*)P_F32(WS_LFB), P_B16(WS_IV), P_B16(WS_GG), P_U8(WS_S), ka->in[I_ONORM], P_B16(WS_H), L, tid, wave, lane);
        typedef attn_body::bf16 abf; const int vcu_ = VCU;
        const float lam = P_F32(WS_LAM)[0]; const float* gsub = ka->in[I_SUBLN];
        if (bid >= 64 && bid < 72) {
            const int bh = bid - 64, b = bh >> 2, h = bh & 3; const size_t rb = (size_t)b * SB;
            attn_body::attn_unit128<8, 1>((const abf*)P_B16(WS_DQ) + rb * 512 + (h * 2) * 64, 512, (const abf*)P_B16(WS_DK) + rb * 512 + (h * 2) * 64, 512, (const abf*)P_B16(WS_DV) + rb * 512 + h * 128, 512,
                                          (abf*)nullptr, 0, 4, 0.f, gsub, (char*)lds);
            attn_body::attn_unit128<8, 2>((const abf*)P_B16(WS_DQ) + rb * 512 + (h * 2 + 1) * 64, 512, (const abf*)P_B16(WS_DK) + rb * 512 + (h * 2 + 1) * 64, 512, (const abf*)P_B16(WS_DV) + rb * 512 + h * 128, 512,
                                          (abf*)P_B16(WS_H) + rb * 1024 + 512 + h * 128, 1024, 4, lam, gsub, (char*)lds);
        }
        if (vcu_ < 256) {
            const int bh = vcu_ >> 5, qb = vcu_ & 31, b = bh >> 2, h = bh & 3; const size_t rb = (size_t)b * SB, rq = rb + 256 + 256 * qb;
            attn_body::attn_unit128<8, 1>((const abf*)P_B16(WS_DQ) + rq * 512 + (h * 2) * 64, 512, (const abf*)P_B16(WS_DK) + rb * 512 + (h * 2) * 64, 512, (const abf*)P_B16(WS_DV) + rb * 512 + h * 128, 512,
                                          (abf*)nullptr, 0, NCHUNK, 0.f, gsub, (char*)lds);
            if (cgrp_ == 1) { LAS float* scr_ = (LAS float*)(L + wave * 8448);
                conv_loop<3>(ka->in[I_EWIN], ka->in[I_EWOUT], ka->in[I_OWQKV], ka->in[I_OWOUT], ka->in[I_MG], ka->in[I_MU], ka->in[I_MD], ws, gw, NGW, scr_, lane); __syncthreads(); }
            attn_body::attn_unit128<8, 2>((const abf*)P_B16(WS_DQ) + rq * 512 + (h * 2 + 1) * 64, 512, (const abf*)P_B16(WS_DK) + rb * 512 + (h * 2 + 1) * 64, 512, (const abf*)P_B16(WS_DV) + rb * 512 + h * 128, 512,
                                          (abf*)P_B16(WS_H) + rq * 1024 + 512 + h * 128, 1024, NCHUNK, lam, gsub, (char*)lds);
        }
        if (cgrp_ == 2) CONV_L0();
#undef CONV_L0
    }
    SEAM(5);
    PHASE(7) { PROLOG
        pg8::Gemm g{P_B16(WS_H), P_B16(WS_WOE), MR, 1024, 1024, 0}; pg8::DenseOrder So; So.init(66, 4, G, bid, false, G == 256 ? 1 : 0);
        pg8::EpiOut0 E{ka->in[I_X], ka->in[I_CTX], P_F32(WS_MOD), P_B16(WS_X)};
        pg8::gemm_phase<pg8::EpiOut0, pg8::DenseOrder, true, true>(L, g, So, E);
        if (G == 256) { pg8::DenseOrder St; St.init(66, 4, G, bid, false, 2, 4); pg8::gemm_phase<pg8::EpiOut0, pg8::DenseOrder, true, true, 0x1>(L, g, St, E); }
    }
    SEAM(7);
#define MOE_LAYER(P, LAYER, LATENT_ONLY) \
    PHASE(P) { PROLOG router_phase(P_B16(WS_X), ka->in[I_NFFN] + (LAYER) * 1024, P_F32(WS_MOD) + (LAYER) * 3 * 6144, ka->in[I_RW], ka->in[I_RB], P_B16(WS_H), P_I32(WS_EXPID), P_F32(WS_EXPW), P_I32(WS_RANK), P_I32(WS_CNT), LATENT_ONLY, L, tid, wave, lane); } \
    SEAM(P); \
    PHASE((P) + 1) { PROLOG for (int r2_ = 0; r2_ < 1 + (int)((REP_MASK >> 21) & 1); ++r2_) index_phase(P_I32(WS_CNT), P_I32(WS_EXPID), P_F32(WS_EXPW), P_I32(WS_RANK), P_B16(WS_H), P_I32(WS_TOKSLOT), P_F32(WS_ROWW), P_B16(WS_XS), P_I32(WS_META), LATENT_ONLY, L, tid, wave, lane); \
        } \
    SEAM((P) + 1); \
    PHASE((P) + 2) { PROLOG const int ntile = __builtin_amdgcn_readfirstlane(P_I32(WS_META)[0]); \
        LAS int* te_ = (LAS int*)(L + 131072); for (int i_ = tid; i_ < ntile; i_ += 512) te_[i_] = P_I32(WS_META)[16 + i_]; __syncthreads(); \
        pg8::Gemm g{P_B16(WS_XS), (const bf16*)(ws + ((LAYER) == 0 ? WS_MOE0_13 : WS_MOE1_13)), ntile * 256, 2048, 512  , (size_t)2048 * 1024}; const int rem_ = (ntile * 8) % G; const bool split_ = rem_ > 0 && 2 * rem_ <= G; \
        pg8::MoeOrder So; So.init(ntile, 8, G, bid, te_, split_ ? 1 : 0); \
        pg8::EpiGateUp8 E{(unsigned char*)P_B16(WS_HID)}; pg8::gemm_phase<pg8::EpiGateUp8, pg8::MoeOrder, true, true, 0xF, true>(L, g, So, E); \
        if (split_) { pg8::MoeOrder St; St.init(ntile, 8, G, bid, te_, 2, 2); pg8::gemm_phase<pg8::EpiGateUp8, pg8::MoeOrder, true, true, 0x3, true>(L, g, St, E); } \
        } \
    SEAM((P) + 2); \
    PHASE((P) + 3) { PROLOG const int ntile = __builtin_amdgcn_readfirstlane(P_I32(WS_META)[0]); \
        LAS int* te_ = (LAS int*)(L + 131072); for (int i_ = tid; i_ < ntile; i_ += 512) te_[i_] = P_I32(WS_META)[16 + i_]; __syncthreads(); \
        pg8::Gemm g{P_B16(WS_HID), (const bf16*)(ws + ((LAYER) == 0 ? WS_MOE0_2 : WS_MOE1_2)), ntile * 256, 1024, 512  , (size_t)1024 * 1024}; const int rem_ = (ntile * 4) % G; const bool split_ = rem_ > 0 && 4 * rem_ <= G; \
        pg8::MoeOrder So; So.init(ntile, 4, G, bid, te_, split_ ? 1 : 0); \
        pg8::EpiDown8 E{P_B16(WS_XS), P_F32(WS_ROWW)}; pg8::gemm_phase<pg8::EpiDown8, pg8::MoeOrder, true, true, 0xF, true>(L, g, So, E); \
        if (split_) { pg8::MoeOrder St; St.init(ntile, 4, G, bid, te_, 2, 4); pg8::gemm_phase<pg8::EpiDown8, pg8::MoeOrder, true, true, 0x1, true>(L, g, St, E); } } \
    SEAM((P) + 3);
    MOE_LAYER(8, 0, false)
    PHASE(12) { PROLOG
        for (int r = gw; r < MR; r += 2 * NGW) { const int r2 = r + NGW; const bool h2 = r2 < MR; const int rb_ = h2 ? r2 : r;
            const int sa0 = P_I32(WS_TOKSLOT)[2 * r], sa1 = P_I32(WS_TOKSLOT)[2 * r + 1], sb0 = P_I32(WS_TOKSLOT)[2 * rb_], sb1 = P_I32(WS_TOKSLOT)[2 * rb_ + 1];
            const int vecA = (r % SB) < 256 ? 2 : r / SB, vecB = (rb_ % SB) < 256 ? 2 : rb_ / SB;
            f32x4 va[4], vb[4]; load_row_b16(va, P_B16(WS_X) + (size_t)r * 1024, lane); load_row_b16(vb, P_B16(WS_X) + (size_t)rb_ * 1024, lane);
            add_moe_rows(va, P_B16(WS_XS) + (size_t)sa0 * 1024, P_B16(WS_XS) + (size_t)sa1 * 1024, P_F32(WS_MOD) + vecA * 6144 + 5120, lane);
            add_moe_rows(vb, P_B16(WS_XS) + (size_t)sb0 * 1024, P_B16(WS_XS) + (size_t)sb1 * 1024, P_F32(WS_MOD) + vecB * 6144 + 5120, lane);
            { store_row_bf16(va, P_B16(WS_X) + (size_t)r * 1024, lane);
              const float* mp = P_F32(WS_MOD) + (3 + vecA) * 6144; normmod_row(va, ka->in[I_NMIX] + 1024, mp + 1024, mp, lane); store_row_bf16(va, P_B16(WS_H) + (size_t)r * 1024, lane); }
            if (h2) { store_row_bf16(vb, P_B16(WS_X) + (size_t)r2 * 1024, lane);
              const float* mp = P_F32(WS_MOD) + (3 + vecB) * 6144; normmod_row(vb, ka->in[I_NMIX] + 1024, mp + 1024, mp, lane); store_row_bf16(vb, P_B16(WS_H) + (size_t)r2 * 1024, lane); } }
    }
    SEAM(12);
    PHASE(13) { PROLOG
        pg8::Gemm g{P_B16(WS_H), P_B16(WS_WQKV), MR, 1536, 1024, 0}; pg8::DenseOrder So; So.init(66, 6, G, bid, false);
        pg8::EpiQKV1 E{P_B16(WS_Q1), P_B16(WS_K1), P_B16(WS_V1), P_F32(WS_ROPE)};
        pg8::gemm_phase<pg8::EpiQKV1, pg8::DenseOrder, true, true>(L, g, So, E);
    }
    SEAM(13);
    PHASE(14) { PROLOG
#define CONV_L1() do { __syncthreads(); LAS float* scr_ = (LAS float*)(L + wave * 16384); conv_loop<1>(ka->in[I_EWIN], ka->in[I_EWOUT], ka->in[I_OWQKV], ka->in[I_OWOUT], ka->in[I_MG], ka->in[I_MU], ka->in[I_MD], ws, gw, NGW, scr_, lane); __syncthreads(); } while (0)
#define SWA_UNITS(i0) do { typedef attn_body::bf16 abf; const int vcu_ = VCU; for (int i = (i0); i < (i0) + 2; ++i) { const int combo = vcu_ >> 5, qb = 4 * (vcu_ & 31) + i; if (combo >= 8) break; \
            const int b = combo >> 2, kvh = combo & 3; const size_t rb = (size_t)b * SB, rq = rb + 256 + 64 * qb; \
            attn_body::attn_unit<8, 1>((const abf*)P_B16(WS_Q1) + rq * 1024 + kvh * 256, 1024, (const abf*)P_B16(WS_K1) + rb * 256 + kvh * 64, 256, (const abf*)P_B16(WS_V1) + rb * 256 + kvh * 64, 256, \
                                       (abf*)P_B16(WS_H) + rq * 1024 + kvh * 256, 1024, 9, 64 * qb, ka->in[I_SINK] + 4 * kvh, (char*)lds); } } while (0)
        const int turn_ = bid % 3;
        if (turn_ == 0) CONV_L1();
        SWA_UNITS(0);
        if (turn_ == 1) CONV_L1();
        SWA_UNITS(2);
        if (turn_ == 2) CONV_L1();
#undef SWA_UNITS
#undef CONV_L1
    }
    SEAM(14);
    PHASE(15) { PROLOG
        pg8::Gemm g{P_B16(WS_H), P_B16(WS_WOO), MR, 1024, 1024, 0}; pg8::DenseOrder So; So.init(64, 4, G, bid, true);
        pg8::EpiOut1 E{P_F32(WS_MOD) + 3 * 6144, P_B16(WS_X)};
        pg8::gemm_phase<pg8::EpiOut1, pg8::DenseOrder, true, true>(L, g, So, E);
    }
    SEAM(15);
    MOE_LAYER(16, 1, true)
    PHASE(20) { PROLOG
        for (int t = gw; t < NBATCH * TLAT; t += 2 * NGW) { const int t2 = (t + NGW < NBATCH * TLAT) ? t + NGW : t; const bool h2 = t2 != t;
            const size_t rA = (size_t)(t >> 13) * SB + 256 + (t & 8191), rB = (size_t)(t2 >> 13) * SB + 256 + (t2 & 8191);
            const int sa0 = P_I32(WS_TOKSLOT)[2 * rA], sa1 = P_I32(WS_TOKSLOT)[2 * rA + 1], sb0 = P_I32(WS_TOKSLOT)[2 * rB], sb1 = P_I32(WS_TOKSLOT)[2 * rB + 1];
            f32x4 va[4], vb[4]; load_row_b16(va, P_B16(WS_X) + rA * 1024, lane); load_row_b16(vb, P_B16(WS_X) + rB * 1024, lane);
            add_moe_rows(va, P_B16(WS_XS) + (size_t)sa0 * 1024, P_B16(WS_XS) + (size_t)sa1 * 1024, P_F32(WS_MOD) + (3 + (t >> 13)) * 6144 + 5120, lane);
            add_moe_rows(vb, P_B16(WS_XS) + (size_t)sb0 * 1024, P_B16(WS_XS) + (size_t)sb1 * 1024, P_F32(WS_MOD) + (3 + (t2 >> 13)) * 6144 + 5120, lane);
            float s2a = 0.f, s2b = 0.f;
#pragma unroll
            for (int j = 0; j < 4; ++j) { s2a += (va[j].x * va[j].x + va[j].y * va[j].y) + (va[j].z * va[j].z + va[j].w * va[j].w); s2b += (vb[j].x * vb[j].x + vb[j].y * vb[j].y) + (vb[j].z * vb[j].z + vb[j].w * vb[j].w); }
            const float rsa = __builtin_amdgcn_rsqf(wave_sum(s2a) * (1.f / 1024.f) + EPS_), rsb = __builtin_amdgcn_rsqf(wave_sum(s2b) * (1.f / 1024.f) + EPS_);
            f32x4* oa = (f32x4*)(ka->out + (size_t)t * 1024) + lane; f32x4* ob = (f32x4*)(ka->out + (size_t)t2 * 1024) + lane;
#pragma unroll
            for (int j = 0; j < 4; ++j) { const f32x4 g = *((const f32x4*)ka->in[I_FNG] + 64 * j + lane); oa[64 * j] = va[j] * rsa * g; if (h2) ob[64 * j] = vb[j] * rsb * g; } }
    }
#undef IN
#undef SEAM
#undef MOE_LAYER
}

#ifndef N_LAUNCHES
#define N_LAUNCHES 1
#endif
extern "C" void kernel_launch(void* const* d_in, const int* in_sizes, int n_in, void* d_out, int out_size, void* d_ws, size_t ws_size, hipStream_t stream) {
    static int grid = 0;
    if (grid == 0) {
        if (n_in != 23 || ws_size < WS_NEED) { fprintf(stderr, "kernel_launch: expected 23 inputs and >= %zu bytes of workspace (got %d, %zu)\n", (size_t)WS_NEED, n_in, ws_size); grid = -1; return; }
        int dev = 0, cus = 0, per_cu = 0;
        hipGetDevice(&dev); hipDeviceGetAttribute(&cus, hipDeviceAttributeMultiprocessorCount, dev);
        if (hipFuncSetAttribute((const void*)dit_fwd, hipFuncAttributeMaxDynamicSharedMemorySize, LDS_BYTES) != hipSuccess) { fprintf(stderr, "kernel_launch: hipFuncSetAttribute failed\n"); grid = -1; return; }
        if (hipOccupancyMaxActiveBlocksPerMultiprocessor(&per_cu, (const void*)dit_fwd, NWAVES * 64, LDS_BYTES) != hipSuccess || per_cu < 1) { fprintf(stderr, "kernel_launch: occupancy query says %d\n", per_cu); per_cu = 1; }
        (void)hipGetLastError();
        grid = cus;
        if (grid != 256) fprintf(stderr, "kernel_launch: %d CUs (built for 256)\n", grid);
    }
    if (grid < 0) return;
    (void)hipMemsetAsync((char*)d_ws + WS_CTL, 0, CTL_ZERO_BYTES, stream);
    KArgs a{};
    for (int i = 0; i < 23; ++i) a.in[i] = (const float*)d_in[i];
    a.out = (float*)d_out; a.ws = (unsigned char*)d_ws;
#if N_LAUNCHES == 1
    a.ph_lo = 0; a.ph_hi = N_PHASES; a.use_cg = 1;
    void* kargs[] = {&a};
    hipError_t e = hipLaunchCooperativeKernel((const void*)dit_fwd, dim3(grid), dim3(NWAVES * 64), kargs, LDS_BYTES, stream);
    if (e != hipSuccess) fprintf(stderr, "kernel_launch: cooperative launch failed: %s\n", hipGetErrorString(e));
#else
    for (int p = 0; p < N_PHASES; ++p) { a.ph_lo = p; a.ph_hi = p + 1; a.use_cg = 0;
        hipLaunchKernelGGL(dit_fwd, dim3(grid), dim3(NWAVES * 64), LDS_BYTES, stream, a); }
#endif
}
```

```cpp
#include <hip/hip_runtime.h>
#include <hip/hip_cooperative_groups.h>
#include <hip/hip_bf16.h>
#include <cstdio>
#include <cstdint>
#include <cmath>
namespace cg = cooperative_groups;

constexpr int DMODEL = 1024, NBATCH = 2, TLAT = 8192, TCTX = 256;
constexpr int SB = TLAT + TCTX;
constexpr int MR = NBATCH * SB;
constexpr int NEXP = 16;
constexpr int MOE_MAXT = 152;
constexpr float EPS_ = 1e-6f;
constexpr float LOG2E = 1.4426950408889634f;
constexpr float C2 = 0.125f * LOG2E;
constexpr int NCHUNK = SB / 64;

constexpr size_t MiB = 1u << 20;
constexpr size_t WS_CTL = 0, CTL_ZERO_BYTES = 64 * 1024;
constexpr size_t WS_MOD = 1 * MiB;
constexpr size_t WS_LB = WS_MOD + 256 * 1024;
constexpr size_t WS_LAM = WS_LB + 8 * 1024;
constexpr size_t WS_ROPE = WS_LAM + 1024;
constexpr size_t WS_EXPID = 2 * MiB;
constexpr size_t WS_EXPW = WS_EXPID + 256 * 1024;
constexpr size_t WS_RANK = WS_EXPW + 256 * 1024;
constexpr size_t WS_TOKSLOT = WS_RANK + 256 * 1024;
constexpr size_t WS_CNT = WS_TOKSLOT + 256 * 1024;
constexpr size_t WS_META = WS_CNT + 32 * 1024;
constexpr size_t WS_ROWW = 4 * MiB;
constexpr size_t WS_TOT = 5 * MiB;
constexpr size_t WS_WIN = 8 * MiB;
constexpr size_t WS_WOE = 16 * MiB;
constexpr size_t WS_WQKV = 18 * MiB;
constexpr size_t WS_WOO = 21 * MiB;
constexpr size_t WS_MOE0_13 = 24 * MiB;
constexpr size_t WS_MOE0_2 = 88 * MiB;
constexpr size_t WS_X = 120 * MiB;
constexpr size_t WS_H = 186 * MiB;
constexpr size_t WS_R = 219 * MiB;
constexpr size_t WS_QH = WS_R;
constexpr size_t WS_LFF = WS_QH + 33 * MiB / 2;
constexpr size_t WS_LFB = WS_LFF + 33 * MiB;
constexpr size_t WS_IV = WS_LFB + 33 * MiB;
constexpr size_t WS_GG = WS_IV + 33 * MiB / 2;
constexpr size_t WS_DQ = WS_GG + 33 * MiB / 2;
constexpr size_t WS_DK = WS_DQ + 33 * MiB / 2;
constexpr size_t WS_DV = WS_DK + 33 * MiB / 2;
constexpr size_t WS_U = WS_DV + 33 * MiB / 2;
constexpr size_t WS_S = WS_U + 66 * MiB;
constexpr size_t WS_OATT = WS_U;
constexpr size_t WS_END0 = WS_S + 66 * MiB;
constexpr size_t WS_MOE1_13 = WS_R;
constexpr size_t WS_MOE1_2 = WS_R + 64 * MiB;
constexpr size_t WS_XS = WS_R + 96 * MiB;
constexpr size_t WS_HID = WS_XS + 76 * MiB;
constexpr size_t WS_Q1 = WS_HID + 76 * MiB;
constexpr size_t WS_K1 = WS_Q1 + 33 * MiB;
constexpr size_t WS_V1 = WS_K1 + 33 * MiB / 4;
constexpr size_t WS_END1 = WS_V1 + 33 * MiB / 4;
constexpr size_t WS_NEED = (WS_END0 > WS_END1 ? WS_END0 : WS_END1);
static_assert(WS_NEED <= 553810048ull, "d_ws map exceeds the guaranteed workspace");
static_assert((size_t)MOE_MAXT * 256 * 1024 * 2 <= 76 * MiB, "XS size");

#define GAS __attribute__((address_space(1)))
#define LAS __attribute__((address_space(3)))
typedef unsigned short bf16;
typedef unsigned v4u __attribute__((ext_vector_type(4)));
typedef float f32x4 __attribute__((ext_vector_type(4)));
typedef short bf16x8 __attribute__((ext_vector_type(8)));
typedef GAS unsigned gu32;
typedef GAS unsigned long long gu64;
#define RLX_AGENT __ATOMIC_RELAXED, __HIP_MEMORY_SCOPE_AGENT
#define LDS_WAIT() asm volatile("s_waitcnt lgkmcnt(0)" ::: "memory")
#define VM_WAIT() asm volatile("s_waitcnt vmcnt(0)" ::: "memory")
__device__ __forceinline__ unsigned long long rt() { return __builtin_amdgcn_s_memrealtime(); }
typedef float f32x2c_t __attribute__((ext_vector_type(2))); typedef __bf16 bf16x2c_t __attribute__((ext_vector_type(2)));
__device__ __forceinline__ unsigned pk2(float lo, float hi) { f32x2c_t v = {lo, hi}; bf16x2c_t b = __builtin_convertvector(v, bf16x2c_t); return __builtin_bit_cast(unsigned, b); }
__device__ __forceinline__ unsigned f2bf(float f) { return pk2(f, 0.f) & 0xffffu; }
template <int CTRL> __device__ __forceinline__ float dpp_f(float v) { return __builtin_bit_cast(float, __builtin_amdgcn_update_dpp(0, __builtin_bit_cast(int, v), CTRL, 0xF, 0xF, true)); }
__device__ __forceinline__ float swap16_sum(float a, float b) { const auto r = __builtin_amdgcn_permlane16_swap(__float_as_uint(a), __float_as_uint(b), false, false); return __uint_as_float(r[0]) + __uint_as_float(r[1]); }
__device__ __forceinline__ float swap32_sum(float a, float b) { const auto r = __builtin_amdgcn_permlane32_swap(__float_as_uint(a), __float_as_uint(b), false, false); return __uint_as_float(r[0]) + __uint_as_float(r[1]); }

#define XB_TMO      128
#define XB_XCNT(j)  (256  + 64 * (j))
#define XB_XSUB(j)  (1280 + 64 * (j))
#define XB_XGEN(j)  (2304 + 64 * (j))
#define XB_TOP      3328
#define XB_TOPGEN   3392
#define XCD_BAR_WORDS 3456
#define XB_SPIN_CAP (1u << 18)

__device__ __forceinline__ unsigned xb_ld(unsigned* p)              { return __hip_atomic_load(p, __ATOMIC_RELAXED, __HIP_MEMORY_SCOPE_AGENT); }
__device__ __forceinline__ unsigned xb_add(unsigned* p, unsigned v) { return __hip_atomic_fetch_add(p, v, __ATOMIC_RELAXED, __HIP_MEMORY_SCOPE_AGENT); }
__device__ __forceinline__ unsigned xb_xcc_id() { return (unsigned)__builtin_amdgcn_s_getreg((3 << 11) | 20) & 0xFu; }
#define XB_SPIN(cond, bar) do { unsigned _sp = 0; while (cond) { __builtin_amdgcn_s_sleep(1); \
    if ((++_sp & 255u) == 0u) { if (xb_ld(&(bar)[XB_TMO])) break; if (_sp > XB_SPIN_CAP) { atomicAdd(&(bar)[XB_TMO], 1u); break; } } } } while (0)

struct XcdBarrier {
    unsigned* bar; unsigned x;
    volatile LAS unsigned* st;
};

__device__ __forceinline__ XcdBarrier xcd_barrier_post(unsigned* bar, volatile LAS unsigned* st) {
    XcdBarrier b; b.bar = bar; b.x = xb_xcc_id(); b.st = st;
    if (threadIdx.x == 0) (void)xb_add(&bar[XB_XCNT(b.x)], 1u);
    return b;
}
__device__ __forceinline__ void xcd_barrier_complete(unsigned* bar, unsigned x, unsigned& nloc, unsigned& nx) {
    const unsigned G = gridDim.x * gridDim.y * gridDim.z;
    unsigned sum, cnt, mine, sp = 0u;
    for (;;) {
        sum = 0u; cnt = 0u; mine = 0u;
#pragma unroll
        for (unsigned j = 0; j < 16; ++j) { const unsigned c = xb_ld(&bar[XB_XCNT(j)]); sum += c; cnt += (c > 0u) ? 1u : 0u; mine = (j == x) ? c : mine; }
        if (sum == G) break;
        __builtin_amdgcn_s_sleep(1);
        if ((++sp & 255u) == 0u) { if (xb_ld(&bar[XB_TMO])) break; if (sp > XB_SPIN_CAP) { atomicAdd(&bar[XB_TMO], 1u); break; } }
    }
    nloc = mine > 0u ? mine : 1u; nx = cnt > 0u ? cnt : 1u;
}

__device__ __forceinline__ void xcd_barrier(const XcdBarrier& b) {
    asm volatile("s_waitcnt vmcnt(0)" ::: "memory");
    __syncthreads();
    if (threadIdx.x == 0) {
        unsigned* bar = b.bar;
        __builtin_amdgcn_s_waitcnt(0);
        unsigned nloc = b.st[0], nx = b.st[1];
        if (nloc == 0u) { xcd_barrier_complete(bar, b.x, nloc, nx); b.st[0] = nloc; b.st[1] = nx; }
        const unsigned old = xb_add(&bar[XB_XSUB(b.x)], 1u);
        const unsigned gen = old / nloc;
        if (old + 1u == (gen + 1u) * nloc) {
            __builtin_amdgcn_fence(__ATOMIC_RELEASE, "agent");
            asm volatile("s_waitcnt vmcnt(0)" ::: "memory");
            const unsigned og = xb_add(&bar[XB_TOP], 1u);
            const unsigned tg = og / nx;
            if (og + 1u == (tg + 1u) * nx) xb_add(&bar[XB_TOPGEN], 1u);
            else XB_SPIN(xb_ld(&bar[XB_TOPGEN]) == tg, bar);
            __builtin_amdgcn_fence(__ATOMIC_ACQUIRE, "agent");
            xb_add(&bar[XB_XGEN(b.x)], 1u);
            asm volatile("s_waitcnt vmcnt(0)" ::: "memory");
        } else {
            XB_SPIN(xb_ld(&bar[XB_XGEN(b.x)]) == gen, bar);
            __builtin_amdgcn_fence(__ATOMIC_ACQUIRE, "agent");
            asm volatile("s_waitcnt vmcnt(0)" ::: "memory");
        }
    }
    __syncthreads();
}
namespace pg8 {
#define PG8_LAS __attribute__((address_space(3)))
typedef unsigned short bf16_t;
typedef short bf16x8 __attribute__((ext_vector_type(8)));
typedef float f32x4 __attribute__((ext_vector_type(4)));
typedef unsigned u32x4 __attribute__((ext_vector_type(4)));
constexpr int BM = 256, BK = 64, HALF = 128, HTB = HALF * BK * 2  , STAGE_BYTES = 8 * HTB, NXCD = 8, WGM = 8;

__host__ __device__ __forceinline__ int lds_byte(int r, int c) { const int st = (r >> 4) * 2 + (c >> 5), rr = r & 15, cc = c & 31, ob = rr * 64 + cc * 2; return st * 1024 + (ob ^ (((ob >> 9) & 1) << 5)); }
__host__ __device__ __forceinline__ void stage_rc(int b, int& R, int& C) { const int st = b / 1024, sb = b % 1024, swz = sb ^ (((sb >> 9) & 1) << 5); R = (st >> 1) * 16 + swz / 64; C = (st & 1) * 32 + (swz % 64) / 2; }
__host__ __device__ __forceinline__ int perm32(int rho) { const int n = rho >> 4, i = rho & 15; return 8 * (i >> 2) + 4 * n + (i & 3); }

struct Unit { int pm, pn, be, mask, qa, qb; };
struct Gemm { const bf16_t* A; const bf16_t* Bt; int M, N, K; size_t bes; };
__device__ __forceinline__ unsigned cvt_pk_bf16(float lo, float hi) { unsigned r; asm volatile("v_cvt_pk_bf16_f32 %0, %1, %2" : "=v"(r) : "v"(lo), "v"(hi)); return r; }
typedef float f32x2 __attribute__((ext_vector_type(2)));

__device__ __forceinline__ bool tail_deal(int L, int nwg, int G, int mode, int parts, int& idx, int& mask, int& qa, int& qb) {
    const int F = nwg / G, R = nwg - F * G; qa = 0; qb = 0; mask = 0xF;
    if (mode == 0) { if (L >= nwg) return false; idx = L; return true; }
    if (mode == 1) { if (L >= F * G) return false; idx = L; return true; }
    if (L >= R * parts) return false;
    idx = F * G + L / parts; const int p = L % parts;
    if (parts == 4) { qa = p >> 1; qb = p & 1; mask = 1; } else { qa = p; mask = 3; }
    return true;
}
struct DenseOrder {
    int nM, nN, nwg, G, c, mode, parts; bool skipctx;
    __device__ void init(int nM_, int nN_, int G_, int c_, bool skip_, int mode_ = 0, int parts_ = 1) { nM = nM_; nN = nN_; nwg = nM * nN; G = G_; c = c_; skipctx = skip_; mode = mode_; parts = parts_; }
    __device__ bool next(int i, Unit& u) const {
        int wgid; if (!tail_deal(i * G + c, nwg, G, mode, parts, wgid, u.mask, u.qa, u.qb)) return false;
        { const int q = nwg / NXCD, r = nwg % NXCD, xcd = wgid % NXCD, off = wgid / NXCD; wgid = (xcd < r ? xcd * (q + 1) : r * (q + 1) + (xcd - r) * q) + off; }
        const int nig = WGM * nN, gid = wgid / nig, fm = gid * WGM, gsz = (nM - fm) < WGM ? (nM - fm) : WGM;
        int pm = fm + ((wgid % nig) % gsz); u.pn = (wgid % nig) / gsz; u.be = 0;
        if (skipctx) pm = (pm >> 5) * 33 + 1 + (pm & 31);
        u.pm = pm; return true;
    }
    __device__ __forceinline__ void a_ready(const Unit&) const {}
    __device__ __forceinline__ void done(const Unit&) const {}
};
struct MoeOrder {
    int nM, nN, nwg, G, c, mode, parts; const PG8_LAS int* tile_e;
    __device__ void init(int nM_, int nN_, int G_, int c_, const PG8_LAS int* te, int mode_ = 0, int parts_ = 1) { nM = nM_; nN = nN_; nwg = nM * nN; G = G_; c = c_; tile_e = te; mode = mode_; parts = parts_; }
    __device__ bool next(int i, Unit& u) const {
        int wgid; if (!tail_deal(i * G + c, nwg, G, mode, parts, wgid, u.mask, u.qa, u.qb)) return false;
        { const int q = nwg / NXCD, r = nwg % NXCD, xcd = wgid % NXCD, off = wgid / NXCD; wgid = (xcd < r ? xcd * (q + 1) : r * (q + 1) + (xcd - r) * q) + off; }
        const int nig = WGM * nN, gid = wgid / nig, fm = gid * WGM, gsz = (nM - fm) < WGM ? (nM - fm) : WGM;
        u.pm = fm + ((wgid % nig) % gsz); u.pn = (wgid % nig) / gsz; u.be = __builtin_amdgcn_readfirstlane(tile_e[u.pm]); return true;
    }
    __device__ __forceinline__ void a_ready(const Unit&) const {}
    __device__ __forceinline__ void done(const Unit&) const {}
};

typedef unsigned u32x2 __attribute__((ext_vector_type(2)));
typedef float f32x2 __attribute__((ext_vector_type(2)));
__device__ __forceinline__ float silu_f(float v) { return v * __builtin_amdgcn_rcpf(1.f + __builtin_amdgcn_exp2f(__builtin_fminf(-v * 1.4426950408889634f, 80.f))); }
__device__ __forceinline__ float sigm_f(float v) { return __builtin_amdgcn_rcpf(1.f + __builtin_amdgcn_exp2f(__builtin_fminf(-v * 1.4426950408889634f, 80.f))); }
__device__ __forceinline__ float lfgate_f(float lb, float v) { const float e = __builtin_amdgcn_exp2f(__builtin_fminf(-v * 1.4426950408889634f, 80.f)); return __builtin_amdgcn_logf((1.f + lb * e) * __builtin_amdgcn_rcpf(1.f + e)) * 0.6931471805599453f; }
__device__ __forceinline__ u32x2 pk4(f32x4 v) { u32x2 w; w.x = cvt_pk_bf16(v[0], v[1]); w.y = cvt_pk_bf16(v[2], v[3]); return w; }
__device__ __forceinline__ u32x4 pair16(u32x2 a, u32x2 b) {
    const auto r0 = __builtin_amdgcn_permlane16_swap(a.x, b.x, false, false), r1 = __builtin_amdgcn_permlane16_swap(a.y, b.y, false, false);
    u32x4 w; w.x = r0[0]; w.y = r1[0]; w.z = r0[1]; w.w = r1[1]; return w;
}

struct EpiInProj {
    static constexpr bool PERM = true, AFTER_DRAIN = false;
    bf16_t *QH, *IV, *GG, *DQ, *DK, *DV; _Float16 *LFF, *LFB; const float* LB;     const float* ROPE;
    __device__ __forceinline__ void operator()(const f32x4 (&acc)[2][2][4][2], const Unit& u, int wr, int wc, int fr, int fq) const {
        const int seg = u.pn >> 1;
        const int cb = (u.pn & 1) * 256 + u.qb * 128 + wc * 32 + 8 * fq;
        const int jt = u.pm % 33; const bool latent = jt != 0;
        const int s0 = jt * 256 + u.qa * 128 + wr * 64 + fr;
        const size_t row0 = (size_t)u.pm * 256 + u.qa * 128 + wr * 64 + fr;
        if (seg == 1 || seg == 2) {
            _Float16* LF = seg == 1 ? LFF : LFB; typedef _Float16 h16x8 __attribute__((ext_vector_type(8))); const float* lbp = LB + (seg - 1) * 512;
#pragma unroll
            for (int bj = 0; bj < 2; ++bj) { const int col = cb + bj * 128; const f32x4 lb0 = *(const f32x4*)(lbp + col), lb1 = *(const f32x4*)(lbp + col + 4);
#pragma unroll
                for (int ai = 0; ai < 2; ++ai)
#pragma unroll
                    for (int m = 0; m < 4; ++m) { if (!(u.mask & (1 << (ai * 2 + bj)))) continue; const f32x4 v0 = acc[ai][bj][m][0], v1 = acc[ai][bj][m][1]; h16x8 o;
#pragma unroll
                        for (int e = 0; e < 4; ++e) { o[e] = (_Float16)lfgate_f(lb0[e], v0[e]); o[4 + e] = (_Float16)lfgate_f(lb1[e], v1[e]); }
                        *(h16x8*)(LF + (row0 + ai * 128 + m * 16) * 512 + col) = o; } }
        } else if (seg == 5 || seg == 6) {
            bf16_t* O = seg == 5 ? DQ : DK; const float sc = seg == 5 ? C2 : 1.f; const float sgn = fq < 2 ? -1.f : 1.f;
#pragma unroll
            for (int ai = 0; ai < 2; ++ai)
#pragma unroll
                for (int m = 0; m < 4; ++m) {
                    float co[8], si[8];
#pragma unroll
                    for (int e = 0; e < 8; ++e) { co[e] = 1.f; si[e] = 0.f; }
                    if (latent) { const int tau = s0 + ai * 128 + m * 16 - 256; const int pos = (wc & 1) ? (tau & 63) : (tau >> 6);
                        const float* rp = ROPE + (pos * 16 + 8 * (fq & 1)) * 2;
#pragma unroll
                        for (int k = 0; k < 4; ++k) { const f32x4 t4 = *(const f32x4*)(rp + 4 * k); co[2 * k] = t4[0]; si[2 * k] = t4[1]; co[2 * k + 1] = t4[2]; si[2 * k + 1] = t4[3]; } }
#pragma unroll
                    for (int bj = 0; bj < 2; ++bj) { if (!(u.mask & (1 << (ai * 2 + bj)))) continue; float x[8], o[8];
#pragma unroll
                        for (int e = 0; e < 4; ++e) { x[e] = acc[ai][bj][m][0][e]; x[4 + e] = acc[ai][bj][m][1][e]; }
#pragma unroll
                        for (int e = 0; e < 8; ++e) { const auto rr = __builtin_amdgcn_permlane32_swap(__float_as_uint(x[e]), __float_as_uint(x[e]), false, false);
                            const float pr = __uint_as_float(fq < 2 ? rr[1] : rr[0]); o[e] = (x[e] * co[e] + sgn * pr * si[e]) * sc; }
                        u32x4 w; w.x = cvt_pk_bf16(o[0], o[1]); w.y = cvt_pk_bf16(o[2], o[3]); w.z = cvt_pk_bf16(o[4], o[5]); w.w = cvt_pk_bf16(o[6], o[7]);
                        *(u32x4*)(O + (row0 + ai * 128 + m * 16) * 512 + cb + bj * 128) = w; } }
        } else {
            bf16_t* O = seg == 0 ? QH : seg == 3 ? IV : seg == 4 ? GG : DV;
#pragma unroll
            for (int ai = 0; ai < 2; ++ai)
#pragma unroll
                for (int m = 0; m < 4; ++m)
#pragma unroll
                    for (int bj = 0; bj < 2; ++bj) { if (!(u.mask & (1 << (ai * 2 + bj)))) continue; f32x4 v0 = acc[ai][bj][m][0], v1 = acc[ai][bj][m][1];
                        if (seg == 0) {
#pragma unroll
                            for (int e = 0; e < 4; ++e) { v0[e] = silu_f(v0[e]) * 0.08838834764831845f; v1[e] = silu_f(v1[e]) * 0.08838834764831845f; } }
                        else if (seg == 4) {
#pragma unroll
                            for (int e = 0; e < 4; ++e) { v0[e] = silu_f(v0[e]); v1[e] = silu_f(v1[e]); } }
                        u32x4 w; w.x = cvt_pk_bf16(v0[0], v0[1]); w.y = cvt_pk_bf16(v0[2], v0[3]); w.z = cvt_pk_bf16(v1[0], v1[1]); w.w = cvt_pk_bf16(v1[2], v1[3]);
                        *(u32x4*)(O + (row0 + ai * 128 + m * 16) * 512 + cb + bj * 128) = w; }
        }
    }
};
#ifndef EPISEL
#define EPISEL (-1)
#endif
template <class E> struct EpiTwice {
    static constexpr bool PERM = E::PERM, AFTER_DRAIN = false; E e;
    __device__ __forceinline__ void operator()(const f32x4 (&acc)[2][2][4][2], const Unit& u, int wr, int wc, int fr, int fq) const { e(acc, u, wr, wc, fr, fq); asm volatile("" ::: "memory");
        if (EPISEL < 0 || (u.pn >> 1) == EPISEL) e(acc, u, wr, wc, fr, fq); }
};

struct EpiOut0 {
    static constexpr bool PERM = false, AFTER_DRAIN = false;
    const float* x; const float* ctx; const float* MODL; bf16_t* X;
    __device__ __forceinline__ void operator()(const f32x4 (&acc)[2][2][4][2], const Unit& u, int wr, int wc, int fr, int fq) const {
        const int b = u.pm / 33, jt = u.pm % 33; const int vec = jt == 0 ? 2 : b;
        const int col0 = u.pn * 256 + u.qb * 128 + wc * 32 + 4 * fq; const float* gp = MODL + vec * 6144 + 2048 + col0;
        f32x4 gv[2][2];
#pragma unroll
        for (int bj = 0; bj < 2; ++bj)
#pragma unroll
            for (int n = 0; n < 2; ++n) gv[bj][n] = *(const f32x4*)(gp + bj * 128 + n * 16);
#pragma unroll
        for (int ai = 0; ai < 2; ++ai)
#pragma unroll
            for (int m = 0; m < 4; ++m) { const int sl = (ai + u.qa) * 128 + wr * 64 + m * 16 + fr;
                const float* src = jt == 0 ? ctx + ((size_t)b * 256 + sl) * 1024 : x + ((size_t)b * 8192 + (jt - 1) * 256 + sl) * 1024;
                bf16_t* dst = X + ((size_t)u.pm * 256 + sl) * 1024;
#pragma unroll
                for (int bj = 0; bj < 2; ++bj) { if (!(u.mask & (1 << (ai * 2 + bj)))) continue; const int c = col0 + bj * 128;
                    *(u32x4*)(dst + c + ((fq & 1) ? 12 : 0)) = pair16(pk4(*(const f32x4*)(src + c) + gv[bj][0] * acc[ai][bj][m][0]), pk4(*(const f32x4*)(src + c + 16) + gv[bj][1] * acc[ai][bj][m][1])); } }
    }
};
struct EpiOut1 {
    static constexpr bool PERM = false, AFTER_DRAIN = false;
    const float* MODL; bf16_t* X;
    __device__ __forceinline__ void operator()(const f32x4 (&acc)[2][2][4][2], const Unit& u, int wr, int wc, int fr, int fq) const {
        const int b = u.pm / 33; const int col0 = u.pn * 256 + u.qb * 128 + wc * 32 + 4 * fq; const float* gp = MODL + b * 6144 + 2048 + col0;
        f32x4 gv[2][2];
#pragma unroll
        for (int bj = 0; bj < 2; ++bj)
#pragma unroll
            for (int n = 0; n < 2; ++n) gv[bj][n] = *(const f32x4*)(gp + bj * 128 + n * 16);
#pragma unroll
        for (int ai = 0; ai < 2; ++ai)
#pragma unroll
            for (int m = 0; m < 4; ++m) { bf16_t* dst = X + ((size_t)u.pm * 256 + (ai + u.qa) * 128 + wr * 64 + m * 16 + fr) * 1024;
#pragma unroll
                for (int bj = 0; bj < 2; ++bj) { if (!(u.mask & (1 << (ai * 2 + bj)))) continue; const int c = col0 + bj * 128; u32x2 o2[2];
#pragma unroll
                    for (int n = 0; n < 2; ++n) { const u32x2 xw = *(const u32x2*)(dst + c + n * 16); f32x4 xv; xv[0] = __uint_as_float(xw.x << 16); xv[1] = __uint_as_float(xw.x & 0xffff0000u); xv[2] = __uint_as_float(xw.y << 16); xv[3] = __uint_as_float(xw.y & 0xffff0000u);
                        o2[n] = pk4(xv + gv[bj][n] * acc[ai][bj][m][n]); }
                    *(u32x4*)(dst + c + ((fq & 1) ? 12 : 0)) = pair16(o2[0], o2[1]); } }
    }
};
__device__ __forceinline__ unsigned pk4_fp8(float a, float b, float c, float d) {
    a = __builtin_fminf(__builtin_fmaxf(a, -448.f), 448.f); b = __builtin_fminf(__builtin_fmaxf(b, -448.f), 448.f); c = __builtin_fminf(__builtin_fmaxf(c, -448.f), 448.f); d = __builtin_fminf(__builtin_fmaxf(d, -448.f), 448.f);
    int p = __builtin_amdgcn_cvt_pk_fp8_f32(a, b, 0, false); p = __builtin_amdgcn_cvt_pk_fp8_f32(c, d, p, true); return (unsigned)p;
}
constexpr float W8_SCALE = 64.f, W8_INV = 1.f / 64.f;
struct EpiGateUp8 {
    static constexpr bool PERM = false, AFTER_DRAIN = false;
    unsigned char* HID;
    __device__ __forceinline__ void operator()(const f32x4 (&acc)[2][2][4][2], const Unit& u, int wr, int wc, int fr, int fq) const {
        const int col0 = u.pn * 128 + wc * 32 + 4 * fq + ((fq & 1) ? 12 : 0);
#pragma unroll
        for (int ai = 0; ai < 2; ++ai)
#pragma unroll
            for (int m = 0; m < 4; ++m) { if (!(u.mask & (3 << (2 * ai)))) continue; f32x4 h0, h1;
#pragma unroll
                for (int e = 0; e < 4; ++e) { h0[e] = silu_f(acc[ai][0][m][0][e] * W8_INV) * (acc[ai][1][m][0][e] * W8_INV); h1[e] = silu_f(acc[ai][0][m][1][e] * W8_INV) * (acc[ai][1][m][1][e] * W8_INV); }
                unsigned char* p = HID + ((size_t)u.pm * 256 + (ai + u.qa) * 128 + wr * 64 + m * 16 + fr) * 1024 + col0;
                { const auto rr = __builtin_amdgcn_permlane16_swap(pk4_fp8(h0[0], h0[1], h0[2], h0[3]), pk4_fp8(h1[0], h1[1], h1[2], h1[3]), false, false); u32x2 w; w.x = rr[0]; w.y = rr[1]; *(u32x2*)p = w; } }
    }
};
struct EpiGateUp {
    static constexpr bool PERM = true, AFTER_DRAIN = false;
    bf16_t* HID;
    __device__ __forceinline__ void operator()(const f32x4 (&acc)[2][2][4][2], const Unit& u, int wr, int wc, int fr, int fq) const {
        const int col0 = u.pn * 128 + wc * 32 + 8 * fq;
#pragma unroll
        for (int ai = 0; ai < 2; ++ai)
#pragma unroll
            for (int m = 0; m < 4; ++m) { if (!(u.mask & (3 << (2 * ai)))) continue; f32x4 h0, h1;
#pragma unroll
                for (int e = 0; e < 4; ++e) { h0[e] = silu_f(acc[ai][0][m][0][e]) * acc[ai][1][m][0][e]; h1[e] = silu_f(acc[ai][0][m][1][e]) * acc[ai][1][m][1][e]; }
                u32x4 w; w.x = cvt_pk_bf16(h0[0], h0[1]); w.y = cvt_pk_bf16(h0[2], h0[3]); w.z = cvt_pk_bf16(h1[0], h1[1]); w.w = cvt_pk_bf16(h1[2], h1[3]);
                *(u32x4*)(HID + ((size_t)u.pm * 256 + (ai + u.qa) * 128 + wr * 64 + m * 16 + fr) * 1024 + col0) = w; }
    }
};
struct EpiDown {
    static constexpr bool PERM = true, AFTER_DRAIN = false;
    bf16_t* YB; const float* ROWW; float oscale;
    __device__ __forceinline__ void operator()(const f32x4 (&acc)[2][2][4][2], const Unit& u, int wr, int wc, int fr, int fq) const {
        const int col0 = u.pn * 256 + u.qb * 128 + wc * 32 + 8 * fq;
#pragma unroll
        for (int ai = 0; ai < 2; ++ai)
#pragma unroll
            for (int m = 0; m < 4; ++m) { const size_t row = (size_t)u.pm * 256 + (ai + u.qa) * 128 + wr * 64 + m * 16 + fr; const float w_ = ROWW[row] * oscale;
#pragma unroll
                for (int bj = 0; bj < 2; ++bj) { if (!(u.mask & (1 << (ai * 2 + bj)))) continue; const f32x4 v0 = acc[ai][bj][m][0] * w_, v1 = acc[ai][bj][m][1] * w_;
                    u32x4 w; w.x = cvt_pk_bf16(v0[0], v0[1]); w.y = cvt_pk_bf16(v0[2], v0[3]); w.z = cvt_pk_bf16(v1[0], v1[1]); w.w = cvt_pk_bf16(v1[2], v1[3]);
                    *(u32x4*)(YB + row * 1024 + col0 + bj * 128) = w; } }
    }
};
struct EpiDown8 {
    static constexpr bool PERM = false, AFTER_DRAIN = false;
    bf16_t* YB; const float* ROWW;
    __device__ __forceinline__ void operator()(const f32x4 (&acc)[2][2][4][2], const Unit& u, int wr, int wc, int fr, int fq) const {
        const int col0 = u.pn * 256 + u.qb * 128 + wc * 32 + 4 * fq + ((fq & 1) ? 12 : 0);
#pragma unroll
        for (int ai = 0; ai < 2; ++ai)
#pragma unroll
            for (int m = 0; m < 4; ++m) { const size_t row = (size_t)u.pm * 256 + (ai + u.qa) * 128 + wr * 64 + m * 16 + fr; const float w_ = ROWW[row] * W8_INV;
#pragma unroll
                for (int bj = 0; bj < 2; ++bj) { if (!(u.mask & (1 << (ai * 2 + bj)))) continue;
                    *(u32x4*)(YB + row * 1024 + col0 + bj * 128) = pair16(pk4(acc[ai][bj][m][0] * w_), pk4(acc[ai][bj][m][1] * w_)); } }
    }
};
struct EpiQKV1 {
    static constexpr bool PERM = false, AFTER_DRAIN = false;
    bf16_t *Q1, *K1, *V1; const float* ROPE;
    __device__ __forceinline__ void operator()(const f32x4 (&acc)[2][2][4][2], const Unit& u, int wr, int wc, int fr, int fq) const {
        const int jt = u.pm % 33; const bool latent = jt != 0;
        const int s0 = jt * 256 + u.qa * 128 + wr * 64 + fr; const size_t row0 = (size_t)u.pm * 256 + u.qa * 128 + wr * 64 + fr;
        const int cb = u.qb * 128 + wc * 32 + 4 * fq;
        if (u.pn == 5) {
#pragma unroll
            for (int ai = 0; ai < 2; ++ai)
#pragma unroll
                for (int m = 0; m < 4; ++m)
#pragma unroll
                    for (int bj = 0; bj < 2; ++bj) { if (!(u.mask & (1 << (ai * 2 + bj)))) continue; *(u32x4*)(V1 + (row0 + ai * 128 + m * 16) * 256 + cb + bj * 128 + ((fq & 1) ? 12 : 0)) = pair16(pk4(acc[ai][bj][m][0]), pk4(acc[ai][bj][m][1])); }
        } else {
            const bool isq = u.pn < 4; bf16_t* O = isq ? Q1 + u.pn * 256 : K1; const int pitch = isq ? 1024 : 256; const float sc = isq ? C2 : 1.f;
#pragma unroll
            for (int ai = 0; ai < 2; ++ai)
#pragma unroll
                for (int m = 0; m < 4; ++m) {
                    f32x4 cs0 = {1.f, 0.f, 1.f, 0.f}, cs1 = {1.f, 0.f, 1.f, 0.f};
                    if (latent) { const int tau = s0 + ai * 128 + m * 16 - 256; const int pos = (wc & 1) ? (tau & 63) : (tau >> 6);
                        const float* rp = ROPE + (pos * 16 + 4 * fq) * 2; cs0 = *(const f32x4*)rp; cs1 = *(const f32x4*)(rp + 4); }
                    const float co[4] = {cs0[0], cs0[2], cs1[0], cs1[2]}, si[4] = {cs0[1], cs0[3], cs1[1], cs1[3]};
#pragma unroll
                    for (int bj = 0; bj < 2; ++bj) { if (!(u.mask & (1 << (ai * 2 + bj)))) continue; const f32x4 a0 = acc[ai][bj][m][0], a1 = acc[ai][bj][m][1]; f32x4 o0, o1;
#pragma unroll
                        for (int e = 0; e < 4; ++e) { o0[e] = (a0[e] * co[e] - a1[e] * si[e]) * sc; o1[e] = (a1[e] * co[e] + a0[e] * si[e]) * sc; }
                        bf16_t* p = O + (row0 + ai * 128 + m * 16) * pitch + cb + bj * 128;
                        *(u32x4*)(p + ((fq & 1) ? 12 : 0)) = pair16(pk4(o0), pk4(o1)); } }
        }
    }
};
template <class Epi, class Sched, bool ALIGN_EPI = false, bool SP2 = false, int TMASK = 0xF, bool F8 = false>
__device__ __forceinline__ void gemm_phase(PG8_LAS unsigned char* lds, const Gemm g, const Sched& S, const Epi& E) {
    int tid_ = threadIdx.x; asm volatile("" : "+v"(tid_));
    const int tid = tid_, wid = __builtin_amdgcn_readfirstlane(tid >> 6), lane = tid & 63, wr = wid >> 2, wc = wid & 3, fr = lane & 15, fq = lane >> 4;
    const int K = g.K, nt = K / BK;
    unsigned voffA, voffB;
    { int R, C; stage_rc(tid * 16, R, C); const int Rb = Epi::PERM ? ((R & ~31) + perm32(R & 31)) : R;
        voffA = (unsigned)(R * K + C) * 2u; voffB = (unsigned)(Rb * K + C) * 2u; }
#define voffB (*(Epi::PERM ? &voffB : &voffA))
    const size_t kstep = (size_t)(BK * 2);
    const size_t hstep = (size_t)HALF * K * 2;
    const size_t tstep = 2 * hstep;
    const unsigned ldsw = (unsigned)wid * 1024u;
    const int aoff = lds_byte(wr * 64 + fr, F8 ? fq * 16 : fq * 8), boff = lds_byte(wc * 32 + fr, F8 ? fq * 16 : fq * 8);
    typedef int v8i_t __attribute__((ext_vector_type(8))); typedef int v4i_t __attribute__((ext_vector_type(4)));
#define PG8_SA(b, h) (((b) * 2 + (h)) * HTB)
#define PG8_SB(b, h) ((4 + (b) * 2 + (h)) * HTB)
#define PG8_STAGE(bufoff, gbase, voff) do { _Pragma("unroll") for (int _i = 0; _i < 2; ++_i) \
        __builtin_amdgcn_global_load_lds((const unsigned*)((const char*)(gbase) + (size_t)_i * 128 * K + (voff)), (PG8_LAS unsigned*)(lds + (bufoff) + ldsw + _i * 8192), 16, 0, 0); } while (0)
#define PG8_LD8(base) __builtin_shufflevector(*(const PG8_LAS v4i_t*)(base), *(const PG8_LAS v4i_t*)((base) + 16), 0, 1, 2, 3, 4, 5, 6, 7)
#define PG8_LDA(dst, b, h) do { if (!((TMASK >> (2 * (h))) & 3)) break; \
        if constexpr (F8) { _Pragma("unroll") for (int m = 0; m < 4; ++m) dst##8[m] = PG8_LD8(lds + PG8_SA(b, h) + aoff + m * 2048); } \
        else { _Pragma("unroll") for (int m = 0; m < 4; ++m) _Pragma("unroll") for (int k = 0; k < 2; ++k) dst[m][k] = *(const PG8_LAS bf16x8*)(lds + PG8_SA(b, h) + aoff + m * 2048 + k * 1024); } } while (0)
#define PG8_LDB(dst, b, h) do { if (!(TMASK & (5 << (h)))) break; \
        if constexpr (F8) { _Pragma("unroll") for (int n = 0; n < 2; ++n) dst##8[n] = PG8_LD8(lds + PG8_SB(b, h) + boff + n * 2048); } \
        else { _Pragma("unroll") for (int n = 0; n < 2; ++n) _Pragma("unroll") for (int k = 0; k < 2; ++k) dst[n][k] = *(const PG8_LAS bf16x8*)(lds + PG8_SB(b, h) + boff + n * 2048 + k * 1024); } } while (0)
#define PG8_MMA(ai, bj, At, Bt) do { if (!((TMASK >> ((ai) * 2 + (bj))) & 1)) break; __builtin_amdgcn_s_setprio(1); \
        if constexpr (F8) { _Pragma("unroll") for (int m = 0; m < 4; ++m) _Pragma("unroll") for (int n = 0; n < 2; ++n) \
            acc[ai][bj][m][n] = __builtin_amdgcn_mfma_scale_f32_16x16x128_f8f6f4(Bt##8[n], At##8[m], acc[ai][bj][m][n], 0, 0, 0, 0x7f7f7f7f, 0, 0x7f7f7f7f); } \
        else { _Pragma("unroll") for (int m = 0; m < 4; ++m) _Pragma("unroll") for (int n = 0; n < 2; ++n) _Pragma("unroll") for (int k = 0; k < 2; ++k) \
            acc[ai][bj][m][n] = __builtin_amdgcn_mfma_f32_16x16x32_bf16(Bt[n][k], At[m][k], acc[ai][bj][m][n], 0, 0, 0); } \
        __builtin_amdgcn_s_setprio(0); } while (0)
#define PG8_WAIT_V(n) asm volatile("s_waitcnt vmcnt(" #n ")" ::: "memory")
#define PG8_WAIT_L(n) asm volatile("s_waitcnt lgkmcnt(" #n ")" ::: "memory")
#define PG8_BAR __builtin_amdgcn_s_barrier()
#define PG8_SCHED __builtin_amdgcn_sched_barrier(0)
    Unit cur, nxt; int ui = 0;
    if (!S.next(0, cur)) return;
    f32x4 acc[2][2][4][2];
#pragma unroll
    for (int a = 0; a < 2; ++a)
#pragma unroll
        for (int b = 0; b < 2; ++b)
#pragma unroll
            for (int m = 0; m < 4; ++m)
#pragma unroll
                for (int n = 0; n < 2; ++n) acc[a][b][m][n] = (f32x4){0.f, 0.f, 0.f, 0.f};
    bf16x8 At[4][2], B0[2][2], B1[2][2];
    v8i_t At8[4], B08[2], B18[2];
    const char* cA = (const char*)g.A + (size_t)cur.pm * tstep + (size_t)cur.qa * hstep; const char* cB = (const char*)g.Bt + (size_t)cur.be * g.bes + (size_t)cur.pn * tstep + (size_t)cur.qb * hstep;
    S.a_ready(cur);
    if constexpr (SP2) {
        PG8_STAGE(PG8_SB(0, 0), cB, voffB); PG8_STAGE(PG8_SB(0, 1), cB + hstep, voffB); PG8_STAGE(PG8_SA(0, 0), cA, voffA); PG8_STAGE(PG8_SA(0, 1), cA + hstep, voffA);
        if (wr == 1) PG8_BAR;
        PG8_WAIT_V(2); PG8_BAR;
        PG8_STAGE(PG8_SB(1, 0), cB + kstep, voffB); PG8_STAGE(PG8_SA(1, 0), cA + kstep, voffA); PG8_STAGE(PG8_SB(1, 1), cB + hstep + kstep, voffB);
        PG8_WAIT_V(6); PG8_BAR;
    } else {
        PG8_STAGE(PG8_SB(0, 0), cB, voffB); PG8_STAGE(PG8_SA(0, 0), cA, voffA); PG8_STAGE(PG8_SB(0, 1), cB + hstep, voffB); PG8_STAGE(PG8_SA(0, 1), cA + hstep, voffA);
        if (wr == 1) PG8_BAR;
        PG8_WAIT_V(4); PG8_BAR;
        PG8_STAGE(PG8_SB(1, 0), cB + kstep, voffB); PG8_STAGE(PG8_SA(1, 0), cA + kstep, voffA); PG8_STAGE(PG8_SB(1, 1), cB + hstep + kstep, voffB);
        PG8_WAIT_V(6); PG8_BAR;
    }
    for (;;) {
        const bool has_next = S.next(ui + 1, nxt);
        const char* nA = has_next ? (const char*)g.A + (size_t)nxt.pm * tstep + (size_t)nxt.qa * hstep : cA; const char* nB = has_next ? (const char*)g.Bt + (size_t)nxt.be * g.bes + (size_t)nxt.pn * tstep + (size_t)nxt.qb * hstep : cB;
#pragma unroll 1
        for (int t = 0; t < nt; t += 2) {
            const bool last = (t == nt - 2);
            const char* a1 = cA + (size_t)(t + 1) * kstep;
            const char* a2 = last ? nA : cA + (size_t)(t + 2) * kstep; const char* b2 = last ? nB : cB + (size_t)(t + 2) * kstep;
            const char* a3 = a2 + kstep; const char* b3 = b2 + kstep;
            if (last && has_next) S.a_ready(nxt);
            if constexpr (SP2) {
            PG8_LDB(B0, 0, 0); PG8_LDB(B1, 0, 1); PG8_SCHED; PG8_LDA(At, 0, 0); PG8_STAGE(PG8_SA(1, 1), a1 + hstep, voffA);
            PG8_WAIT_V(8); PG8_WAIT_L(0); PG8_BAR; PG8_MMA(0, 0, At, B0); PG8_MMA(0, 1, At, B1); PG8_BAR; PG8_SCHED;
            PG8_LDA(At, 0, 1); PG8_STAGE(PG8_SB(0, 0), b2, voffB); PG8_STAGE(PG8_SB(0, 1), b2 + hstep, voffB); PG8_STAGE(PG8_SA(0, 0), a2, voffA);
            PG8_WAIT_V(8); PG8_WAIT_L(0); PG8_BAR; PG8_MMA(1, 0, At, B0); PG8_MMA(1, 1, At, B1); PG8_BAR; PG8_SCHED;
            PG8_LDB(B0, 1, 0); PG8_LDB(B1, 1, 1); PG8_SCHED; PG8_LDA(At, 1, 0); PG8_STAGE(PG8_SA(0, 1), a2 + hstep, voffA);
            PG8_WAIT_V(8); PG8_WAIT_L(0); PG8_BAR; PG8_MMA(0, 0, At, B0); PG8_MMA(0, 1, At, B1); PG8_BAR; PG8_SCHED;
            PG8_LDA(At, 1, 1); PG8_STAGE(PG8_SB(1, 0), b3, voffB); PG8_STAGE(PG8_SB(1, 1), b3 + hstep, voffB); PG8_STAGE(PG8_SA(1, 0), a3, voffA);
            PG8_WAIT_V(8); PG8_WAIT_L(0); PG8_BAR; PG8_MMA(1, 0, At, B0); PG8_MMA(1, 1, At, B1); PG8_BAR; PG8_SCHED;
            } else {
            PG8_LDB(B0, 0, 0); PG8_SCHED; PG8_LDA(At, 0, 0); PG8_STAGE(PG8_SA(1, 1), a1 + hstep, voffA);
            PG8_WAIT_L(8); PG8_BAR; PG8_WAIT_L(0); PG8_MMA(0, 0, At, B0); PG8_BAR; PG8_SCHED;
            PG8_LDB(B1, 0, 1); PG8_STAGE(PG8_SB(0, 0), b2, voffB);
            PG8_BAR; PG8_WAIT_L(0); PG8_MMA(0, 1, At, B1); PG8_BAR;
            PG8_LDA(At, 0, 1); PG8_STAGE(PG8_SA(0, 0), a2, voffA);
            PG8_BAR; PG8_WAIT_L(0); PG8_MMA(1, 0, At, B0); PG8_BAR; PG8_SCHED;
            PG8_STAGE(PG8_SB(0, 1), b2 + hstep, voffB);
            PG8_WAIT_V(6); PG8_BAR; PG8_MMA(1, 1, At, B1); PG8_BAR;
            PG8_LDB(B0, 1, 0); PG8_SCHED; PG8_LDA(At, 1, 0); PG8_STAGE(PG8_SA(0, 1), a2 + hstep, voffA);
            PG8_WAIT_L(8); PG8_BAR; PG8_WAIT_L(0); PG8_MMA(0, 0, At, B0); PG8_BAR; PG8_SCHED;
            PG8_LDB(B1, 1, 1); PG8_STAGE(PG8_SB(1, 0), b3, voffB);
            PG8_BAR; PG8_WAIT_L(0); PG8_MMA(0, 1, At, B1); PG8_BAR;
            PG8_LDA(At, 1, 1); PG8_STAGE(PG8_SA(1, 0), a3, voffA);
            PG8_BAR; PG8_WAIT_L(0); PG8_MMA(1, 0, At, B0); PG8_BAR; PG8_SCHED;
            PG8_STAGE(PG8_SB(1, 1), b3 + hstep, voffB);
            PG8_WAIT_V(6); PG8_BAR; PG8_MMA(1, 1, At, B1); PG8_BAR;
            }
        }
        if constexpr (ALIGN_EPI) { if (wr == 0) PG8_BAR; }
        if constexpr (!Epi::AFTER_DRAIN) { int t_e = threadIdx.x; asm volatile("" : "+v"(t_e)); const int fr_e = t_e & 15, fq_e = (t_e >> 4) & 3;
            E(acc, cur, wr, wc, fr_e, fq_e); S.done(cur); }
        if (!has_next) break;
#pragma unroll
        for (int a = 0; a < 2; ++a)
#pragma unroll
            for (int b = 0; b < 2; ++b)
#pragma unroll
                for (int m = 0; m < 4; ++m)
#pragma unroll
                    for (int n = 0; n < 2; ++n) acc[a][b][m][n] = (f32x4){0.f, 0.f, 0.f, 0.f};
        cur = nxt; cA = nA; cB = nB; ++ui;
        if constexpr (ALIGN_EPI) { if (wr == 1) PG8_BAR; }
    }
    PG8_WAIT_V(0);
    if constexpr (!ALIGN_EPI) { if (wr == 0) PG8_BAR; }
    PG8_BAR;
    if constexpr (Epi::AFTER_DRAIN) { E.fused(acc, cur, wr, wc, fr, fq, lds, wid, lane); S.done(cur); }
#undef PG8_SA
#undef PG8_SB
#undef PG8_STAGE
#undef voffB
#undef PG8_LDA
#undef PG8_LDB
#undef PG8_MMA
#undef PG8_LD8
#undef PG8_WAIT_V
#undef PG8_WAIT_L
#undef PG8_BAR
#undef PG8_SCHED
}
}
namespace attn_body {
using bf16=__hip_bfloat16;
using bf16x8=__attribute__((ext_vector_type(8)))short;
using s16x4=__attribute__((ext_vector_type(4)))short;
using f32x16=__attribute__((ext_vector_type(16)))float;
using u32x4=__attribute__((ext_vector_type(4)))unsigned;
constexpr int D=64;
constexpr int NW=8,QBLK=32,QB=QBLK*NW,KVBLK=64;
constexpr int ATTN_UNIT_ROWS=QB;
__device__ __forceinline__ int crow(int r,int hi){return (r&3)+8*(r>>2)+4*hi;}
#define SBAR() __builtin_amdgcn_sched_barrier(0)
__device__ __forceinline__ void swamask(f32x16&p0,f32x16&p1,int dq0,bool tin,int hi){
  const float NEG=-INFINITY;
  #pragma unroll
  for(int r=0;r<16;++r){const int kv=4*hi+(r&3)+8*(r>>2); const int d0=dq0-kv, d1=d0-32;
    if(!(tin&&d0>=-128&&d0<=128))p0[r]=NEG; if(!(tin&&d1>=-128&&d1<=128))p1[r]=NEG;}
}

constexpr int NSLOT=3, SLOTB=8192;
constexpr int LDS_K=0, LDS_V=NSLOT*SLOTB, LDS_WS=2*NSLOT*SLOTB, LDS_OST=LDS_WS+NW*64*4, LDS_BYTES=LDS_OST+NW*4096;
constexpr float C2A=0.125f*1.4426950408889634f;
__device__ __forceinline__ void glds16(const void*gsrc,unsigned lds_dst){unsigned keep;
  asm volatile("s_mov_b32 %0, m0\n\ts_mov_b32 m0, %2\n\ts_nop 0\n\tglobal_load_lds_dwordx4 %1, off\n\ts_mov_b32 m0, %0":"=&s"(keep):"v"(gsrc),"s"(lds_dst):"memory");}
__device__ __forceinline__ float max3f(float a,float b,float c){float r;asm("v_max3_f32 %0, %1, %2, %3":"=v"(r):"v"(a),"v"(b),"v"(c));return r;}
__device__ __forceinline__ float max2f(float a,float b){float r;asm("v_max_f32_e32 %0, %1, %2":"=v"(r):"v"(a),"v"(b));return r;}
__device__ __forceinline__ float fadd_s(float a,float b){float r;asm("v_add_f32_e32 %0, %1, %2":"=v"(r):"v"(a),"v"(b));return r;}
__device__ __forceinline__ float fsub_s(float a,float b){float r;asm("v_sub_f32_e32 %0, %1, %2":"=v"(r):"v"(a),"v"(b));return r;}
typedef float f32x2_t __attribute__((ext_vector_type(2))); typedef __bf16 bf16x2_t __attribute__((ext_vector_type(2)));
__device__ __forceinline__ unsigned cvtpk_s(float lo,float hi){f32x2_t v={lo,hi};bf16x2_t b=__builtin_convertvector(v,bf16x2_t);return __builtin_bit_cast(unsigned,b);}
#define WAIT_BAR(N) asm volatile("s_waitcnt vmcnt(" #N ") lgkmcnt(0)\n\ts_barrier":::"memory")

__device__ __forceinline__ void qkt(f32x16&p0,f32x16&p1,const char*Kslot,const bf16x8*qr,const f32x16&negm,int r32,int hi){
  const char*kb=Kslot+hi*1024+r32*16;
  #pragma unroll
  for(int d0=0;d0<4;++d0){
    const bf16x8 b0=*reinterpret_cast<const bf16x8*>(kb+d0*2048);
    const bf16x8 b1=*reinterpret_cast<const bf16x8*>(kb+d0*2048+512);
    if(d0==0){p0=__builtin_amdgcn_mfma_f32_32x32x16_bf16(b0,qr[0],negm,0,0,0);p1=__builtin_amdgcn_mfma_f32_32x32x16_bf16(b1,qr[0],negm,0,0,0);}
    else{p0=__builtin_amdgcn_mfma_f32_32x32x16_bf16(b0,qr[d0],p0,0,0,0);p1=__builtin_amdgcn_mfma_f32_32x32x16_bf16(b1,qr[d0],p1,0,0,0);}}
}
typedef __attribute__((address_space(3))) const char* lds_cptr;
typedef short v4i16_t __attribute__((ext_vector_type(4)));
__device__ __forceinline__ void kload8(bf16x8*kf,lds_cptr kp){
  kf[0]=*(const __attribute__((address_space(3))) bf16x8*)(kp);      kf[1]=*(const __attribute__((address_space(3))) bf16x8*)(kp+512);
  kf[2]=*(const __attribute__((address_space(3))) bf16x8*)(kp+2048); kf[3]=*(const __attribute__((address_space(3))) bf16x8*)(kp+2560);
  kf[4]=*(const __attribute__((address_space(3))) bf16x8*)(kp+4096); kf[5]=*(const __attribute__((address_space(3))) bf16x8*)(kp+4608);
  kf[6]=*(const __attribute__((address_space(3))) bf16x8*)(kp+6144); kf[7]=*(const __attribute__((address_space(3))) bf16x8*)(kp+6656);
}
__device__ __forceinline__ void kload2(bf16x8*kf,lds_cptr kp,int j){ kf[2*j]=*(const __attribute__((address_space(3))) bf16x8*)(kp+j*2048); kf[2*j+1]=*(const __attribute__((address_space(3))) bf16x8*)(kp+j*2048+512); }
__device__ __forceinline__ s16x4 vtr(lds_cptr p){ return __builtin_bit_cast(s16x4,__builtin_amdgcn_ds_read_tr16_b64_v4i16((__attribute__((address_space(3))) v4i16_t*)p)); }
__device__ __forceinline__ float rowmax(const f32x16&p0,const f32x16&p1){
  float a=max3f(p0[0],p0[1],p1[0]),b=max3f(p0[2],p0[3],p1[1]);a=max3f(a,p1[2],p1[3]);
  #pragma unroll
  for(int r=4;r<16;r+=4){a=max3f(a,p0[r],p0[r+1]);b=max3f(b,p0[r+2],p0[r+3]);a=max3f(a,p1[r],p1[r+1]);b=max3f(b,p1[r+2],p1[r+3]);}
  const float m=max2f(a,b);
  auto rr=__builtin_amdgcn_permlane32_swap(__float_as_uint(m),__float_as_uint(m),false,false);
  return max2f(__uint_as_float(rr[0]),__uint_as_float(rr[1]));
}
__device__ __forceinline__ void pv(f32x16*o,int vb,bf16x8 pa0,bf16x8 pa1,bf16x8 pa2,bf16x8 pa3){
  #pragma unroll
  for(int d0=0;d0<2;++d0){s16x4 lo[4],hi[4];
    #pragma unroll
    for(int ks=0;ks<4;++ks){
      asm volatile("ds_read_b64_tr_b16 %0,%1 offset:%c2":"=&v"(lo[ks]):"v"(vb),"i"(d0*4096+ks*1024):"memory");
      asm volatile("ds_read_b64_tr_b16 %0,%1 offset:%c2":"=&v"(hi[ks]):"v"(vb),"i"(d0*4096+ks*1024+512):"memory");}
    asm volatile("s_waitcnt lgkmcnt(0)":::"memory");SBAR();
    #define PK(k) (bf16x8){lo[k][0],lo[k][1],lo[k][2],lo[k][3],hi[k][0],hi[k][1],hi[k][2],hi[k][3]}
    o[d0]=__builtin_amdgcn_mfma_f32_32x32x16_bf16(pa0,PK(0),o[d0],0,0,0);
    o[d0]=__builtin_amdgcn_mfma_f32_32x32x16_bf16(pa1,PK(1),o[d0],0,0,0);
    o[d0]=__builtin_amdgcn_mfma_f32_32x32x16_bf16(pa2,PK(2),o[d0],0,0,0);
    o[d0]=__builtin_amdgcn_mfma_f32_32x32x16_bf16(pa3,PK(3),o[d0],0,0,0);
    #undef PK
  }
}

#ifndef ATTN_STORE16
#define ATTN_STORE16(p,v) (*(u32x4*)(p)=(v))
#endif
template<int THRL,int MODE> __device__ __forceinline__ void attn_unit(const bf16*Qw0,int QP,const bf16*__restrict__ Kh,int KP,const bf16*__restrict__ Vh,int VP,bf16*Ow0,int OP,int NT,int tau0,const float*sinkp,char*shm){
  const int tid=threadIdx.x,lane=tid&63,r32=lane&31,hi=lane>>5; const int wid=__builtin_amdgcn_readfirstlane(tid>>6);
  const int wrow=(MODE==1)?(wid&1)*QBLK:wid*QBLK, wcol=(MODE==1)?(wid>>1)*64:0;
  const float sink_l2=(MODE==1)?sinkp[wid>>1]*1.4426950408889634f:0.f;
  const bf16*Qw=Qw0+(long)wrow*QP+wcol;
  const unsigned lds0=(unsigned)(uintptr_t)shm;
  float*wsf=(float*)(shm+LDS_WS)+wid*64;
  const bf16*ksrc=Kh+(long)lane*KP+wid*8;
  const bf16*vsrc=Vh+(long)(16*(wid&3)+(lane>>2))*VP+(wid>>2)*32+(lane&3)*8;
  const unsigned kdst=lds0+LDS_K+wid*1024, vdst=lds0+LDS_V+wid*1024;
  #define TROW(t) ((MODE==0||(t)<4)?(long)(t)*KVBLK:(long)(256+min(max(tau0-128+64*((t)-4),0),8192-64)))
  #define DMA_K(t,slot) glds16(ksrc+TROW(t)*KP,(unsigned)__builtin_amdgcn_readfirstlane(kdst+(slot)))
  #define DMA_V(t,slot) glds16(vsrc+TROW(t)*VP,(unsigned)__builtin_amdgcn_readfirstlane(vdst+(slot)))
  const int vb0=(int)(lds0+LDS_V)+((lane>>4)&1)*32+(lane&3)*8+(4*hi+((lane&15)>>2))*64;
  const char*Kbase=shm+LDS_K; bf16x8 kf[8];
  const lds_cptr shm3=(lds_cptr)shm; const lds_cptr kp0=shm3+LDS_K+hi*1024+r32*16; const lds_cptr vp0=shm3+LDS_V+((lane>>4)&1)*32+(lane&3)*8+(4*hi+((lane&15)>>2))*64;
  DMA_K(0,0);DMA_V(0,0);DMA_K(1,SLOTB);
  bf16x8 qr[4];
  #pragma unroll
  for(int d0=0;d0<4;++d0)qr[d0]=*reinterpret_cast<const bf16x8*>(&Qw[(long)r32*QP+d0*16+hi*8]);
  float mhat=0.f,l_reg=0.f;f32x16 o[2];o[0]=f32x16{};o[1]=f32x16{};f32x16 negm=f32x16{};asm volatile("":"+v"(negm));
  const int qrel=wrow+r32;
  #define CMASK(P0,P1,t) do{ if(MODE==1){ if((t)>=4){ const int ts_=tau0-128+64*((t)-4); swamask(P0,P1,qrel+128-64*((t)-4),(ts_>=0&&ts_<8192),hi);} } }while(0)
  bool resc=false;
  #define START(P0,P1) do{ const float rm=rowmax(P0,P1); resc=false; \
    { const float dl=rm; mhat=fadd_s(mhat,dl); \
      _Pragma("unroll") for(int r=0;r<16;++r){P0[r]=fsub_s(P0[r],dl);P1[r]=fsub_s(P1[r],dl);} \
      _Pragma("unroll") for(int r=0;r<16;++r)negm[r]=-mhat; asm volatile("":"+v"(negm)); } \
    _Pragma("unroll") for(int r=0;r<16;++r)P0[r]=__builtin_amdgcn_exp2f(P0[r]); }while(0)
  #define RESC() do{ if(resc){ asm volatile("s_waitcnt lgkmcnt(0)":::"memory"); \
      _Pragma("unroll") for(int d_=0;d_<2;++d_) _Pragma("unroll") for(int r=0;r<16;++r)o[d_][r]*=wsf[crow(r,hi)]; } }while(0)
  f32x16 pA0,pA1,pB0,pB1;
  int sl_prev=0,sl_cur=0,sl_next=SLOTB;
  #define ROT() do{sl_prev=sl_cur;sl_cur=sl_next;sl_next=(sl_next==(NSLOT-1)*SLOTB)?0:sl_next+SLOTB;}while(0)
  DMA_K(2,2*SLOTB);
  WAIT_BAR(3);
  qkt(pA0,pA1,Kbase,qr,negm,r32,hi);asm volatile("s_nop 15\n\ts_nop 7":"+v"(pA0),"+v"(pA1));CMASK(pA0,pA1,0);
  START(pA0,pA1);
  _Pragma("unroll") for(int r=0;r<16;++r)pA1[r]=__builtin_amdgcn_exp2f(pA1[r]);
  WAIT_BAR(0);
  DMA_K(3,0);DMA_V(1,SLOTB);
  ROT();
  kload8(kf,kp0+sl_cur);
  WAIT_BAR(2);
  s16x4 vlo[8],vhi[8]; u32x4 pw0,pw1,pw2,pw3;
  #define PKW(P,B) cvtpk_s(P[B],P[B+1])
  #define PAF(k) __builtin_bit_cast(bf16x8,pw##k)
  #define VFR(i) (bf16x8){vlo[i][0],vlo[i][1],vlo[i][2],vlo[i][3],vhi[i][0],vhi[i][1],vhi[i][2],vhi[i][3]}
  #define PIN(x) asm volatile("":"+v"(x))
  #define MX3(a,b,c) __builtin_fmaxf(__builtin_fmaxf((a),(b)),(c))
  #define GAPA(MF,A0,A1,A2,A3,W0,W1,PW) do{ MF; sacc+=A0; sacc+=A1; sacc+=A2; sacc+=A3; PIN(sacc); W0; W1; PIN(PW); SBAR(); }while(0)
  #define EX(v) __builtin_amdgcn_exp2f(v)
  #define GAPB(MF,X,B) do{ MF; X[B]=EX(X[B]); X[B+1]=EX(X[B+1]); X[B+2]=EX(X[B+2]); X[B+3]=EX(X[B+3]); PIN(X); SBAR(); }while(0)
  #define VRD(i) do{ vlo[i]=vtr(vp_+(((i)>>2)*4096+((i)&3)*1024)); vhi[i]=vtr(vp_+(((i)>>2)*4096+((i)&3)*1024+512)); }while(0)
  #define KRD(G,j) do{ if(G){ kload2(kf,kp0+sl_next,j); SBAR(); } }while(0)
  #define STEP(C0,C1,P0,P1,t,GK,GV,GL) do{ SBAR(); \
    const lds_cptr vp_=vp0+sl_prev; \
    VRD(0); SBAR(); float sacc=(P0[0]+P0[1]); \
    GAPA(C0=__builtin_amdgcn_mfma_f32_32x32x16_bf16(kf[0],qr[0],negm,0,0,0), P0[2],P0[3],P0[4],P0[5],     pw0[0]=PKW(P0,0), pw0[1]=PKW(P0,2), pw0); \
    VRD(4); SBAR(); GAPA(C1=__builtin_amdgcn_mfma_f32_32x32x16_bf16(kf[1],qr[0],negm,0,0,0), P0[6],P0[7],P0[8],P0[9],     pw0[2]=PKW(P0,4), pw0[3]=PKW(P0,6), pw0); \
    VRD(1); SBAR(); GAPA(C0=__builtin_amdgcn_mfma_f32_32x32x16_bf16(kf[2],qr[1],C0,0,0,0),   P0[10],P0[11],P0[12],P0[13], pw1[0]=PKW(P0,8), pw1[1]=PKW(P0,10), pw1); \
    VRD(5); SBAR(); GAPA(C1=__builtin_amdgcn_mfma_f32_32x32x16_bf16(kf[3],qr[1],C1,0,0,0),   P0[14],P0[15],P1[0],P1[1],   pw1[2]=PKW(P0,12),pw1[3]=PKW(P0,14), pw1); \
    VRD(2); SBAR(); GAPA(C0=__builtin_amdgcn_mfma_f32_32x32x16_bf16(kf[4],qr[2],C0,0,0,0),   P1[2],P1[3],P1[4],P1[5],     pw2[0]=PKW(P1,0), pw2[1]=PKW(P1,2), pw2); \
    VRD(6); SBAR(); GAPA(C1=__builtin_amdgcn_mfma_f32_32x32x16_bf16(kf[5],qr[2],C1,0,0,0),   P1[6],P1[7],P1[8],P1[9],     pw2[2]=PKW(P1,4), pw2[3]=PKW(P1,6), pw2); \
    VRD(3); SBAR(); GAPA(C0=__builtin_amdgcn_mfma_f32_32x32x16_bf16(kf[6],qr[3],C0,0,0,0),   P1[10],P1[11],P1[12],P1[13], pw3[0]=PKW(P1,8), pw3[1]=PKW(P1,10), pw3); \
    VRD(7); SBAR(); GAPA(C1=__builtin_amdgcn_mfma_f32_32x32x16_bf16(kf[7],qr[3],C1,0,0,0),   P1[14],P1[15],0.f,0.f,       pw3[2]=PKW(P1,12),pw3[3]=PKW(P1,14), pw3); \
    l_reg+=sacc; \
    if(GK){DMA_K((t)+3,sl_cur);} if(GV){DMA_V((t)+1,sl_next);} \
    CMASK(C0,C1,t); \
    { float a=MX3(C0[0],C0[1],C1[0]),b=MX3(C0[2],C0[3],C1[1]); a=MX3(a,C1[2],C1[3]); \
      _Pragma("unroll") for(int r=4;r<16;r+=4){a=MX3(a,C0[r],C0[r+1]);b=MX3(b,C0[r+2],C0[r+3]);a=MX3(a,C1[r],C1[r+1]);b=MX3(b,C1[r+2],C1[r+3]);} \
      float rm=__builtin_fmaxf(a,b); { auto rr=__builtin_amdgcn_permlane32_swap(__float_as_uint(rm),__float_as_uint(rm),false,false); rm=__builtin_fmaxf(__uint_as_float(rr[0]),__uint_as_float(rr[1])); } \
      resc=false; \
      if(__builtin_expect(__any(rm>(float)THRL),0)){ const float dl=__builtin_fmaxf(rm,0.f); mhat+=dl; \
        _Pragma("unroll") for(int r=0;r<16;++r){C0[r]-=dl;C1[r]-=dl;} \
        _Pragma("unroll") for(int r=0;r<16;++r)negm[r]=-mhat; asm volatile("":"+v"(negm)); \
        const float f=__builtin_amdgcn_exp2f(-dl); l_reg*=f; if(hi==0)wsf[r32]=f; resc=true; } } \
    SBAR(); \
    GAPB(o[0]=__builtin_amdgcn_mfma_f32_32x32x16_bf16(PAF(0),VFR(0),o[0],0,0,0), C0,0); \
    GAPB(o[1]=__builtin_amdgcn_mfma_f32_32x32x16_bf16(PAF(0),VFR(4),o[1],0,0,0), C0,4); \
    KRD(GL,0); GAPB(o[0]=__builtin_amdgcn_mfma_f32_32x32x16_bf16(PAF(1),VFR(1),o[0],0,0,0), C0,8); \
    KRD(GL,1); GAPB(o[1]=__builtin_amdgcn_mfma_f32_32x32x16_bf16(PAF(1),VFR(5),o[1],0,0,0), C0,12); \
    KRD(GL,2); GAPB(o[0]=__builtin_amdgcn_mfma_f32_32x32x16_bf16(PAF(2),VFR(2),o[0],0,0,0), C1,0); \
    KRD(GL,3); GAPB(o[1]=__builtin_amdgcn_mfma_f32_32x32x16_bf16(PAF(2),VFR(6),o[1],0,0,0), C1,4); \
    GAPB(o[0]=__builtin_amdgcn_mfma_f32_32x32x16_bf16(PAF(3),VFR(3),o[0],0,0,0), C1,8); \
    GAPB(o[1]=__builtin_amdgcn_mfma_f32_32x32x16_bf16(PAF(3),VFR(7),o[1],0,0,0), C1,12); \
    }while(0)
  int t=1;
  for(;t+5<NT;t+=2){
    STEP(pB0,pB1,pA0,pA1,t,true,true,true);     WAIT_BAR(2); RESC(); ROT();
    STEP(pA0,pA1,pB0,pB1,t+1,true,true,true);   WAIT_BAR(2); RESC(); ROT();
  }
  #define ENDW(tt) do{ if((tt)+3<NT){WAIT_BAR(2);} else if((tt)+2<NT){WAIT_BAR(1);} else {WAIT_BAR(0);} }while(0)
  #define DRAIN(X0,X1) do{ float sacc=X0[0]+X0[1]; _Pragma("unroll") for(int r=2;r<16;++r)sacc+=X0[r]; _Pragma("unroll") for(int r=0;r<16;++r)sacc+=X1[r]; l_reg+=sacc; \
    pw0=(u32x4){PKW(X0,0),PKW(X0,2),PKW(X0,4),PKW(X0,6)};pw1=(u32x4){PKW(X0,8),PKW(X0,10),PKW(X0,12),PKW(X0,14)};pw2=(u32x4){PKW(X1,0),PKW(X1,2),PKW(X1,4),PKW(X1,6)};pw3=(u32x4){PKW(X1,8),PKW(X1,10),PKW(X1,12),PKW(X1,14)}; \
    SBAR(); pv(o,vb0+sl_cur,PAF(0),PAF(1),PAF(2),PAF(3)); }while(0)
  if(NT&1){
    for(;t+2<NT;t+=2){
      STEP(pB0,pB1,pA0,pA1,t,(t+3<NT),(t+1<NT),(t+1<NT));       ENDW(t);   RESC(); ROT();
      STEP(pA0,pA1,pB0,pB1,t+1,(t+4<NT),(t+2<NT),(t+2<NT));     ENDW(t+1); RESC(); ROT();
    }
    STEP(pB0,pB1,pA0,pA1,t,false,true,true); ENDW(t); RESC(); ROT();
    STEP(pA0,pA1,pB0,pB1,NT-1,false,false,false); RESC();
    DRAIN(pA0,pA1);
  } else {
  for(;t+1<NT;t+=2){
    STEP(pB0,pB1,pA0,pA1,t,(t+3<NT),(t+1<NT),(t+1<NT));       ENDW(t);   RESC(); ROT();
    STEP(pA0,pA1,pB0,pB1,t+1,(t+4<NT),(t+2<NT),(t+2<NT));     ENDW(t+1); RESC(); ROT();
  }
  STEP(pB0,pB1,pA0,pA1,NT-1,false,false,false); RESC();
  DRAIN(pB0,pB1);
  }
  #undef DRAIN
  #undef PKW
  #undef PAF
  #undef VFR
  #undef PIN
  #undef MX3
  #undef GAPA
  #undef GAPB
  #undef EX
  #undef VRD
  #undef KRD
  #undef STEP
  #undef ENDW
  {auto rr=__builtin_amdgcn_permlane32_swap(__float_as_uint(l_reg),__float_as_uint(l_reg),false,false);l_reg=__uint_as_float(rr[0])+__uint_as_float(rr[1]);}
  if(MODE==1)l_reg+=__builtin_amdgcn_exp2f(sink_l2-mhat);
  if(hi==0)wsf[32+r32]=l_reg;asm volatile("s_waitcnt lgkmcnt(0)":::"memory");
  float rli[16];
  #pragma unroll
  for(int r=0;r<16;++r)rli[r]=__builtin_amdgcn_rcpf(wsf[32+crow(r,hi)]);
  bf16*Ow=Ow0+(long)wrow*OP+wcol;
  { bf16*stg=(bf16*)(shm+LDS_OST)+wid*2048;
    #pragma unroll
    for(int r=0;r<16;++r){const int orow=crow(r,hi);
      #pragma unroll
      for(int d0=0;d0<2;++d0)stg[orow*64+d0*32+r32]=__float2bfloat16(o[d0][r]*rli[r]);}
    asm volatile("s_waitcnt lgkmcnt(0)":::"memory");
    #pragma unroll
    for(int i=0;i<4;++i){const int row=i*8+(lane>>3),ch=lane&7; const u32x4 v=*(const u32x4*)(stg+row*64+ch*8); ATTN_STORE16(Ow+(long)row*OP+ch*8,v);} }
  asm volatile("s_waitcnt lgkmcnt(0)\n\ts_barrier":::"memory");
  #undef DMA_K
  #undef TROW
  #undef DMA_V
  #undef CMASK
  #undef START
  #undef RESC
  #undef ROT
}
constexpr int ATTN_LDS_BYTES=LDS_BYTES;
#undef SBAR
#undef WAIT_BAR
}
namespace attn_body {
constexpr int X_K=0, X_V=3*8192, X_WS=X_V+3*16384, X_OST=X_WS+NW*64*4, X_BYTES=X_OST+NW*8192;
#define SBAR() __builtin_amdgcn_sched_barrier(0)
#define WAIT_BAR(N) asm volatile("s_waitcnt vmcnt(" #N ") lgkmcnt(0)\n\ts_barrier":::"memory")
__device__ __forceinline__ void pv128(f32x16*o,int vb,bf16x8 pa0,bf16x8 pa1,bf16x8 pa2,bf16x8 pa3){
  #pragma unroll
  for(int d0=0;d0<4;++d0){s16x4 lo[4],hi[4];
    #pragma unroll
    for(int ks=0;ks<4;++ks){
      asm volatile("ds_read_b64_tr_b16 %0,%1 offset:%c2":"=&v"(lo[ks]):"v"(vb),"i"(d0*4096+ks*1024):"memory");
      asm volatile("ds_read_b64_tr_b16 %0,%1 offset:%c2":"=&v"(hi[ks]):"v"(vb),"i"(d0*4096+ks*1024+512):"memory");}
    asm volatile("s_waitcnt lgkmcnt(0)":::"memory");SBAR();
    #define PK(k) (bf16x8){lo[k][0],lo[k][1],lo[k][2],lo[k][3],hi[k][0],hi[k][1],hi[k][2],hi[k][3]}
    o[d0]=__builtin_amdgcn_mfma_f32_32x32x16_bf16(pa0,PK(0),o[d0],0,0,0);
    o[d0]=__builtin_amdgcn_mfma_f32_32x32x16_bf16(pa1,PK(1),o[d0],0,0,0);
    o[d0]=__builtin_amdgcn_mfma_f32_32x32x16_bf16(pa2,PK(2),o[d0],0,0,0);
    o[d0]=__builtin_amdgcn_mfma_f32_32x32x16_bf16(pa3,PK(3),o[d0],0,0,0);
    #undef PK
  }
}
template<int THRL,int EPI> __device__ __forceinline__ void attn_unit128(const bf16*Qw0,int QP,const bf16*__restrict__ Kh,int KP,const bf16*__restrict__ Vh,int VP,bf16*Ow0,int OP,int NT,float lam,const float*gsub,char*shm){
  const int tid=threadIdx.x,lane=tid&63,r32=lane&31,hi=lane>>5; const int wid=__builtin_amdgcn_readfirstlane(tid>>6);
  const bf16*Qw=Qw0+(long)(wid*QBLK)*QP;
  const unsigned lds0=(unsigned)(uintptr_t)shm;
  float*wsf=(float*)(shm+X_WS)+wid*64;
  const bf16*ksrc=Kh+(long)lane*KP+wid*8;
  const bf16*vsrc=Vh+(long)(16*(wid&3)+(lane>>2))*VP+(wid>>2)*32+(lane&3)*8;
  const unsigned kdst=lds0+X_K+wid*1024, vdst=lds0+X_V+wid*1024;
  #define DMA_K(t,slot) glds16(ksrc+(long)(t)*KVBLK*KP,(unsigned)__builtin_amdgcn_readfirstlane(kdst+(slot)))
  #define DMA_V(t,slot) do{ glds16(vsrc+(long)(t)*KVBLK*VP,(unsigned)__builtin_amdgcn_readfirstlane(vdst+2*(slot))); glds16(vsrc+(long)(t)*KVBLK*VP+64,(unsigned)__builtin_amdgcn_readfirstlane(vdst+2*(slot)+8192)); }while(0)
  const char*Kbase=shm+X_K; bf16x8 kf[8];
  const lds_cptr shm3=(lds_cptr)shm; const lds_cptr kp0=shm3+X_K+hi*1024+r32*16; const lds_cptr vp0=shm3+X_V+((lane>>4)&1)*32+(lane&3)*8+(4*hi+((lane&15)>>2))*64;
  DMA_K(0,0);DMA_V(0,0);DMA_K(1,SLOTB);
  bf16x8 qr[4];
  #pragma unroll
  for(int d0=0;d0<4;++d0)qr[d0]=*reinterpret_cast<const bf16x8*>(&Qw[(long)r32*QP+d0*16+hi*8]);
  float mhat=0.f,l_reg=0.f;f32x16 o[4];o[0]=f32x16{};o[1]=f32x16{};o[2]=f32x16{};o[3]=f32x16{};f32x16 negm=f32x16{};asm volatile("":"+v"(negm));
  bool resc=false;
  #define START(P0,P1) do{ const float rm=rowmax(P0,P1); resc=false; \
    { const float dl=rm; mhat=fadd_s(mhat,dl); \
      _Pragma("unroll") for(int r=0;r<16;++r){P0[r]=fsub_s(P0[r],dl);P1[r]=fsub_s(P1[r],dl);} \
      _Pragma("unroll") for(int r=0;r<16;++r)negm[r]=-mhat; asm volatile("":"+v"(negm)); } \
    _Pragma("unroll") for(int r=0;r<16;++r)P0[r]=__builtin_amdgcn_exp2f(P0[r]); }while(0)
  #define RESC() do{ if(resc){ asm volatile("s_waitcnt lgkmcnt(0)":::"memory"); \
      _Pragma("unroll") for(int d_=0;d_<4;++d_) _Pragma("unroll") for(int r=0;r<16;++r)o[d_][r]*=wsf[crow(r,hi)]; } }while(0)
  f32x16 pC0,pC1;
  int sl_prev=0,sl_cur=0,sl_next=SLOTB;
  #define ROT() do{sl_prev=sl_cur;sl_cur=sl_next;sl_next=(sl_next==(NSLOT-1)*SLOTB)?0:sl_next+SLOTB;}while(0)
  DMA_K(2,2*SLOTB);
  WAIT_BAR(3);
  s16x4 vlo[6],vhi[6]; u32x4 pw0,pw1,pw2,pw3;
  #define PKW(P,B) cvtpk_s(P[B],P[B+1])
  #define PAF(k) __builtin_bit_cast(bf16x8,pw##k)
  #define VFR(i) (bf16x8){vlo[i][0],vlo[i][1],vlo[i][2],vlo[i][3],vhi[i][0],vhi[i][1],vhi[i][2],vhi[i][3]}
  #define PIN(x) asm volatile("":"+v"(x))
  #define MX3(a,b,c) __builtin_fmaxf(__builtin_fmaxf((a),(b)),(c))
  #define EX(v) __builtin_amdgcn_exp2f(v)
  qkt(pC0,pC1,Kbase,qr,negm,r32,hi);asm volatile("s_nop 15\n\ts_nop 7":"+v"(pC0),"+v"(pC1));
  START(pC0,pC1);
  _Pragma("unroll") for(int r=0;r<16;++r)pC1[r]=__builtin_amdgcn_exp2f(pC1[r]);
  { float sacc=pC0[0]+pC0[1]; _Pragma("unroll") for(int r=2;r<16;++r)sacc+=pC0[r]; _Pragma("unroll") for(int r=0;r<16;++r)sacc+=pC1[r]; l_reg+=sacc;
    pw0=(u32x4){PKW(pC0,0),PKW(pC0,2),PKW(pC0,4),PKW(pC0,6)};pw1=(u32x4){PKW(pC0,8),PKW(pC0,10),PKW(pC0,12),PKW(pC0,14)};pw2=(u32x4){PKW(pC1,0),PKW(pC1,2),PKW(pC1,4),PKW(pC1,6)};pw3=(u32x4){PKW(pC1,8),PKW(pC1,10),PKW(pC1,12),PKW(pC1,14)}; }
  WAIT_BAR(0);
  DMA_K(3,0);DMA_V(1,SLOTB);
  ROT();
  kload8(kf,kp0+sl_cur);
  WAIT_BAR(3);
  #define VRDG(i,ks,d0) do{ vlo[i]=vtr(vp_+((d0)*4096+(ks)*1024)); vhi[i]=vtr(vp_+((d0)*4096+(ks)*1024+512)); }while(0)
  #define KRD(G,j) do{ if(G){ kload2(kf,kp0+sl_next,j); } }while(0)
  #define GA(i,ks,d0,MF) do{ VRDG(i,ks,d0); SBAR(); MF; SBAR(); }while(0)
  #define GN(MF) do{ MF; SBAR(); }while(0)
  #define GB0(MF,X,B,RL) do{ MF; X[B]=EX(X[B]); X[B+1]=EX(X[B+1]); PIN(X); RL; SBAR(); }while(0)
  #define GB1(MF,X,B,Y,C,PW,J,RL) do{ MF; X[B]=EX(X[B]); X[B+1]=EX(X[B+1]); PIN(X); sacc+=Y[C]; sacc+=Y[C+1]; PIN(sacc); PW[J]=PKW(Y,C); PIN(PW); RL; SBAR(); }while(0)
  #define PVM(d0,k,i) o[d0]=__builtin_amdgcn_mfma_f32_32x32x16_bf16(PAF(k),VFR(i),o[d0],0,0,0)
  #define STEP(t,GK,GV,GL) do{ SBAR(); \
    const lds_cptr vp_=vp0+2*sl_prev; \
    GN(pC0=__builtin_amdgcn_mfma_f32_32x32x16_bf16(kf[0],qr[0],negm,0,0,0)); \
    GN(pC1=__builtin_amdgcn_mfma_f32_32x32x16_bf16(kf[1],qr[0],negm,0,0,0)); \
    GA(0,0,0,pC0=__builtin_amdgcn_mfma_f32_32x32x16_bf16(kf[2],qr[1],pC0,0,0,0)); \
    GA(1,0,1,pC1=__builtin_amdgcn_mfma_f32_32x32x16_bf16(kf[3],qr[1],pC1,0,0,0)); \
    GA(2,0,2,pC0=__builtin_amdgcn_mfma_f32_32x32x16_bf16(kf[4],qr[2],pC0,0,0,0)); \
    GA(3,0,3,pC1=__builtin_amdgcn_mfma_f32_32x32x16_bf16(kf[5],qr[2],pC1,0,0,0)); \
    GA(4,1,0,pC0=__builtin_amdgcn_mfma_f32_32x32x16_bf16(kf[6],qr[3],pC0,0,0,0)); \
    GA(5,1,1,pC1=__builtin_amdgcn_mfma_f32_32x32x16_bf16(kf[7],qr[3],pC1,0,0,0)); \
    if(GK){DMA_K((t)+3,sl_cur);} if(GV){DMA_V((t)+1,sl_next);} \
    { float a=MX3(pC0[0],pC0[1],pC1[0]),b=MX3(pC0[2],pC0[3],pC1[1]); a=MX3(a,pC1[2],pC1[3]); \
      _Pragma("unroll") for(int r=4;r<16;r+=4){a=MX3(a,pC0[r],pC0[r+1]);b=MX3(b,pC0[r+2],pC0[r+3]);a=MX3(a,pC1[r],pC1[r+1]);b=MX3(b,pC1[r+2],pC1[r+3]);} \
      float rm=__builtin_fmaxf(a,b); { auto rr=__builtin_amdgcn_permlane32_swap(__float_as_uint(rm),__float_as_uint(rm),false,false); rm=__builtin_fmaxf(__uint_as_float(rr[0]),__uint_as_float(rr[1])); } \
      resc=false; \
      if(__builtin_expect(__any(rm>(float)THRL),0)){ const float dl=__builtin_fmaxf(rm,0.f); mhat+=dl; \
        _Pragma("unroll") for(int r=0;r<16;++r){pC0[r]-=dl;pC1[r]-=dl;} \
        _Pragma("unroll") for(int r=0;r<16;++r)negm[r]=-mhat; asm volatile("":"+v"(negm)); \
        const float f=__builtin_amdgcn_exp2f(-dl); l_reg*=f; if(hi==0)wsf[r32]=f; resc=true; } } \
    SBAR(); \
    float sacc=0.f; \
    GB0(PVM(0,0,0),pC0,0, VRDG(0,1,2)); \
    GB0(PVM(1,0,1),pC0,2, VRDG(1,1,3)); \
    GB0(PVM(2,0,2),pC0,4, VRDG(2,2,0)); \
    GB0(PVM(3,0,3),pC0,6, VRDG(3,2,1)); \
    GB1(PVM(0,1,4),pC0,8, pC0,0,pw0,0, VRDG(4,2,2)); \
    GB1(PVM(1,1,5),pC0,10, pC0,2,pw0,1, VRDG(5,2,3)); \
    GB1(PVM(2,1,0),pC0,12, pC0,4,pw0,2, VRDG(0,3,0)); \
    GB1(PVM(3,1,1),pC0,14, pC0,6,pw0,3, VRDG(1,3,1)); \
    GB1(PVM(0,2,2),pC1,0, pC0,8,pw1,0, VRDG(2,3,2)); \
    GB1(PVM(1,2,3),pC1,2, pC0,10,pw1,1, VRDG(3,3,3)); \
    GB1(PVM(2,2,4),pC1,4, pC0,12,pw1,2, (void)0); \
    GB1(PVM(3,2,5),pC1,6, pC0,14,pw1,3, (void)0); \
    GB1(PVM(0,3,0),pC1,8, pC1,0,pw2,0, KRD(GL,0)); \
    GB1(PVM(1,3,1),pC1,10, pC1,2,pw2,1, KRD(GL,1)); \
    GB1(PVM(2,3,2),pC1,12, pC1,4,pw2,2, KRD(GL,2)); \
    GB1(PVM(3,3,3),pC1,14, pC1,6,pw2,3, KRD(GL,3)); \
    sacc+=pC1[8];sacc+=pC1[9];pw3[0]=PKW(pC1,8); sacc+=pC1[10];sacc+=pC1[11];pw3[1]=PKW(pC1,10); sacc+=pC1[12];sacc+=pC1[13];pw3[2]=PKW(pC1,12); sacc+=pC1[14];sacc+=pC1[15];pw3[3]=PKW(pC1,14); \
    l_reg+=sacc; PIN(pw3); \
    }while(0)
  int t=1;
  for(;t+5<NT;t+=2){
    STEP(t,true,true,true);     WAIT_BAR(3); RESC(); ROT();
    STEP(t+1,true,true,true);   WAIT_BAR(3); RESC(); ROT();
  }
  #define ENDW(tt) do{ if((tt)+3<NT){WAIT_BAR(3);} else if((tt)+2<NT){WAIT_BAR(2);} else {WAIT_BAR(0);} }while(0)
  for(;t+1<NT;t+=2){
    STEP(t,(t+3<NT),(t+1<NT),(t+1<NT));       ENDW(t);   RESC(); ROT();
    STEP(t+1,(t+4<NT),(t+2<NT),(t+2<NT));     ENDW(t+1); RESC(); ROT();
  }
  STEP(NT-1,false,false,false); RESC();
  SBAR(); pv128(o,(int)(unsigned)(uintptr_t)vp0+2*sl_cur,PAF(0),PAF(1),PAF(2),PAF(3));
  #undef PKW
  #undef PAF
  #undef VFR
  #undef PIN
  #undef MX3
  #undef EX
  #undef VRDG
  #undef KRD
  #undef GA
  #undef GN
  #undef GB0
  #undef GB1
  #undef PVM
  #undef STEP
  #undef ENDW
  {auto rr=__builtin_amdgcn_permlane32_swap(__float_as_uint(l_reg),__float_as_uint(l_reg),false,false);l_reg=__uint_as_float(rr[0])+__uint_as_float(rr[1]);}
  if(hi==0)wsf[32+r32]=l_reg;asm volatile("s_waitcnt lgkmcnt(0)":::"memory");
  float rli[16];
  #pragma unroll
  for(int r=0;r<16;++r)rli[r]=__builtin_amdgcn_rcpf(wsf[32+crow(r,hi)]);
  bf16*Ow=Ow0+(long)(wid*QBLK)*OP;
  { bf16*stg=(bf16*)(shm+X_OST)+wid*4096;
    if(EPI==2){
      float gl[4];
      #pragma unroll
      for(int d0=0;d0<4;++d0)gl[d0]=gsub[d0*32+r32];
      #pragma unroll
      for(int r=0;r<16;++r){const int orow=crow(r,hi); float ss=0.f;
        #pragma unroll
        for(int d0=0;d0<4;++d0){const float dd=__bfloat162float(stg[orow*128+d0*32+r32])-lam*(o[d0][r]*rli[r]); o[d0][r]=dd; ss+=dd*dd;}
        ss+=dpp_f<0xB1>(ss);ss+=dpp_f<0x4E>(ss);ss+=dpp_f<0x141>(ss);ss+=dpp_f<0x140>(ss);ss=swap16_sum(ss,ss);
        const float rs=0.8f/sqrtf(ss*(1.f/128.f)+1e-6f);
        #pragma unroll
        for(int d0=0;d0<4;++d0)stg[orow*128+d0*32+r32]=__float2bfloat16(o[d0][r]*rs*gl[d0]);}
    } else {
    #pragma unroll
    for(int r=0;r<16;++r){const int orow=crow(r,hi);
      #pragma unroll
      for(int d0=0;d0<4;++d0)stg[orow*128+d0*32+r32]=__float2bfloat16(o[d0][r]*rli[r]);}
    }
    asm volatile("s_waitcnt lgkmcnt(0)":::"memory");
    if(EPI!=1){
    #pragma unroll
    for(int i=0;i<8;++i){const int row=i*4+(lane>>4),ch=lane&15; const u32x4 v=*(const u32x4*)(stg+row*128+ch*8); ATTN_STORE16(Ow+(long)row*OP+ch*8,v);} } }
  asm volatile("s_waitcnt lgkmcnt(0)\n\ts_barrier":::"memory");
  #undef DMA_K
  #undef DMA_V
  #undef START
  #undef RESC
  #undef ROT
}
#undef SBAR
#undef WAIT_BAR
}

typedef unsigned u32x2f __attribute__((ext_vector_type(2)));
constexpr int NWAVES = 8;
constexpr int LDS_BYTES = 147456;
__device__ __forceinline__ float wave_sum(float v) {
    v += dpp_f<0xB1>(v);
    v += dpp_f<0x4E>(v);
    v += dpp_f<0x141>(v);
    v += dpp_f<0x140>(v);
    v = swap16_sum(v, v); v = swap32_sum(v, v);
    return v;
}
__device__ __forceinline__ float bf2f(unsigned short h) { return __uint_as_float((unsigned)h << 16); }
__device__ __forceinline__ float silu_d(float v) { return v / (1.f + __expf(-v)); }

__device__ __forceinline__ void titem_load(const float* src, int ldw, f32x4 (&r)[8], int lane) {
#pragma unroll
    for (int i = 0; i < 8; ++i) r[i] = *(const GAS f32x4*)(src + (size_t)(8 * i + (lane >> 3)) * ldw + 4 * (lane & 7));
}
__device__ __forceinline__ void titem_finish(const f32x4 (&r)[8], bf16* dst, LAS float* scr, int lane) {
#pragma unroll
    for (int i = 0; i < 8; ++i) { LAS float* p = scr + (8 * i + (lane >> 3)) * 33 + 4 * (lane & 7); p[0] = r[i].x; p[1] = r[i].y; p[2] = r[i].z; p[3] = r[i].w; }
    LDS_WAIT(); asm volatile("" ::: "memory");
    const int c = lane & 7;
#pragma unroll
    for (int j = 0; j < 4; ++j) { const int n = (lane >> 3) + 8 * j; const LAS float* q = scr + (8 * c) * 33 + n;
        v4u o; o.x = pk2(q[0 * 33], q[1 * 33]); o.y = pk2(q[2 * 33], q[3 * 33]); o.z = pk2(q[4 * 33], q[5 * 33]); o.w = pk2(q[6 * 33], q[7 * 33]);
        *(GAS v4u*)(dst + (size_t)n * 1024 + 8 * c) = o; }
    LDS_WAIT(); asm volatile("" ::: "memory");
}
__device__ __forceinline__ void titem_finish8(const f32x4 (&r)[8], unsigned char* dst8, LAS float* scr, int lane) {
#pragma unroll
    for (int i = 0; i < 8; ++i) { LAS float* p = scr + (8 * i + (lane >> 3)) * 33 + 4 * (lane & 7); p[0] = r[i].x; p[1] = r[i].y; p[2] = r[i].z; p[3] = r[i].w; }
    LDS_WAIT(); asm volatile("" ::: "memory");
    const int c = lane & 7;
#pragma unroll
    for (int j = 0; j < 4; ++j) { const int n = (lane >> 3) + 8 * j; const LAS float* q = scr + (8 * c) * 33 + n;
        u32x2f o; o.x = pg8::pk4_fp8(q[0 * 33] * pg8::W8_SCALE, q[1 * 33] * pg8::W8_SCALE, q[2 * 33] * pg8::W8_SCALE, q[3 * 33] * pg8::W8_SCALE);
        o.y = pg8::pk4_fp8(q[4 * 33] * pg8::W8_SCALE, q[5 * 33] * pg8::W8_SCALE, q[6 * 33] * pg8::W8_SCALE, q[7 * 33] * pg8::W8_SCALE);
        *(GAS u32x2f*)(dst8 + (size_t)n * 1024 + 8 * c) = o; }
    LDS_WAIT(); asm volatile("" ::: "memory");
}
constexpr int CONV_ND = 2048 + 512 + 768 + 512, CONV_NM = 16 * 3 * 512;
#define CONV_DESC(MODE, it, src, ldw, dst) do { int r_ = (it); \
    if ((MODE) == 0) { \
        if (r_ < 2048) { const int kb = r_ >> 7, nb = r_ & 127; src = win + (size_t)(64 * kb) * 4096 + 32 * nb; ldw = 4096; dst = (bf16*)(ws + WS_WIN) + (size_t)(32 * nb) * 1024 + 64 * kb; } \
        else if (r_ < 2560) { r_ -= 2048; const int kb = r_ >> 5, nb = r_ & 31; src = wout0 + (size_t)(64 * kb) * 1024 + 32 * nb; ldw = 1024; dst = (bf16*)(ws + WS_WOE) + (size_t)(32 * nb) * 1024 + 64 * kb; } \
        else if (r_ < 3328) { r_ -= 2560; const int kb = r_ / 48, nb = r_ % 48; src = wqkv + (size_t)(64 * kb) * 1536 + 32 * nb; ldw = 1536; dst = (bf16*)(ws + WS_WQKV) + (size_t)(32 * nb) * 1024 + 64 * kb; } \
        else { r_ -= 3328; const int kb = r_ >> 5, nb = r_ & 31; src = wout1 + (size_t)(64 * kb) * 1024 + 32 * nb; ldw = 1024; dst = (bf16*)(ws + WS_WOO) + (size_t)(32 * nb) * 1024 + 64 * kb; } \
    } else { const int im = r_; const size_t wo = (MODE) == 3 ? 0 : (size_t)16 * 1024 * 1024; \
        const int e = im / 1536, rem = im % 1536, which = rem >> 9, item = rem & 511, kb = item >> 5, nb = item & 31; \
        const float* W = (which == 0 ? mg : which == 1 ? mu : md) + wo; \
        src = W + ((size_t)e * 1024 + 64 * kb) * 1024 + 32 * nb; ldw = 1024; \
        unsigned char* W13 = ws + ((MODE) == 3 ? WS_MOE0_13 : WS_MOE1_13); unsigned char* W2 = ws + ((MODE) == 3 ? WS_MOE0_2 : WS_MOE1_2);     \
        dst = (bf16*)(which < 2 ? W13 + ((size_t)e * 2048 + (nb >> 2) * 256 + which * 128 + (nb & 3) * 32) * 1024 + 64 * kb : W2 + ((size_t)e * 1024 + 32 * nb) * 1024 + 64 * kb); } } while (0)
template <int MODE> __device__ __forceinline__ void conv_loop(const float* win, const float* wout0, const float* wqkv, const float* wout1, const float* mg, const float* mu, const float* md,
                                                            unsigned char* ws, int first, int stride, LAS float* scr, int lane) {
    const int total = MODE == 0 ? CONV_ND : CONV_NM; int it = first; if (it >= total) return;
    f32x4 r0[8], r1[8], r2[8], r3[8]; const float* s_; int ldw; bf16 *d0, *d1, *d2, *d3;
#define CONV_ISSUE(R, D, idx) do { if ((idx) < total) { CONV_DESC(MODE, (idx), s_, ldw, D); titem_load(s_, ldw, R, lane); } } while (0)
#define CONV_FIN(R, D) do { if constexpr (MODE == 0) titem_finish(R, D, scr, lane); else titem_finish8(R, (unsigned char*)D, scr, lane); } while (0)
    CONV_ISSUE(r0, d0, it); CONV_ISSUE(r1, d1, it + stride); CONV_ISSUE(r2, d2, it + 2 * stride);
    for (;;) {
        CONV_ISSUE(r3, d3, it + 3 * stride); CONV_FIN(r0, d0); if (it + stride >= total) break;
        CONV_ISSUE(r0, d0, it + 4 * stride); CONV_FIN(r1, d1); if (it + 2 * stride >= total) break;
        CONV_ISSUE(r1, d1, it + 5 * stride); CONV_FIN(r2, d2); if (it + 3 * stride >= total) break;
        CONV_ISSUE(r2, d2, it + 6 * stride); CONV_FIN(r3, d3); if (it + 4 * stride >= total) break;
        it += 4 * stride;
    }
#undef CONV_ISSUE
#undef CONV_FIN
}

__device__ __forceinline__ void normmod_row(f32x4 (&v)[4], const float* g, const float* sc, const float* sh, int lane) {
    float s2 = 0.f;
#pragma unroll
    for (int j = 0; j < 4; ++j) s2 += (v[j].x * v[j].x + v[j].y * v[j].y) + (v[j].z * v[j].z + v[j].w * v[j].w);
    const float rstd = __builtin_amdgcn_rsqf(wave_sum(s2) * (1.f / 1024.f) + EPS_);
#pragma unroll
    for (int j = 0; j < 4; ++j) { const f32x4 gv = *((const f32x4*)g + 64 * j + lane), scv = *((const f32x4*)sc + 64 * j + lane), shv = *((const f32x4*)sh + 64 * j + lane);
        v[j] = v[j] * rstd * gv * (1.f + scv) + shv; }
}
__device__ __forceinline__ void store_row_bf16(const f32x4 (&v)[4], bf16* orow, int lane) {
    GAS unsigned long long* o8 = (GAS unsigned long long*)orow + lane;
#pragma unroll
    for (int j = 0; j < 4; ++j) o8[64 * j] = (unsigned long long)pk2(v[j].x, v[j].y) | ((unsigned long long)pk2(v[j].z, v[j].w) << 32);
}
__device__ __forceinline__ void load_row_b16(f32x4 (&v)[4], const bf16* xrow, int lane) {
    const u32x2f* xr = (const u32x2f*)xrow + lane;
#pragma unroll
    for (int j = 0; j < 4; ++j) { const u32x2f w = xr[64 * j]; v[j].x = __uint_as_float(w.x << 16); v[j].y = __uint_as_float(w.x & 0xffff0000u); v[j].z = __uint_as_float(w.y << 16); v[j].w = __uint_as_float(w.y & 0xffff0000u); }
}
__device__ __forceinline__ void load_row_f32(f32x4 (&v)[4], const float* xrow, int lane) {
    const f32x4* xr = (const f32x4*)xrow + lane;
#pragma unroll
    for (int j = 0; j < 4; ++j) v[j] = xr[64 * j];
}
__device__ __forceinline__ void add_moe_rows(f32x4 (&v)[4], const bf16* y0, const bf16* y1, const float* gate, int lane) {
#pragma unroll
    for (int j = 0; j < 4; ++j) { const u32x2f a = *((const u32x2f*)y0 + 64 * j + lane), b = *((const u32x2f*)y1 + 64 * j + lane); const f32x4 gv = *((const f32x4*)gate + 64 * j + lane);
        f32x4 f; f.x = __uint_as_float(a.x << 16) + __uint_as_float(b.x << 16); f.y = __uint_as_float(a.x & 0xffff0000u) + __uint_as_float(b.x & 0xffff0000u);
        f.z = __uint_as_float(a.y << 16) + __uint_as_float(b.y << 16); f.w = __uint_as_float(a.y & 0xffff0000u) + __uint_as_float(b.y & 0xffff0000u);
        v[j] = v[j] + gv * f; }
}

typedef float f32x2g __attribute__((ext_vector_type(2)));
typedef float f32x4g __attribute__((ext_vector_type(4)));
constexpr int HG_QI = 0, HG_QN = 17408, HG_KO = 34816, HG_VT = 52224, HG_SC = 70656, HG_ST = 79872, HG_SCR = 114688;
constexpr int HG_LDQ = 272, HG_LDT = 144;
typedef short hbf16x8 __attribute__((ext_vector_type(8)));
typedef float hf32x4 __attribute__((ext_vector_type(4)));
__device__ __forceinline__ int hg_chunk(int dir, int j) { return dir == 0 ? j : (j < 4 ? 3 - j : 135 - j); }
__device__ __forceinline__ void hg_scan(int dir, int dk, int tq, LAS float* scr, const float (&v)[16], float (&cum)[16], float& tot, float& ref) {
    float c[16]; float run = 0.f;
#pragma unroll
    for (int i = 0; i < 16; ++i) { run += v[i]; c[i] = run; }
    scr[tq * 128 + dk] = run;
    __syncthreads();
    const float q0 = scr[dk], q1 = scr[128 + dk], q2 = scr[256 + dk], q3 = scr[384 + dk];
    tot = (q0 + q1) + (q2 + q3);
    if (dir == 0) { const float off = (tq > 0 ? q0 : 0.f) + (tq > 1 ? q1 : 0.f) + (tq > 2 ? q2 : 0.f);
#pragma unroll
        for (int i = 0; i < 16; ++i) cum[i] = c[i] + off;
        ref = q0 + q1; }
    else { const float off = (tq < 3 ? q3 : 0.f) + (tq < 2 ? q2 : 0.f) + (tq < 1 ? q1 : 0.f);
#pragma unroll
        for (int i = 0; i < 16; ++i) cum[i] = (run - c[i] + v[i]) + off;
        ref = q2 + q3; }
    __syncthreads();
}
__device__ __forceinline__ void hg_ld16(const unsigned short* p, int tid, unsigned (&w)[8]) {
    const int c = tid & 127, tq = tid >> 7;
#pragma unroll
    for (int i = 0; i < 8; ++i) { const unsigned lo = p[(size_t)(16 * tq + 2 * i) * 512 + c], hi = p[(size_t)(16 * tq + 2 * i + 1) * 512 + c]; w[i] = lo | (hi << 16); }
}
__device__ __forceinline__ float h2f(unsigned short h) { return (float)__builtin_bit_cast(_Float16, h); }
__device__ __forceinline__ void hg_store_vt(const unsigned (&w)[8], LAS unsigned char* L, int tid) {
    const int dv = tid & 127, tq = tid >> 7;
    LAS v4u* d = (LAS v4u*)(L + HG_VT + dv * HG_LDT + tq * 32);
    d[0] = (v4u){w[0], w[1], w[2], w[3]}; d[1] = (v4u){w[4], w[5], w[6], w[7]};
}
__device__ __forceinline__ void hgrn_pass1(int first, int stride, int total, const _Float16* LFF, const _Float16* LFB, const bf16* IV, unsigned char* U, float* TOT, LAS unsigned char* L, int tid, int wave, int lane) {
    const int dk = tid & 127, tq = tid >> 7, fr = lane & 15, fq = lane >> 4;
    unsigned nlf[8], niv[8];
#define HG1_LOAD(u_) do { const int j_ = (u_) % NCHUNK, sq_ = (u_) / NCHUNK, dir_ = sq_ >> 3, b_ = (sq_ >> 2) & 1, h_ = sq_ & 3; const size_t r0_ = (size_t)b_ * SB + 64 * j_; \
        hg_ld16((const unsigned short*)((dir_ ? LFB : LFF) + r0_ * 512 + h_ * 128), tid, nlf); hg_ld16(IV + r0_ * 512 + h_ * 128, tid, niv); } while (0)
    if (first < total) HG1_LOAD(first);
    for (int u = first; u < total; u += stride) {
        const int j = u % NCHUNK, sq = u / NCHUNK, dir = sq >> 3;
        const int n = hg_chunk(dir, j);
        float v[16]; unsigned iv[8];
#pragma unroll
        for (int i = 0; i < 8; ++i) { v[2 * i] = h2f((unsigned short)(nlf[i] & 0xffffu)); v[2 * i + 1] = h2f((unsigned short)(nlf[i] >> 16)); iv[i] = niv[i]; }
        if (u + stride < total) HG1_LOAD(u + stride);
        float cum[16], tot, ref;
        hg_scan(dir, dk, tq, (LAS float*)(L + HG_SCR), v, cum, tot, ref);
        unsigned w[8];
#pragma unroll
        for (int i = 0; i < 8; ++i) { const float k0 = (1.f - __expf(v[2 * i])) * __expf(tot - cum[2 * i]), k1 = (1.f - __expf(v[2 * i + 1])) * __expf(tot - cum[2 * i + 1]); w[i] = pk2(k0, k1); }
        { LAS v4u* d = (LAS v4u*)(L + HG_QI + dk * HG_LDT + tq * 32); d[0] = (v4u){w[0], w[1], w[2], w[3]}; d[1] = (v4u){w[4], w[5], w[6], w[7]}; }
        if (tq == 0) TOT[((size_t)sq * NCHUNK + n) * 128 + dk] = tot;
        hg_store_vt(iv, L, tid);
        __syncthreads();
        hf32x4 acc[8];
#pragma unroll
        for (int nt = 0; nt < 8; ++nt) acc[nt] = (hf32x4){0.f, 0.f, 0.f, 0.f};
#pragma unroll
        for (int kk = 0; kk < 2; ++kk) { const hbf16x8 A = *(const LAS hbf16x8*)(L + HG_QI + (16 * wave + fr) * HG_LDT + kk * 64 + fq * 16);
#pragma unroll
            for (int nt = 0; nt < 8; ++nt) { const hbf16x8 B = *(const LAS hbf16x8*)(L + HG_VT + (16 * nt + fr) * HG_LDT + kk * 64 + fq * 16);
                acc[nt] = __builtin_amdgcn_mfma_f32_16x16x32_bf16(A, B, acc[nt], 0, 0, 0); } }
        unsigned char* up = U + ((size_t)sq * NCHUNK + n) * 16384 + 16 * wave + 4 * fq;
#pragma unroll
        for (int nt = 0; nt < 8; ++nt) *(unsigned*)(up + (size_t)(16 * nt + fr) * 128) = pg8::pk4_fp8(acc[nt][0], acc[nt][1], acc[nt][2], acc[nt][3]);
        __syncthreads();
    }
#undef HG1_LOAD
}
__device__ __forceinline__ void hgrn_pass2(const unsigned char* U, const float* TOT, unsigned char* S, int gtid, int nthreads) {
    for (int idx = gtid; idx < 16 * 4096; idx += nthreads) {
        const int sq = idx >> 12, p = idx & 4095;
        const unsigned* up = (const unsigned*)(U + (size_t)sq * NCHUNK * 16384) + p; unsigned* sp = (unsigned*)(S + (size_t)sq * NCHUNK * 16384) + p;
        const f32x4g* tp = (const f32x4g*)(TOT + (size_t)sq * NCHUNK * 128) + (p & 31);
        float s0 = 0.f, s1 = 0.f, s2 = 0.f, s3 = 0.f;
        for (int n = 0; n < NCHUNK; n += 22) {
            unsigned uu[22]; f32x4g tt[22];
#pragma unroll
            for (int k = 0; k < 22; ++k) { uu[k] = up[(size_t)(n + k) * 4096]; tt[k] = tp[(size_t)(n + k) * 32]; }
#pragma unroll
            for (int k = 0; k < 22; ++k) { sp[(size_t)(n + k) * 4096] = pg8::pk4_fp8(s0, s1, s2, s3);
                const f32x2g lo = __builtin_amdgcn_cvt_pk_f32_fp8((int)uu[k], false), hi = __builtin_amdgcn_cvt_pk_f32_fp8((int)uu[k], true);
                s0 = __expf(tt[k].x) * s0 + lo.x; s1 = __expf(tt[k].y) * s1 + lo.y; s2 = __expf(tt[k].z) * s2 + hi.x; s3 = __expf(tt[k].w) * s3 + hi.y; }
        }
    }
}
__device__ __forceinline__ void hg3_dir(int dir, const float (&v)[16], const float (&qv)[16], const v4u (&st)[2], hf32x4 (&acc)[4], LAS unsigned char* L, int tid, int wave, int lane) {
    const int dk = tid & 127, tq = tid >> 7, fr = lane & 15, fq = lane >> 4, mt_o = wave & 3, ntb = 4 * (wave >> 2);
    float cum[16], tot, ref;
    hg_scan(dir, dk, tq, (LAS float*)(L + HG_SCR), v, cum, tot, ref);
#pragma unroll
    for (int i = 0; i < 16; ++i) { const int t = 16 * tq + i;
        const float qi = qv[i] * __expf(cum[i] - ref), qn = qv[i] * __expf(cum[i]), ko = (1.f - __expf(v[i])) * __expf(ref - cum[i]);
        *(LAS unsigned short*)(L + HG_QI + t * HG_LDQ + dk * 2) = (unsigned short)f2bf(qi);
        *(LAS unsigned short*)(L + HG_QN + t * HG_LDQ + dk * 2) = (unsigned short)f2bf(qn);
        *(LAS unsigned short*)(L + HG_KO + t * HG_LDQ + dk * 2) = (unsigned short)f2bf(ko); }
    { LAS v4u* d = (LAS v4u*)(L + HG_ST + (tid >> 2) * HG_LDQ + (tid & 3) * 64);
#pragma unroll
        for (int k = 0; k < 4; ++k) { unsigned w[4];
#pragma unroll
            for (int c = 0; c < 2; ++c) { const int x = (int)st[k >> 1][2 * (k & 1) + c]; const f32x2g lo = __builtin_amdgcn_cvt_pk_f32_fp8(x, false), hi = __builtin_amdgcn_cvt_pk_f32_fp8(x, true);
                w[2 * c] = pk2(lo.x, lo.y); w[2 * c + 1] = pk2(hi.x, hi.y); }
            d[k] = (v4u){w[0], w[1], w[2], w[3]}; } }
    __syncthreads();
    {
        const int mt = wave >> 1;
#pragma unroll
        for (int n2 = 0; n2 < 2; ++n2) { const int nt = 2 * (wave & 1) + n2; hf32x4 sc = {0.f, 0.f, 0.f, 0.f};
#pragma unroll
            for (int kk = 0; kk < 4; ++kk) { const hbf16x8 A = *(const LAS hbf16x8*)(L + HG_QI + (16 * mt + fr) * HG_LDQ + kk * 64 + fq * 16);
                const hbf16x8 B = *(const LAS hbf16x8*)(L + HG_KO + (16 * nt + fr) * HG_LDQ + kk * 64 + fq * 16);
                sc = __builtin_amdgcn_mfma_f32_16x16x32_bf16(A, B, sc, 0, 0, 0); }
#pragma unroll
            for (int r = 0; r < 4; ++r) { const int t = 16 * mt + 4 * fq + r, s_ = 16 * nt + fr; const bool keep = dir ? (s_ >= t) : (s_ <= t);
                *(LAS unsigned short*)(L + HG_SC + t * HG_LDT + s_ * 2) = (unsigned short)f2bf(keep ? sc[r] : 0.f); } }
    }
    __syncthreads();
#pragma unroll
    for (int nt = 0; nt < 4; ++nt) {
#pragma unroll
        for (int kk = 0; kk < 2; ++kk) { const hbf16x8 A = *(const LAS hbf16x8*)(L + HG_SC + (16 * mt_o + fr) * HG_LDT + kk * 64 + fq * 16);
            const hbf16x8 B = *(const LAS hbf16x8*)(L + HG_VT + (16 * (ntb + nt) + fr) * HG_LDT + kk * 64 + fq * 16);
            acc[nt] = __builtin_amdgcn_mfma_f32_16x16x32_bf16(A, B, acc[nt], 0, 0, 0); }
#pragma unroll
        for (int kk = 0; kk < 4; ++kk) { const hbf16x8 A = *(const LAS hbf16x8*)(L + HG_QN + (16 * mt_o + fr) * HG_LDQ + kk * 64 + fq * 16);
            const hbf16x8 B = *(const LAS hbf16x8*)(L + HG_ST + (16 * (ntb + nt) + fr) * HG_LDQ + kk * 64 + fq * 16);
            acc[nt] = __builtin_amdgcn_mfma_f32_16x16x32_bf16(A, B, acc[nt], 0, 0, 0); }
    }
    __syncthreads();
}
__device__ __forceinline__ void hgrn_pass3_unit(int u, const bf16* QH, const _Float16* LFF, const _Float16* LFB, const bf16* IV, const bf16* GG, const unsigned char* S, const float* onorm_g, bf16* Y,
                                                LAS unsigned char* L, int tid, int wave, int lane) {
    const int j = u % NCHUNK, bh = u / NCHUNK, b = bh >> 2, h = bh & 3;
    const size_t row0 = (size_t)b * SB + 64 * j;
    const int fr = lane & 15, fq = lane >> 4;
    unsigned wf[8], wb[8], wq[8], wi[8]; v4u stf[2], stb[2];
    hg_ld16((const unsigned short*)(LFF + row0 * 512 + h * 128), tid, wf); hg_ld16((const unsigned short*)(LFB + row0 * 512 + h * 128), tid, wb);
    hg_ld16(QH + row0 * 512 + h * 128, tid, wq); hg_ld16(IV + row0 * 512 + h * 128, tid, wi);
    { const unsigned char* sp = S + ((size_t)bh * NCHUNK + hg_chunk(0, j)) * 16384 + (tid >> 2) * 128 + (tid & 3) * 32; const unsigned char* sq_ = S + ((size_t)(8 + bh) * NCHUNK + hg_chunk(1, j)) * 16384 + (tid >> 2) * 128 + (tid & 3) * 32;
#pragma unroll
        for (int k = 0; k < 2; ++k) { stf[k] = *((const GAS v4u*)sp + k); stb[k] = *((const GAS v4u*)sq_ + k); } }
    hg_store_vt(wi, L, tid);
    float vf[16], vb[16], qv[16];
#pragma unroll
    for (int i = 0; i < 8; ++i) { vf[2 * i] = h2f((unsigned short)(wf[i] & 0xffffu)); vf[2 * i + 1] = h2f((unsigned short)(wf[i] >> 16)); vb[2 * i] = h2f((unsigned short)(wb[i] & 0xffffu)); vb[2 * i + 1] = h2f((unsigned short)(wb[i] >> 16));
        qv[2 * i] = __uint_as_float(wq[i] << 16); qv[2 * i + 1] = __uint_as_float(wq[i] & 0xffff0000u); }
    hf32x4 acc[4];
#pragma unroll
    for (int nt = 0; nt < 4; ++nt) acc[nt] = (hf32x4){0.f, 0.f, 0.f, 0.f};
    const int mt_o = wave & 3, ntb = 4 * (wave >> 2);
    hg3_dir(0, vf, qv, stf, acc, L, tid, wave, lane);
    hg3_dir(1, vb, qv, stb, acc, L, tid, wave, lane);
    LAS float* red = (LAS float*)(L + HG_SCR);
    float ss[4];
#pragma unroll
    for (int r = 0; r < 4; ++r) { float s = 0.f;
#pragma unroll
        for (int nt = 0; nt < 4; ++nt) s += acc[nt][r] * acc[nt][r];
        s += dpp_f<0xB1>(s); s += dpp_f<0x4E>(s); s += dpp_f<0x141>(s); s += dpp_f<0x140>(s); ss[r] = s; }
    if (fr == 0) {
#pragma unroll
        for (int r = 0; r < 4; ++r) red[(wave >> 2) * 64 + 16 * mt_o + 4 * fq + r] = ss[r]; }
    __syncthreads();
#pragma unroll
    for (int r = 0; r < 4; ++r) { const int t = 16 * mt_o + 4 * fq + r; const float rstd = __builtin_amdgcn_rsqf((red[t] + red[64 + t]) * (1.f / 128.f) + EPS_);
#pragma unroll
        for (int nt = 0; nt < 4; ++nt) { const int dv = 16 * (ntb + nt) + fr; const float gg = bf2f(GG[(row0 + t) * 512 + h * 128 + dv]);
            Y[(row0 + t) * 1024 + h * 128 + dv] = (bf16)f2bf(acc[nt][r] * rstd * onorm_g[dv] * gg); } }
    __syncthreads();
}

#ifndef TS_PHASE
#define TS_PHASE (-1)
#endif
struct KArgs { const float* in[23]; float* out; unsigned char* ws; int ph_lo, ph_hi, use_cg, pad; };
constexpr int N_PHASES = 21;
enum { I_X = 0, I_C, I_CTX, I_CCTX, I_ADAW, I_ADAB, I_NMIX, I_NFFN, I_EWIN, I_EWOUT, I_LBL, I_ONORM, I_DLAM, I_SUBLN, I_OWQKV, I_OWOUT, I_SINK, I_RW, I_RB, I_MG, I_MU, I_MD, I_FNG };

__device__ __forceinline__ float xreduce16(const float (&a)[16], int lane) {
    const bool b3 = (lane & 8) != 0, b2 = (lane & 4) != 0;
    float b[8], c[4], d[2];
#pragma unroll
    for (int e = 0; e < 8; ++e) b[e] = swap32_sum(a[e], a[e + 8]);
#pragma unroll
    for (int e = 0; e < 4; ++e) c[e] = swap16_sum(b[e], b[e + 4]);
#pragma unroll
    for (int e = 0; e < 2; ++e) { const float keep = b3 ? c[e + 2] : c[e], send = b3 ? c[e] : c[e + 2]; d[e] = keep + dpp_f<0x140>(send); }
    float x; { const float keep = b2 ? d[1] : d[0], send = b2 ? d[0] : d[1]; x = keep + dpp_f<0x141>(send); }
    x += dpp_f<0x4E>(x); x += dpp_f<0xB1>(x);
    return x;
}
__device__ __forceinline__ void load_row_raw(u32x2f (&w)[4], const bf16* xrow, int lane) {
    const u32x2f* xr = (const u32x2f*)xrow + lane;
#pragma unroll
    for (int j = 0; j < 4; ++j) w[j] = xr[64 * j];
}
__device__ __forceinline__ void raw_to_f32(f32x4 (&v)[4], const u32x2f (&w)[4]) {
#pragma unroll
    for (int j = 0; j < 4; ++j) { v[j].x = __uint_as_float(w[j].x << 16); v[j].y = __uint_as_float(w[j].x & 0xffff0000u); v[j].z = __uint_as_float(w[j].y << 16); v[j].w = __uint_as_float(w[j].y & 0xffff0000u); }
}
__device__ __forceinline__ void router_phase(const bf16* X, const float* gffn, const float* MODL, const float* rw, const float* rb, bf16* H2, int* EXPID, float* EXPW, int* RANK, int* CNT,
                                             bool latent_only, LAS unsigned char* L, int tid, int wave, int lane) {
    LAS float* rwT = (LAS float*)L;
    LAS int* cnt = (LAS int*)(L + 16 * 1028 * 4);
    LAS float* LG = (LAS float*)(L + 16 * 1028 * 4 + 64);
    for (int i = tid; i < 16384; i += 512) rwT[(i & 15) * 1028 + (i >> 4)] = rw[i];
    if (tid < 16) cnt[tid] = 0;
    __syncthreads();
    const int base = blockIdx.x * 66;
    u32x2f n0[4], n1[4];
    load_row_raw(n0, X + (size_t)(base + wave) * 1024, lane); load_row_raw(n1, X + (size_t)(base + wave + 8) * 1024, lane);
    for (int rr = wave; rr < 66; rr += 16) {
        f32x4 v0[4], v1[4]; raw_to_f32(v0, n0); raw_to_f32(v1, n1);
        if (rr + 16 < 66) load_row_raw(n0, X + (size_t)(base + rr + 16) * 1024, lane);
        if (rr + 24 < 66) load_row_raw(n1, X + (size_t)(base + rr + 24) * 1024, lane);
        const int r0 = base + rr, r1 = r0 + 8, b0 = r0 / SB, s0 = r0 % SB, b1 = r1 / SB, s1 = r1 % SB;
        const bool do0 = !(latent_only && s0 < 256), do1 = (rr + 8 < 66) && !(latent_only && s1 < 256);
        if (!do0 && !do1) continue;
        if (do0) { const float* mp = MODL + (s0 < 256 ? 2 : b0) * 6144; normmod_row(v0, gffn, mp + 4096, mp + 3072, lane);
            GAS unsigned* o4 = (GAS unsigned*)((unsigned char*)H2 + (size_t)r0 * 1024) + lane;
#pragma unroll
            for (int j = 0; j < 4; ++j) o4[64 * j] = pg8::pk4_fp8(v0[j].x, v0[j].y, v0[j].z, v0[j].w); }
        if (do1) { const float* mp = MODL + (s1 < 256 ? 2 : b1) * 6144; normmod_row(v1, gffn, mp + 4096, mp + 3072, lane);
            GAS unsigned* o4 = (GAS unsigned*)((unsigned char*)H2 + (size_t)r1 * 1024) + lane;
#pragma unroll
            for (int j = 0; j < 4; ++j) o4[64 * j] = pg8::pk4_fp8(v1[j].x, v1[j].y, v1[j].z, v1[j].w); }
        float a0[16], a1[16];
#pragma unroll
        for (int e = 0; e < 16; ++e) { float x0 = 0.f, x1 = 0.f;
#pragma unroll
            for (int j = 0; j < 4; ++j) { const f32x4 w = *(const LAS f32x4*)(rwT + e * 1028 + 256 * j + 4 * lane);
                x0 += (v0[j].x * w.x + v0[j].y * w.y) + (v0[j].z * w.z + v0[j].w * w.w); x1 += (v1[j].x * w.x + v1[j].y * w.y) + (v1[j].z * w.z + v1[j].w * w.w); }
            a0[e] = x0; a1[e] = x1; }
        const float l0 = xreduce16(a0, lane), l1 = xreduce16(a1, lane);
        if ((lane & 3) == 0) { if (do0) LG[rr * 17 + (lane >> 2)] = l0; if (do1) LG[(rr + 8) * 17 + (lane >> 2)] = l1; }
    }
    __syncthreads();
    if (tid < 66) {
        const int r = base + tid, s = r % SB;
        if (!(latent_only && s < 256)) {
            float aff[16], sel[16];
#pragma unroll
            for (int e = 0; e < 16; ++e) { aff[e] = 1.f / (1.f + __expf(-LG[tid * 17 + e])); sel[e] = aff[e] + rb[e]; }
            int grp = 0; float best = -1e30f;
#pragma unroll
            for (int g = 0; g < 4; ++g) { float m1 = -1e30f, m2 = -1e30f;
#pragma unroll
                for (int k = 0; k < 4; ++k) { const float x = sel[4 * g + k]; if (x > m1) { m2 = m1; m1 = x; } else if (x > m2) m2 = x; }
                const float sc = m1 + m2; if (sc > best) { best = sc; grp = g; } }
            float s4[4], a4[4];
#pragma unroll
            for (int k = 0; k < 4; ++k) { s4[k] = grp == 0 ? sel[k] : grp == 1 ? sel[4 + k] : grp == 2 ? sel[8 + k] : sel[12 + k]; a4[k] = grp == 0 ? aff[k] : grp == 1 ? aff[4 + k] : grp == 2 ? aff[8 + k] : aff[12 + k]; }
            int i1 = 0;
#pragma unroll
            for (int k = 1; k < 4; ++k) if (s4[k] > s4[i1]) i1 = k;
            int i2 = i1 == 0 ? 1 : 0;
#pragma unroll
            for (int k = 0; k < 4; ++k) if (k != i1 && k != i2 && s4[k] > s4[i2]) i2 = k;
            const float a1 = i1 == 0 ? a4[0] : i1 == 1 ? a4[1] : i1 == 2 ? a4[2] : a4[3], a2 = i2 == 0 ? a4[0] : i2 == 1 ? a4[1] : i2 == 2 ? a4[2] : a4[3];
            const int e1 = 4 * grp + i1, e2 = 4 * grp + i2; const float inv = 1.f / (a1 + a2);
            const int r1 = __hip_atomic_fetch_add(cnt + e1, 1, __ATOMIC_RELAXED, __HIP_MEMORY_SCOPE_WORKGROUP), r2 = __hip_atomic_fetch_add(cnt + e2, 1, __ATOMIC_RELAXED, __HIP_MEMORY_SCOPE_WORKGROUP);
            EXPID[2 * r] = e1; EXPID[2 * r + 1] = e2; EXPW[2 * r] = a1 * inv; EXPW[2 * r + 1] = a2 * inv; RANK[2 * r] = r1; RANK[2 * r + 1] = r2;
        }
    }
    __syncthreads();
    if (tid < 16) CNT[blockIdx.x * 16 + tid] = cnt[tid];
    __syncthreads();
}
__device__ __forceinline__ void index_phase(const int* CNT, const int* EXPID, const float* EXPW, const int* RANK, const bf16* H2, int* TOKSLOT, float* ROWW, bf16* XS, int* META,
                                            bool latent_only, LAS unsigned char* L, int tid, int wave, int lane) {
    LAS int* part = (LAS int*)L;
    LAS int* base = part + 512;
    LAS int* pst = base + 16;
    { const int e = tid & 15, g = tid >> 4; int s = 0;
#pragma unroll
        for (int k = 0; k < 8; ++k) s += CNT[(8 * g + k) * 16 + e];
        part[g * 16 + e] = s; }
    __syncthreads();
    if (tid < 16) { const int e = tid; int tot = 0, off = 0; const int gb = blockIdx.x >> 3;
        for (int g = 0; g < 32; ++g) { const int p = part[g * 16 + e]; tot += p; if (g < gb) off += p; }
        for (int bb = gb * 8; bb < (int)blockIdx.x; ++bb) off += CNT[bb * 16 + e];
        base[e] = off; pst[e] = (tot + 255) >> 8; }
    __syncthreads();
    if (tid == 0) { int run = 0;
        for (int e = 0; e < 16; ++e) { const int nt = pst[e]; pst[e] = run * 256;
            if (blockIdx.x == 0) for (int k = 0; k < nt; ++k) META[16 + run + k] = e;
            run += nt; }
        pst[16] = run * 256; if (blockIdx.x == 0) META[0] = run; }
    __syncthreads();
    int dest = -1;
    { const int a = wave + 8 * lane, r = blockIdx.x * 66 + (a >> 1), k = a & 1;
      if (lane < 17 && a < 132 && !(latent_only && (r % SB) < 256)) { const int e = EXPID[2 * r + k]; dest = pst[e] + base[e] + RANK[2 * r + k]; TOKSLOT[2 * r + k] = dest; ROWW[dest] = EXPW[2 * r + k]; } }
    for (int i0 = 0; i0 < 20; i0 += 4) {
        v4u va[4]; int d[4];
#pragma unroll
        for (int q = 0; q < 4; ++q) { d[q] = __shfl(dest, (i0 + q) & 63); const int a = wave + 8 * (i0 + q); if (i0 + q >= 17 || a >= 132) d[q] = -1;
            if (d[q] >= 0) va[q] = *((const GAS v4u*)((const unsigned char*)H2 + (size_t)(blockIdx.x * 66 + (a >> 1)) * 1024) + lane); }
#pragma unroll
        for (int q = 0; q < 4; ++q) if (d[q] >= 0) *((GAS v4u*)((unsigned char*)XS + (size_t)d[q] * 1024) + lane) = va[q];
    }
    __syncthreads();
}

typedef const __attribute__((address_space(4))) KArgs KArgsC;
#define PROLOG \
    KArgsC* ka = ka0; asm volatile("" : "+s"(ka)); \
    unsigned char* const ws = ka->ws; \
    int tid = threadIdx.x; asm volatile("" : "+v"(tid)); \
    const int lane = tid & 63, wave = __builtin_amdgcn_readfirstlane(tid >> 6); \
    const int G = gridDim.x, bid = blockIdx.x, gw = bid * NWAVES + wave, NGW = G * NWAVES; \
    (void)lane; (void)gw; (void)NGW; (void)ws;
#define P_F32(off) ((float*)(ws + (off)))
#define P_I32(off) ((int*)(ws + (off)))
#define P_B16(off) ((bf16*)(ws + (off)))
#define P_U8(off) ((unsigned char*)(ws + (off)))
__global__ void __launch_bounds__(NWAVES * 64, 2) dit_fwd(KArgs args_by_value) {
    extern __shared__ __attribute__((aligned(16))) unsigned char lds[];
    LAS unsigned char* L = (LAS unsigned char*)lds;
    KArgsC* ka0 = (KArgsC*)__builtin_amdgcn_kernarg_segment_ptr();
    const int lo = ka0->ph_lo, hi = ka0->ph_hi;
    volatile LAS unsigned* bst = (volatile LAS unsigned*)(L + LDS_BYTES - 64);
    if (threadIdx.x < 2) bst[threadIdx.x] = 0u;
    __syncthreads();
    if (ka0->use_cg) (void)xcd_barrier_post((unsigned*)(ka0->ws + WS_CTL) + 1024, bst);
    if (TS_PHASE == 0 && blockIdx.x == 0 && threadIdx.x == 0) *(volatile LAS unsigned long long*)(L + LDS_BYTES - 32) = __builtin_amdgcn_s_memrealtime();
#define IN(k) (lo <= (k) && (k) < hi)
#ifndef REP_MASK
#define REP_MASK 0
#endif
#define PHASE(k) for (int rep_ = IN(k) ? 0 : 99; rep_ < 1 + (int)((REP_MASK >> (k)) & 1); ++rep_)
#define TS_MARK(k) do { if (TS_PHASE >= 0 && blockIdx.x == 0 && threadIdx.x == 0) { volatile LAS unsigned long long* tw_ = (volatile LAS unsigned long long*)(L + LDS_BYTES - 32); \
        if ((k) + 1 == TS_PHASE) tw_[0] = __builtin_amdgcn_s_memrealtime(); \
        if ((k) == TS_PHASE) { const unsigned long long t1_ = __builtin_amdgcn_s_memrealtime(), d_ = 4ull * (t1_ - tw_[0]); while (__builtin_amdgcn_s_memrealtime() - t1_ < d_) __builtin_amdgcn_s_sleep(8); } } } while (0)
#define SEAM(k) do { if (IN(k) && IN((k) + 1) && ka0->use_cg) { for (int sr_ = 0; sr_ < 1 + (int)((REP_MASK >> 27) & 1); ++sr_) { \
        XcdBarrier xb_; xb_.bar = (unsigned*)(ka0->ws + WS_CTL) + 1024; xb_.x = xb_xcc_id(); xb_.st = bst; xcd_barrier(xb_); } TS_MARK(k); } } while (0)
#define VCU ((G % 8 == 0) ? (bid % 8) * (G / 8) + bid / 8 : bid)

    PHASE(0) { PROLOG
        for (int r24_ = 0; r24_ < 1 + (int)((REP_MASK >> 24) & 1); ++r24_) { LAS float* scr = (LAS float*)(L + wave * 16384);
          conv_loop<0>(ka->in[I_EWIN], ka->in[I_EWOUT], ka->in[I_OWQKV], ka->in[I_OWOUT], ka->in[I_MG], ka->in[I_MU], ka->in[I_MD], ws, gw, NGW, scr, lane); }
        __syncthreads();
        for (int r25_ = 0; r25_ < 1 + (int)((REP_MASK >> 25) & 1); ++r25_) {
            const int l = bid >> 7, col0 = 48 * (bid & 127);
            LAS float* sl = (LAS float*)L;
            LAS float* red = sl + 3072;
            for (int i = tid; i < 3072; i += 512) sl[i] = silu_d(i < 2048 ? ka->in[I_C][i] : ka->in[I_CCTX][i - 2048]);
            __syncthreads();
            const int r = lane >> 4, cs = lane & 15;
            const float* aw = ka->in[I_ADAW] + ((size_t)l * 1024 + 128 * wave + r) * 6144 + col0 + 3 * cs;
            const LAS float* sp = sl + 128 * wave + r;
            float a[3][3];
#pragma unroll
            for (int v = 0; v < 3; ++v) { a[v][0] = 0.f; a[v][1] = 0.f; a[v][2] = 0.f; }
#pragma unroll 1
            for (int i0 = 0; i0 < 32; i0 += 16) { float w0[16], w1[16], w2[16];
#pragma unroll
                for (int i = 0; i < 16; ++i) { const float* p = aw + (size_t)(4 * (i0 + i)) * 6144; w0[i] = p[0]; w1[i] = p[1]; w2[i] = p[2]; }
#pragma unroll
                for (int i = 0; i < 16; ++i) {
#pragma unroll
                    for (int v = 0; v < 3; ++v) { const float sv = sp[1024 * v + 4 * (i0 + i)]; a[v][0] += sv * w0[i]; a[v][1] += sv * w1[i]; a[v][2] += sv * w2[i]; } } }
#pragma unroll
            for (int v = 0; v < 3; ++v) {
#pragma unroll
                for (int j = 0; j < 3; ++j) { float x = a[v][j]; x += __shfl_xor(x, 16); x += __shfl_xor(x, 32); a[v][j] = x; } }
            if (r == 0) {
#pragma unroll
                for (int v = 0; v < 3; ++v) { red[(wave * 3 + v) * 48 + 3 * cs] = a[v][0]; red[(wave * 3 + v) * 48 + 3 * cs + 1] = a[v][1]; red[(wave * 3 + v) * 48 + 3 * cs + 2] = a[v][2]; } }
            __syncthreads();
            if (tid < 144) { const int v = tid / 48, jj = tid % 48; float x = ka->in[I_ADAB][l * 6144 + col0 + jj];
#pragma unroll
                for (int w = 0; w < 8; ++w) x += red[(w * 3 + v) * 48 + jj];
                P_F32(WS_MOD)[(l * 3 + v) * 6144 + col0 + jj] = x; }
            __syncthreads();
        }
        if (bid == 96) {
            for (int i = tid; i < 1024; i += 512) { const float* lg = ka->in[I_LBL]; const float l0 = lg[i], l1 = lg[1024 + i], l2 = lg[2048 + i]; const float m = fmaxf(l0, fmaxf(l1, l2));
                const float e0 = expf(l0 - m), e1 = expf(l1 - m), e2 = expf(l2 - m); P_F32(WS_LB)[i] = e0 / (e0 + e1 + e2); }
            if (wave == 0) { const float* lp = ka->in[I_DLAM]; const float s0 = wave_sum(lp[lane] * lp[64 + lane]), s1 = wave_sum(lp[128 + lane] * lp[192 + lane]);
                if (lane == 0) P_F32(WS_LAM)[0] = expf(s0) - expf(s1) + 0.2f; }
        } else if (bid == 97) {
            for (int i = tid; i < 2048; i += 512) { const int pos = i >> 4, jj = i & 15; const float inv = 1.0f / powf(10000.0f, (float)(2 * jj) / 32.0f); const float ang = (float)pos * inv;
                P_F32(WS_ROPE)[2 * i] = cosf(ang); P_F32(WS_ROPE)[2 * i + 1] = sinf(ang); }
        }
    }
    SEAM(0);
    PHASE(1) { PROLOG
        for (int r = gw; r < MR; r += 2 * NGW) { const int r2 = r + NGW; const bool h2 = r2 < MR;
            const int b = r / SB, s_ = r % SB, b2 = h2 ? r2 / SB : b, s2_ = h2 ? r2 % SB : s_;
            const float* srcA = s_ < 256 ? ka->in[I_CTX] + ((size_t)b * 256 + s_) * 1024 : ka->in[I_X] + ((size_t)b * 8192 + s_ - 256) * 1024;
            const float* srcB = s2_ < 256 ? ka->in[I_CTX] + ((size_t)b2 * 256 + s2_) * 1024 : ka->in[I_X] + ((size_t)b2 * 8192 + s2_ - 256) * 1024;
            f32x4 va[4], vb[4]; load_row_f32(va, srcA, lane); load_row_f32(vb, srcB, lane);
            const float* mpA = P_F32(WS_MOD) + (s_ < 256 ? 2 : b) * 6144; const float* mpB = P_F32(WS_MOD) + (s2_ < 256 ? 2 : b2) * 6144;
            normmod_row(va, ka->in[I_NMIX], mpA + 1024, mpA, lane); store_row_bf16(va, P_B16(WS_H) + (size_t)r * 1024, lane);
            if (h2) { normmod_row(vb, ka->in[I_NMIX], mpB + 1024, mpB, lane); store_row_bf16(vb, P_B16(WS_H) + (size_t)r2 * 1024, lane); } }
    }
    SEAM(1);
    PHASE(2) { PROLOG
        pg8::Gemm g{P_B16(WS_H), P_B16(WS_WIN), MR, 4096, 1024, 0}; pg8::DenseOrder So; So.init(66, 16, G, bid, false, G == 256 ? 1 : 0);
        pg8::EpiInProj E{P_B16(WS_QH), P_B16(WS_IV), P_B16(WS_GG), P_B16(WS_DQ), P_B16(WS_DK), P_B16(WS_DV), (_Float16*)P_F32(WS_LFF), (_Float16*)P_F32(WS_LFB), P_F32(WS_LB), P_F32(WS_ROPE)};
#if (REP_MASK >> 28) & 1
        { pg8::EpiTwice<pg8::EpiInProj> E2{E}; pg8::gemm_phase<pg8::EpiTwice<pg8::EpiInProj>, pg8::DenseOrder, true, true>(L, g, So, E2); }
#else
        pg8::gemm_phase<pg8::EpiInProj, pg8::DenseOrder, true, true>(L, g, So, E);
#endif
        if (G == 256) { pg8::DenseOrder St; St.init(66, 16, G, bid, false, 2, 4); pg8::gemm_phase<pg8::EpiInProj, pg8::DenseOrder, true, true, 0x1>(L, g, St, E); }
    }
    SEAM(2);
    PHASE(3) { PROLOG hgrn_pass1(bid, G, 16 * NCHUNK, (_Float16*)P_F32(WS_LFF), (_Float16*)P_F32(WS_LFB), P_B16(WS_IV), P_U8(WS_U), P_F32(WS_TOT), L, tid, wave, lane); }
    SEAM(3);
    PHASE(4) { PROLOG if (tid < 256) hgrn_pass2(P_U8(WS_U), P_F32(WS_TOT), P_U8(WS_S), bid * 256 + tid, G * 256); }
    SEAM(4);
    PHASE(5) { PROLOG
#define CONV_L0() do { LAS float* scr_ = (LAS float*)(L + wave * 16384); conv_loop<3>(ka->in[I_EWIN], ka->in[I_EWOUT], ka->in[I_OWQKV], ka->in[I_OWOUT], ka->in[I_MG], ka->in[I_MU], ka->in[I_MD], ws, gw, NGW, scr_, lane); __syncthreads(); } while (0)
        const int cgrp_ = bid % 3;
        if (cgrp_ == 0) CONV_L0();
        for (int r4_ = 0; r4_ < 1 + (int)((REP_MASK >> 23) & 1); ++r4_) for (int u = bid; u < 8 * NCHUNK; u += G) hgrn_pass3_unit(u, P_B16(WS_QH), (_Float16*)P_F32(WS_LFF), (_Float16*)P_F32(WS_LFB), P_B16(WS_IV), P_B16(WS_GG), P_U8(WS_S), ka->in[I_ONORM], P_B16(WS_H), L, tid, wave, lane);
        typedef attn_body::bf16 abf; const int vcu_ = VCU;
        const float lam = P_F32(WS_LAM)[0]; const float* gsub = ka->in[I_SUBLN];
        if (bid >= 64 && bid < 72) {
            const int bh = bid - 64, b = bh >> 2, h = bh & 3; const size_t rb = (size_t)b * SB;
            attn_body::attn_unit128<8, 1>((const abf*)P_B16(WS_DQ) + rb * 512 + (h * 2) * 64, 512, (const abf*)P_B16(WS_DK) + rb * 512 + (h * 2) * 64, 512, (const abf*)P_B16(WS_DV) + rb * 512 + h * 128, 512,
                                          (abf*)nullptr, 0, 4, 0.f, gsub, (char*)lds);
            attn_body::attn_unit128<8, 2>((const abf*)P_B16(WS_DQ) + rb * 512 + (h * 2 + 1) * 64, 512, (const abf*)P_B16(WS_DK) + rb * 512 + (h * 2 + 1) * 64, 512, (const abf*)P_B16(WS_DV) + rb * 512 + h * 128, 512,
                                          (abf*)P_B16(WS_H) + rb * 1024 + 512 + h * 128, 1024, 4, lam, gsub, (char*)lds);
        }
        if (vcu_ < 256) {
            const int bh = vcu_ >> 5, qb = vcu_ & 31, b = bh >> 2, h = bh & 3; const size_t rb = (size_t)b * SB, rq = rb + 256 + 256 * qb;
            attn_body::attn_unit128<8, 1>((const abf*)P_B16(WS_DQ) + rq * 512 + (h * 2) * 64, 512, (const abf*)P_B16(WS_DK) + rb * 512 + (h * 2) * 64, 512, (const abf*)P_B16(WS_DV) + rb * 512 + h * 128, 512,
                                          (abf*)nullptr, 0, NCHUNK, 0.f, gsub, (char*)lds);
            if (cgrp_ == 1) { LAS float* scr_ = (LAS float*)(L + wave * 8448);
                conv_loop<3>(ka->in[I_EWIN], ka->in[I_EWOUT], ka->in[I_OWQKV], ka->in[I_OWOUT], ka->in[I_MG], ka->in[I_MU], ka->in[I_MD], ws, gw, NGW, scr_, lane); __syncthreads(); }
            attn_body::attn_unit128<8, 2>((const abf*)P_B16(WS_DQ) + rq * 512 + (h * 2 + 1) * 64, 512, (const abf*)P_B16(WS_DK) + rb * 512 + (h * 2 + 1) * 64, 512, (const abf*)P_B16(WS_DV) + rb * 512 + h * 128, 512,
                                          (abf*)P_B16(WS_H) + rq * 1024 + 512 + h * 128, 1024, NCHUNK, lam, gsub, (char*)lds);
        }
        if (cgrp_ == 2) CONV_L0();
#undef CONV_L0
    }
    SEAM(5);
    PHASE(7) { PROLOG
        pg8::Gemm g{P_B16(WS_H), P_B16(WS_WOE), MR, 1024, 1024, 0}; pg8::DenseOrder So; So.init(66, 4, G, bid, false, G == 256 ? 1 : 0);
        pg8::EpiOut0 E{ka->in[I_X], ka->in[I_CTX], P_F32(WS_MOD), P_B16(WS_X)};
        pg8::gemm_phase<pg8::EpiOut0, pg8::DenseOrder, true, true>(L, g, So, E);
        if (G == 256) { pg8::DenseOrder St; St.init(66, 4, G, bid, false, 2, 4); pg8::gemm_phase<pg8::EpiOut0, pg8::DenseOrder, true, true, 0x1>(L, g, St, E); }
    }
    SEAM(7);
#define MOE_LAYER(P, LAYER, LATENT_ONLY) \
    PHASE(P) { PROLOG router_phase(P_B16(WS_X), ka->in[I_NFFN] + (LAYER) * 1024, P_F32(WS_MOD) + (LAYER) * 3 * 6144, ka->in[I_RW], ka->in[I_RB], P_B16(WS_H), P_I32(WS_EXPID), P_F32(WS_EXPW), P_I32(WS_RANK), P_I32(WS_CNT), LATENT_ONLY, L, tid, wave, lane); } \
    SEAM(P); \
    PHASE((P) + 1) { PROLOG for (int r2_ = 0; r2_ < 1 + (int)((REP_MASK >> 21) & 1); ++r2_) index_phase(P_I32(WS_CNT), P_I32(WS_EXPID), P_F32(WS_EXPW), P_I32(WS_RANK), P_B16(WS_H), P_I32(WS_TOKSLOT), P_F32(WS_ROWW), P_B16(WS_XS), P_I32(WS_META), LATENT_ONLY, L, tid, wave, lane); \
        } \
    SEAM((P) + 1); \
    PHASE((P) + 2) { PROLOG const int ntile = __builtin_amdgcn_readfirstlane(P_I32(WS_META)[0]); \
        LAS int* te_ = (LAS int*)(L + 131072); for (int i_ = tid; i_ < ntile; i_ += 512) te_[i_] = P_I32(WS_META)[16 + i_]; __syncthreads(); \
        pg8::Gemm g{P_B16(WS_XS), (const bf16*)(ws + ((LAYER) == 0 ? WS_MOE0_13 : WS_MOE1_13)), ntile * 256, 2048, 512  , (size_t)2048 * 1024}; const int rem_ = (ntile * 8) % G; const bool split_ = rem_ > 0 && 2 * rem_ <= G; \
        pg8::MoeOrder So; So.init(ntile, 8, G, bid, te_, split_ ? 1 : 0); \
        pg8::EpiGateUp8 E{(unsigned char*)P_B16(WS_HID)}; pg8::gemm_phase<pg8::EpiGateUp8, pg8::MoeOrder, true, true, 0xF, true>(L, g, So, E); \
        if (split_) { pg8::MoeOrder St; St.init(ntile, 8, G, bid, te_, 2, 2); pg8::gemm_phase<pg8::EpiGateUp8, pg8::MoeOrder, true, true, 0x3, true>(L, g, St, E); } \
        } \
    SEAM((P) + 2); \
    PHASE((P) + 3) { PROLOG const int ntile = __builtin_amdgcn_readfirstlane(P_I32(WS_META)[0]); \
        LAS int* te_ = (LAS int*)(L + 131072); for (int i_ = tid; i_ < ntile; i_ += 512) te_[i_] = P_I32(WS_META)[16 + i_]; __syncthreads(); \
        pg8::Gemm g{P_B16(WS_HID), (const bf16*)(ws + ((LAYER) == 0 ? WS_MOE0_2 : WS_MOE1_2)), ntile * 256, 1024, 512  , (size_t)1024 * 1024}; const int rem_ = (ntile * 4) % G; const bool split_ = rem_ > 0 && 4 * rem_ <= G; \
        pg8::MoeOrder So; So.init(ntile, 4, G, bid, te_, split_ ? 1 : 0); \
        pg8::EpiDown8 E{P_B16(WS_XS), P_F32(WS_ROWW)}; pg8::gemm_phase<pg8::EpiDown8, pg8::MoeOrder, true, true, 0xF, true>(L, g, So, E); \
        if (split_) { pg8::MoeOrder St; St.init(ntile, 4, G, bid, te_, 2, 4); pg8::gemm_phase<pg8::EpiDown8, pg8::MoeOrder, true, true, 0x1, true>(L, g, St, E); } } \
    SEAM((P) + 3);
    MOE_LAYER(8, 0, false)
    PHASE(12) { PROLOG
        for (int r = gw; r < MR; r += 2 * NGW) { const int r2 = r + NGW; const bool h2 = r2 < MR; const int rb_ = h2 ? r2 : r;
            const int sa0 = P_I32(WS_TOKSLOT)[2 * r], sa1 = P_I32(WS_TOKSLOT)[2 * r + 1], sb0 = P_I32(WS_TOKSLOT)[2 * rb_], sb1 = P_I32(WS_TOKSLOT)[2 * rb_ + 1];
            const int vecA = (r % SB) < 256 ? 2 : r / SB, vecB = (rb_ % SB) < 256 ? 2 : rb_ / SB;
            f32x4 va[4], vb[4]; load_row_b16(va, P_B16(WS_X) + (size_t)r * 1024, lane); load_row_b16(vb, P_B16(WS_X) + (size_t)rb_ * 1024, lane);
            add_moe_rows(va, P_B16(WS_XS) + (size_t)sa0 * 1024, P_B16(WS_XS) + (size_t)sa1 * 1024, P_F32(WS_MOD) + vecA * 6144 + 5120, lane);
            add_moe_rows(vb, P_B16(WS_XS) + (size_t)sb0 * 1024, P_B16(WS_XS) + (size_t)sb1 * 1024, P_F32(WS_MOD) + vecB * 6144 + 5120, lane);
            { store_row_bf16(va, P_B16(WS_X) + (size_t)r * 1024, lane);
              const float* mp = P_F32(WS_MOD) + (3 + vecA) * 6144; normmod_row(va, ka->in[I_NMIX] + 1024, mp + 1024, mp, lane); store_row_bf16(va, P_B16(WS_H) + (size_t)r * 1024, lane); }
            if (h2) { store_row_bf16(vb, P_B16(WS_X) + (size_t)r2 * 1024, lane);
              const float* mp = P_F32(WS_MOD) + (3 + vecB) * 6144; normmod_row(vb, ka->in[I_NMIX] + 1024, mp + 1024, mp, lane); store_row_bf16(vb, P_B16(WS_H) + (size_t)r2 * 1024, lane); } }
    }
    SEAM(12);
    PHASE(13) { PROLOG
        pg8::Gemm g{P_B16(WS_H), P_B16(WS_WQKV), MR, 1536, 1024, 0}; pg8::DenseOrder So; So.init(66, 6, G, bid, false);
        pg8::EpiQKV1 E{P_B16(WS_Q1), P_B16(WS_K1), P_B16(WS_V1), P_F32(WS_ROPE)};
        pg8::gemm_phase<pg8::EpiQKV1, pg8::DenseOrder, true, true>(L, g, So, E);
    }
    SEAM(13);
    PHASE(14) { PROLOG
#define CONV_L1() do { __syncthreads(); LAS float* scr_ = (LAS float*)(L + wave * 16384); conv_loop<1>(ka->in[I_EWIN], ka->in[I_EWOUT], ka->in[I_OWQKV], ka->in[I_OWOUT], ka->in[I_MG], ka->in[I_MU], ka->in[I_MD], ws, gw, NGW, scr_, lane); __syncthreads(); } while (0)
#define SWA_UNITS(i0) do { typedef attn_body::bf16 abf; const int vcu_ = VCU; for (int i = (i0); i < (i0) + 2; ++i) { const int combo = vcu_ >> 5, qb = 4 * (vcu_ & 31) + i; if (combo >= 8) break; \
            const int b = combo >> 2, kvh = combo & 3; const size_t rb = (size_t)b * SB, rq = rb + 256 + 64 * qb; \
            attn_body::attn_unit<8, 1>((const abf*)P_B16(WS_Q1) + rq * 1024 + kvh * 256, 1024, (const abf*)P_B16(WS_K1) + rb * 256 + kvh * 64, 256, (const abf*)P_B16(WS_V1) + rb * 256 + kvh * 64, 256, \
                                       (abf*)P_B16(WS_H) + rq * 1024 + kvh * 256, 1024, 9, 64 * qb, ka->in[I_SINK] + 4 * kvh, (char*)lds); } } while (0)
        const int turn_ = bid % 3;
        if (turn_ == 0) CONV_L1();
        SWA_UNITS(0);
        if (turn_ == 1) CONV_L1();
        SWA_UNITS(2);
        if (turn_ == 2) CONV_L1();
#undef SWA_UNITS
#undef CONV_L1
    }
    SEAM(14);
    PHASE(15) { PROLOG
        pg8::Gemm g{P_B16(WS_H), P_B16(WS_WOO), MR, 1024, 1024, 0}; pg8::DenseOrder So; So.init(64, 4, G, bid, true);
        pg8::EpiOut1 E{P_F32(WS_MOD) + 3 * 6144, P_B16(WS_X)};
        pg8::gemm_phase<pg8::EpiOut1, pg8::DenseOrder, true, true>(L, g, So, E);
    }
    SEAM(15);
    MOE_LAYER(16, 1, true)
    PHASE(20) { PROLOG
        for (int t = gw; t < NBATCH * TLAT; t += 2 * NGW) { const int t2 = (t + NGW < NBATCH * TLAT) ? t + NGW : t; const bool h2 = t2 != t;
            const size_t rA = (size_t)(t >> 13) * SB + 256 + (t & 8191), rB = (size_t)(t2 >> 13) * SB + 256 + (t2 & 8191);
            const int sa0 = P_I32(WS_TOKSLOT)[2 * rA], sa1 = P_I32(WS_TOKSLOT)[2 * rA + 1], sb0 = P_I32(WS_TOKSLOT)[2 * rB], sb1 = P_I32(WS_TOKSLOT)[2 * rB + 1];
            f32x4 va[4], vb[4]; load_row_b16(va, P_B16(WS_X) + rA * 1024, lane); load_row_b16(vb, P_B16(WS_X) + rB * 1024, lane);
            add_moe_rows(va, P_B16(WS_XS) + (size_t)sa0 * 1024, P_B16(WS_XS) + (size_t)sa1 * 1024, P_F32(WS_MOD) + (3 + (t >> 13)) * 6144 + 5120, lane);
            add_moe_rows(vb, P_B16(WS_XS) + (size_t)sb0 * 1024, P_B16(WS_XS) + (size_t)sb1 * 1024, P_F32(WS_MOD) + (3 + (t2 >> 13)) * 6144 + 5120, lane);
            float s2a = 0.f, s2b = 0.f;
#pragma unroll
            for (int j = 0; j < 4; ++j) { s2a += (va[j].x * va[j].x + va[j].y * va[j].y) + (va[j].z * va[j].z + va[j].w * va[j].w); s2b += (vb[j].x * vb[j].x + vb[j].y * vb[j].y) + (vb[j].z * vb[j].z + vb[j].w * vb[j].w); }
            const float rsa = __builtin_amdgcn_rsqf(wave_sum(s2a) * (1.f / 1024.f) + EPS_), rsb = __builtin_amdgcn_rsqf(wave_sum(s2b) * (1.f / 1024.f) + EPS_);
            f32x4* oa = (f32x4*)(ka->out + (size_t)t * 1024) + lane; f32x4* ob = (f32x4*)(ka->out + (size_t)t2 * 1024) + lane;
#pragma unroll
            for (int j = 0; j < 4; ++j) { const f32x4 g = *((const f32x4*)ka->in[I_FNG] + 64 * j + lane); oa[64 * j] = va[j] * rsa * g; if (h2) ob[64 * j] = vb[j] * rsb * g; } }
    }
#undef IN
#undef SEAM
#undef MOE_LAYER
}

#ifndef N_LAUNCHES
#define N_LAUNCHES 1
#endif
extern "C" void kernel_launch(void* const* d_in, const int* in_sizes, int n_in, void* d_out, int out_size, void* d_ws, size_t ws_size, hipStream_t stream) {
    static int grid = 0;
    if (grid == 0) {
        if (n_in != 23 || ws_size < WS_NEED) { fprintf(stderr, "kernel_launch: expected 23 inputs and >= %zu bytes of workspace (got %d, %zu)\n", (size_t)WS_NEED, n_in, ws_size); grid = -1; return; }
        int dev = 0, cus = 0, per_cu = 0;
        hipGetDevice(&dev); hipDeviceGetAttribute(&cus, hipDeviceAttributeMultiprocessorCount, dev);
        if (hipFuncSetAttribute((const void*)dit_fwd, hipFuncAttributeMaxDynamicSharedMemorySize, LDS_BYTES) != hipSuccess) { fprintf(stderr, "kernel_launch: hipFuncSetAttribute failed\n"); grid = -1; return; }
        if (hipOccupancyMaxActiveBlocksPerMultiprocessor(&per_cu, (const void*)dit_fwd, NWAVES * 64, LDS_BYTES) != hipSuccess || per_cu < 1) { fprintf(stderr, "kernel_launch: occupancy query says %d\n", per_cu); per_cu = 1; }
        (void)hipGetLastError();
        grid = cus;
        if (grid != 256) fprintf(stderr, "kernel_launch: %d CUs (built for 256)\n", grid);
    }
    if (grid < 0) return;
    (void)hipMemsetAsync((char*)d_ws + WS_CTL, 0, CTL_ZERO_BYTES, stream);
    KArgs a{};
    for (int i = 0; i < 23; ++i) a.in[i] = (const float*)d_in[i];
    a.out = (float*)d_out; a.ws = (unsigned char*)d_ws;
#if N_LAUNCHES == 1
    a.ph_lo = 0; a.ph_hi = N_PHASES; a.use_cg = 1;
    void* kargs[] = {&a};
    hipError_t e = hipLaunchCooperativeKernel((const void*)dit_fwd, dim3(grid), dim3(NWAVES * 64), kargs, LDS_BYTES, stream);
    if (e != hipSuccess) fprintf(stderr, "kernel_launch: cooperative launch failed: %s\n", hipGetErrorString(e));
#else
    for (int p = 0; p < N_PHASES; ++p) { a.ph_lo = p; a.ph_hi = p + 1; a.use_cg = 0;
        hipLaunchKernelGGL(dit_fwd, dim3(grid), dim3(NWAVES * 64), LDS_BYTES, stream, a); }
#endif
}
```

```cpp
#include <hip/hip_runtime.h>
#include <hip/hip_cooperative_groups.h>
#include <hip/hip_bf16.h>
#include <cstdio>
#include <cstdint>
#include <cmath>
namespace cg = cooperative_groups;

constexpr int DMODEL = 1024, NBATCH = 2, TLAT = 8192, TCTX = 256;
constexpr int SB = TLAT + TCTX;
constexpr int MR = NBATCH * SB;
constexpr int NEXP = 16;
constexpr int MOE_MAXT = 152;
constexpr float EPS_ = 1e-6f;
constexpr float LOG2E = 1.4426950408889634f;
constexpr float C2 = 0.125f * LOG2E;
constexpr int NCHUNK = SB / 64;

constexpr size_t MiB = 1u << 20;
constexpr size_t WS_CTL = 0, CTL_ZERO_BYTES = 64 * 1024;
constexpr size_t WS_MOD = 1 * MiB;
constexpr size_t WS_LB = WS_MOD + 256 * 1024;
constexpr size_t WS_LAM = WS_LB + 8 * 1024;
constexpr size_t WS_ROPE = WS_LAM + 1024;
constexpr size_t WS_EXPID = 2 * MiB;
constexpr size_t WS_EXPW = WS_EXPID + 256 * 1024;
constexpr size_t WS_RANK = WS_EXPW + 256 * 1024;
constexpr size_t WS_TOKSLOT = WS_RANK + 256 * 1024;
constexpr size_t WS_CNT = WS_TOKSLOT + 256 * 1024;
constexpr size_t WS_META = WS_CNT + 32 * 1024;
constexpr size_t WS_ROWW = 4 * MiB;
constexpr size_t WS_TOT = 5 * MiB;
constexpr size_t WS_WIN = 8 * MiB;
constexpr size_t WS_WOE = 16 * MiB;
constexpr size_t WS_WQKV = 18 * MiB;
constexpr size_t WS_WOO = 21 * MiB;
constexpr size_t WS_MOE0_13 = 24 * MiB;
constexpr size_t WS_MOE0_2 = 88 * MiB;
constexpr size_t WS_X = 120 * MiB;
constexpr size_t WS_H = 186 * MiB;
constexpr size_t WS_R = 219 * MiB;
constexpr size_t WS_QH = WS_R;
constexpr size_t WS_LFF = WS_QH + 33 * MiB / 2;
constexpr size_t WS_LFB = WS_LFF + 33 * MiB;
constexpr size_t WS_IV = WS_LFB + 33 * MiB;
constexpr size_t WS_GG = WS_IV + 33 * MiB / 2;
constexpr size_t WS_DQ = WS_GG + 33 * MiB / 2;
constexpr size_t WS_DK = WS_DQ + 33 * MiB / 2;
constexpr size_t WS_DV = WS_DK + 33 * MiB / 2;
constexpr size_t WS_U = WS_DV + 33 * MiB / 2;
constexpr size_t WS_S = WS_U + 66 * MiB;
constexpr size_t WS_OATT = WS_U;
constexpr size_t WS_END0 = WS_S + 66 * MiB;
constexpr size_t WS_MOE1_13 = WS_R;
constexpr size_t WS_MOE1_2 = WS_R + 64 * MiB;
constexpr size_t WS_XS = WS_R + 96 * MiB;
constexpr size_t WS_HID = WS_XS + 76 * MiB;
constexpr size_t WS_Q1 = WS_HID + 76 * MiB;
constexpr size_t WS_K1 = WS_Q1 + 33 * MiB;
constexpr size_t WS_V1 = WS_K1 + 33 * MiB / 4;
constexpr size_t WS_END1 = WS_V1 + 33 * MiB / 4;
constexpr size_t WS_NEED = (WS_END0 > WS_END1 ? WS_END0 : WS_END1);
static_assert(WS_NEED <= 553810048ull, "d_ws map exceeds the guaranteed workspace");
static_assert((size_t)MOE_MAXT * 256 * 1024 * 2 <= 76 * MiB, "XS size");

#define GAS __attribute__((address_space(1)))
#define LAS __attribute__((address_space(3)))
typedef unsigned short bf16;
typedef unsigned v4u __attribute__((ext_vector_type(4)));
typedef float f32x4 __attribute__((ext_vector_type(4)));
typedef short bf16x8 __attribute__((ext_vector_type(8)));
typedef GAS unsigned gu32;
typedef GAS unsigned long long gu64;
#define RLX_AGENT __ATOMIC_RELAXED, __HIP_MEMORY_SCOPE_AGENT
#define LDS_WAIT() asm volatile("s_waitcnt lgkmcnt(0)" ::: "memory")
#define VM_WAIT() asm volatile("s_waitcnt vmcnt(0)" ::: "memory")
__device__ __forceinline__ unsigned long long rt() { return __builtin_amdgcn_s_memrealtime(); }
typedef float f32x2c_t __attribute__((ext_vector_type(2))); typedef __bf16 bf16x2c_t __attribute__((ext_vector_type(2)));
__device__ __forceinline__ unsigned pk2(float lo, float hi) { f32x2c_t v = {lo, hi}; bf16x2c_t b = __builtin_convertvector(v, bf16x2c_t); return __builtin_bit_cast(unsigned, b); }
__device__ __forceinline__ unsigned f2bf(float f) { return pk2(f, 0.f) & 0xffffu; }
template <int CTRL> __device__ __forceinline__ float dpp_f(float v) { return __builtin_bit_cast(float, __builtin_amdgcn_update_dpp(0, __builtin_bit_cast(int, v), CTRL, 0xF, 0xF, true)); }
__device__ __forceinline__ float swap16_sum(float a, float b) { const auto r = __builtin_amdgcn_permlane16_swap(__float_as_uint(a), __float_as_uint(b), false, false); return __uint_as_float(r[0]) + __uint_as_float(r[1]); }
__device__ __forceinline__ float swap32_sum(float a, float b) { const auto r = __builtin_amdgcn_permlane32_swap(__float_as_uint(a), __float_as_uint(b), false, false); return __uint_as_float(r[0]) + __uint_as_float(r[1]); }

#define XB_TMO      128
#define XB_XCNT(j)  (256  + 64 * (j))
#define XB_XSUB(j)  (1280 + 64 * (j))
#define XB_XGEN(j)  (2304 + 64 * (j))
#define XB_TOP      3328
#define XB_TOPGEN   3392
#define XCD_BAR_WORDS 3456
#define XB_SPIN_CAP (1u << 18)

__device__ __forceinline__ unsigned xb_ld(unsigned* p)              { return __hip_atomic_load(p, __ATOMIC_RELAXED, __HIP_MEMORY_SCOPE_AGENT); }
__device__ __forceinline__ unsigned xb_add(unsigned* p, unsigned v) { return __hip_atomic_fetch_add(p, v, __ATOMIC_RELAXED, __HIP_MEMORY_SCOPE_AGENT); }
__device__ __forceinline__ unsigned xb_xcc_id() { return (unsigned)__builtin_amdgcn_s_getreg((3 << 11) | 20) & 0xFu; }
#define XB_SPIN(cond, bar) do { unsigned _sp = 0; while (cond) { __builtin_amdgcn_s_sleep(1); \
    if ((++_sp & 255u) == 0u) { if (xb_ld(&(bar)[XB_TMO])) break; if (_sp > XB_SPIN_CAP) { atomicAdd(&(bar)[XB_TMO], 1u); break; } } } } while (0)

struct XcdBarrier {
    unsigned* bar; unsigned x;
    volatile LAS unsigned* st;
};

__device__ __forceinline__ XcdBarrier xcd_barrier_post(unsigned* bar, volatile LAS unsigned* st) {
    XcdBarrier b; b.bar = bar; b.x = xb_xcc_id(); b.st = st;
    if (threadIdx.x == 0) (void)xb_add(&bar[XB_XCNT(b.x)], 1u);
    return b;
}
__device__ __forceinline__ void xcd_barrier_complete(unsigned* bar, unsigned x, unsigned& nloc, unsigned& nx) {
    const unsigned G = gridDim.x * gridDim.y * gridDim.z;
    unsigned sum, cnt, mine, sp = 0u;
    for (;;) {
        sum = 0u; cnt = 0u; mine = 0u;
#pragma unroll
        for (unsigned j = 0; j < 16; ++j) { const unsigned c = xb_ld(&bar[XB_XCNT(j)]); sum += c; cnt += (c > 0u) ? 1u : 0u; mine = (j == x) ? c : mine; }
        if (sum == G) break;
        __builtin_amdgcn_s_sleep(1);
        if ((++sp & 255u) == 0u) { if (xb_ld(&bar[XB_TMO])) break; if (sp > XB_SPIN_CAP) { atomicAdd(&bar[XB_TMO], 1u); break; } }
    }
    nloc = mine > 0u ? mine : 1u; nx = cnt > 0u ? cnt : 1u;
}

__device__ __forceinline__ void xcd_barrier(const XcdBarrier& b) {
    asm volatile("s_waitcnt vmcnt(0)" ::: "memory");
    __syncthreads();
    if (threadIdx.x == 0) {
        unsigned* bar = b.bar;
        __builtin_amdgcn_s_waitcnt(0);
        unsigned nloc = b.st[0], nx = b.st[1];
        if (nloc == 0u) { xcd_barrier_complete(bar, b.x, nloc, nx); b.st[0] = nloc; b.st[1] = nx; }
        const unsigned old = xb_add(&bar[XB_XSUB(b.x)], 1u);
        const unsigned gen = old / nloc;
        if (old + 1u == (gen + 1u) * nloc) {
            __builtin_amdgcn_fence(__ATOMIC_RELEASE, "agent");
            asm volatile("s_waitcnt vmcnt(0)" ::: "memory");
            const unsigned og = xb_add(&bar[XB_TOP], 1u);
            const unsigned tg = og / nx;
            if (og + 1u == (tg + 1u) * nx) xb_add(&bar[XB_TOPGEN], 1u);
            else XB_SPIN(xb_ld(&bar[XB_TOPGEN]) == tg, bar);
            __builtin_amdgcn_fence(__ATOMIC_ACQUIRE, "agent");
            xb_add(&bar[XB_XGEN(b.x)], 1u);
            asm volatile("s_waitcnt vmcnt(0)" ::: "memory");
        } else {
            XB_SPIN(xb_ld(&bar[XB_XGEN(b.x)]) == gen, bar);
            __builtin_amdgcn_fence(__ATOMIC_ACQUIRE, "agent");
            asm volatile("s_waitcnt vmcnt(0)" ::: "memory");
        }
    }
    __syncthreads();
}
namespace pg8 {
#define PG8_LAS __attribute__((address_space(3)))
typedef unsigned short bf16_t;
typedef short bf16x8 __attribute__((ext_vector_type(8)));
typedef float f32x4 __attribute__((ext_vector_type(4)));
typedef unsigned u32x4 __attribute__((ext_vector_type(4)));
constexpr int BM = 256, BK = 64, HALF = 128, HTB = HALF * BK * 2  , STAGE_BYTES = 8 * HTB, NXCD = 8, WGM = 8;

__host__ __device__ __forceinline__ int lds_byte(int r, int c) { const int st = (r >> 4) * 2 + (c >> 5), rr = r & 15, cc = c & 31, ob = rr * 64 + cc * 2; return st * 1024 + (ob ^ (((ob >> 9) & 1) << 5)); }
__host__ __device__ __forceinline__ void stage_rc(int b, int& R, int& C) { const int st = b / 1024, sb = b % 1024, swz = sb ^ (((sb >> 9) & 1) << 5); R = (st >> 1) * 16 + swz / 64; C = (st & 1) * 32 + (swz % 64) / 2; }
__host__ __device__ __forceinline__ int perm32(int rho) { const int n = rho >> 4, i = rho & 15; return 8 * (i >> 2) + 4 * n + (i & 3); }

struct Unit { int pm, pn, be, mask, qa, qb; };
struct Gemm { const bf16_t* A; const bf16_t* Bt; int M, N, K; size_t bes; };
__device__ __forceinline__ unsigned cvt_pk_bf16(float lo, float hi) { unsigned r; asm volatile("v_cvt_pk_bf16_f32 %0, %1, %2" : "=v"(r) : "v"(lo), "v"(hi)); return r; }
typedef float f32x2 __attribute__((ext_vector_type(2)));

__device__ __forceinline__ bool tail_deal(int L, int nwg, int G, int mode, int parts, int& idx, int& mask, int& qa, int& qb) {
    const int F = nwg / G, R = nwg - F * G; qa = 0; qb = 0; mask = 0xF;
    if (mode == 0) { if (L >= nwg) return false; idx = L; return true; }
    if (mode == 1) { if (L >= F * G) return false; idx = L; return true; }
    if (L >= R * parts) return false;
    idx = F * G + L / parts; const int p = L % parts;
    if (parts == 4) { qa = p >> 1; qb = p & 1; mask = 1; } else { qa = p; mask = 3; }
    return true;
}
struct DenseOrder {
    int nM, nN, nwg, G, c, mode, parts; bool skipctx;
    __device__ void init(int nM_, int nN_, int G_, int c_, bool skip_, int mode_ = 0, int parts_ = 1) { nM = nM_; nN = nN_; nwg = nM * nN; G = G_; c = c_; skipctx = skip_; mode = mode_; parts = parts_; }
    __device__ bool next(int i, Unit& u) const {
        int wgid; if (!tail_deal(i * G + c, nwg, G, mode, parts, wgid, u.mask, u.qa, u.qb)) return false;
        { const int q = nwg / NXCD, r = nwg % NXCD, xcd = wgid % NXCD, off = wgid / NXCD; wgid = (xcd < r ? xcd * (q + 1) : r * (q + 1) + (xcd - r) * q) + off; }
        const int nig = WGM * nN, gid = wgid / nig, fm = gid * WGM, gsz = (nM - fm) < WGM ? (nM - fm) : WGM;
        int pm = fm + ((wgid % nig) % gsz); u.pn = (wgid % nig) / gsz; u.be = 0;
        if (skipctx) pm = (pm >> 5) * 33 + 1 + (pm & 31);
        u.pm = pm; return true;
    }
    __device__ __forceinline__ void a_ready(const Unit&) const {}
    __device__ __forceinline__ void done(const Unit&) const {}
};
struct MoeOrder {
    int nM, nN, nwg, G, c, mode, parts; const PG8_LAS int* tile_e;
    __device__ void init(int nM_, int nN_, int G_, int c_, const PG8_LAS int* te, int mode_ = 0, int parts_ = 1) { nM = nM_; nN = nN_; nwg = nM * nN; G = G_; c = c_; tile_e = te; mode = mode_; parts = parts_; }
    __device__ bool next(int i, Unit& u) const {
        int wgid; if (!tail_deal(i * G + c, nwg, G, mode, parts, wgid, u.mask, u.qa, u.qb)) return false;
        { const int q = nwg / NXCD, r = nwg % NXCD, xcd = wgid % NXCD, off = wgid / NXCD; wgid = (xcd < r ? xcd * (q + 1) : r * (q + 1) + (xcd - r) * q) + off; }
        const int nig = WGM * nN, gid = wgid / nig, fm = gid * WGM, gsz = (nM - fm) < WGM ? (nM - fm) : WGM;
        u.pm = fm + ((wgid % nig) % gsz); u.pn = (wgid % nig) / gsz; u.be = __builtin_amdgcn_readfirstlane(tile_e[u.pm]); return true;
    }
    __device__ __forceinline__ void a_ready(const Unit&) const {}
    __device__ __forceinline__ void done(const Unit&) const {}
};

typedef unsigned u32x2 __attribute__((ext_vector_type(2)));
typedef float f32x2 __attribute__((ext_vector_type(2)));
__device__ __forceinline__ float silu_f(float v) { return v * __builtin_amdgcn_rcpf(1.f + __builtin_amdgcn_exp2f(__builtin_fminf(-v * 1.4426950408889634f, 80.f))); }
__device__ __forceinline__ float sigm_f(float v) { return __builtin_amdgcn_rcpf(1.f + __builtin_amdgcn_exp2f(__builtin_fminf(-v * 1.4426950408889634f, 80.f))); }
__device__ __forceinline__ float lfgate_f(float lb, float v) { const float e = __builtin_amdgcn_exp2f(__builtin_fminf(-v * 1.4426950408889634f, 80.f)); return __builtin_amdgcn_logf((1.f + lb * e) * __builtin_amdgcn_rcpf(1.f + e)) * 0.6931471805599453f; }
__device__ __forceinline__ u32x2 pk4(f32x4 v) { u32x2 w; w.x = cvt_pk_bf16(v[0], v[1]); w.y = cvt_pk_bf16(v[2], v[3]); return w; }
__device__ __forceinline__ u32x4 pair16(u32x2 a, u32x2 b) {
    const auto r0 = __builtin_amdgcn_permlane16_swap(a.x, b.x, false, false), r1 = __builtin_amdgcn_permlane16_swap(a.y, b.y, false, false);
    u32x4 w; w.x = r0[0]; w.y = r1[0]; w.z = r0[1]; w.w = r1[1]; return w;
}

struct EpiInProj {
    static constexpr bool PERM = true, AFTER_DRAIN = false;
    bf16_t *QH, *IV, *GG, *DQ, *DK, *DV; _Float16 *LFF, *LFB; const float* LB;     const float* ROPE;
    __device__ __forceinline__ void operator()(const f32x4 (&acc)[2][2][4][2], const Unit& u, int wr, int wc, int fr, int fq) const {
        const int seg = u.pn >> 1;
        const int cb = (u.pn & 1) * 256 + u.qb * 128 + wc * 32 + 8 * fq;
        const int jt = u.pm % 33; const bool latent = jt != 0;
        const int s0 = jt * 256 + u.qa * 128 + wr * 64 + fr;
        const size_t row0 = (size_t)u.pm * 256 + u.qa * 128 + wr * 64 + fr;
        if (seg == 1 || seg == 2) {
            _Float16* LF = seg == 1 ? LFF : LFB; typedef _Float16 h16x8 __attribute__((ext_vector_type(8))); const float* lbp = LB + (seg - 1) * 512;
#pragma unroll
            for (int bj = 0; bj < 2; ++bj) { const int col = cb + bj * 128; const f32x4 lb0 = *(const f32x4*)(lbp + col), lb1 = *(const f32x4*)(lbp + col + 4);
#pragma unroll
                for (int ai = 0; ai < 2; ++ai)
#pragma unroll
                    for (int m = 0; m < 4; ++m) { if (!(u.mask & (1 << (ai * 2 + bj)))) continue; const f32x4 v0 = acc[ai][bj][m][0], v1 = acc[ai][bj][m][1]; h16x8 o;
#pragma unroll
                        for (int e = 0; e < 4; ++e) { o[e] = (_Float16)lfgate_f(lb0[e], v0[e]); o[4 + e] = (_Float16)lfgate_f(lb1[e], v1[e]); }
                        *(h16x8*)(LF + (row0 + ai * 128 + m * 16) * 512 + col) = o; } }
        } else if (seg == 5 || seg == 6) {
            bf16_t* O = seg == 5 ? DQ : DK; const float sc = seg == 5 ? C2 : 1.f; const float sgn = fq < 2 ? -1.f : 1.f;
#pragma unroll
            for (int ai = 0; ai < 2; ++ai)
#pragma unroll
                for (int m = 0; m < 4; ++m) {
                    float co[8], si[8];
#pragma unroll
                    for (int e = 0; e < 8; ++e) { co[e] = 1.f; si[e] = 0.f; }
                    if (latent) { const int tau = s0 + ai * 128 + m * 16 - 256; const int pos = (wc & 1) ? (tau & 63) : (tau >> 6);
                        const float* rp = ROPE + (pos * 16 + 8 * (fq & 1)) * 2;
#pragma unroll
                        for (int k = 0; k < 4; ++k) { const f32x4 t4 = *(const f32x4*)(rp + 4 * k); co[2 * k] = t4[0]; si[2 * k] = t4[1]; co[2 * k + 1] = t4[2]; si[2 * k + 1] = t4[3]; } }
#pragma unroll
                    for (int bj = 0; bj < 2; ++bj) { if (!(u.mask & (1 << (ai * 2 + bj)))) continue; float x[8], o[8];
#pragma unroll
                        for (int e = 0; e < 4; ++e) { x[e] = acc[ai][bj][m][0][e]; x[4 + e] = acc[ai][bj][m][1][e]; }
#pragma unroll
                        for (int e = 0; e < 8; ++e) { const auto rr = __builtin_amdgcn_permlane32_swap(__float_as_uint(x[e]), __float_as_uint(x[e]), false, false);
                            const float pr = __uint_as_float(fq < 2 ? rr[1] : rr[0]); o[e] = (x[e] * co[e] + sgn * pr * si[e]) * sc; }
                        u32x4 w; w.x = cvt_pk_bf16(o[0], o[1]); w.y = cvt_pk_bf16(o[2], o[3]); w.z = cvt_pk_bf16(o[4], o[5]); w.w = cvt_pk_bf16(o[6], o[7]);
                        *(u32x4*)(O + (row0 + ai * 128 + m * 16) * 512 + cb + bj * 128) = w; } }
        } else {
            bf16_t* O = seg == 0 ? QH : seg == 3 ? IV : seg == 4 ? GG : DV;
#pragma unroll
            for (int ai = 0; ai < 2; ++ai)
#pragma unroll
                for (int m = 0; m < 4; ++m)
#pragma unroll
                    for (int bj = 0; bj < 2; ++bj) { if (!(u.mask & (1 << (ai * 2 + bj)))) continue; f32x4 v0 = acc[ai][bj][m][0], v1 = acc[ai][bj][m][1];
                        if (seg == 0) {
#pragma unroll
                            for (int e = 0; e < 4; ++e) { v0[e] = silu_f(v0[e]) * 0.08838834764831845f; v1[e] = silu_f(v1[e]) * 0.08838834764831845f; } }
                        else if (seg == 4) {
#pragma unroll
                            for (int e = 0; e < 4; ++e) { v0[e] = silu_f(v0[e]); v1[e] = silu_f(v1[e]); } }
                        u32x4 w; w.x = cvt_pk_bf16(v0[0], v0[1]); w.y = cvt_pk_bf16(v0[2], v0[3]); w.z = cvt_pk_bf16(v1[0], v1[1]); w.w = cvt_pk_bf16(v1[2], v1[3]);
                        *(u32x4*)(O + (row0 + ai * 128 + m * 16) * 512 + cb + bj * 128) = w; }
        }
    }
};
#ifndef EPISEL
#define EPISEL (-1)
#endif
template <class E> struct EpiTwice {
    static constexpr bool PERM = E::PERM, AFTER_DRAIN = false; E e;
    __device__ __forceinline__ void operator()(const f32x4 (&acc)[2][2][4][2], const Unit& u, int wr, int wc, int fr, int fq) const { e(acc, u, wr, wc, fr, fq); asm volatile("" ::: "memory");
        if (EPISEL < 0 || (u.pn >> 1) == EPISEL) e(acc, u, wr, wc, fr, fq); }
};

struct EpiOut0 {
    static constexpr bool PERM = false, AFTER_DRAIN = false;
    const float* x; const float* ctx; const float* MODL; bf16_t* X;
    __device__ __forceinline__ void operator()(const f32x4 (&acc)[2][2][4][2], const Unit& u, int wr, int wc, int fr, int fq) const {
        const int b = u.pm / 33, jt = u.pm % 33; const int vec = jt == 0 ? 2 : b;
        const int col0 = u.pn * 256 + u.qb * 128 + wc * 32 + 4 * fq; const float* gp = MODL + vec * 6144 + 2048 + col0;
        f32x4 gv[2][2];
#pragma unroll
        for (int bj = 0; bj < 2; ++bj)
#pragma unroll
            for (int n = 0; n < 2; ++n) gv[bj][n] = *(const f32x4*)(gp + bj * 128 + n * 16);
#pragma unroll
        for (int ai = 0; ai < 2; ++ai)
#pragma unroll
            for (int m = 0; m < 4; ++m) { const int sl = (ai + u.qa) * 128 + wr * 64 + m * 16 + fr;
                const float* src = jt == 0 ? ctx + ((size_t)b * 256 + sl) * 1024 : x + ((size_t)b * 8192 + (jt - 1) * 256 + sl) * 1024;
                bf16_t* dst = X + ((size_t)u.pm * 256 + sl) * 1024;
#pragma unroll
                for (int bj = 0; bj < 2; ++bj) { if (!(u.mask & (1 << (ai * 2 + bj)))) continue; const int c = col0 + bj * 128;
                    *(u32x4*)(dst + c + ((fq & 1) ? 12 : 0)) = pair16(pk4(*(const f32x4*)(src + c) + gv[bj][0] * acc[ai][bj][m][0]), pk4(*(const f32x4*)(src + c + 16) + gv[bj][1] * acc[ai][bj][m][1])); } }
    }
};
struct EpiOut1 {
    static constexpr bool PERM = false, AFTER_DRAIN = false;
    const float* MODL; bf16_t* X;
    __device__ __forceinline__ void operator()(const f32x4 (&acc)[2][2][4][2], const Unit& u, int wr, int wc, int fr, int fq) const {
        const int b = u.pm / 33; const int col0 = u.pn * 256 + u.qb * 128 + wc * 32 + 4 * fq; const float* gp = MODL + b * 6144 + 2048 + col0;
        f32x4 gv[2][2];
#pragma unroll
        for (int bj = 0; bj < 2; ++bj)
#pragma unroll
            for (int n = 0; n < 2; ++n) gv[bj][n] = *(const f32x4*)(gp + bj * 128 + n * 16);
#pragma unroll
        for (int ai = 0; ai < 2; ++ai)
#pragma unroll
            for (int m = 0; m < 4; ++m) { bf16_t* dst = X + ((size_t)u.pm * 256 + (ai + u.qa) * 128 + wr * 64 + m * 16 + fr) * 1024;
#pragma unroll
                for (int bj = 0; bj < 2; ++bj) { if (!(u.mask & (1 << (ai * 2 + bj)))) continue; const int c = col0 + bj * 128; u32x2 o2[2];
#pragma unroll
                    for (int n = 0; n < 2; ++n) { const u32x2 xw = *(const u32x2*)(dst + c + n * 16); f32x4 xv; xv[0] = __uint_as_float(xw.x << 16); xv[1] = __uint_as_float(xw.x & 0xffff0000u); xv[2] = __uint_as_float(xw.y << 16); xv[3] = __uint_as_float(xw.y & 0xffff0000u);
                        o2[n] = pk4(xv + gv[bj][n] * acc[ai][bj][m][n]); }
                    *(u32x4*)(dst + c + ((fq & 1) ? 12 : 0)) = pair16(o2[0], o2[1]); } }
    }
};
__device__ __forceinline__ unsigned pk4_fp8(float a, float b, float c, float d) {
    a = __builtin_fminf(__builtin_fmaxf(a, -448.f), 448.f); b = __builtin_fminf(__builtin_fmaxf(b, -448.f), 448.f); c = __builtin_fminf(__builtin_fmaxf(c, -448.f), 448.f); d = __builtin_fminf(__builtin_fmaxf(d, -448.f), 448.f);
    int p = __builtin_amdgcn_cvt_pk_fp8_f32(a, b, 0, false); p = __builtin_amdgcn_cvt_pk_fp8_f32(c, d, p, true); return (unsigned)p;
}
constexpr float W8_SCALE = 64.f, W8_INV = 1.f / 64.f;
struct EpiGateUp8 {
    static constexpr bool PERM = false, AFTER_DRAIN = false;
    unsigned char* HID;
    __device__ __forceinline__ void operator()(const f32x4 (&acc)[2][2][4][2], const Unit& u, int wr, int wc, int fr, int fq) const {
        const int col0 = u.pn * 128 + wc * 32 + 4 * fq + ((fq & 1) ? 12 : 0);
#pragma unroll
        for (int ai = 0; ai < 2; ++ai)
#pragma unroll
            for (int m = 0; m < 4; ++m) { if (!(u.mask & (3 << (2 * ai)))) continue; f32x4 h0, h1;
#pragma unroll
                for (int e = 0; e < 4; ++e) { h0[e] = silu_f(acc[ai][0][m][0][e] * W8_INV) * (acc[ai][1][m][0][e] * W8_INV); h1[e] = silu_f(acc[ai][0][m][1][e] * W8_INV) * (acc[ai][1][m][1][e] * W8_INV); }
                unsigned char* p = HID + ((size_t)u.pm * 256 + (ai + u.qa) * 128 + wr * 64 + m * 16 + fr) * 1024 + col0;
                { const auto rr = __builtin_amdgcn_permlane16_swap(pk4_fp8(h0[0], h0[1], h0[2], h0[3]), pk4_fp8(h1[0], h1[1], h1[2], h1[3]), false, false); u32x2 w; w.x = rr[0]; w.y = rr[1]; *(u32x2*)p = w; } }
    }
};
struct EpiGateUp {
    static constexpr bool PERM = true, AFTER_DRAIN = false;
    bf16_t* HID;
    __device__ __forceinline__ void operator()(const f32x4 (&acc)[2][2][4][2], const Unit& u, int wr, int wc, int fr, int fq) const {
        const int col0 = u.pn * 128 + wc * 32 + 8 * fq;
#pragma unroll
        for (int ai = 0; ai < 2; ++ai)
#pragma unroll
            for (int m = 0; m < 4; ++m) { if (!(u.mask & (3 << (2 * ai)))) continue; f32x4 h0, h1;
#pragma unroll
                for (int e = 0; e < 4; ++e) { h0[e] = silu_f(acc[ai][0][m][0][e]) * acc[ai][1][m][0][e]; h1[e] = silu_f(acc[ai][0][m][1][e]) * acc[ai][1][m][1][e]; }
                u32x4 w; w.x = cvt_pk_bf16(h0[0], h0[1]); w.y = cvt_pk_bf16(h0[2], h0[3]); w.z = cvt_pk_bf16(h1[0], h1[1]); w.w = cvt_pk_bf16(h1[2], h1[3]);
                *(u32x4*)(HID + ((size_t)u.pm * 256 + (ai + u.qa) * 128 + wr * 64 + m * 16 + fr) * 1024 + col0) = w; }
    }
};
struct EpiDown {
    static constexpr bool PERM = true, AFTER_DRAIN = false;
    bf16_t* YB; const float* ROWW; float oscale;
    __device__ __forceinline__ void operator()(const f32x4 (&acc)[2][2][4][2], const Unit& u, int wr, int wc, int fr, int fq) const {
        const int col0 = u.pn * 256 + u.qb * 128 + wc * 32 + 8 * fq;
#pragma unroll
        for (int ai = 0; ai < 2; ++ai)
#pragma unroll
            for (int m = 0; m < 4; ++m) { const size_t row = (size_t)u.pm * 256 + (ai + u.qa) * 128 + wr * 64 + m * 16 + fr; const float w_ = ROWW[row] * oscale;
#pragma unroll
                for (int bj = 0; bj < 2; ++bj) { if (!(u.mask & (1 << (ai * 2 + bj)))) continue; const f32x4 v0 = acc[ai][bj][m][0] * w_, v1 = acc[ai][bj][m][1] * w_;
                    u32x4 w; w.x = cvt_pk_bf16(v0[0], v0[1]); w.y = cvt_pk_bf16(v0[2], v0[3]); w.z = cvt_pk_bf16(v1[0], v1[1]); w.w = cvt_pk_bf16(v1[2], v1[3]);
                    *(u32x4*)(YB + row * 1024 + col0 + bj * 128) = w; } }
    }
};
struct EpiDown8 {
    static constexpr bool PERM = false, AFTER_DRAIN = false;
    bf16_t* YB; const float* ROWW;
    __device__ __forceinline__ void operator()(const f32x4 (&acc)[2][2][4][2], const Unit& u, int wr, int wc, int fr, int fq) const {
        const int col0 = u.pn * 256 + u.qb * 128 + wc * 32 + 4 * fq + ((fq & 1) ? 12 : 0);
#pragma unroll
        for (int ai = 0; ai < 2; ++ai)
#pragma unroll
            for (int m = 0; m < 4; ++m) { const size_t row = (size_t)u.pm * 256 + (ai + u.qa) * 128 + wr * 64 + m * 16 + fr; const float w_ = ROWW[row] * W8_INV;
#pragma unroll
                for (int bj = 0; bj < 2; ++bj) { if (!(u.mask & (1 << (ai * 2 + bj)))) continue;
                    *(u32x4*)(YB + row * 1024 + col0 + bj * 128) = pair16(pk4(acc[ai][bj][m][0] * w_), pk4(acc[ai][bj][m][1] * w_)); } }
    }
};
struct EpiQKV1 {
    static constexpr bool PERM = false, AFTER_DRAIN = false;
    bf16_t *Q1, *K1, *V1; const float* ROPE;
    __device__ __forceinline__ void operator()(const f32x4 (&acc)[2][2][4][2], const Unit& u, int wr, int wc, int fr, int fq) const {
        const int jt = u.pm % 33; const bool latent = jt != 0;
        const int s0 = jt * 256 + u.qa * 128 + wr * 64 + fr; const size_t row0 = (size_t)u.pm * 256 + u.qa * 128 + wr * 64 + fr;
        const int cb = u.qb * 128 + wc * 32 + 4 * fq;
        if (u.pn == 5) {
#pragma unroll
            for (int ai = 0; ai < 2; ++ai)
#pragma unroll
                for (int m = 0; m < 4; ++m)
#pragma unroll
                    for (int bj = 0; bj < 2; ++bj) { if (!(u.mask & (1 << (ai * 2 + bj)))) continue; *(u32x4*)(V1 + (row0 + ai * 128 + m * 16) * 256 + cb + bj * 128 + ((fq & 1) ? 12 : 0)) = pair16(pk4(acc[ai][bj][m][0]), pk4(acc[ai][bj][m][1])); }
        } else {
            const bool isq = u.pn < 4; bf16_t* O = isq ? Q1 + u.pn * 256 : K1; const int pitch = isq ? 1024 : 256; const float sc = isq ? C2 : 1.f;
#pragma unroll
            for (int ai = 0; ai < 2; ++ai)
#pragma unroll
                for (int m = 0; m < 4; ++m) {
                    f32x4 cs0 = {1.f, 0.f, 1.f, 0.f}, cs1 = {1.f, 0.f, 1.f, 0.f};
                    if (latent) { const int tau = s0 + ai * 128 + m * 16 - 256; const int pos = (wc & 1) ? (tau & 63) : (tau >> 6);
                        const float* rp = ROPE + (pos * 16 + 4 * fq) * 2; cs0 = *(const f32x4*)rp; cs1 = *(const f32x4*)(rp + 4); }
                    const float co[4] = {cs0[0], cs0[2], cs1[0], cs1[2]}, si[4] = {cs0[1], cs0[3], cs1[1], cs1[3]};
#pragma unroll
                    for (int bj = 0; bj < 2; ++bj) { if (!(u.mask & (1 << (ai * 2 + bj)))) continue; const f32x4 a0 = acc[ai][bj][m][0], a1 = acc[ai][bj][m][1]; f32x4 o0, o1;
#pragma unroll
                        for (int e = 0; e < 4; ++e) { o0[e] = (a0[e] * co[e] - a1[e] * si[e]) * sc; o1[e] = (a1[e] * co[e] + a0[e] * si[e]) * sc; }
                        bf16_t* p = O + (row0 + ai * 128 + m * 16) * pitch + cb + bj * 128;
                        *(u32x4*)(p + ((fq & 1) ? 12 : 0)) = pair16(pk4(o0), pk4(o1)); } }
        }
    }
};
template <class Epi, class Sched, bool ALIGN_EPI = false, bool SP2 = false, int TMASK = 0xF, bool F8 = false>
__device__ __forceinline__ void gemm_phase(PG8_LAS unsigned char* lds, const Gemm g, const Sched& S, const Epi& E) {
    int tid_ = threadIdx.x; asm volatile("" : "+v"(tid_));
    const int tid = tid_, wid = __builtin_amdgcn_readfirstlane(tid >> 6), lane = tid & 63, wr = wid >> 2, wc = wid & 3, fr = lane & 15, fq = lane >> 4;
    const int K = g.K, nt = K / BK;
    unsigned voffA, voffB;
    { int R, C; stage_rc(tid * 16, R, C); const int Rb = Epi::PERM ? ((R & ~31) + perm32(R & 31)) : R;
        voffA = (unsigned)(R * K + C) * 2u; voffB = (unsigned)(Rb * K + C) * 2u; }
#define voffB (*(Epi::PERM ? &voffB : &voffA))
    const size_t kstep = (size_t)(BK * 2);
    const size_t hstep = (size_t)HALF * K * 2;
    const size_t tstep = 2 * hstep;
    const unsigned ldsw = (unsigned)wid * 1024u;
    const int aoff = lds_byte(wr * 64 + fr, F8 ? fq * 16 : fq * 8), boff = lds_byte(wc * 32 + fr, F8 ? fq * 16 : fq * 8);
    typedef int v8i_t __attribute__((ext_vector_type(8))); typedef int v4i_t __attribute__((ext_vector_type(4)));
#define PG8_SA(b, h) (((b) * 2 + (h)) * HTB)
#define PG8_SB(b, h) ((4 + (b) * 2 + (h)) * HTB)
#define PG8_STAGE(bufoff, gbase, voff) do { _Pragma("unroll") for (int _i = 0; _i < 2; ++_i) \
        __builtin_amdgcn_global_load_lds((const unsigned*)((const char*)(gbase) + (size_t)_i * 128 * K + (voff)), (PG8_LAS unsigned*)(lds + (bufoff) + ldsw + _i * 8192), 16, 0, 0); } while (0)
#define PG8_LD8(base) __builtin_shufflevector(*(const PG8_LAS v4i_t*)(base), *(const PG8_LAS v4i_t*)((base) + 16), 0, 1, 2, 3, 4, 5, 6, 7)
#define PG8_LDA(dst, b, h) do { if (!((TMASK >> (2 * (h))) & 3)) break; \
        if constexpr (F8) { _Pragma("unroll") for (int m = 0; m < 4; ++m) dst##8[m] = PG8_LD8(lds + PG8_SA(b, h) + aoff + m * 2048); } \
        else { _Pragma("unroll") for (int m = 0; m < 4; ++m) _Pragma("unroll") for (int k = 0; k < 2; ++k) dst[m][k] = *(const PG8_LAS bf16x8*)(lds + PG8_SA(b, h) + aoff + m * 2048 + k * 1024); } } while (0)
#define PG8_LDB(dst, b, h) do { if (!(TMASK & (5 << (h)))) break; \
        if constexpr (F8) { _Pragma("unroll") for (int n = 0; n < 2; ++n) dst##8[n] = PG8_LD8(lds + PG8_SB(b, h) + boff + n * 2048); } \
        else { _Pragma("unroll") for (int n = 0; n < 2; ++n) _Pragma("unroll") for (int k = 0; k < 2; ++k) dst[n][k] = *(const PG8_LAS bf16x8*)(lds + PG8_SB(b, h) + boff + n * 2048 + k * 1024); } } while (0)
#define PG8_MMA(ai, bj, At, Bt) do { if (!((TMASK >> ((ai) * 2 + (bj))) & 1)) break; __builtin_amdgcn_s_setprio(1); \
        if constexpr (F8) { _Pragma("unroll") for (int m = 0; m < 4; ++m) _Pragma("unroll") for (int n = 0; n < 2; ++n) \
            acc[ai][bj][m][n] = __builtin_amdgcn_mfma_scale_f32_16x16x128_f8f6f4(Bt##8[n], At##8[m], acc[ai][bj][m][n], 0, 0, 0, 0x7f7f7f7f, 0, 0x7f7f7f7f); } \
        else { _Pragma("unroll") for (int m = 0; m < 4; ++m) _Pragma("unroll") for (int n = 0; n < 2; ++n) _Pragma("unroll") for (int k = 0; k < 2; ++k) \
            acc[ai][bj][m][n] = __builtin_amdgcn_mfma_f32_16x16x32_bf16(Bt[n][k], At[m][k], acc[ai][bj][m][n], 0, 0, 0); } \
        __builtin_amdgcn_s_setprio(0); } while (0)
#define PG8_WAIT_V(n) asm volatile("s_waitcnt vmcnt(" #n ")" ::: "memory")
#define PG8_WAIT_L(n) asm volatile("s_waitcnt lgkmcnt(" #n ")" ::: "memory")
#define PG8_BAR __builtin_amdgcn_s_barrier()
#define PG8_SCHED __builtin_amdgcn_sched_barrier(0)
    Unit cur, nxt; int ui = 0;
    if (!S.next(0, cur)) return;
    f32x4 acc[2][2][4][2];
#pragma unroll
    for (int a = 0; a < 2; ++a)
#pragma unroll
        for (int b = 0; b < 2; ++b)
#pragma unroll
            for (int m = 0; m < 4; ++m)
#pragma unroll
                for (int n = 0; n < 2; ++n) acc[a][b][m][n] = (f32x4){0.f, 0.f, 0.f, 0.f};
    bf16x8 At[4][2], B0[2][2], B1[2][2];
    v8i_t At8[4], B08[2], B18[2];
    const char* cA = (const char*)g.A + (size_t)cur.pm * tstep + (size_t)cur.qa * hstep; const char* cB = (const char*)g.Bt + (size_t)cur.be * g.bes + (size_t)cur.pn * tstep + (size_t)cur.qb * hstep;
    S.a_ready(cur);
    if constexpr (SP2) {
        PG8_STAGE(PG8_SB(0, 0), cB, voffB); PG8_STAGE(PG8_SB(0, 1), cB + hstep, voffB); PG8_STAGE(PG8_SA(0, 0), cA, voffA); PG8_STAGE(PG8_SA(0, 1), cA + hstep, voffA);
        if (wr == 1) PG8_BAR;
        PG8_WAIT_V(2); PG8_BAR;
        PG8_STAGE(PG8_SB(1, 0), cB + kstep, voffB); PG8_STAGE(PG8_SA(1, 0), cA + kstep, voffA); PG8_STAGE(PG8_SB(1, 1), cB + hstep + kstep, voffB);
        PG8_WAIT_V(6); PG8_BAR;
    } else {
        PG8_STAGE(PG8_SB(0, 0), cB, voffB); PG8_STAGE(PG8_SA(0, 0), cA, voffA); PG8_STAGE(PG8_SB(0, 1), cB + hstep, voffB); PG8_STAGE(PG8_SA(0, 1), cA + hstep, voffA);
        if (wr == 1) PG8_BAR;
        PG8_WAIT_V(4); PG8_BAR;
        PG8_STAGE(PG8_SB(1, 0), cB + kstep, voffB); PG8_STAGE(PG8_SA(1, 0), cA + kstep, voffA); PG8_STAGE(PG8_SB(1, 1), cB + hstep + kstep, voffB);
        PG8_WAIT_V(6); PG8_BAR;
    }
    for (;;) {
        const bool has_next = S.next(ui + 1, nxt);
        const char* nA = has_next ? (const char*)g.A + (size_t)nxt.pm * tstep + (size_t)nxt.qa * hstep : cA; const char* nB = has_next ? (const char*)g.Bt + (size_t)nxt.be * g.bes + (size_t)nxt.pn * tstep + (size_t)nxt.qb * hstep : cB;
#pragma unroll 1
        for (int t = 0; t < nt; t += 2) {
            const bool last = (t == nt - 2);
            const char* a1 = cA + (size_t)(t + 1) * kstep;
            const char* a2 = last ? nA : cA + (size_t)(t + 2) * kstep; const char* b2 = last ? nB : cB + (size_t)(t + 2) * kstep;
            const char* a3 = a2 + kstep; const char* b3 = b2 + kstep;
            if (last && has_next) S.a_ready(nxt);
            if constexpr (SP2) {
            PG8_LDB(B0, 0, 0); PG8_LDB(B1, 0, 1); PG8_SCHED; PG8_LDA(At, 0, 0); PG8_STAGE(PG8_SA(1, 1), a1 + hstep, voffA);
            PG8_WAIT_V(8); PG8_WAIT_L(0); PG8_BAR; PG8_MMA(0, 0, At, B0); PG8_MMA(0, 1, At, B1); PG8_BAR; PG8_SCHED;
            PG8_LDA(At, 0, 1); PG8_STAGE(PG8_SB(0, 0), b2, voffB); PG8_STAGE(PG8_SB(0, 1), b2 + hstep, voffB); PG8_STAGE(PG8_SA(0, 0), a2, voffA);
            PG8_WAIT_V(8); PG8_WAIT_L(0); PG8_BAR; PG8_MMA(1, 0, At, B0); PG8_MMA(1, 1, At, B1); PG8_BAR; PG8_SCHED;
            PG8_LDB(B0, 1, 0); PG8_LDB(B1, 1, 1); PG8_SCHED; PG8_LDA(At, 1, 0); PG8_STAGE(PG8_SA(0, 1), a2 + hstep, voffA);
            PG8_WAIT_V(8); PG8_WAIT_L(0); PG8_BAR; PG8_MMA(0, 0, At, B0); PG8_MMA(0, 1, At, B1); PG8_BAR; PG8_SCHED;
            PG8_LDA(At, 1, 1); PG8_STAGE(PG8_SB(1, 0), b3, voffB); PG8_STAGE(PG8_SB(1, 1), b3 + hstep, voffB); PG8_STAGE(PG8_SA(1, 0), a3, voffA);
            PG8_WAIT_V(8); PG8_WAIT_L(0); PG8_BAR; PG8_MMA(1, 0, At, B0); PG8_MMA(1, 1, At, B1); PG8_BAR; PG8_SCHED;
            } else {
            PG8_LDB(B0, 0, 0); PG8_SCHED; PG8_LDA(At, 0, 0); PG8_STAGE(PG8_SA(1, 1), a1 + hstep, voffA);
            PG8_WAIT_L(8); PG8_BAR; PG8_WAIT_L(0); PG8_MMA(0, 0, At, B0); PG8_BAR; PG8_SCHED;
            PG8_LDB(B1, 0, 1); PG8_STAGE(PG8_SB(0, 0), b2, voffB);
            PG8_BAR; PG8_WAIT_L(0); PG8_MMA(0, 1, At, B1); PG8_BAR;
            PG8_LDA(At, 0, 1); PG8_STAGE(PG8_SA(0, 0), a2, voffA);
            PG8_BAR; PG8_WAIT_L(0); PG8_MMA(1, 0, At, B0); PG8_BAR; PG8_SCHED;
            PG8_STAGE(PG8_SB(0, 1), b2 + hstep, voffB);
            PG8_WAIT_V(6); PG8_BAR; PG8_MMA(1, 1, At, B1); PG8_BAR;
            PG8_LDB(B0, 1, 0); PG8_SCHED; PG8_LDA(At, 1, 0); PG8_STAGE(PG8_SA(0, 1), a2 + hstep, voffA);
            PG8_WAIT_L(8); PG8_BAR; PG8_WAIT_L(0); PG8_MMA(0, 0, At, B0); PG8_BAR; PG8_SCHED;
            PG8_LDB(B1, 1, 1); PG8_STAGE(PG8_SB(1, 0), b3, voffB);
            PG8_BAR; PG8_WAIT_L(0); PG8_MMA(0, 1, At, B1); PG8_BAR;
            PG8_LDA(At, 1, 1); PG8_STAGE(PG8_SA(1, 0), a3, voffA);
            PG8_BAR; PG8_WAIT_L(0); PG8_MMA(1, 0, At, B0); PG8_BAR; PG8_SCHED;
            PG8_STAGE(PG8_SB(1, 1), b3 + hstep, voffB);
            PG8_WAIT_V(6); PG8_BAR; PG8_MMA(1, 1, At, B1); PG8_BAR;
            }
        }
        if constexpr (ALIGN_EPI) { if (wr == 0) PG8_BAR; }
        if constexpr (!Epi::AFTER_DRAIN) { int t_e = threadIdx.x; asm volatile("" : "+v"(t_e)); const int fr_e = t_e & 15, fq_e = (t_e >> 4) & 3;
            E(acc, cur, wr, wc, fr_e, fq_e); S.done(cur); }
        if (!has_next) break;
#pragma unroll
        for (int a = 0; a < 2; ++a)
#pragma unroll
            for (int b = 0; b < 2; ++b)
#pragma unroll
                for (int m = 0; m < 4; ++m)
#pragma unroll
                    for (int n = 0; n < 2; ++n) acc[a][b][m][n] = (f32x4){0.f, 0.f, 0.f, 0.f};
        cur = nxt; cA = nA; cB = nB; ++ui;
        if constexpr (ALIGN_EPI) { if (wr == 1) PG8_BAR; }
    }
    PG8_WAIT_V(0);
    if constexpr (!ALIGN_EPI) { if (wr == 0) PG8_BAR; }
    PG8_BAR;
    if constexpr (Epi::AFTER_DRAIN) { E.fused(acc, cur, wr, wc, fr, fq, lds, wid, lane); S.done(cur); }
#undef PG8_SA
#undef PG8_SB
#undef PG8_STAGE
#undef voffB
#undef PG8_LDA
#undef PG8_LDB
#undef PG8_MMA
#undef PG8_LD8
#undef PG8_WAIT_V
#undef PG8_WAIT_L
#undef PG8_BAR
#undef PG8_SCHED
}
}
namespace attn_body {
using bf16=__hip_bfloat16;
using bf16x8=__attribute__((ext_vector_type(8)))short;
using s16x4=__attribute__((ext_vector_type(4)))short;
using f32x16=__attribute__((ext_vector_type(16)))float;
using u32x4=__attribute__((ext_vector_type(4)))unsigned;
constexpr int D=64;
constexpr int NW=8,QBLK=32,QB=QBLK*NW,KVBLK=64;
constexpr int ATTN_UNIT_ROWS=QB;
__device__ __forceinline__ int crow(int r,int hi){return (r&3)+8*(r>>2)+4*hi;}
#define SBAR() __builtin_amdgcn_sched_barrier(0)
__device__ __forceinline__ void swamask(f32x16&p0,f32x16&p1,int dq0,bool tin,int hi){
  const float NEG=-INFINITY;
  #pragma unroll
  for(int r=0;r<16;++r){const int kv=4*hi+(r&3)+8*(r>>2); const int d0=dq0-kv, d1=d0-32;
    if(!(tin&&d0>=-128&&d0<=128))p0[r]=NEG; if(!(tin&&d1>=-128&&d1<=128))p1[r]=NEG;}
}

constexpr int NSLOT=3, SLOTB=8192;
constexpr int LDS_K=0, LDS_V=NSLOT*SLOTB, LDS_WS=2*NSLOT*SLOTB, LDS_OST=LDS_WS+NW*64*4, LDS_BYTES=LDS_OST+NW*4096;
constexpr float C2A=0.125f*1.4426950408889634f;
__device__ __forceinline__ void glds16(const void*gsrc,unsigned lds_dst){unsigned keep;
  asm volatile("s_mov_b32 %0, m0\n\ts_mov_b32 m0, %2\n\ts_nop 0\n\tglobal_load_lds_dwordx4 %1, off\n\ts_mov_b32 m0, %0":"=&s"(keep):"v"(gsrc),"s"(lds_dst):"memory");}
__device__ __forceinline__ float max3f(float a,float b,float c){float r;asm("v_max3_f32 %0, %1, %2, %3":"=v"(r):"v"(a),"v"(b),"v"(c));return r;}
__device__ __forceinline__ float max2f(float a,float b){float r;asm("v_max_f32_e32 %0, %1, %2":"=v"(r):"v"(a),"v"(b));return r;}
__device__ __forceinline__ float fadd_s(float a,float b){float r;asm("v_add_f32_e32 %0, %1, %2":"=v"(r):"v"(a),"v"(b));return r;}
__device__ __forceinline__ float fsub_s(float a,float b){float r;asm("v_sub_f32_e32 %0, %1, %2":"=v"(r):"v"(a),"v"(b));return r;}
typedef float f32x2_t __attribute__((ext_vector_type(2))); typedef __bf16 bf16x2_t __attribute__((ext_vector_type(2)));
__device__ __forceinline__ unsigned cvtpk_s(float lo,float hi){f32x2_t v={lo,hi};bf16x2_t b=__builtin_convertvector(v,bf16x2_t);return __builtin_bit_cast(unsigned,b);}
#define WAIT_BAR(N) asm volatile("s_waitcnt vmcnt(" #N ") lgkmcnt(0)\n\ts_barrier":::"memory")

__device__ __forceinline__ void qkt(f32x16&p0,f32x16&p1,const char*Kslot,const bf16x8*qr,const f32x16&negm,int r32,int hi){
  const char*kb=Kslot+hi*1024+r32*16;
  #pragma unroll
  for(int d0=0;d0<4;++d0){
    const bf16x8 b0=*reinterpret_cast<const bf16x8*>(kb+d0*2048);
    const bf16x8 b1=*reinterpret_cast<const bf16x8*>(kb+d0*2048+512);
    if(d0==0){p0=__builtin_amdgcn_mfma_f32_32x32x16_bf16(b0,qr[0],negm,0,0,0);p1=__builtin_amdgcn_mfma_f32_32x32x16_bf16(b1,qr[0],negm,0,0,0);}
    else{p0=__builtin_amdgcn_mfma_f32_32x32x16_bf16(b0,qr[d0],p0,0,0,0);p1=__builtin_amdgcn_mfma_f32_32x32x16_bf16(b1,qr[d0],p1,0,0,0);}}
}
typedef __attribute__((address_space(3))) const char* lds_cptr;
typedef short v4i16_t __attribute__((ext_vector_type(4)));
__device__ __forceinline__ void kload8(bf16x8*kf,lds_cptr kp){
  kf[0]=*(const __attribute__((address_space(3))) bf16x8*)(kp);      kf[1]=*(const __attribute__((address_space(3))) bf16x8*)(kp+512);
  kf[2]=*(const __attribute__((address_space(3))) bf16x8*)(kp+2048); kf[3]=*(const __attribute__((address_space(3))) bf16x8*)(kp+2560);
  kf[4]=*(const __attribute__((address_space(3))) bf16x8*)(kp+4096); kf[5]=*(const __attribute__((address_space(3))) bf16x8*)(kp+4608);
  kf[6]=*(const __attribute__((address_space(3))) bf16x8*)(kp+6144); kf[7]=*(const __attribute__((address_space(3))) bf16x8*)(kp+6656);
}
__device__ __forceinline__ void kload2(bf16x8*kf,lds_cptr kp,int j){ kf[2*j]=*(const __attribute__((address_space(3))) bf16x8*)(kp+j*2048); kf[2*j+1]=*(const __attribute__((address_space(3))) bf16x8*)(kp+j*2048+512); }
__device__ __forceinline__ s16x4 vtr(lds_cptr p){ return __builtin_bit_cast(s16x4,__builtin_amdgcn_ds_read_tr16_b64_v4i16((__attribute__((address_space(3))) v4i16_t*)p)); }
__device__ __forceinline__ float rowmax(const f32x16&p0,const f32x16&p1){
  float a=max3f(p0[0],p0[1],p1[0]),b=max3f(p0[2],p0[3],p1[1]);a=max3f(a,p1[2],p1[3]);
  #pragma unroll
  for(int r=4;r<16;r+=4){a=max3f(a,p0[r],p0[r+1]);b=max3f(b,p0[r+2],p0[r+3]);a=max3f(a,p1[r],p1[r+1]);b=max3f(b,p1[r+2],p1[r+3]);}
  const float m=max2f(a,b);
  auto rr=__builtin_amdgcn_permlane32_swap(__float_as_uint(m),__float_as_uint(m),false,false);
  return max2f(__uint_as_float(rr[0]),__uint_as_float(rr[1]));
}
__device__ __forceinline__ void pv(f32x16*o,int vb,bf16x8 pa0,bf16x8 pa1,bf16x8 pa2,bf16x8 pa3){
  #pragma unroll
  for(int d0=0;d0<2;++d0){s16x4 lo[4],hi[4];
    #pragma unroll
    for(int ks=0;ks<4;++ks){
      asm volatile("ds_read_b64_tr_b16 %0,%1 offset:%c2":"=&v"(lo[ks]):"v"(vb),"i"(d0*4096+ks*1024):"memory");
      asm volatile("ds_read_b64_tr_b16 %0,%1 offset:%c2":"=&v"(hi[ks]):"v"(vb),"i"(d0*4096+ks*1024+512):"memory");}
    asm volatile("s_waitcnt lgkmcnt(0)":::"memory");SBAR();
    #define PK(k) (bf16x8){lo[k][0],lo[k][1],lo[k][2],lo[k][3],hi[k][0],hi[k][1],hi[k][2],hi[k][3]}
    o[d0]=__builtin_amdgcn_mfma_f32_32x32x16_bf16(pa0,PK(0),o[d0],0,0,0);
    o[d0]=__builtin_amdgcn_mfma_f32_32x32x16_bf16(pa1,PK(1),o[d0],0,0,0);
    o[d0]=__builtin_amdgcn_mfma_f32_32x32x16_bf16(pa2,PK(2),o[d0],0,0,0);
    o[d0]=__builtin_amdgcn_mfma_f32_32x32x16_bf16(pa3,PK(3),o[d0],0,0,0);
    #undef PK
  }
}

#ifndef ATTN_STORE16
#define ATTN_STORE16(p,v) (*(u32x4*)(p)=(v))
#endif
template<int THRL,int MODE> __device__ __forceinline__ void attn_unit(const bf16*Qw0,int QP,const bf16*__restrict__ Kh,int KP,const bf16*__restrict__ Vh,int VP,bf16*Ow0,int OP,int NT,int tau0,const float*sinkp,char*shm){
  const int tid=threadIdx.x,lane=tid&63,r32=lane&31,hi=lane>>5; const int wid=__builtin_amdgcn_readfirstlane(tid>>6);
  const int wrow=(MODE==1)?(wid&1)*QBLK:wid*QBLK, wcol=(MODE==1)?(wid>>1)*64:0;
  const float sink_l2=(MODE==1)?sinkp[wid>>1]*1.4426950408889634f:0.f;
  const bf16*Qw=Qw0+(long)wrow*QP+wcol;
  const unsigned lds0=(unsigned)(uintptr_t)shm;
  float*wsf=(float*)(shm+LDS_WS)+wid*64;
  const bf16*ksrc=Kh+(long)lane*KP+wid*8;
  const bf16*vsrc=Vh+(long)(16*(wid&3)+(lane>>2))*VP+(wid>>2)*32+(lane&3)*8;
  const unsigned kdst=lds0+LDS_K+wid*1024, vdst=lds0+LDS_V+wid*1024;
  #define TROW(t) ((MODE==0||(t)<4)?(long)(t)*KVBLK:(long)(256+min(max(tau0-128+64*((t)-4),0),8192-64)))
  #define DMA_K(t,slot) glds16(ksrc+TROW(t)*KP,(unsigned)__builtin_amdgcn_readfirstlane(kdst+(slot)))
  #define DMA_V(t,slot) glds16(vsrc+TROW(t)*VP,(unsigned)__builtin_amdgcn_readfirstlane(vdst+(slot)))
  const int vb0=(int)(lds0+LDS_V)+((lane>>4)&1)*32+(lane&3)*8+(4*hi+((lane&15)>>2))*64;
  const char*Kbase=shm+LDS_K; bf16x8 kf[8];
  const lds_cptr shm3=(lds_cptr)shm; const lds_cptr kp0=shm3+LDS_K+hi*1024+r32*16; const lds_cptr vp0=shm3+LDS_V+((lane>>4)&1)*32+(lane&3)*8+(4*hi+((lane&15)>>2))*64;
  DMA_K(0,0);DMA_V(0,0);DMA_K(1,SLOTB);
  bf16x8 qr[4];
  #pragma unroll
  for(int d0=0;d0<4;++d0)qr[d0]=*reinterpret_cast<const bf16x8*>(&Qw[(long)r32*QP+d0*16+hi*8]);
  float mhat=0.f,l_reg=0.f;f32x16 o[2];o[0]=f32x16{};o[1]=f32x16{};f32x16 negm=f32x16{};asm volatile("":"+v"(negm));
  const int qrel=wrow+r32;
  #define CMASK(P0,P1,t) do{ if(MODE==1){ if((t)>=4){ const int ts_=tau0-128+64*((t)-4); swamask(P0,P1,qrel+128-64*((t)-4),(ts_>=0&&ts_<8192),hi);} } }while(0)
  bool resc=false;
  #define START(P0,P1) do{ const float rm=rowmax(P0,P1); resc=false; \
    { const float dl=rm; mhat=fadd_s(mhat,dl); \
      _Pragma("unroll") for(int r=0;r<16;++r){P0[r]=fsub_s(P0[r],dl);P1[r]=fsub_s(P1[r],dl);} \
      _Pragma("unroll") for(int r=0;r<16;++r)negm[r]=-mhat; asm volatile("":"+v"(negm)); } \
    _Pragma("unroll") for(int r=0;r<16;++r)P0[r]=__builtin_amdgcn_exp2f(P0[r]); }while(0)
  #define RESC() do{ if(resc){ asm volatile("s_waitcnt lgkmcnt(0)":::"memory"); \
      _Pragma("unroll") for(int d_=0;d_<2;++d_) _Pragma("unroll") for(int r=0;r<16;++r)o[d_][r]*=wsf[crow(r,hi)]; } }while(0)
  f32x16 pA0,pA1,pB0,pB1;
  int sl_prev=0,sl_cur=0,sl_next=SLOTB;
  #define ROT() do{sl_prev=sl_cur;sl_cur=sl_next;sl_next=(sl_next==(NSLOT-1)*SLOTB)?0:sl_next+SLOTB;}while(0)
  DMA_K(2,2*SLOTB);
  WAIT_BAR(3);
  qkt(pA0,pA1,Kbase,qr,negm,r32,hi);asm volatile("s_nop 15\n\ts_nop 7":"+v"(pA0),"+v"(pA1));CMASK(pA0,pA1,0);
  START(pA0,pA1);
  _Pragma("unroll") for(int r=0;r<16;++r)pA1[r]=__builtin_amdgcn_exp2f(pA1[r]);
  WAIT_BAR(0);
  DMA_K(3,0);DMA_V(1,SLOTB);
  ROT();
  kload8(kf,kp0+sl_cur);
  WAIT_BAR(2);
  s16x4 vlo[8],vhi[8]; u32x4 pw0,pw1,pw2,pw3;
  #define PKW(P,B) cvtpk_s(P[B],P[B+1])
  #define PAF(k) __builtin_bit_cast(bf16x8,pw##k)
  #define VFR(i) (bf16x8){vlo[i][0],vlo[i][1],vlo[i][2],vlo[i][3],vhi[i][0],vhi[i][1],vhi[i][2],vhi[i][3]}
  #define PIN(x) asm volatile("":"+v"(x))
  #define MX3(a,b,c) __builtin_fmaxf(__builtin_fmaxf((a),(b)),(c))
  #define GAPA(MF,A0,A1,A2,A3,W0,W1,PW) do{ MF; sacc+=A0; sacc+=A1; sacc+=A2; sacc+=A3; PIN(sacc); W0; W1; PIN(PW); SBAR(); }while(0)
  #define EX(v) __builtin_amdgcn_exp2f(v)
  #define GAPB(MF,X,B) do{ MF; X[B]=EX(X[B]); X[B+1]=EX(X[B+1]); X[B+2]=EX(X[B+2]); X[B+3]=EX(X[B+3]); PIN(X); SBAR(); }while(0)
  #define VRD(i) do{ vlo[i]=vtr(vp_+(((i)>>2)*4096+((i)&3)*1024)); vhi[i]=vtr(vp_+(((i)>>2)*4096+((i)&3)*1024+512)); }while(0)
  #define KRD(G,j) do{ if(G){ kload2(kf,kp0+sl_next,j); SBAR(); } }while(0)
  #define STEP(C0,C1,P0,P1,t,GK,GV,GL) do{ SBAR(); \
    const lds_cptr vp_=vp0+sl_prev; \
    VRD(0); SBAR(); float sacc=(P0[0]+P0[1]); \
    GAPA(C0=__builtin_amdgcn_mfma_f32_32x32x16_bf16(kf[0],qr[0],negm,0,0,0), P0[2],P0[3],P0[4],P0[5],     pw0[0]=PKW(P0,0), pw0[1]=PKW(P0,2), pw0); \
    VRD(4); SBAR(); GAPA(C1=__builtin_amdgcn_mfma_f32_32x32x16_bf16(kf[1],qr[0],negm,0,0,0), P0[6],P0[7],P0[8],P0[9],     pw0[2]=PKW(P0,4), pw0[3]=PKW(P0,6), pw0); \
    VRD(1); SBAR(); GAPA(C0=__builtin_amdgcn_mfma_f32_32x32x16_bf16(kf[2],qr[1],C0,0,0,0),   P0[10],P0[11],P0[12],P0[13], pw1[0]=PKW(P0,8), pw1[1]=PKW(P0,10), pw1); \
    VRD(5); SBAR(); GAPA(C1=__builtin_amdgcn_mfma_f32_32x32x16_bf16(kf[3],qr[1],C1,0,0,0),   P0[14],P0[15],P1[0],P1[1],   pw1[2]=PKW(P0,12),pw1[3]=PKW(P0,14), pw1); \
    VRD(2); SBAR(); GAPA(C0=__builtin_amdgcn_mfma_f32_32x32x16_bf16(kf[4],qr[2],C0,0,0,0),   P1[2],P1[3],P1[4],P1[5],     pw2[0]=PKW(P1,0), pw2[1]=PKW(P1,2), pw2); \
    VRD(6); SBAR(); GAPA(C1=__builtin_amdgcn_mfma_f32_32x32x16_bf16(kf[5],qr[2],C1,0,0,0),   P1[6],P1[7],P1[8],P1[9],     pw2[2]=PKW(P1,4), pw2[3]=PKW(P1,6), pw2); \
    VRD(3); SBAR(); GAPA(C0=__builtin_amdgcn_mfma_f32_32x32x16_bf16(kf[6],qr[3],C0,0,0,0),   P1[10],P1[11],P1[12],P1[13], pw3[0]=PKW(P1,8), pw3[1]=PKW(P1,10), pw3); \
    VRD(7); SBAR(); GAPA(C1=__builtin_amdgcn_mfma_f32_32x32x16_bf16(kf[7],qr[3],C1,0,0,0),   P1[14],P1[15],0.f,0.f,       pw3[2]=PKW(P1,12),pw3[3]=PKW(P1,14), pw3); \
    l_reg+=sacc; \
    if(GK){DMA_K((t)+3,sl_cur);} if(GV){DMA_V((t)+1,sl_next);} \
    CMASK(C0,C1,t); \
    { float a=MX3(C0[0],C0[1],C1[0]),b=MX3(C0[2],C0[3],C1[1]); a=MX3(a,C1[2],C1[3]); \
      _Pragma("unroll") for(int r=4;r<16;r+=4){a=MX3(a,C0[r],C0[r+1]);b=MX3(b,C0[r+2],C0[r+3]);a=MX3(a,C1[r],C1[r+1]);b=MX3(b,C1[r+2],C1[r+3]);} \
      float rm=__builtin_fmaxf(a,b); { auto rr=__builtin_amdgcn_permlane32_swap(__float_as_uint(rm),__float_as_uint(rm),false,false); rm=__builtin_fmaxf(__uint_as_float(rr[0]),__uint_as_float(rr[1])); } \
      resc=false; \
      if(__builtin_expect(__any(rm>(float)THRL),0)){ const float dl=__builtin_fmaxf(rm,0.f); mhat+=dl; \
        _Pragma("unroll") for(int r=0;r<16;++r){C0[r]-=dl;C1[r]-=dl;} \
        _Pragma("unroll") for(int r=0;r<16;++r)negm[r]=-mhat; asm volatile("":"+v"(negm)); \
        const float f=__builtin_amdgcn_exp2f(-dl); l_reg*=f; if(hi==0)wsf[r32]=f; resc=true; } } \
    SBAR(); \
    GAPB(o[0]=__builtin_amdgcn_mfma_f32_32x32x16_bf16(PAF(0),VFR(0),o[0],0,0,0), C0,0); \
    GAPB(o[1]=__builtin_amdgcn_mfma_f32_32x32x16_bf16(PAF(0),VFR(4),o[1],0,0,0), C0,4); \
    KRD(GL,0); GAPB(o[0]=__builtin_amdgcn_mfma_f32_32x32x16_bf16(PAF(1),VFR(1),o[0],0,0,0), C0,8); \
    KRD(GL,1); GAPB(o[1]=__builtin_amdgcn_mfma_f32_32x32x16_bf16(PAF(1),VFR(5),o[1],0,0,0), C0,12); \
    KRD(GL,2); GAPB(o[0]=__builtin_amdgcn_mfma_f32_32x32x16_bf16(PAF(2),VFR(2),o[0],0,0,0), C1,0); \
    KRD(GL,3); GAPB(o[1]=__builtin_amdgcn_mfma_f32_32x32x16_bf16(PAF(2),VFR(6),o[1],0,0,0), C1,4); \
    GAPB(o[0]=__builtin_amdgcn_mfma_f32_32x32x16_bf16(PAF(3),VFR(3),o[0],0,0,0), C1,8); \
    GAPB(o[1]=__builtin_amdgcn_mfma_f32_32x32x16_bf16(PAF(3),VFR(7),o[1],0,0,0), C1,12); \
    }while(0)
  int t=1;
  for(;t+5<NT;t+=2){
    STEP(pB0,pB1,pA0,pA1,t,true,true,true);     WAIT_BAR(2); RESC(); ROT();
    STEP(pA0,pA1,pB0,pB1,t+1,true,true,true);   WAIT_BAR(2); RESC(); ROT();
  }
  #define ENDW(tt) do{ if((tt)+3<NT){WAIT_BAR(2);} else if((tt)+2<NT){WAIT_BAR(1);} else {WAIT_BAR(0);} }while(0)
  #define DRAIN(X0,X1) do{ float sacc=X0[0]+X0[1]; _Pragma("unroll") for(int r=2;r<16;++r)sacc+=X0[r]; _Pragma("unroll") for(int r=0;r<16;++r)sacc+=X1[r]; l_reg+=sacc; \
    pw0=(u32x4){PKW(X0,0),PKW(X0,2),PKW(X0,4),PKW(X0,6)};pw1=(u32x4){PKW(X0,8),PKW(X0,10),PKW(X0,12),PKW(X0,14)};pw2=(u32x4){PKW(X1,0),PKW(X1,2),PKW(X1,4),PKW(X1,6)};pw3=(u32x4){PKW(X1,8),PKW(X1,10),PKW(X1,12),PKW(X1,14)}; \
    SBAR(); pv(o,vb0+sl_cur,PAF(0),PAF(1),PAF(2),PAF(3)); }while(0)
  if(NT&1){
    for(;t+2<NT;t+=2){
      STEP(pB0,pB1,pA0,pA1,t,(t+3<NT),(t+1<NT),(t+1<NT));       ENDW(t);   RESC(); ROT();
      STEP(pA0,pA1,pB0,pB1,t+1,(t+4<NT),(t+2<NT),(t+2<NT));     ENDW(t+1); RESC(); ROT();
    }
    STEP(pB0,pB1,pA0,pA1,t,false,true,true); ENDW(t); RESC(); ROT();
    STEP(pA0,pA1,pB0,pB1,NT-1,false,false,false); RESC();
    DRAIN(pA0,pA1);
  } else {
  for(;t+1<NT;t+=2){
    STEP(pB0,pB1,pA0,pA1,t,(t+3<NT),(t+1<NT),(t+1<NT));       ENDW(t);   RESC(); ROT();
    STEP(pA0,pA1,pB0,pB1,t+1,(t+4<NT),(t+2<NT),(t+2<NT));     ENDW(t+1); RESC(); ROT();
  }
  STEP(pB0,pB1,pA0,pA1,NT-1,false,false,false); RESC();
  DRAIN(pB0,pB1);
  }
  #undef DRAIN
  #undef PKW
  #undef PAF
  #undef VFR
  #undef PIN
  #undef MX3
  #undef GAPA
  #undef GAPB
  #undef EX
  #undef VRD
  #undef KRD
  #undef STEP
  #undef ENDW
  {auto rr=__builtin_amdgcn_permlane32_swap(__float_as_uint(l_reg),__float_as_uint(l_reg),false,false);l_reg=__uint_as_float(rr[0])+__uint_as_float(rr[1]);}
  if(MODE==1)l_reg+=__builtin_amdgcn_exp2f(sink_l2-mhat);
  if(hi==0)wsf[32+r32]=l_reg;asm volatile("s_waitcnt lgkmcnt(0)":::"memory");
  float rli[16];
  #pragma unroll
  for(int r=0;r<16;++r)rli[r]=__builtin_amdgcn_rcpf(wsf[32+crow(r,hi)]);
  bf16*Ow=Ow0+(long)wrow*OP+wcol;
  { bf16*stg=(bf16*)(shm+LDS_OST)+wid*2048;
    #pragma unroll
    for(int r=0;r<16;++r){const int orow=crow(r,hi);
      #pragma unroll
      for(int d0=0;d0<2;++d0)stg[orow*64+d0*32+r32]=__float2bfloat16(o[d0][r]*rli[r]);}
    asm volatile("s_waitcnt lgkmcnt(0)":::"memory");
    #pragma unroll
    for(int i=0;i<4;++i){const int row=i*8+(lane>>3),ch=lane&7; const u32x4 v=*(const u32x4*)(stg+row*64+ch*8); ATTN_STORE16(Ow+(long)row*OP+ch*8,v);} }
  asm volatile("s_waitcnt lgkmcnt(0)\n\ts_barrier":::"memory");
  #undef DMA_K
  #undef TROW
  #undef DMA_V
  #undef CMASK
  #undef START
  #undef RESC
  #undef ROT
}
constexpr int ATTN_LDS_BYTES=LDS_BYTES;
#undef SBAR
#undef WAIT_BAR
}
namespace attn_body {
constexpr int X_K=0, X_V=3*8192, X_WS=X_V+3*16384, X_OST=X_WS+NW*64*4, X_BYTES=X_OST+NW*8192;
#define SBAR() __builtin_amdgcn_sched_barrier(0)
#define WAIT_BAR(N) asm volatile("s_waitcnt vmcnt(" #N ") lgkmcnt(0)\n\ts_barrier":::"memory")
__device__ __forceinline__ void pv128(f32x16*o,int vb,bf16x8 pa0,bf16x8 pa1,bf16x8 pa2,bf16x8 pa3){
  #pragma unroll
  for(int d0=0;d0<4;++d0){s16x4 lo[4],hi[4];
    #pragma unroll
    for(int ks=0;ks<4;++ks){
      asm volatile("ds_read_b64_tr_b16 %0,%1 offset:%c2":"=&v"(lo[ks]):"v"(vb),"i"(d0*4096+ks*1024):"memory");
      asm volatile("ds_read_b64_tr_b16 %0,%1 offset:%c2":"=&v"(hi[ks]):"v"(vb),"i"(d0*4096+ks*1024+512):"memory");}
    asm volatile("s_waitcnt lgkmcnt(0)":::"memory");SBAR();
    #define PK(k) (bf16x8){lo[k][0],lo[k][1],lo[k][2],lo[k][3],hi[k][0],hi[k][1],hi[k][2],hi[k][3]}
    o[d0]=__builtin_amdgcn_mfma_f32_32x32x16_bf16(pa0,PK(0),o[d0],0,0,0);
    o[d0]=__builtin_amdgcn_mfma_f32_32x32x16_bf16(pa1,PK(1),o[d0],0,0,0);
    o[d0]=__builtin_amdgcn_mfma_f32_32x32x16_bf16(pa2,PK(2),o[d0],0,0,0);
    o[d0]=__builtin_amdgcn_mfma_f32_32x32x16_bf16(pa3,PK(3),o[d0],0,0,0);
    #undef PK
  }
}
template<int THRL,int EPI> __device__ __forceinline__ void attn_unit128(const bf16*Qw0,int QP,const bf16*__restrict__ Kh,int KP,const bf16*__restrict__ Vh,int VP,bf16*Ow0,int OP,int NT,float lam,const float*gsub,char*shm){
  const int tid=threadIdx.x,lane=tid&63,r32=lane&31,hi=lane>>5; const int wid=__builtin_amdgcn_readfirstlane(tid>>6);
  const bf16*Qw=Qw0+(long)(wid*QBLK)*QP;
  const unsigned lds0=(unsigned)(uintptr_t)shm;
  float*wsf=(float*)(shm+X_WS)+wid*64;
  const bf16*ksrc=Kh+(long)lane*KP+wid*8;
  const bf16*vsrc=Vh+(long)(16*(wid&3)+(lane>>2))*VP+(wid>>2)*32+(lane&3)*8;
  const unsigned kdst=lds0+X_K+wid*1024, vdst=lds0+X_V+wid*1024;
  #define DMA_K(t,slot) glds16(ksrc+(long)(t)*KVBLK*KP,(unsigned)__builtin_amdgcn_readfirstlane(kdst+(slot)))
  #define DMA_V(t,slot) do{ glds16(vsrc+(long)(t)*KVBLK*VP,(unsigned)__builtin_amdgcn_readfirstlane(vdst+2*(slot))); glds16(vsrc+(long)(t)*KVBLK*VP+64,(unsigned)__builtin_amdgcn_readfirstlane(vdst+2*(slot)+8192)); }while(0)
  const char*Kbase=shm+X_K; bf16x8 kf[8];
  const lds_cptr shm3=(lds_cptr)shm; const lds_cptr kp0=shm3+X_K+hi*1024+r32*16; const lds_cptr vp0=shm3+X_V+((lane>>4)&1)*32+(lane&3)*8+(4*hi+((lane&15)>>2))*64;
  DMA_K(0,0);DMA_V(0,0);DMA_K(1,SLOTB);
  bf16x8 qr[4];
  #pragma unroll
  for(int d0=0;d0<4;++d0)qr[d0]=*reinterpret_cast<const bf16x8*>(&Qw[(long)r32*QP+d0*16+hi*8]);
  float mhat=0.f,l_reg=0.f;f32x16 o[4];o[0]=f32x16{};o[1]=f32x16{};o[2]=f32x16{};o[3]=f32x16{};f32x16 negm=f32x16{};asm volatile("":"+v"(negm));
  bool resc=false;
  #define START(P0,P1) do{ const float rm=rowmax(P0,P1); resc=false; \
    { const float dl=rm; mhat=fadd_s(mhat,dl); \
      _Pragma("unroll") for(int r=0;r<16;++r){P0[r]=fsub_s(P0[r],dl);P1[r]=fsub_s(P1[r],dl);} \
      _Pragma("unroll") for(int r=0;r<16;++r)negm[r]=-mhat; asm volatile("":"+v"(negm)); } \
    _Pragma("unroll") for(int r=0;r<16;++r)P0[r]=__builtin_amdgcn_exp2f(P0[r]); }while(0)
  #define RESC() do{ if(resc){ asm volatile("s_waitcnt lgkmcnt(0)":::"memory"); \
      _Pragma("unroll") for(int d_=0;d_<4;++d_) _Pragma("unroll") for(int r=0;r<16;++r)o[d_][r]*=wsf[crow(r,hi)]; } }while(0)
  f32x16 pC0,pC1;
  int sl_prev=0,sl_cur=0,sl_next=SLOTB;
  #define ROT() do{sl_prev=sl_cur;sl_cur=sl_next;sl_next=(sl_next==(NSLOT-1)*SLOTB)?0:sl_next+SLOTB;}while(0)
  DMA_K(2,2*SLOTB);
  WAIT_BAR(3);
  s16x4 vlo[6],vhi[6]; u32x4 pw0,pw1,pw2,pw3;
  #define PKW(P,B) cvtpk_s(P[B],P[B+1])
  #define PAF(k) __builtin_bit_cast(bf16x8,pw##k)
  #define VFR(i) (bf16x8){vlo[i][0],vlo[i][1],vlo[i][2],vlo[i][3],vhi[i][0],vhi[i][1],vhi[i][2],vhi[i][3]}
  #define PIN(x) asm volatile("":"+v"(x))
  #define MX3(a,b,c) __builtin_fmaxf(__builtin_fmaxf((a),(b)),(c))
  #define EX(v) __builtin_amdgcn_exp2f(v)
  qkt(pC0,pC1,Kbase,qr,negm,r32,hi);asm volatile("s_nop 15\n\ts_nop 7":"+v"(pC0),"+v"(pC1));
  START(pC0,pC1);
  _Pragma("unroll") for(int r=0;r<16;++r)pC1[r]=__builtin_amdgcn_exp2f(pC1[r]);
  { float sacc=pC0[0]+pC0[1]; _Pragma("unroll") for(int r=2;r<16;++r)sacc+=pC0[r]; _Pragma("unroll") for(int r=0;r<16;++r)sacc+=pC1[r]; l_reg+=sacc;
    pw0=(u32x4){PKW(pC0,0),PKW(pC0,2),PKW(pC0,4),PKW(pC0,6)};pw1=(u32x4){PKW(pC0,8),PKW(pC0,10),PKW(pC0,12),PKW(pC0,14)};pw2=(u32x4){PKW(pC1,0),PKW(pC1,2),PKW(pC1,4),PKW(pC1,6)};pw3=(u32x4){PKW(pC1,8),PKW(pC1,10),PKW(pC1,12),PKW(pC1,14)}; }
  WAIT_BAR(0);
  DMA_K(3,0);DMA_V(1,SLOTB);
  ROT();
  kload8(kf,kp0+sl_cur);
  WAIT_BAR(3);
  #define VRDG(i,ks,d0) do{ vlo[i]=vtr(vp_+((d0)*4096+(ks)*1024)); vhi[i]=vtr(vp_+((d0)*4096+(ks)*1024+512)); }while(0)
  #define KRD(G,j) do{ if(G){ kload2(kf,kp0+sl_next,j); } }while(0)
  #define GA(i,ks,d0,MF) do{ VRDG(i,ks,d0); SBAR(); MF; SBAR(); }while(0)
  #define GN(MF) do{ MF; SBAR(); }while(0)
  #define GB0(MF,X,B,RL) do{ MF; X[B]=EX(X[B]); X[B+1]=EX(X[B+1]); PIN(X); RL; SBAR(); }while(0)
  #define GB1(MF,X,B,Y,C,PW,J,RL) do{ MF; X[B]=EX(X[B]); X[B+1]=EX(X[B+1]); PIN(X); sacc+=Y[C]; sacc+=Y[C+1]; PIN(sacc); PW[J]=PKW(Y,C); PIN(PW); RL; SBAR(); }while(0)
  #define PVM(d0,k,i) o[d0]=__builtin_amdgcn_mfma_f32_32x32x16_bf16(PAF(k),VFR(i),o[d0],0,0,0)
  #define STEP(t,GK,GV,GL) do{ SBAR(); \
    const lds_cptr vp_=vp0+2*sl_prev; \
    GN(pC0=__builtin_amdgcn_mfma_f32_32x32x16_bf16(kf[0],qr[0],negm,0,0,0)); \
    GN(pC1=__builtin_amdgcn_mfma_f32_32x32x16_bf16(kf[1],qr[0],negm,0,0,0)); \
    GA(0,0,0,pC0=__builtin_amdgcn_mfma_f32_32x32x16_bf16(kf[2],qr[1],pC0,0,0,0)); \
    GA(1,0,1,pC1=__builtin_amdgcn_mfma_f32_32x32x16_bf16(kf[3],qr[1],pC1,0,0,0)); \
    GA(2,0,2,pC0=__builtin_amdgcn_mfma_f32_32x32x16_bf16(kf[4],qr[2],pC0,0,0,0)); \
    GA(3,0,3,pC1=__builtin_amdgcn_mfma_f32_32x32x16_bf16(kf[5],qr[2],pC1,0,0,0)); \
    GA(4,1,0,pC0=__builtin_amdgcn_mfma_f32_32x32x16_bf16(kf[6],qr[3],pC0,0,0,0)); \
    GA(5,1,1,pC1=__builtin_amdgcn_mfma_f32_32x32x16_bf16(kf[7],qr[3],pC1,0,0,0)); \
    if(GK){DMA_K((t)+3,sl_cur);} if(GV){DMA_V((t)+1,sl_next);} \
    { float a=MX3(pC0[0],pC0[1],pC1[0]),b=MX3(pC0[2],pC0[3],pC1[1]); a=MX3(a,pC1[2],pC1[3]); \
      _Pragma("unroll") for(int r=4;r<16;r+=4){a=MX3(a,pC0[r],pC0[r+1]);b=MX3(b,pC0[r+2],pC0[r+3]);a=MX3(a,pC1[r],pC1[r+1]);b=MX3(b,pC1[r+2],pC1[r+3]);} \
      float rm=__builtin_fmaxf(a,b); { auto rr=__builtin_amdgcn_permlane32_swap(__float_as_uint(rm),__float_as_uint(rm),false,false); rm=__builtin_fmaxf(__uint_as_float(rr[0]),__uint_as_float(rr[1])); } \
      resc=false; \
      if(__builtin_expect(__any(rm>(float)THRL),0)){ const float dl=__builtin_fmaxf(rm,0.f); mhat+=dl; \
        _Pragma("unroll") for(int r=0;r<16;++r){pC0[r]-=dl;pC1[r]-=dl;} \
        _Pragma("unroll") for(int r=0;r<16;++r)negm[r]=-mhat; asm volatile("":"+v"(negm)); \
        const float f=__builtin_amdgcn_exp2f(-dl); l_reg*=f; if(hi==0)wsf[r32]=f; resc=true; } } \
    SBAR(); \
    float sacc=0.f; \
    GB0(PVM(0,0,0),pC0,0, VRDG(0,1,2)); \
    GB0(PVM(1,0,1),pC0,2, VRDG(1,1,3)); \
    GB0(PVM(2,0,2),pC0,4, VRDG(2,2,0)); \
    GB0(PVM(3,0,3),pC0,6, VRDG(3,2,1)); \
    GB1(PVM(0,1,4),pC0,8, pC0,0,pw0,0, VRDG(4,2,2)); \
    GB1(PVM(1,1,5),pC0,10, pC0,2,pw0,1, VRDG(5,2,3)); \
    GB1(PVM(2,1,0),pC0,12, pC0,4,pw0,2, VRDG(0,3,0)); \
    GB1(PVM(3,1,1),pC0,14, pC0,6,pw0,3, VRDG(1,3,1)); \
    GB1(PVM(0,2,2),pC1,0, pC0,8,pw1,0, VRDG(2,3,2)); \
    GB1(PVM(1,2,3),pC1,2, pC0,10,pw1,1, VRDG(3,3,3)); \
    GB1(PVM(2,2,4),pC1,4, pC0,12,pw1,2, (void)0); \
    GB1(PVM(3,2,5),pC1,6, pC0,14,pw1,3, (void)0); \
    GB1(PVM(0,3,0),pC1,8, pC1,0,pw2,0, KRD(GL,0)); \
    GB1(PVM(1,3,1),pC1,10, pC1,2,pw2,1, KRD(GL,1)); \
    GB1(PVM(2,3,2),pC1,12, pC1,4,pw2,2, KRD(GL,2)); \
    GB1(PVM(3,3,3),pC1,14, pC1,6,pw2,3, KRD(GL,3)); \
    sacc+=pC1[8];sacc+=pC1[9];pw3[0]=PKW(pC1,8); sacc+=pC1[10];sacc+=pC1[11];pw3[1]=PKW(pC1,10); sacc+=pC1[12];sacc+=pC1[13];pw3[2]=PKW(pC1,12); sacc+=pC1[14];sacc+=pC1[15];pw3[3]=PKW(pC1,14); \
    l_reg+=sacc; PIN(pw3); \
    }while(0)
  int t=1;
  for(;t+5<NT;t+=2){
    STEP(t,true,true,true);     WAIT_BAR(3); RESC(); ROT();
    STEP(t+1,true,true,true);   WAIT_BAR(3); RESC(); ROT();
  }
  #define ENDW(tt) do{ if((tt)+3<NT){WAIT_BAR(3);} else if((tt)+2<NT){WAIT_BAR(2);} else {WAIT_BAR(0);} }while(0)
  for(;t+1<NT;t+=2){
    STEP(t,(t+3<NT),(t+1<NT),(t+1<NT));       ENDW(t);   RESC(); ROT();
    STEP(t+1,(t+4<NT),(t+2<NT),(t+2<NT));     ENDW(t+1); RESC(); ROT();
  }
  STEP(NT-1,false,false,false); RESC();
  SBAR(); pv128(o,(int)(unsigned)(uintptr_t)vp0+2*sl_cur,PAF(0),PAF(1),PAF(2),PAF(3));
  #undef PKW
  #undef PAF
  #undef VFR
  #undef PIN
  #undef MX3
  #undef EX
  #undef VRDG
  #undef KRD
  #undef GA
  #undef GN
  #undef GB0
  #undef GB1
  #undef PVM
  #undef STEP
  #undef ENDW
  {auto rr=__builtin_amdgcn_permlane32_swap(__float_as_uint(l_reg),__float_as_uint(l_reg),false,false);l_reg=__uint_as_float(rr[0])+__uint_as_float(rr[1]);}
  if(hi==0)wsf[32+r32]=l_reg;asm volatile("s_waitcnt lgkmcnt(0)":::"memory");
  float rli[16];
  #pragma unroll
  for(int r=0;r<16;++r)rli[r]=__builtin_amdgcn_rcpf(wsf[32+crow(r,hi)]);
  bf16*Ow=Ow0+(long)(wid*QBLK)*OP;
  { bf16*stg=(bf16*)(shm+X_OST)+wid*4096;
    if(EPI==2){
      float gl[4];
      #pragma unroll
      for(int d0=0;d0<4;++d0)gl[d0]=gsub[d0*32+r32];
      #pragma unroll
      for(int r=0;r<16;++r){const int orow=crow(r,hi); float ss=0.f;
        #pragma unroll
        for(int d0=0;d0<4;++d0){const float dd=__bfloat162float(stg[orow*128+d0*32+r32])-lam*(o[d0][r]*rli[r]); o[d0][r]=dd; ss+=dd*dd;}
        ss+=dpp_f<0xB1>(ss);ss+=dpp_f<0x4E>(ss);ss+=dpp_f<0x141>(ss);ss+=dpp_f<0x140>(ss);ss=swap16_sum(ss,ss);
        const float rs=0.8f/sqrtf(ss*(1.f/128.f)+1e-6f);
        #pragma unroll
        for(int d0=0;d0<4;++d0)stg[orow*128+d0*32+r32]=__float2bfloat16(o[d0][r]*rs*gl[d0]);}
    } else {
    #pragma unroll
    for(int r=0;r<16;++r){const int orow=crow(r,hi);
      #pragma unroll
      for(int d0=0;d0<4;++d0)stg[orow*128+d0*32+r32]=__float2bfloat16(o[d0][r]*rli[r]);}
    }
    asm volatile("s_waitcnt lgkmcnt(0)":::"memory");
    if(EPI!=1){
    #pragma unroll
    for(int i=0;i<8;++i){const int row=i*4+(lane>>4),ch=lane&15; const u32x4 v=*(const u32x4*)(stg+row*128+ch*8); ATTN_STORE16(Ow+(long)row*OP+ch*8,v);} } }
  asm volatile("s_waitcnt lgkmcnt(0)\n\ts_barrier":::"memory");
  #undef DMA_K
  #undef DMA_V
  #undef START
  #undef RESC
  #undef ROT
}
#undef SBAR
#undef WAIT_BAR
}

typedef unsigned u32x2f __attribute__((ext_vector_type(2)));
constexpr int NWAVES = 8;
constexpr int LDS_BYTES = 147456;
__device__ __forceinline__ float wave_sum(float v) {
    v += dpp_f<0xB1>(v);
    v += dpp_f<0x4E>(v);
    v += dpp_f<0x141>(v);
    v += dpp_f<0x140>(v);
    v = swap16_sum(v, v); v = swap32_sum(v, v);
    return v;
}
__device__ __forceinline__ float bf2f(unsigned short h) { return __uint_as_float((unsigned)h << 16); }
__device__ __forceinline__ float silu_d(float v) { return v / (1.f + __expf(-v)); }

__device__ __forceinline__ void titem_load(const float* src, int ldw, f32x4 (&r)[8], int lane) {
#pragma unroll
    for (int i = 0; i < 8; ++i) r[i] = *(const GAS f32x4*)(src + (size_t)(8 * i + (lane >> 3)) * ldw + 4 * (lane & 7));
}
__device__ __forceinline__ void titem_finish(const f32x4 (&r)[8], bf16* dst, LAS float* scr, int lane) {
#pragma unroll
    for (int i = 0; i < 8; ++i) { LAS float* p = scr + (8 * i + (lane >> 3)) * 33 + 4 * (lane & 7); p[0] = r[i].x; p[1] = r[i].y; p[2] = r[i].z; p[3] = r[i].w; }
    LDS_WAIT(); asm volatile("" ::: "memory");
    const int c = lane & 7;
#pragma unroll
    for (int j = 0; j < 4; ++j) { const int n = (lane >> 3) + 8 * j; const LAS float* q = scr + (8 * c) * 33 + n;
        v4u o; o.x = pk2(q[0 * 33], q[1 * 33]); o.y = pk2(q[2 * 33], q[3 * 33]); o.z = pk2(q[4 * 33], q[5 * 33]); o.w = pk2(q[6 * 33], q[7 * 33]);
        *(GAS v4u*)(dst + (size_t)n * 1024 + 8 * c) = o; }
    LDS_WAIT(); asm volatile("" ::: "memory");
}
__device__ __forceinline__ void titem_finish8(const f32x4 (&r)[8], unsigned char* dst8, LAS float* scr, int lane) {
#pragma unroll
    for (int i = 0; i < 8; ++i) { LAS float* p = scr + (8 * i + (lane >> 3)) * 33 + 4 * (lane & 7); p[0] = r[i].x; p[1] = r[i].y; p[2] = r[i].z; p[3] = r[i].w; }
    LDS_WAIT(); asm volatile("" ::: "memory");
    const int c = lane & 7;
#pragma unroll
    for (int j = 0; j < 4; ++j) { const int n = (lane >> 3) + 8 * j; const LAS float* q = scr + (8 * c) * 33 + n;
        u32x2f o; o.x = pg8::pk4_fp8(q[0 * 33] * pg8::W8_SCALE, q[1 * 33] * pg8::W8_SCALE, q[2 * 33] * pg8::W8_SCALE, q[3 * 33] * pg8::W8_SCALE);
        o.y = pg8::pk4_fp8(q[4 * 33] * pg8::W8_SCALE, q[5 * 33] * pg8::W8_SCALE, q[6 * 33] * pg8::W8_SCALE, q[7 * 33] * pg8::W8_SCALE);
        *(GAS u32x2f*)(dst8 + (size_t)n * 1024 + 8 * c) = o; }
    LDS_WAIT(); asm volatile("" ::: "memory");
}
constexpr int CONV_ND = 2048 + 512 + 768 + 512, CONV_NM = 16 * 3 * 512;
#define CONV_DESC(MODE, it, src, ldw, dst) do { int r_ = (it); \
    if ((MODE) == 0) { \
        if (r_ < 2048) { const int kb = r_ >> 7, nb = r_ & 127; src = win + (size_t)(64 * kb) * 4096 + 32 * nb; ldw = 4096; dst = (bf16*)(ws + WS_WIN) + (size_t)(32 * nb) * 1024 + 64 * kb; } \
        else if (r_ < 2560) { r_ -= 2048; const int kb = r_ >> 5, nb = r_ & 31; src = wout0 + (size_t)(64 * kb) * 1024 + 32 * nb; ldw = 1024; dst = (bf16*)(ws + WS_WOE) + (size_t)(32 * nb) * 1024 + 64 * kb; } \
        else if (r_ < 3328) { r_ -= 2560; const int kb = r_ / 48, nb = r_ % 48; src = wqkv + (size_t)(64 * kb) * 1536 + 32 * nb; ldw = 1536; dst = (bf16*)(ws + WS_WQKV) + (size_t)(32 * nb) * 1024 + 64 * kb; } \
        else { r_ -= 3328; const int kb = r_ >> 5, nb = r_ & 31; src = wout1 + (size_t)(64 * kb) * 1024 + 32 * nb; ldw = 1024; dst = (bf16*)(ws + WS_WOO) + (size_t)(32 * nb) * 1024 + 64 * kb; } \
    } else { const int im = r_; const size_t wo = (MODE) == 3 ? 0 : (size_t)16 * 1024 * 1024; \
        const int e = im / 1536, rem = im % 1536, which = rem >> 9, item = rem & 511, kb = item >> 5, nb = item & 31; \
        const float* W = (which == 0 ? mg : which == 1 ? mu : md) + wo; \
        src = W + ((size_t)e * 1024 + 64 * kb) * 1024 + 32 * nb; ldw = 1024; \
        unsigned char* W13 = ws + ((MODE) == 3 ? WS_MOE0_13 : WS_MOE1_13); unsigned char* W2 = ws + ((MODE) == 3 ? WS_MOE0_2 : WS_MOE1_2);     \
        dst = (bf16*)(which < 2 ? W13 + ((size_t)e * 2048 + (nb >> 2) * 256 + which * 128 + (nb & 3) * 32) * 1024 + 64 * kb : W2 + ((size_t)e * 1024 + 32 * nb) * 1024 + 64 * kb); } } while (0)
template <int MODE> __device__ __forceinline__ void conv_loop(const float* win, const float* wout0, const float* wqkv, const float* wout1, const float* mg, const float* mu, const float* md,
                                                            unsigned char* ws, int first, int stride, LAS float* scr, int lane) {
    const int total = MODE == 0 ? CONV_ND : CONV_NM; int it = first; if (it >= total) return;
    f32x4 r0[8], r1[8], r2[8], r3[8]; const float* s_; int ldw; bf16 *d0, *d1, *d2, *d3;
#define CONV_ISSUE(R, D, idx) do { if ((idx) < total) { CONV_DESC(MODE, (idx), s_, ldw, D); titem_load(s_, ldw, R, lane); } } while (0)
#define CONV_FIN(R, D) do { if constexpr (MODE == 0) titem_finish(R, D, scr, lane); else titem_finish8(R, (unsigned char*)D, scr, lane); } while (0)
    CONV_ISSUE(r0, d0, it); CONV_ISSUE(r1, d1, it + stride); CONV_ISSUE(r2, d2, it + 2 * stride);
    for (;;) {
        CONV_ISSUE(r3, d3, it + 3 * stride); CONV_FIN(r0, d0); if (it + stride >= total) break;
        CONV_ISSUE(r0, d0, it + 4 * stride); CONV_FIN(r1, d1); if (it + 2 * stride >= total) break;
        CONV_ISSUE(r1, d1, it + 5 * stride); CONV_FIN(r2, d2); if (it + 3 * stride >= total) break;
        CONV_ISSUE(r2, d2, it + 6 * stride); CONV_FIN(r3, d3); if (it + 4 * stride >= total) break;
        it += 4 * stride;
    }
#undef CONV_ISSUE
#undef CONV_FIN
}

__device__ __forceinline__ void normmod_row(f32x4 (&v)[4], const float* g, const float* sc, const float* sh, int lane) {
    float s2 = 0.f;
#pragma unroll
    for (int j = 0; j < 4; ++j) s2 += (v[j].x * v[j].x + v[j].y * v[j].y) + (v[j].z * v[j].z + v[j].w * v[j].w);
    const float rstd = __builtin_amdgcn_rsqf(wave_sum(s2) * (1.f / 1024.f) + EPS_);
#pragma unroll
    for (int j = 0; j < 4; ++j) { const f32x4 gv = *((const f32x4*)g + 64 * j + lane), scv = *((const f32x4*)sc + 64 * j + lane), shv = *((const f32x4*)sh + 64 * j + lane);
        v[j] = v[j] * rstd * gv * (1.f + scv) + shv; }
}
__device__ __forceinline__ void store_row_bf16(const f32x4 (&v)[4], bf16* orow, int lane) {
    GAS unsigned long long* o8 = (GAS unsigned long long*)orow + lane;
#pragma unroll
    for (int j = 0; j < 4; ++j) o8[64 * j] = (unsigned long long)pk2(v[j].x, v[j].y) | ((unsigned long long)pk2(v[j].z, v[j].w) << 32);
}
__device__ __forceinline__ void load_row_b16(f32x4 (&v)[4], const bf16* xrow, int lane) {
    const u32x2f* xr = (const u32x2f*)xrow + lane;
#pragma unroll
    for (int j = 0; j < 4; ++j) { const u32x2f w = xr[64 * j]; v[j].x = __uint_as_float(w.x << 16); v[j].y = __uint_as_float(w.x & 0xffff0000u); v[j].z = __uint_as_float(w.y << 16); v[j].w = __uint_as_float(w.y & 0xffff0000u); }
}
__device__ __forceinline__ void load_row_f32(f32x4 (&v)[4], const float* xrow, int lane) {
    const f32x4* xr = (const f32x4*)xrow + lane;
#pragma unroll
    for (int j = 0; j < 4; ++j) v[j] = xr[64 * j];
}
__device__ __forceinline__ void add_moe_rows(f32x4 (&v)[4], const bf16* y0, const bf16* y1, const float* gate, int lane) {
#pragma unroll
    for (int j = 0; j < 4; ++j) { const u32x2f a = *((const u32x2f*)y0 + 64 * j + lane), b = *((const u32x2f*)y1 + 64 * j + lane); const f32x4 gv = *((const f32x4*)gate + 64 * j + lane);
        f32x4 f; f.x = __uint_as_float(a.x << 16) + __uint_as_float(b.x << 16); f.y = __uint_as_float(a.x & 0xffff0000u) + __uint_as_float(b.x & 0xffff0000u);
        f.z = __uint_as_float(a.y << 16) + __uint_as_float(b.y << 16); f.w = __uint_as_float(a.y & 0xffff0000u) + __uint_as_float(b.y & 0xffff0000u);
        v[j] = v[j] + gv * f; }
}

typedef float f32x2g __attribute__((ext_vector_type(2)));
typedef float f32x4g __attribute__((ext_vector_type(4)));
constexpr int HG_QI = 0, HG_QN = 17408, HG_KO = 34816, HG_VT = 52224, HG_SC = 70656, HG_ST = 79872, HG_SCR = 114688;
constexpr int HG_LDQ = 272, HG_LDT = 144;
typedef short hbf16x8 __attribute__((ext_vector_type(8)));
typedef float hf32x4 __attribute__((ext_vector_type(4)));
__device__ __forceinline__ int hg_chunk(int dir, int j) { return dir == 0 ? j : (j < 4 ? 3 - j : 135 - j); }
__device__ __forceinline__ void hg_scan(int dir, int dk, int tq, LAS float* scr, const float (&v)[16], float (&cum)[16], float& tot, float& ref) {
    float c[16]; float run = 0.f;
#pragma unroll
    for (int i = 0; i < 16; ++i) { run += v[i]; c[i] = run; }
    scr[tq * 128 + dk] = run;
    __syncthreads();
    const float q0 = scr[dk], q1 = scr[128 + dk], q2 = scr[256 + dk], q3 = scr[384 + dk];
    tot = (q0 + q1) + (q2 + q3);
    if (dir == 0) { const float off = (tq > 0 ? q0 : 0.f) + (tq > 1 ? q1 : 0.f) + (tq > 2 ? q2 : 0.f);
#pragma unroll
        for (int i = 0; i < 16; ++i) cum[i] = c[i] + off;
        ref = q0 + q1; }
    else { const float off = (tq < 3 ? q3 : 0.f) + (tq < 2 ? q2 : 0.f) + (tq < 1 ? q1 : 0.f);
#pragma unroll
        for (int i = 0; i < 16; ++i) cum[i] = (run - c[i] + v[i]) + off;
        ref = q2 + q3; }
    __syncthreads();
}
__device__ __forceinline__ void hg_ld16(const unsigned short* p, int tid, unsigned (&w)[8]) {
    const int c = tid & 127, tq = tid >> 7;
#pragma unroll
    for (int i = 0; i < 8; ++i) { const unsigned lo = p[(size_t)(16 * tq + 2 * i) * 512 + c], hi = p[(size_t)(16 * tq + 2 * i + 1) * 512 + c]; w[i] = lo | (hi << 16); }
}
__device__ __forceinline__ float h2f(unsigned short h) { return (float)__builtin_bit_cast(_Float16, h); }
__device__ __forceinline__ void hg_store_vt(const unsigned (&w)[8], LAS unsigned char* L, int tid) {
    const int dv = tid & 127, tq = tid >> 7;
    LAS v4u* d = (LAS v4u*)(L + HG_VT + dv * HG_LDT + tq * 32);
    d[0] = (v4u){w[0], w[1], w[2], w[3]}; d[1] = (v4u){w[4], w[5], w[6], w[7]};
}
__device__ __forceinline__ void hgrn_pass1(int first, int stride, int total, const _Float16* LFF, const _Float16* LFB, const bf16* IV, unsigned char* U, float* TOT, LAS unsigned char* L, int tid, int wave, int lane) {
    const int dk = tid & 127, tq = tid >> 7, fr = lane & 15, fq = lane >> 4;
    unsigned nlf[8], niv[8];
#define HG1_LOAD(u_) do { const int j_ = (u_) % NCHUNK, sq_ = (u_) / NCHUNK, dir_ = sq_ >> 3, b_ = (sq_ >> 2) & 1, h_ = sq_ & 3; const size_t r0_ = (size_t)b_ * SB + 64 * j_; \
        hg_ld16((const unsigned short*)((dir_ ? LFB : LFF) + r0_ * 512 + h_ * 128), tid, nlf); hg_ld16(IV + r0_ * 512 + h_ * 128, tid, niv); } while (0)
    if (first < total) HG1_LOAD(first);
    for (int u = first; u < total; u += stride) {
        const int j = u % NCHUNK, sq = u / NCHUNK, dir = sq >> 3;
        const int n = hg_chunk(dir, j);
        float v[16]; unsigned iv[8];
#pragma unroll
        for (int i = 0; i < 8; ++i) { v[2 * i] = h2f((unsigned short)(nlf[i] & 0xffffu)); v[2 * i + 1] = h2f((unsigned short)(nlf[i] >> 16)); iv[i] = niv[i]; }
        if (u + stride < total) HG1_LOAD(u + stride);
        float cum[16], tot, ref;
        hg_scan(dir, dk, tq, (LAS float*)(L + HG_SCR), v, cum, tot, ref);
        unsigned w[8];
#pragma unroll
        for (int i = 0; i < 8; ++i) { const float k0 = (1.f - __expf(v[2 * i])) * __expf(tot - cum[2 * i]), k1 = (1.f - __expf(v[2 * i + 1])) * __expf(tot - cum[2 * i + 1]); w[i] = pk2(k0, k1); }
        { LAS v4u* d = (LAS v4u*)(L + HG_QI + dk * HG_LDT + tq * 32); d[0] = (v4u){w[0], w[1], w[2], w[3]}; d[1] = (v4u){w[4], w[5], w[6], w[7]}; }
        if (tq == 0) TOT[((size_t)sq * NCHUNK + n) * 128 + dk] = tot;
        hg_store_vt(iv, L, tid);
        __syncthreads();
        hf32x4 acc[8];
#pragma unroll
        for (int nt = 0; nt < 8; ++nt) acc[nt] = (hf32x4){0.f, 0.f, 0.f, 0.f};
#pragma unroll
        for (int kk = 0; kk < 2; ++kk) { const hbf16x8 A = *(const LAS hbf16x8*)(L + HG_QI + (16 * wave + fr) * HG_LDT + kk * 64 + fq * 16);
#pragma unroll
            for (int nt = 0; nt < 8; ++nt) { const hbf16x8 B = *(const LAS hbf16x8*)(L + HG_VT + (16 * nt + fr) * HG_LDT + kk * 64 + fq * 16);
                acc[nt] = __builtin_amdgcn_mfma_f32_16x16x32_bf16(A, B, acc[nt], 0, 0, 0); } }
        unsigned char* up = U + ((size_t)sq * NCHUNK + n) * 16384 + 16 * wave + 4 * fq;
#pragma unroll
        for (int nt = 0; nt < 8; ++nt) *(unsigned*)(up + (size_t)(16 * nt + fr) * 128) = pg8::pk4_fp8(acc[nt][0], acc[nt][1], acc[nt][2], acc[nt][3]);
        __syncthreads();
    }
#undef HG1_LOAD
}
__device__ __forceinline__ void hgrn_pass2(const unsigned char* U, const float* TOT, unsigned char* S, int gtid, int nthreads) {
    for (int idx = gtid; idx < 16 * 4096; idx += nthreads) {
        const int sq = idx >> 12, p = idx & 4095;
        const unsigned* up = (const unsigned*)(U + (size_t)sq * NCHUNK * 16384) + p; unsigned* sp = (unsigned*)(S + (size_t)sq * NCHUNK * 16384) + p;
        const f32x4g* tp = (const f32x4g*)(TOT + (size_t)sq * NCHUNK * 128) + (p & 31);
        float s0 = 0.f, s1 = 0.f, s2 = 0.f, s3 = 0.f;
        for (int n = 0; n < NCHUNK; n += 22) {
            unsigned uu[22]; f32x4g tt[22];
#pragma unroll
            for (int k = 0; k < 22; ++k) { uu[k] = up[(size_t)(n + k) * 4096]; tt[k] = tp[(size_t)(n + k) * 32]; }
#pragma unroll
            for (int k = 0; k < 22; ++k) { sp[(size_t)(n + k) * 4096] = pg8::pk4_fp8(s0, s1, s2, s3);
                const f32x2g lo = __builtin_amdgcn_cvt_pk_f32_fp8((int)uu[k], false), hi = __builtin_amdgcn_cvt_pk_f32_fp8((int)uu[k], true);
                s0 = __expf(tt[k].x) * s0 + lo.x; s1 = __expf(tt[k].y) * s1 + lo.y; s2 = __expf(tt[k].z) * s2 + hi.x; s3 = __expf(tt[k].w) * s3 + hi.y; }
        }
    }
}
__device__ __forceinline__ void hg3_dir(int dir, const float (&v)[16], const float (&qv)[16], const v4u (&st)[2], hf32x4 (&acc)[4], LAS unsigned char* L, int tid, int wave, int lane) {
    const int dk = tid & 127, tq = tid >> 7, fr = lane & 15, fq = lane >> 4, mt_o = wave & 3, ntb = 4 * (wave >> 2);
    float cum[16], tot, ref;
    hg_scan(dir, dk, tq, (LAS float*)(L + HG_SCR), v, cum, tot, ref);
#pragma unroll
    for (int i = 0; i < 16; ++i) { const int t = 16 * tq + i;
        const float qi = qv[i] * __expf(cum[i] - ref), qn = qv[i] * __expf(cum[i]), ko = (1.f - __expf(v[i])) * __expf(ref - cum[i]);
        *(LAS unsigned short*)(L + HG_QI + t * HG_LDQ + dk * 2) = (unsigned short)f2bf(qi);
        *(LAS unsigned short*)(L + HG_QN + t * HG_LDQ + dk * 2) = (unsigned short)f2bf(qn);
        *(LAS unsigned short*)(L + HG_KO + t * HG_LDQ + dk * 2) = (unsigned short)f2bf(ko); }
    { LAS v4u* d = (LAS v4u*)(L + HG_ST + (tid >> 2) * HG_LDQ + (tid & 3) * 64);
#pragma unroll
        for (int k = 0; k < 4; ++k) { unsigned w[4];
#pragma unroll
            for (int c = 0; c < 2; ++c) { const int x = (int)st[k >> 1][2 * (k & 1) + c]; const f32x2g lo = __builtin_amdgcn_cvt_pk_f32_fp8(x, false), hi = __builtin_amdgcn_cvt_pk_f32_fp8(x, true);
                w[2 * c] = pk2(lo.x, lo.y); w[2 * c + 1] = pk2(hi.x, hi.y); }
            d[k] = (v4u){w[0], w[1], w[2], w[3]}; } }
    __syncthreads();
    {
        const int mt = wave >> 1;
#pragma unroll
        for (int n2 = 0; n2 < 2; ++n2) { const int nt = 2 * (wave & 1) + n2; hf32x4 sc = {0.f, 0.f, 0.f, 0.f};
#pragma unroll
            for (int kk = 0; kk < 4; ++kk) { const hbf16x8 A = *(const LAS hbf16x8*)(L + HG_QI + (16 * mt + fr) * HG_LDQ + kk * 64 + fq * 16);
                const hbf16x8 B = *(const LAS hbf16x8*)(L + HG_KO + (16 * nt + fr) * HG_LDQ + kk * 64 + fq * 16);
                sc = __builtin_amdgcn_mfma_f32_16x16x32_bf16(A, B, sc, 0, 0, 0); }
#pragma unroll
            for (int r = 0; r < 4; ++r) { const int t = 16 * mt + 4 * fq + r, s_ = 16 * nt + fr; const bool keep = dir ? (s_ >= t) : (s_ <= t);
                *(LAS unsigned short*)(L + HG_SC + t * HG_LDT + s_ * 2) = (unsigned short)f2bf(keep ? sc[r] : 0.f); } }
    }
    __syncthreads();
#pragma unroll
    for (int nt = 0; nt < 4; ++nt) {
#pragma unroll
        for (int kk = 0; kk < 2; ++kk) { const hbf16x8 A = *(const LAS hbf16x8*)(L + HG_SC + (16 * mt_o + fr) * HG_LDT + kk * 64 + fq * 16);
            const hbf16x8 B = *(const LAS hbf16x8*)(L + HG_VT + (16 * (ntb + nt) + fr) * HG_LDT + kk * 64 + fq * 16);
            acc[nt] = __builtin_amdgcn_mfma_f32_16x16x32_bf16(A, B, acc[nt], 0, 0, 0); }
#pragma unroll
        for (int kk = 0; kk < 4; ++kk) { const hbf16x8 A = *(const LAS hbf16x8*)(L + HG_QN + (16 * mt_o + fr) * HG_LDQ + kk * 64 + fq * 16);
            const hbf16x8 B = *(const LAS hbf16x8*)(L + HG_ST + (16 * (ntb + nt) + fr) * HG_LDQ + kk * 64 + fq * 16);
            acc[nt] = __builtin_amdgcn_mfma_f32_16x16x32_bf16(A, B, acc[nt], 0, 0, 0); }
    }
    __syncthreads();
}
__device__ __forceinline__ void hgrn_pass3_unit(int u, const bf16* QH, const _Float16* LFF, const _Float16* LFB, const bf16* IV, const bf16* GG, const unsigned char* S, const float* onorm_g, bf16* Y,
                                                LAS unsigned char* L, int tid, int wave, int lane) {
    const int j = u % NCHUNK, bh = u / NCHUNK, b = bh >> 2, h = bh & 3;
    const size_t row0 = (size_t)b * SB + 64 * j;
    const int fr = lane & 15, fq = lane >> 4;
    unsigned wf[8], wb[8], wq[8], wi[8]; v4u stf[2], stb[2];
    hg_ld16((const unsigned short*)(LFF + row0 * 512 + h * 128), tid, wf); hg_ld16((const unsigned short*)(LFB + row0 * 512 + h * 128), tid, wb);
    hg_ld16(QH + row0 * 512 + h * 128, tid, wq); hg_ld16(IV + row0 * 512 + h * 128, tid, wi);
    { const unsigned char* sp = S + ((size_t)bh * NCHUNK + hg_chunk(0, j)) * 16384 + (tid >> 2) * 128 + (tid & 3) * 32; const unsigned char* sq_ = S + ((size_t)(8 + bh) * NCHUNK + hg_chunk(1, j)) * 16384 + (tid >> 2) * 128 + (tid & 3) * 32;
#pragma unroll
        for (int k = 0; k < 2; ++k) { stf[k] = *((const GAS v4u*)sp + k); stb[k] = *((const GAS v4u*)sq_ + k); } }
    const int lrow = tid >> 4, lcc = tid & 15;
    const v4u gg0 = *(const GAS v4u*)(GG + (row0 + lrow) * 512 + h * 128 + lcc * 8), gg1 = *(const GAS v4u*)(GG + (row0 + lrow + 32) * 512 + h * 128 + lcc * 8);
    hg_store_vt(wi, L, tid);
    float vf[16], vb[16], qv[16];
#pragma unroll
    for (int i = 0; i < 8; ++i) { vf[2 * i] = h2f((unsigned short)(wf[i] & 0xffffu)); vf[2 * i + 1] = h2f((unsigned short)(wf[i] >> 16)); vb[2 * i] = h2f((unsigned short)(wb[i] & 0xffffu)); vb[2 * i + 1] = h2f((unsigned short)(wb[i] >> 16));
        qv[2 * i] = __uint_as_float(wq[i] << 16); qv[2 * i + 1] = __uint_as_float(wq[i] & 0xffff0000u); }
    hf32x4 acc[4];
#pragma unroll
    for (int nt = 0; nt < 4; ++nt) acc[nt] = (hf32x4){0.f, 0.f, 0.f, 0.f};
    const int mt_o = wave & 3, ntb = 4 * (wave >> 2);
    hg3_dir(0, vf, qv, stf, acc, L, tid, wave, lane);
    hg3_dir(1, vb, qv, stb, acc, L, tid, wave, lane);
    LAS float* red = (LAS float*)(L + HG_SCR);
    float ss[4];
#pragma unroll
    for (int r = 0; r < 4; ++r) { float s = 0.f;
#pragma unroll
        for (int nt = 0; nt < 4; ++nt) s += acc[nt][r] * acc[nt][r];
        s += dpp_f<0xB1>(s); s += dpp_f<0x4E>(s); s += dpp_f<0x141>(s); s += dpp_f<0x140>(s); ss[r] = s; }
    if (fr == 0) {
#pragma unroll
        for (int r = 0; r < 4; ++r) red[(wave >> 2) * 64 + 16 * mt_o + 4 * fq + r] = ss[r]; }
    { const int o = lrow * HG_LDQ + lcc * 16; *(LAS v4u*)(L + HG_QN + o) = gg0; *(LAS v4u*)(L + HG_QN + o + 32 * HG_LDQ) = gg1; }
    __syncthreads();
#pragma unroll
    for (int r = 0; r < 4; ++r) { const int t = 16 * mt_o + 4 * fq + r; const float rstd = __builtin_amdgcn_rsqf((red[t] + red[64 + t]) * (1.f / 128.f) + EPS_);
#pragma unroll
        for (int nt = 0; nt < 4; ++nt) { const int dv = 16 * (ntb + nt) + fr; const float gg = bf2f(*(const LAS unsigned short*)(L + HG_QN + t * HG_LDQ + dv * 2));
            *(LAS unsigned short*)(L + HG_QI + t * HG_LDQ + dv * 2) = (unsigned short)f2bf(acc[nt][r] * rstd * onorm_g[dv] * gg); } }
    __syncthreads();
    { const int o = lrow * HG_LDQ + lcc * 16; const v4u y0 = *(const LAS v4u*)(L + HG_QI + o), y1 = *(const LAS v4u*)(L + HG_QI + o + 32 * HG_LDQ);
      *(GAS v4u*)(Y + (row0 + lrow) * 1024 + h * 128 + lcc * 8) = y0; *(GAS v4u*)(Y + (row0 + lrow + 32) * 1024 + h * 128 + lcc * 8) = y1; }
    __syncthreads();
}

#ifndef TS_PHASE
#define TS_PHASE (-1)
#endif
struct KArgs { const float* in[23]; float* out; unsigned char* ws; int ph_lo, ph_hi, use_cg, pad; };
constexpr int N_PHASES = 21;
enum { I_X = 0, I_C, I_CTX, I_CCTX, I_ADAW, I_ADAB, I_NMIX, I_NFFN, I_EWIN, I_EWOUT, I_LBL, I_ONORM, I_DLAM, I_SUBLN, I_OWQKV, I_OWOUT, I_SINK, I_RW, I_RB, I_MG, I_MU, I_MD, I_FNG };

__device__ __forceinline__ float xreduce16(const float (&a)[16], int lane) {
    const bool b3 = (lane & 8) != 0, b2 = (lane & 4) != 0;
    float b[8], c[4], d[2];
#pragma unroll
    for (int e = 0; e < 8; ++e) b[e] = swap32_sum(a[e], a[e + 8]);
#pragma unroll
    for (int e = 0; e < 4; ++e) c[e] = swap16_sum(b[e], b[e + 4]);
#pragma unroll
    for (int e = 0; e < 2; ++e) { const float keep = b3 ? c[e + 2] : c[e], send = b3 ? c[e] : c[e + 2]; d[e] = keep + dpp_f<0x140>(send); }
    float x; { const float keep = b2 ? d[1] : d[0], send = b2 ? d[0] : d[1]; x = keep + dpp_f<0x141>(send); }
    x += dpp_f<0x4E>(x); x += dpp_f<0xB1>(x);
    return x;
}
__device__ __forceinline__ void load_row_raw(u32x2f (&w)[4], const bf16* xrow, int lane) {
    const u32x2f* xr = (const u32x2f*)xrow + lane;
#pragma unroll
    for (int j = 0; j < 4; ++j) w[j] = xr[64 * j];
}
__device__ __forceinline__ void raw_to_f32(f32x4 (&v)[4], const u32x2f (&w)[4]) {
#pragma unroll
    for (int j = 0; j < 4; ++j) { v[j].x = __uint_as_float(w[j].x << 16); v[j].y = __uint_as_float(w[j].x & 0xffff0000u); v[j].z = __uint_as_float(w[j].y << 16); v[j].w = __uint_as_float(w[j].y & 0xffff0000u); }
}
__device__ __forceinline__ void router_phase(const bf16* X, const float* gffn, const float* MODL, const float* rw, const float* rb, bf16* H2, int* EXPID, float* EXPW, int* RANK, int* CNT,
                                             bool latent_only, LAS unsigned char* L, int tid, int wave, int lane) {
    LAS float* rwT = (LAS float*)L;
    LAS int* cnt = (LAS int*)(L + 16 * 1028 * 4);
    LAS float* LG = (LAS float*)(L + 16 * 1028 * 4 + 64);
    for (int i = tid; i < 16384; i += 512) rwT[(i & 15) * 1028 + (i >> 4)] = rw[i];
    if (tid < 16) cnt[tid] = 0;
    __syncthreads();
    const int base = blockIdx.x * 66;
    u32x2f n0[4], n1[4];
    load_row_raw(n0, X + (size_t)(base + wave) * 1024, lane); load_row_raw(n1, X + (size_t)(base + wave + 8) * 1024, lane);
    for (int rr = wave; rr < 66; rr += 16) {
        f32x4 v0[4], v1[4]; raw_to_f32(v0, n0); raw_to_f32(v1, n1);
        if (rr + 16 < 66) load_row_raw(n0, X + (size_t)(base + rr + 16) * 1024, lane);
        if (rr + 24 < 66) load_row_raw(n1, X + (size_t)(base + rr + 24) * 1024, lane);
        const int r0 = base + rr, r1 = r0 + 8, b0 = r0 / SB, s0 = r0 % SB, b1 = r1 / SB, s1 = r1 % SB;
        const bool do0 = !(latent_only && s0 < 256), do1 = (rr + 8 < 66) && !(latent_only && s1 < 256);
        if (!do0 && !do1) continue;
        if (do0) { const float* mp = MODL + (s0 < 256 ? 2 : b0) * 6144; normmod_row(v0, gffn, mp + 4096, mp + 3072, lane);
            GAS unsigned* o4 = (GAS unsigned*)((unsigned char*)H2 + (size_t)r0 * 1024) + lane;
#pragma unroll
            for (int j = 0; j < 4; ++j) o4[64 * j] = pg8::pk4_fp8(v0[j].x, v0[j].y, v0[j].z, v0[j].w); }
        if (do1) { const float* mp = MODL + (s1 < 256 ? 2 : b1) * 6144; normmod_row(v1, gffn, mp + 4096, mp + 3072, lane);
            GAS unsigned* o4 = (GAS unsigned*)((unsigned char*)H2 + (size_t)r1 * 1024) + lane;
#pragma unroll
            for (int j = 0; j < 4; ++j) o4[64 * j] = pg8::pk4_fp8(v1[j].x, v1[j].y, v1[j].z, v1[j].w); }
        float a0[16], a1[16];
#pragma unroll
        for (int e = 0; e < 16; ++e) { float x0 = 0.f, x1 = 0.f;
#pragma unroll
            for (int j = 0; j < 4; ++j) { const f32x4 w = *(const LAS f32x4*)(rwT + e * 1028 + 256 * j + 4 * lane);
                x0 += (v0[j].x * w.x + v0[j].y * w.y) + (v0[j].z * w.z + v0[j].w * w.w); x1 += (v1[j].x * w.x + v1[j].y * w.y) + (v1[j].z * w.z + v1[j].w * w.w); }
            a0[e] = x0; a1[e] = x1; }
        const float l0 = xreduce16(a0, lane), l1 = xreduce16(a1, lane);
        if ((lane & 3) == 0) { if (do0) LG[rr * 17 + (lane >> 2)] = l0; if (do1) LG[(rr + 8) * 17 + (lane >> 2)] = l1; }
    }
    __syncthreads();
    if (tid < 66) {
        const int r = base + tid, s = r % SB;
        if (!(latent_only && s < 256)) {
            float aff[16], sel[16];
#pragma unroll
            for (int e = 0; e < 16; ++e) { aff[e] = 1.f / (1.f + __expf(-LG[tid * 17 + e])); sel[e] = aff[e] + rb[e]; }
            int grp = 0; float best = -1e30f;
#pragma unroll
            for (int g = 0; g < 4; ++g) { float m1 = -1e30f, m2 = -1e30f;
#pragma unroll
                for (int k = 0; k < 4; ++k) { const float x = sel[4 * g + k]; if (x > m1) { m2 = m1; m1 = x; } else if (x > m2) m2 = x; }
                const float sc = m1 + m2; if (sc > best) { best = sc; grp = g; } }
            float s4[4], a4[4];
#pragma unroll
            for (int k = 0; k < 4; ++k) { s4[k] = grp == 0 ? sel[k] : grp == 1 ? sel[4 + k] : grp == 2 ? sel[8 + k] : sel[12 + k]; a4[k] = grp == 0 ? aff[k] : grp == 1 ? aff[4 + k] : grp == 2 ? aff[8 + k] : aff[12 + k]; }
            int i1 = 0;
#pragma unroll
            for (int k = 1; k < 4; ++k) if (s4[k] > s4[i1]) i1 = k;
            int i2 = i1 == 0 ? 1 : 0;
#pragma unroll
            for (int k = 0; k < 4; ++k) if (k != i1 && k != i2 && s4[k] > s4[i2]) i2 = k;
            const float a1 = i1 == 0 ? a4[0] : i1 == 1 ? a4[1] : i1 == 2 ? a4[2] : a4[3], a2 = i2 == 0 ? a4[0] : i2 == 1 ? a4[1] : i2 == 2 ? a4[2] : a4[3];
            const int e1 = 4 * grp + i1, e2 = 4 * grp + i2; const float inv = 1.f / (a1 + a2);
            const int r1 = __hip_atomic_fetch_add(cnt + e1, 1, __ATOMIC_RELAXED, __HIP_MEMORY_SCOPE_WORKGROUP), r2 = __hip_atomic_fetch_add(cnt + e2, 1, __ATOMIC_RELAXED, __HIP_MEMORY_SCOPE_WORKGROUP);
            EXPID[2 * r] = e1; EXPID[2 * r + 1] = e2; EXPW[2 * r] = a1 * inv; EXPW[2 * r + 1] = a2 * inv; RANK[2 * r] = r1; RANK[2 * r + 1] = r2;
        }
    }
    __syncthreads();
    if (tid < 16) CNT[blockIdx.x * 16 + tid] = cnt[tid];
    __syncthreads();
}
__device__ __forceinline__ void index_phase(const int* CNT, const int* EXPID, const float* EXPW, const int* RANK, const bf16* H2, int* TOKSLOT, float* ROWW, bf16* XS, int* META,
                                            bool latent_only, LAS unsigned char* L, int tid, int wave, int lane) {
    LAS int* part = (LAS int*)L;
    LAS int* base = part + 512;
    LAS int* pst = base + 16;
    { const int e = tid & 15, g = tid >> 4; int s = 0;
#pragma unroll
        for (int k = 0; k < 8; ++k) s += CNT[(8 * g + k) * 16 + e];
        part[g * 16 + e] = s; }
    __syncthreads();
    if (tid < 16) { const int e = tid; int tot = 0, off = 0; const int gb = blockIdx.x >> 3;
        for (int g = 0; g < 32; ++g) { const int p = part[g * 16 + e]; tot += p; if (g < gb) off += p; }
        for (int bb = gb * 8; bb < (int)blockIdx.x; ++bb) off += CNT[bb * 16 + e];
        base[e] = off; pst[e] = (tot + 255) >> 8; }
    __syncthreads();
    if (tid == 0) { int run = 0;
        for (int e = 0; e < 16; ++e) { const int nt = pst[e]; pst[e] = run * 256;
            if (blockIdx.x == 0) for (int k = 0; k < nt; ++k) META[16 + run + k] = e;
            run += nt; }
        pst[16] = run * 256; if (blockIdx.x == 0) META[0] = run; }
    __syncthreads();
    int dest = -1;
    { const int a = wave + 8 * lane, r = blockIdx.x * 66 + (a >> 1), k = a & 1;
      if (lane < 17 && a < 132 && !(latent_only && (r % SB) < 256)) { const int e = EXPID[2 * r + k]; dest = pst[e] + base[e] + RANK[2 * r + k]; TOKSLOT[2 * r + k] = dest; ROWW[dest] = EXPW[2 * r + k]; } }
    for (int i0 = 0; i0 < 20; i0 += 4) {
        v4u va[4]; int d[4];
#pragma unroll
        for (int q = 0; q < 4; ++q) { d[q] = __shfl(dest, (i0 + q) & 63); const int a = wave + 8 * (i0 + q); if (i0 + q >= 17 || a >= 132) d[q] = -1;
            if (d[q] >= 0) va[q] = *((const GAS v4u*)((const unsigned char*)H2 + (size_t)(blockIdx.x * 66 + (a >> 1)) * 1024) + lane); }
#pragma unroll
        for (int q = 0; q < 4; ++q) if (d[q] >= 0) *((GAS v4u*)((unsigned char*)XS + (size_t)d[q] * 1024) + lane) = va[q];
    }
    __syncthreads();
}

typedef const __attribute__((address_space(4))) KArgs KArgsC;
#define PROLOG \
    KArgsC* ka = ka0; asm volatile("" : "+s"(ka)); \
    unsigned char* const ws = ka->ws; \
    int tid = threadIdx.x; asm volatile("" : "+v"(tid)); \
    const int lane = tid & 63, wave = __builtin_amdgcn_readfirstlane(tid >> 6); \
    const int G = gridDim.x, bid = blockIdx.x, gw = bid * NWAVES + wave, NGW = G * NWAVES; \
    (void)lane; (void)gw; (void)NGW; (void)ws;
#define P_F32(off) ((float*)(ws + (off)))
#define P_I32(off) ((int*)(ws + (off)))
#define P_B16(off) ((bf16*)(ws + (off)))
#define P_U8(off) ((unsigned char*)(ws + (off)))
__global__ void __launch_bounds__(NWAVES * 64, 2) dit_fwd(KArgs args_by_value) {
    extern __shared__ __attribute__((aligned(16))) unsigned char lds[];
    LAS unsigned char* L = (LAS unsigned char*)lds;
    KArgsC* ka0 = (KArgsC*)__builtin_amdgcn_kernarg_segment_ptr();
    const int lo = ka0->ph_lo, hi = ka0->ph_hi;
    volatile LAS unsigned* bst = (volatile LAS unsigned*)(L + LDS_BYTES - 64);
    if (threadIdx.x < 2) bst[threadIdx.x] = 0u;
    __syncthreads();
    if (ka0->use_cg) (void)xcd_barrier_post((unsigned*)(ka0->ws + WS_CTL) + 1024, bst);
    if (TS_PHASE == 0 && blockIdx.x == 0 && threadIdx.x == 0) *(volatile LAS unsigned long long*)(L + LDS_BYTES - 32) = __builtin_amdgcn_s_memrealtime();
#define IN(k) (lo <= (k) && (k) < hi)
#ifndef REP_MASK
#define REP_MASK 0
#endif
#define PHASE(k) for (int rep_ = IN(k) ? 0 : 99; rep_ < 1 + (int)((REP_MASK >> (k)) & 1); ++rep_)
#define TS_MARK(k) do { if (TS_PHASE >= 0 && blockIdx.x == 0 && threadIdx.x == 0) { volatile LAS unsigned long long* tw_ = (volatile LAS unsigned long long*)(L + LDS_BYTES - 32); \
        if ((k) + 1 == TS_PHASE) tw_[0] = __builtin_amdgcn_s_memrealtime(); \
        if ((k) == TS_PHASE) { const unsigned long long t1_ = __builtin_amdgcn_s_memrealtime(), d_ = 4ull * (t1_ - tw_[0]); while (__builtin_amdgcn_s_memrealtime() - t1_ < d_) __builtin_amdgcn_s_sleep(8); } } } while (0)
#define SEAM(k) do { if (IN(k) && IN((k) + 1) && ka0->use_cg) { for (int sr_ = 0; sr_ < 1 + (int)((REP_MASK >> 27) & 1); ++sr_) { \
        XcdBarrier xb_; xb_.bar = (unsigned*)(ka0->ws + WS_CTL) + 1024; xb_.x = xb_xcc_id(); xb_.st = bst; xcd_barrier(xb_); } TS_MARK(k); } } while (0)
#define VCU ((G % 8 == 0) ? (bid % 8) * (G / 8) + bid / 8 : bid)

    PHASE(0) { PROLOG
        for (int r24_ = 0; r24_ < 1 + (int)((REP_MASK >> 24) & 1); ++r24_) { LAS float* scr = (LAS float*)(L + wave * 16384);
          conv_loop<0>(ka->in[I_EWIN], ka->in[I_EWOUT], ka->in[I_OWQKV], ka->in[I_OWOUT], ka->in[I_MG], ka->in[I_MU], ka->in[I_MD], ws, gw, NGW, scr, lane); }
        __syncthreads();
        for (int r25_ = 0; r25_ < 1 + (int)((REP_MASK >> 25) & 1); ++r25_) {
            const int l = bid >> 7, col0 = 48 * (bid & 127);
            LAS float* sl = (LAS float*)L;
            LAS float* red = sl + 3072;
            for (int i = tid; i < 3072; i += 512) sl[i] = silu_d(i < 2048 ? ka->in[I_C][i] : ka->in[I_CCTX][i - 2048]);
            __syncthreads();
            const int r = lane >> 4, cs = lane & 15;
            const float* aw = ka->in[I_ADAW] + ((size_t)l * 1024 + 128 * wave + r) * 6144 + col0 + 3 * cs;
            const LAS float* sp = sl + 128 * wave + r;
            float a[3][3];
#pragma unroll
            for (int v = 0; v < 3; ++v) { a[v][0] = 0.f; a[v][1] = 0.f; a[v][2] = 0.f; }
#pragma unroll 1
            for (int i0 = 0; i0 < 32; i0 += 16) { float w0[16], w1[16], w2[16];
#pragma unroll
                for (int i = 0; i < 16; ++i) { const float* p = aw + (size_t)(4 * (i0 + i)) * 6144; w0[i] = p[0]; w1[i] = p[1]; w2[i] = p[2]; }
#pragma unroll
                for (int i = 0; i < 16; ++i) {
#pragma unroll
                    for (int v = 0; v < 3; ++v) { const float sv = sp[1024 * v + 4 * (i0 + i)]; a[v][0] += sv * w0[i]; a[v][1] += sv * w1[i]; a[v][2] += sv * w2[i]; } } }
#pragma unroll
            for (int v = 0; v < 3; ++v) {
#pragma unroll
                for (int j = 0; j < 3; ++j) { float x = a[v][j]; x += __shfl_xor(x, 16); x += __shfl_xor(x, 32); a[v][j] = x; } }
            if (r == 0) {
#pragma unroll
                for (int v = 0; v < 3; ++v) { red[(wave * 3 + v) * 48 + 3 * cs] = a[v][0]; red[(wave * 3 + v) * 48 + 3 * cs + 1] = a[v][1]; red[(wave * 3 + v) * 48 + 3 * cs + 2] = a[v][2]; } }
            __syncthreads();
            if (tid < 144) { const int v = tid / 48, jj = tid % 48; float x = ka->in[I_ADAB][l * 6144 + col0 + jj];
#pragma unroll
                for (int w = 0; w < 8; ++w) x += red[(w * 3 + v) * 48 + jj];
                P_F32(WS_MOD)[(l * 3 + v) * 6144 + col0 + jj] = x; }
            __syncthreads();
        }
        if (bid == 96) {
            for (int i = tid; i < 1024; i += 512) { const float* lg = ka->in[I_LBL]; const float l0 = lg[i], l1 = lg[1024 + i], l2 = lg[2048 + i]; const float m = fmaxf(l0, fmaxf(l1, l2));
                const float e0 = expf(l0 - m), e1 = expf(l1 - m), e2 = expf(l2 - m); P_F32(WS_LB)[i] = e0 / (e0 + e1 + e2); }
            if (wave == 0) { const float* lp = ka->in[I_DLAM]; const float s0 = wave_sum(lp[lane] * lp[64 + lane]), s1 = wave_sum(lp[128 + lane] * lp[192 + lane]);
                if (lane == 0) P_F32(WS_LAM)[0] = expf(s0) - expf(s1) + 0.2f; }
        } else if (bid == 97) {
            for (int i = tid; i < 2048; i += 512) { const int pos = i >> 4, jj = i & 15; const float inv = 1.0f / powf(10000.0f, (float)(2 * jj) / 32.0f); const float ang = (float)pos * inv;
                P_F32(WS_ROPE)[2 * i] = cosf(ang); P_F32(WS_ROPE)[2 * i + 1] = sinf(ang); }
        }
    }
    SEAM(0);
    PHASE(1) { PROLOG
        for (int r = gw; r < MR; r += 2 * NGW) { const int r2 = r + NGW; const bool h2 = r2 < MR;
            const int b = r / SB, s_ = r % SB, b2 = h2 ? r2 / SB : b, s2_ = h2 ? r2 % SB : s_;
            const float* srcA = s_ < 256 ? ka->in[I_CTX] + ((size_t)b * 256 + s_) * 1024 : ka->in[I_X] + ((size_t)b * 8192 + s_ - 256) * 1024;
            const float* srcB = s2_ < 256 ? ka->in[I_CTX] + ((size_t)b2 * 256 + s2_) * 1024 : ka->in[I_X] + ((size_t)b2 * 8192 + s2_ - 256) * 1024;
            f32x4 va[4], vb[4]; load_row_f32(va, srcA, lane); load_row_f32(vb, srcB, lane);
            const float* mpA = P_F32(WS_MOD) + (s_ < 256 ? 2 : b) * 6144; const float* mpB = P_F32(WS_MOD) + (s2_ < 256 ? 2 : b2) * 6144;
            normmod_row(va, ka->in[I_NMIX], mpA + 1024, mpA, lane); store_row_bf16(va, P_B16(WS_H) + (size_t)r * 1024, lane);
            if (h2) { normmod_row(vb, ka->in[I_NMIX], mpB + 1024, mpB, lane); store_row_bf16(vb, P_B16(WS_H) + (size_t)r2 * 1024, lane); } }
    }
    SEAM(1);
    PHASE(2) { PROLOG
        pg8::Gemm g{P_B16(WS_H), P_B16(WS_WIN), MR, 4096, 1024, 0}; pg8::DenseOrder So; So.init(66, 16, G, bid, false, G == 256 ? 1 : 0);
        pg8::EpiInProj E{P_B16(WS_QH), P_B16(WS_IV), P_B16(WS_GG), P_B16(WS_DQ), P_B16(WS_DK), P_B16(WS_DV), (_Float16*)P_F32(WS_LFF), (_Float16*)P_F32(WS_LFB), P_F32(WS_LB), P_F32(WS_ROPE)};
#if (REP_MASK >> 28) & 1
        { pg8::EpiTwice<pg8::EpiInProj> E2{E}; pg8::gemm_phase<pg8::EpiTwice<pg8::EpiInProj>, pg8::DenseOrder, true, true>(L, g, So, E2); }
#else
        pg8::gemm_phase<pg8::EpiInProj, pg8::DenseOrder, true, true>(L, g, So, E);
#endif
        if (G == 256) { pg8::DenseOrder St; St.init(66, 16, G, bid, false, 2, 4); pg8::gemm_phase<pg8::EpiInProj, pg8::DenseOrder, true, true, 0x1>(L, g, St, E); }
    }
    SEAM(2);
    PHASE(3) { PROLOG hgrn_pass1(bid, G, 16 * NCHUNK, (_Float16*)P_F32(WS_LFF), (_Float16*)P_F32(WS_LFB), P_B16(WS_IV), P_U8(WS_U), P_F32(WS_TOT), L, tid, wave, lane); }
    SEAM(3);
    PHASE(4) { PROLOG if (tid < 256) hgrn_pass2(P_U8(WS_U), P_F32(WS_TOT), P_U8(WS_S), bid * 256 + tid, G * 256); }
    SEAM(4);
    PHASE(5) { PROLOG
#define CONV_L0() do { LAS float* scr_ = (LAS float*)(L + wave * 16384); conv_loop<3>(ka->in[I_EWIN], ka->in[I_EWOUT], ka->in[I_OWQKV], ka->in[I_OWOUT], ka->in[I_MG], ka->in[I_MU], ka->in[I_MD], ws, gw, NGW, scr_, lane); __syncthreads(); } while (0)
        const int cgrp_ = bid % 3;
        if (cgrp_ == 0) CONV_L0();
        for (int r4_ = 0; r4_ < 1 + (int)((REP_MASK >> 23) & 1); ++r4_) for (int u = bid; u < 8 * NCHUNK; u += G) hgrn_pass3_unit(u, P_B16(WS_QH), (_Float16*)P_F32(WS_LFF), (_Float16*)P_F32(WS_LFB), P_B16(WS_IV), P_B16(WS_GG), P_U8(WS_S), ka->in[I_ONORM], P_B16(WS_H), L, tid, wave, lane);
        typedef attn_body::bf16 abf; const int vcu_ = VCU;
        const float lam = P_F32(WS_LAM)[0]; const float* gsub = ka->in[I_SUBLN];
        if (bid >= 64 && bid < 72) {
            const int bh = bid - 64, b = bh >> 2, h = bh & 3; const size_t rb = (size_t)b * SB;
            attn_body::attn_unit128<8, 1>((const abf*)P_B16(WS_DQ) + rb * 512 + (h * 2) * 64, 512, (const abf*)P_B16(WS_DK) + rb * 512 + (h * 2) * 64, 512, (const abf*)P_B16(WS_DV) + rb * 512 + h * 128, 512,
                                          (abf*)nullptr, 0, 4, 0.f, gsub, (char*)lds);
            attn_body::attn_unit128<8, 2>((const abf*)P_B16(WS_DQ) + rb * 512 + (h * 2 + 1) * 64, 512, (const abf*)P_B16(WS_DK) + rb * 512 + (h * 2 + 1) * 64, 512, (const abf*)P_B16(WS_DV) + rb * 512 + h * 128, 512,
                                          (abf*)P_B16(WS_H) + rb * 1024 + 512 + h * 128, 1024, 4, lam, gsub, (char*)lds);
        }
        if (vcu_ < 256) {
            const int bh = vcu_ >> 5, qb = vcu_ & 31, b = bh >> 2, h = bh & 3; const size_t rb = (size_t)b * SB, rq = rb + 256 + 256 * qb;
            attn_body::attn_unit128<8, 1>((const abf*)P_B16(WS_DQ) + rq * 512 + (h * 2) * 64, 512, (const abf*)P_B16(WS_DK) + rb * 512 + (h * 2) * 64, 512, (const abf*)P_B16(WS_DV) + rb * 512 + h * 128, 512,
                                          (abf*)nullptr, 0, NCHUNK, 0.f, gsub, (char*)lds);
            if (cgrp_ == 1) { LAS float* scr_ = (LAS float*)(L + wave * 8448);
                conv_loop<3>(ka->in[I_EWIN], ka->in[I_EWOUT], ka->in[I_OWQKV], ka->in[I_OWOUT], ka->in[I_MG], ka->in[I_MU], ka->in[I_MD], ws, gw, NGW, scr_, lane); __syncthreads(); }
            attn_body::attn_unit128<8, 2>((const abf*)P_B16(WS_DQ) + rq * 512 + (h * 2 + 1) * 64, 512, (const abf*)P_B16(WS_DK) + rb * 512 + (h * 2 + 1) * 64, 512, (const abf*)P_B16(WS_DV) + rb * 512 + h * 128, 512,
                                          (abf*)P_B16(WS_H) + rq * 1024 + 512 + h * 128, 1024, NCHUNK, lam, gsub, (char*)lds);
        }
        if (cgrp_ == 2) CONV_L0();
#undef CONV_L0
    }
    SEAM(5);
    PHASE(7) { PROLOG
        pg8::Gemm g{P_B16(WS_H), P_B16(WS_WOE), MR, 1024, 1024, 0}; pg8::DenseOrder So; So.init(66, 4, G, bid, false, G == 256 ? 1 : 0);
        pg8::EpiOut0 E{ka->in[I_X], ka->in[I_CTX], P_F32(WS_MOD), P_B16(WS_X)};
        pg8::gemm_phase<pg8::EpiOut0, pg8::DenseOrder, true, true>(L, g, So, E);
        if (G == 256) { pg8::DenseOrder St; St.init(66, 4, G, bid, false, 2, 4); pg8::gemm_phase<pg8::EpiOut0, pg8::DenseOrder, true, true, 0x1>(L, g, St, E); }
    }
    SEAM(7);
#define MOE_LAYER(P, LAYER, LATENT_ONLY) \
    PHASE(P) { PROLOG router_phase(P_B16(WS_X), ka->in[I_NFFN] + (LAYER) * 1024, P_F32(WS_MOD) + (LAYER) * 3 * 6144, ka->in[I_RW], ka->in[I_RB], P_B16(WS_H), P_I32(WS_EXPID), P_F32(WS_EXPW), P_I32(WS_RANK), P_I32(WS_CNT), LATENT_ONLY, L, tid, wave, lane); } \
    SEAM(P); \
    PHASE((P) + 1) { PROLOG for (int r2_ = 0; r2_ < 1 + (int)((REP_MASK >> 21) & 1); ++r2_) index_phase(P_I32(WS_CNT), P_I32(WS_EXPID), P_F32(WS_EXPW), P_I32(WS_RANK), P_B16(WS_H), P_I32(WS_TOKSLOT), P_F32(WS_ROWW), P_B16(WS_XS), P_I32(WS_META), LATENT_ONLY, L, tid, wave, lane); \
        } \
    SEAM((P) + 1); \
    PHASE((P) + 2) { PROLOG const int ntile = __builtin_amdgcn_readfirstlane(P_I32(WS_META)[0]); \
        LAS int* te_ = (LAS int*)(L + 131072); for (int i_ = tid; i_ < ntile; i_ += 512) te_[i_] = P_I32(WS_META)[16 + i_]; __syncthreads(); \
        pg8::Gemm g{P_B16(WS_XS), (const bf16*)(ws + ((LAYER) == 0 ? WS_MOE0_13 : WS_MOE1_13)), ntile * 256, 2048, 512  , (size_t)2048 * 1024}; const int rem_ = (ntile * 8) % G; const bool split_ = rem_ > 0 && 2 * rem_ <= G; \
        pg8::MoeOrder So; So.init(ntile, 8, G, bid, te_, split_ ? 1 : 0); \
        pg8::EpiGateUp8 E{(unsigned char*)P_B16(WS_HID)}; pg8::gemm_phase<pg8::EpiGateUp8, pg8::MoeOrder, true, true, 0xF, true>(L, g, So, E); \
        if (split_) { pg8::MoeOrder St; St.init(ntile, 8, G, bid, te_, 2, 2); pg8::gemm_phase<pg8::EpiGateUp8, pg8::MoeOrder, true, true, 0x3, true>(L, g, St, E); } \
        } \
    SEAM((P) + 2); \
    PHASE((P) + 3) { PROLOG const int ntile = __builtin_amdgcn_readfirstlane(P_I32(WS_META)[0]); \
        LAS int* te_ = (LAS int*)(L + 131072); for (int i_ = tid; i_ < ntile; i_ += 512) te_[i_] = P_I32(WS_META)[16 + i_]; __syncthreads(); \
        pg8::Gemm g{P_B16(WS_HID), (const bf16*)(ws + ((LAYER) == 0 ? WS_MOE0_2 : WS_MOE1_2)), ntile * 256, 1024, 512  , (size_t)1024 * 1024}; const int rem_ = (ntile * 4) % G; const bool split_ = rem_ > 0 && 4 * rem_ <= G; \
        pg8::MoeOrder So; So.init(ntile, 4, G, bid, te_, split_ ? 1 : 0); \
        pg8::EpiDown8 E{P_B16(WS_XS), P_F32(WS_ROWW)}; pg8::gemm_phase<pg8::EpiDown8, pg8::MoeOrder, true, true, 0xF, true>(L, g, So, E); \
        if (split_) { pg8::MoeOrder St; St.init(ntile, 4, G, bid, te_, 2, 4); pg8::gemm_phase<pg8::EpiDown8, pg8::MoeOrder, true, true, 0x1, true>(L, g, St, E); } } \
    SEAM((P) + 3);
    MOE_LAYER(8, 0, false)
    PHASE(12) { PROLOG
        for (int r = gw; r < MR; r += 2 * NGW) { const int r2 = r + NGW; const bool h2 = r2 < MR; const int rb_ = h2 ? r2 : r;
            const int sa0 = P_I32(WS_TOKSLOT)[2 * r], sa1 = P_I32(WS_TOKSLOT)[2 * r + 1], sb0 = P_I32(WS_TOKSLOT)[2 * rb_], sb1 = P_I32(WS_TOKSLOT)[2 * rb_ + 1];
            const int vecA = (r % SB) < 256 ? 2 : r / SB, vecB = (rb_ % SB) < 256 ? 2 : rb_ / SB;
            f32x4 va[4], vb[4]; load_row_b16(va, P_B16(WS_X) + (size_t)r * 1024, lane); load_row_b16(vb, P_B16(WS_X) + (size_t)rb_ * 1024, lane);
            add_moe_rows(va, P_B16(WS_XS) + (size_t)sa0 * 1024, P_B16(WS_XS) + (size_t)sa1 * 1024, P_F32(WS_MOD) + vecA * 6144 + 5120, lane);
            add_moe_rows(vb, P_B16(WS_XS) + (size_t)sb0 * 1024, P_B16(WS_XS) + (size_t)sb1 * 1024, P_F32(WS_MOD) + vecB * 6144 + 5120, lane);
            { store_row_bf16(va, P_B16(WS_X) + (size_t)r * 1024, lane);
              const float* mp = P_F32(WS_MOD) + (3 + vecA) * 6144; normmod_row(va, ka->in[I_NMIX] + 1024, mp + 1024, mp, lane); store_row_bf16(va, P_B16(WS_H) + (size_t)r * 1024, lane); }
            if (h2) { store_row_bf16(vb, P_B16(WS_X) + (size_t)r2 * 1024, lane);
              const float* mp = P_F32(WS_MOD) + (3 + vecB) * 6144; normmod_row(vb, ka->in[I_NMIX] + 1024, mp + 1024, mp, lane); store_row_bf16(vb, P_B16(WS_H) + (size_t)r2 * 1024, lane); } }
    }
    SEAM(12);
    PHASE(13) { PROLOG
        pg8::Gemm g{P_B16(WS_H), P_B16(WS_WQKV), MR, 1536, 1024, 0}; pg8::DenseOrder So; So.init(66, 6, G, bid, false);
        pg8::EpiQKV1 E{P_B16(WS_Q1), P_B16(WS_K1), P_B16(WS_V1), P_F32(WS_ROPE)};
        pg8::gemm_phase<pg8::EpiQKV1, pg8::DenseOrder, true, true>(L, g, So, E);
    }
    SEAM(13);
    PHASE(14) { PROLOG
#define CONV_L1() do { __syncthreads(); LAS float* scr_ = (LAS float*)(L + wave * 16384); conv_loop<1>(ka->in[I_EWIN], ka->in[I_EWOUT], ka->in[I_OWQKV], ka->in[I_OWOUT], ka->in[I_MG], ka->in[I_MU], ka->in[I_MD], ws, gw, NGW, scr_, lane); __syncthreads(); } while (0)
#define SWA_UNITS(i0) do { typedef attn_body::bf16 abf; const int vcu_ = VCU; for (int i = (i0); i < (i0) + 2; ++i) { const int combo = vcu_ >> 5, qb = 4 * (vcu_ & 31) + i; if (combo >= 8) break; \
            const int b = combo >> 2, kvh = combo & 3; const size_t rb = (size_t)b * SB, rq = rb + 256 + 64 * qb; \
            attn_body::attn_unit<8, 1>((const abf*)P_B16(WS_Q1) + rq * 1024 + kvh * 256, 1024, (const abf*)P_B16(WS_K1) + rb * 256 + kvh * 64, 256, (const abf*)P_B16(WS_V1) + rb * 256 + kvh * 64, 256, \
                                       (abf*)P_B16(WS_H) + rq * 1024 + kvh * 256, 1024, 9, 64 * qb, ka->in[I_SINK] + 4 * kvh, (char*)lds); } } while (0)
        const int turn_ = bid % 3;
        if (turn_ == 0) CONV_L1();
        SWA_UNITS(0);
        if (turn_ == 1) CONV_L1();
        SWA_UNITS(2);
        if (turn_ == 2) CONV_L1();
#undef SWA_UNITS
#undef CONV_L1
    }
    SEAM(14);
    PHASE(15) { PROLOG
        pg8::Gemm g{P_B16(WS_H), P_B16(WS_WOO), MR, 1024, 1024, 0}; pg8::DenseOrder So; So.init(64, 4, G, bid, true);
        pg8::EpiOut1 E{P_F32(WS_MOD) + 3 * 6144, P_B16(WS_X)};
        pg8::gemm_phase<pg8::EpiOut1, pg8::DenseOrder, true, true>(L, g, So, E);
    }
    SEAM(15);
    MOE_LAYER(16, 1, true)
    PHASE(20) { PROLOG
        for (int t = gw; t < NBATCH * TLAT; t += 2 * NGW) { const int t2 = (t + NGW < NBATCH * TLAT) ? t + NGW : t; const bool h2 = t2 != t;
            const size_t rA = (size_t)(t >> 13) * SB + 256 + (t & 8191), rB = (size_t)(t2 >> 13) * SB + 256 + (t2 & 8191);
            const int sa0 = P_I32(WS_TOKSLOT)[2 * rA], sa1 = P_I32(WS_TOKSLOT)[2 * rA + 1], sb0 = P_I32(WS_TOKSLOT)[2 * rB], sb1 = P_I32(WS_TOKSLOT)[2 * rB + 1];
            f32x4 va[4], vb[4]; load_row_b16(va, P_B16(WS_X) + rA * 1024, lane); load_row_b16(vb, P_B16(WS_X) + rB * 1024, lane);
            add_moe_rows(va, P_B16(WS_XS) + (size_t)sa0 * 1024, P_B16(WS_XS) + (size_t)sa1 * 1024, P_F32(WS_MOD) + (3 + (t >> 13)) * 6144 + 5120, lane);
            add_moe_rows(vb, P_B16(WS_XS) + (size_t)sb0 * 1024, P_B16(WS_XS) + (size_t)sb1 * 1024, P_F32(WS_MOD) + (3 + (t2 >> 13)) * 6144 + 5120, lane);
            float s2a = 0.f, s2b = 0.f;
#pragma unroll
            for (int j = 0; j < 4; ++j) { s2a += (va[j].x * va[j].x + va[j].y * va[j].y) + (va[j].z * va[j].z + va[j].w * va[j].w); s2b += (vb[j].x * vb[j].x + vb[j].y * vb[j].y) + (vb[j].z * vb[j].z + vb[j].w * vb[j].w); }
            const float rsa = __builtin_amdgcn_rsqf(wave_sum(s2a) * (1.f / 1024.f) + EPS_), rsb = __builtin_amdgcn_rsqf(wave_sum(s2b) * (1.f / 1024.f) + EPS_);
            f32x4* oa = (f32x4*)(ka->out + (size_t)t * 1024) + lane; f32x4* ob = (f32x4*)(ka->out + (size_t)t2 * 1024) + lane;
#pragma unroll
            for (int j = 0; j < 4; ++j) { const f32x4 g = *((const f32x4*)ka->in[I_FNG] + 64 * j + lane); oa[64 * j] = va[j] * rsa * g; if (h2) ob[64 * j] = vb[j] * rsb * g; } }
    }
#undef IN
#undef SEAM
#undef MOE_LAYER
}

#ifndef N_LAUNCHES
#define N_LAUNCHES 1
#endif
extern "C" void kernel_launch(void* const* d_in, const int* in_sizes, int n_in, void* d_out, int out_size, void* d_ws, size_t ws_size, hipStream_t stream) {
    static int grid = 0;
    if (grid == 0) {
        if (n_in != 23 || ws_size < WS_NEED) { fprintf(stderr, "kernel_launch: expected 23 inputs and >= %zu bytes of workspace (got %d, %zu)\n", (size_t)WS_NEED, n_in, ws_size); grid = -1; return; }
        int dev = 0, cus = 0, per_cu = 0;
        hipGetDevice(&dev); hipDeviceGetAttribute(&cus, hipDeviceAttributeMultiprocessorCount, dev);
        if (hipFuncSetAttribute((const void*)dit_fwd, hipFuncAttributeMaxDynamicSharedMemorySize, LDS_BYTES) != hipSuccess) { fprintf(stderr, "kernel_launch: hipFuncSetAttribute failed\n"); grid = -1; return; }
        if (hipOccupancyMaxActiveBlocksPerMultiprocessor(&per_cu, (const void*)dit_fwd, NWAVES * 64, LDS_BYTES) != hipSuccess || per_cu < 1) { fprintf(stderr, "kernel_launch: occupancy query says %d\n", per_cu); per_cu = 1; }
        (void)hipGetLastError();
        grid = cus;
        if (grid != 256) fprintf(stderr, "kernel_launch: %d CUs (built for 256)\n", grid);
    }
    if (grid < 0) return;
    (void)hipMemsetAsync((char*)d_ws + WS_CTL, 0, CTL_ZERO_BYTES, stream);
    KArgs a{};
    for (int i = 0; i < 23; ++i) a.in[i] = (const float*)d_in[i];
    a.out = (float*)d_out; a.ws = (unsigned char*)d_ws;
#if N_LAUNCHES == 1
    a.ph_lo = 0; a.ph_hi = N_PHASES; a.use_cg = 1;
    void* kargs[] = {&a};
    hipError_t e = hipLaunchCooperativeKernel((const void*)dit_fwd, dim3(grid), dim3(NWAVES * 64), kargs, LDS_BYTES, stream);
    if (e != hipSuccess) fprintf(stderr, "kernel_launch: cooperative launch failed: %s\n", hipGetErrorString(e));
#else
    for (int p = 0; p < N_PHASES; ++p) { a.ph_lo = p; a.ph_hi = p + 1; a.use_cg = 0;
        hipLaunchKernelGGL(dit_fwd, dim3(grid), dim3(NWAVES * 64), LDS_BYTES, stream, a); }
#endif
}
```
